# Optimizing an MI355X kernel written in HIP

```python
import math
import jax
import jax.numpy as jnp
from jax import lax
import numpy as np

D_MODEL = 1024
BATCH = 32
SEQ = 2048
DEPTH = 4

GRID_W = 64
CTX_LEN = 256
N_MIXERS = 2

DA_HEADS = 8
DA_HEAD_DIM = 64
DA_V_DIM = 2 * DA_HEAD_DIM
DA_QK = DA_HEADS * 2 * DA_HEAD_DIM
DA_SCALE = DA_HEAD_DIM ** -0.5
Q_BLOCK = 128

RT_HEADS = 4
RT_QK_DIM = 256
RT_V_DIM = 512
RT_QK = RT_HEADS * RT_QK_DIM
RT_V = RT_HEADS * RT_V_DIM
RT_IN = 2 * RT_QK + 3 * RT_V
RT_SPLITS = (RT_QK, 2 * RT_QK, 2 * RT_QK + RT_V, 2 * RT_QK + 2 * RT_V)
RT_SCALE = RT_QK_DIM ** -0.5
RT_CHUNK = 128

MOE_GROUPS = 4
MOE_EXPERTS_PER_GROUP = 8
MOE_EXPERTS = MOE_GROUPS * MOE_EXPERTS_PER_GROUP
MOE_TOP_K = 2
MOE_HIDDEN = 512

ROPE_BASE = 10000.0
RMS_EPS = 1e-6

kernel_name = "hybrid_diffattn_retention_hmoe_dit"


def _rms_normalize(x):
    xf = x.astype(jnp.float32)
    return xf * lax.rsqrt(jnp.mean(xf * xf, axis=-1, keepdims=True) + RMS_EPS)


def _rms_norm(x, g):
    return (_rms_normalize(x) * g.astype(jnp.float32)).astype(x.dtype)


def _modulate(h, shift, scale):
    return h * (1.0 + scale) + shift


def _axial_rope(n_tokens, head_dim):
    rows = n_tokens // GRID_W
    t = jnp.arange(rows * GRID_W)
    row = (t // GRID_W).astype(jnp.float32)
    col = (t % GRID_W).astype(jnp.float32)
    n_freq = head_dim // 4
    inv_freq = ROPE_BASE ** (-jnp.arange(n_freq, dtype=jnp.float32) / n_freq)
    ang = jnp.concatenate([row[:, None] * inv_freq, col[:, None] * inv_freq], axis=-1)
    return jnp.cos(ang), jnp.sin(ang)


def _apply_rope(x, cos, sin):
    extra = x.ndim - 3
    c = cos.reshape(cos.shape[0], *([1] * extra), cos.shape[1])
    s = sin.reshape(sin.shape[0], *([1] * extra), sin.shape[1])
    x1, x2 = jnp.split(x.astype(jnp.float32), 2, axis=-1)
    return jnp.concatenate([x1 * c - x2 * s, x1 * s + x2 * c], axis=-1).astype(x.dtype)


def _diff_attention(h, n_ctx, w_qkv, q_g, k_g, lam, subln_g, w_o, lam_init, cos, sin, need_ctx):
    B, N, _ = h.shape
    S = N - n_ctx
    q, k, v = jnp.split(h @ w_qkv, 3, axis=-1)
    q = _rms_norm(q.reshape(B, N, DA_HEADS, 2, DA_HEAD_DIM), q_g)
    k = _rms_norm(k.reshape(B, N, DA_HEADS, 2, DA_HEAD_DIM), k_g)
    v = v.reshape(B, N, DA_HEADS, DA_V_DIM)
    q_lat = _apply_rope(q[:, n_ctx:], cos, sin)
    k = jnp.concatenate([k[:, :n_ctx], _apply_rope(k[:, n_ctx:], cos, sin)], axis=1)
    lam_f = lam.astype(jnp.float32)
    lam_full = jnp.exp(jnp.sum(lam_f[0] * lam_f[1])) - jnp.exp(jnp.sum(lam_f[2] * lam_f[3])) + lam_init

    def attend(qb, kb, vb):
        s = jnp.einsum('bqhmd,bkhmd->bhmqk', qb, kb).astype(jnp.float32) * DA_SCALE
        p = jax.nn.softmax(s, axis=-1)
        a = p[:, :, 0] - lam_full * p[:, :, 1]
        return jnp.einsum('bhqk,bkhe->bqhe', a.astype(vb.dtype), vb)

    nb = S // Q_BLOCK
    q_blocks = jnp.moveaxis(q_lat.reshape(B, nb, Q_BLOCK, DA_HEADS, 2, DA_HEAD_DIM), 1, 0)
    o_lat = lax.map(lambda qb: attend(qb, k, v), q_blocks)
    o_lat = jnp.moveaxis(o_lat, 0, 1).reshape(B, S, DA_HEADS, DA_V_DIM)
    if need_ctx:
        o_ctx = attend(q[:, :n_ctx], k[:, :n_ctx], v[:, :n_ctx])
        o = jnp.concatenate([o_ctx, o_lat], axis=1)
    else:
        o = o_lat
    o = _rms_norm(o, subln_g) * (1.0 - lam_init)
    return o.reshape(B, o.shape[1], DA_HEADS * DA_V_DIM) @ w_o


def _retention_scan(q, k, v, log_g, state0):
    B, H, n, dk = q.shape
    dv = v.shape[-1]
    nc = n // RT_CHUNK
    pos = jnp.arange(RT_CHUNK, dtype=jnp.float32)
    rel = pos[:, None] - pos[None, :]
    lg = log_g[:, None]
    decay_intra = jnp.where(rel >= 0, jnp.exp(log_g[:, None, None] * jnp.maximum(rel, 0.0)), 0.0)
    decay_q = jnp.exp(lg * (pos + 1.0))[:, :, None]
    decay_k = jnp.exp(lg * (RT_CHUNK - 1.0 - pos))[:, :, None]
    decay_chunk = jnp.exp(log_g * RT_CHUNK)[:, None, None]

    def chunks(t):
        return jnp.moveaxis(t.astype(jnp.float32).reshape(B, H, nc, RT_CHUNK, t.shape[-1]), 2, 0)

    def step(state, qkv):
        qc, kc, vc = qkv
        scores = jnp.einsum('bhqd,bhkd->bhqk', qc, kc) * decay_intra
        y = jnp.einsum('bhqk,bhke->bhqe', scores, vc) + jnp.einsum('bhqd,bhde->bhqe', qc, state) * decay_q
        state = state * decay_chunk + jnp.einsum('bhkd,bhke->bhde', kc * decay_k, vc)
        return state, y

    state, ys = lax.scan(step, state0, (chunks(q), chunks(k), chunks(v)))
    return jnp.moveaxis(ys, 0, 2).reshape(B, H, n, dv), state


def _final_state(k, v, log_g):
    n = k.shape[2]
    w = jnp.exp(log_g[:, None] * (n - 1.0 - jnp.arange(n, dtype=jnp.float32)))
    return jnp.einsum('bhnd,hn,bhne->bhde', k.astype(jnp.float32), w, v.astype(jnp.float32))


def _retention_direction(q, k, v, n_ctx, log_g, need_ctx):
    qc, kc, vc = q[:, :, :n_ctx], k[:, :, :n_ctx], v[:, :, :n_ctx]
    if need_ctx:
        zero = jnp.zeros((q.shape[0], RT_HEADS, RT_QK_DIM, RT_V_DIM), jnp.float32)
        y_ctx, s_ctx = _retention_scan(qc, kc, vc, log_g, zero)
    else:
        y_ctx, s_ctx = None, _final_state(kc, vc, log_g)
    y_lat, _ = _retention_scan(q[:, :, n_ctx:], k[:, :, n_ctx:], v[:, :, n_ctx:], log_g, s_ctx)
    return y_ctx, y_lat


def _flip_parts(t, n_ctx):
    return jnp.concatenate([jnp.flip(t[:, :, :n_ctx], axis=2), jnp.flip(t[:, :, n_ctx:], axis=2)], axis=2)


def _retention(h, n_ctx, w_in, decay, w_o, cos, sin, need_ctx):
    B, N, _ = h.shape
    q, k, v, g_f, g_b = jnp.split(h @ w_in, RT_SPLITS, axis=-1)

    def rope_lat(t):
        return jnp.concatenate([t[:, :n_ctx], _apply_rope(t[:, n_ctx:], cos, sin)], axis=1)

    q = jnp.transpose(rope_lat(q.reshape(B, N, RT_HEADS, RT_QK_DIM)), (0, 2, 1, 3))
    k = jnp.transpose(rope_lat(k.reshape(B, N, RT_HEADS, RT_QK_DIM)) * RT_SCALE, (0, 2, 1, 3))
    v = jnp.transpose(v.reshape(B, N, RT_HEADS, RT_V_DIM), (0, 2, 1, 3))
    log_g = jnp.log1p(-jnp.exp(decay.astype(jnp.float32)))
    yc_f, yl_f = _retention_direction(q, k, v, n_ctx, log_g[0], need_ctx)
    yc_b, yl_b = _retention_direction(_flip_parts(q, n_ctx), _flip_parts(k, n_ctx), _flip_parts(v, n_ctx),
                                      n_ctx, log_g[1], need_ctx)
    yl_b = jnp.flip(yl_b, axis=2)
    if need_ctx:
        y_f = jnp.concatenate([yc_f, yl_f], axis=2)
        y_b = jnp.concatenate([jnp.flip(yc_b, axis=2), yl_b], axis=2)
        gf, gb = g_f, g_b
    else:
        y_f, y_b = yl_f, yl_b
        gf, gb = g_f[:, n_ctx:], g_b[:, n_ctx:]

    def group_norm(y):
        y = jnp.transpose(y, (0, 2, 1, 3))
        return _rms_normalize(y).reshape(B, y.shape[1], RT_V)

    o = group_norm(y_f) * jax.nn.silu(gf.astype(jnp.float32)) + group_norm(y_b) * jax.nn.silu(gb.astype(jnp.float32))
    return o.astype(h.dtype) @ w_o


def _hier_moe(h, w_group, b_group, w_expert, b_expert, w_gate, w_up, w_down):
    B, N, D = h.shape
    t = h.reshape(B * N, D)
    p_group = jax.nn.softmax((t @ w_group + b_group).astype(jnp.float32), axis=-1)
    p_sel, g_idx = lax.top_k(p_group, 1)
    e_logits = (t @ w_expert + b_expert).astype(jnp.float32).reshape(B * N, MOE_GROUPS, MOE_EXPERTS_PER_GROUP)
    e_logits = jnp.einsum('tge,tg->te', e_logits, jax.nn.one_hot(g_idx[:, 0], MOE_GROUPS, dtype=jnp.float32))
    top_logit, e_idx = lax.top_k(e_logits, MOE_TOP_K)
    w_sel = jax.nn.softmax(top_logit, axis=-1) * p_sel
    expert_id = g_idx * MOE_EXPERTS_PER_GROUP + e_idx
    combine = jnp.einsum('tk,tke->te', w_sel,
                         jax.nn.one_hot(expert_id, MOE_EXPERTS, dtype=jnp.float32)).astype(h.dtype)
    y = jnp.zeros_like(t)
    for e in range(MOE_EXPERTS):
        a = jax.nn.silu(t @ w_gate[e]) * (t @ w_up[e])
        y = y + combine[:, e:e + 1] * (a @ w_down[e])
    return y.reshape(B, N, D)


def setup_inputs(seed: int = 0) -> dict:
    key = jax.random.key(seed)
    ks = jax.random.split(key, 24)
    D = D_MODEL
    n_da = (DEPTH + N_MIXERS - 1) // N_MIXERS
    n_rt = DEPTH // N_MIXERS

    def nrm(k, shape, s):
        return jax.random.normal(k, shape, jnp.float32) * s

    rt_decay = (-(5.0 + jnp.arange(RT_HEADS, dtype=jnp.float32)) * math.log(2.0)
                + nrm(ks[15], (n_rt, 2, RT_HEADS), 0.05))
    return {
        "x": nrm(ks[0], (BATCH, SEQ, D), 1.0),
        "c": nrm(ks[1], (BATCH, D), 1.0),
        "ctx": nrm(ks[2], (BATCH, CTX_LEN, D), 1.0),
        "c_ctx": nrm(ks[3], (D,), 1.0),
        "norm1_g": 1.0 + nrm(ks[4], (DEPTH, D), 0.02),
        "norm2_g": 1.0 + nrm(ks[5], (DEPTH, D), 0.02),
        "ada_w": nrm(ks[6], (DEPTH, D, 6 * D), 0.5 * D ** -0.5),
        "ada_b": nrm(ks[7], (DEPTH, 6 * D), 0.02),
        "da_w_qkv": nrm(ks[8], (n_da, D, 3 * DA_QK), D ** -0.5),
        "da_q_norm_g": 1.0 + nrm(ks[9], (n_da, DA_HEAD_DIM), 0.02),
        "da_k_norm_g": 1.0 + nrm(ks[10], (n_da, DA_HEAD_DIM), 0.02),
        "da_lambda": nrm(ks[11], (n_da, 4, DA_HEAD_DIM), 0.1),
        "da_subln_g": 1.0 + nrm(ks[12], (n_da, DA_V_DIM), 0.02),
        "da_w_o": nrm(ks[13], (n_da, DA_HEADS * DA_V_DIM, D), (DA_HEADS * DA_V_DIM) ** -0.5),
        "rt_w_in": nrm(ks[14], (n_rt, D, RT_IN), D ** -0.5),
        "rt_decay": rt_decay,
        "rt_w_o": nrm(ks[16], (n_rt, RT_V, D), RT_V ** -0.5),
        "moe_w_group": nrm(ks[17], (DEPTH, D, MOE_GROUPS), D ** -0.5),
        "moe_b_group": nrm(ks[18], (DEPTH, MOE_GROUPS), 0.01),
        "moe_w_expert": nrm(ks[19], (DEPTH, D, MOE_EXPERTS), D ** -0.5),
        "moe_b_expert": nrm(ks[20], (DEPTH, MOE_EXPERTS), 0.01),
        "moe_w_gate": nrm(ks[21], (DEPTH, MOE_EXPERTS, D, MOE_HIDDEN), D ** -0.5),
        "moe_w_up": nrm(ks[22], (DEPTH, MOE_EXPERTS, D, MOE_HIDDEN), D ** -0.5),
        "moe_w_down": nrm(ks[23], (DEPTH, MOE_EXPERTS, MOE_HIDDEN, D), MOE_HIDDEN ** -0.5),
    }


def reference(x, c, ctx, c_ctx, norm1_g, norm2_g, ada_w, ada_b, da_w_qkv, da_q_norm_g, da_k_norm_g,
              da_lambda, da_subln_g, da_w_o, rt_w_in, rt_decay, rt_w_o, moe_w_group, moe_b_group,
              moe_w_expert, moe_b_expert, moe_w_gate, moe_w_up, moe_w_down):
    S = x.shape[1]
    n_ctx = ctx.shape[1]
    cos_da, sin_da = _axial_rope(S, DA_HEAD_DIM)
    cos_rt, sin_rt = _axial_rope(S, RT_QK_DIM)
    silu_c = jax.nn.silu(c)[:, None, :]
    silu_cc = jax.nn.silu(c_ctx)[None, None, :]
    h_lat, h_ctx = x, ctx
    for i in range(DEPTH):
        need_ctx = i < DEPTH - 1
        m_lat = jnp.split(silu_c @ ada_w[i] + ada_b[i], 6, axis=-1)
        m_ctx = jnp.split(silu_cc @ ada_w[i] + ada_b[i], 6, axis=-1)

        a = jnp.concatenate([_modulate(_rms_norm(h_ctx, norm1_g[i]), m_ctx[0], m_ctx[1]),
                             _modulate(_rms_norm(h_lat, norm1_g[i]), m_lat[0], m_lat[1])], axis=1)
        j = i // N_MIXERS
        if i % N_MIXERS == 0:
            lam_init = 0.8 - 0.6 * math.exp(-0.3 * i)
            o = _diff_attention(a, n_ctx, da_w_qkv[j], da_q_norm_g[j], da_k_norm_g[j], da_lambda[j],
                                da_subln_g[j], da_w_o[j], lam_init, cos_da, sin_da, need_ctx)
        else:
            o = _retention(a, n_ctx, rt_w_in[j], rt_decay[j], rt_w_o[j], cos_rt, sin_rt, need_ctx)
        h_lat = h_lat + m_lat[2] * o[:, -S:]

        moe = (moe_w_group[i], moe_b_group[i], moe_w_expert[i], moe_b_expert[i],
               moe_w_gate[i], moe_w_up[i], moe_w_down[i])
        f_lat_in = _modulate(_rms_norm(h_lat, norm2_g[i]), m_lat[3], m_lat[4])
        if need_ctx:
            h_ctx = h_ctx + m_ctx[2] * o[:, :n_ctx]
            f_ctx_in = _modulate(_rms_norm(h_ctx, norm2_g[i]), m_ctx[3], m_ctx[4])
            f = _hier_moe(jnp.concatenate([f_ctx_in, f_lat_in], axis=1), *moe)
            h_ctx = h_ctx + m_ctx[5] * f[:, :n_ctx]
            h_lat = h_lat + m_lat[5] * f[:, n_ctx:]
        else:
            f = _hier_moe(f_lat_in, *moe)
            h_lat = h_lat + m_lat[5] * f
    return h_lat
```

```cpp
#include <hip/hip_runtime.h>
#include <cstdio>
#include <cstdint>

#define LAS __attribute__((address_space(3)))
#define DI __device__ __forceinline__
typedef unsigned short bf16_t;
typedef short bf16x8 __attribute__((ext_vector_type(8)));
typedef short s16x4 __attribute__((ext_vector_type(4)));
typedef float f32x4 __attribute__((ext_vector_type(4)));
typedef float f32x2 __attribute__((ext_vector_type(2)));
typedef float f32x16 __attribute__((ext_vector_type(16)));
typedef unsigned u32x4 __attribute__((ext_vector_type(4)));
typedef unsigned u32x2 __attribute__((ext_vector_type(2)));
typedef __bf16 bf16x2_t __attribute__((ext_vector_type(2)));

DI unsigned pk_bf16(float lo, float hi) { f32x2 v = {lo, hi}; return __builtin_bit_cast(unsigned, __builtin_convertvector(v, bf16x2_t)); }
DI float bf_lo(unsigned u) { return __uint_as_float(u << 16); }
DI float bf_hi(unsigned u) { return __uint_as_float(u & 0xffff0000u); }
DI float bf_f(bf16_t v) { return __uint_as_float(((unsigned)v) << 16); }
DI float wave_sum(float v) {
#pragma unroll
    for (int o = 32; o >= 1; o >>= 1) v += __shfl_xor(v, o);
    return v;
}
DI int launder(int x) { asm volatile("" : "+v"(x)); return x; }
DI unsigned char* launder_p(unsigned char* p) { asm volatile("" : "+s"(p)); return p; }
DI float silu_f(float x) { return x / (1.0f + __expf(-x)); }

constexpr int NB = 32, SEQ = 2048, CTXL = 256, NTOK = SEQ + CTXL, DM = 1024, DEPTH = 4;
constexpr int T = NB * NTOK;
constexpr int NTILE = T / 256;
constexpr int NEXP = 32, MOEH = 512;
constexpr int MAXROWS = 2 * T + NEXP * 256;
constexpr float RMS_EPS = 1e-6f;
constexpr float LOG2E = 1.4426950408889634f;

constexpr size_t MiB = 1ull << 20;
constexpr size_t WS_CTL = 0;
constexpr size_t WS_ADA = 1 * MiB;
constexpr size_t WS_ROPE = 5 * MiB;
constexpr size_t WS_MISC = 8 * MiB;
constexpr size_t WS_HCTX = 16 * MiB;
constexpr size_t WS_WQK = 48 * MiB;
constexpr size_t WS_WV = 56 * MiB;
constexpr size_t WS_WODA = 60 * MiB;
constexpr size_t WS_WIN = 64 * MiB;
constexpr size_t WS_WORT = 96 * MiB;
constexpr size_t WS_WGU = 104 * MiB;
constexpr size_t WS_WD = 168 * MiB;
constexpr size_t WS_ABUF = 200 * MiB;
constexpr size_t WS_OBUF = 344 * MiB;
constexpr size_t WS_PROJ = 488 * MiB;
constexpr size_t WS_END = 1064 * MiB;
constexpr size_t PJ_Q = 0, PJ_K = 144 * MiB, PJ_VT = 288 * MiB;
constexpr size_t PJ_SA = 0, PJ_ACT = 304 * MiB, PJ_Y2 = 0;
constexpr size_t RP_CDA = 0, RP_SDA = 256 * 1024, RP_CRT = 512 * 1024, RP_SRT = 512 * 1024 + 1 * MiB;
constexpr size_t MS_EID = 0, MS_WSEL = 1 * MiB, MS_ROWMAP = 2 * MiB, MS_SSQ = 3 * MiB;
constexpr int CW_BAR = 0;
constexpr int CW_CNT = 4096;
constexpr int CW_CUR = 4096 + 256;

constexpr int LDS_BYTES = 155648;
constexpr int LDS_MISC = 147456;
constexpr int LDS_TILE_E = 131072;

#define XB_TMO      128
#define XB_XCNT(j)  (256  + 64 * (j))
#define XB_XSUB(j)  (1280 + 64 * (j))
#define XB_XGEN(j)  (2304 + 64 * (j))
#define XB_TOP      3328
#define XB_TOPGEN   3392
#define XCD_BAR_WORDS 3456
#define XB_SPIN_CAP (1u << 18)

__device__ __forceinline__ unsigned xb_ld(unsigned* p)              { return __hip_atomic_load(p, __ATOMIC_RELAXED, __HIP_MEMORY_SCOPE_AGENT); }
__device__ __forceinline__ unsigned xb_add(unsigned* p, unsigned v) { return __hip_atomic_fetch_add(p, v, __ATOMIC_RELAXED, __HIP_MEMORY_SCOPE_AGENT); }
__device__ __forceinline__ unsigned xb_xcc_id() { return (unsigned)__builtin_amdgcn_s_getreg((3 << 11) | 20) & 0xFu; }
#define XB_SPIN(cond, bar) do { unsigned _sp = 0; while (cond) { __builtin_amdgcn_s_sleep(1); \
    if ((++_sp & 255u) == 0u) { if (xb_ld(&(bar)[XB_TMO])) break; if (_sp > XB_SPIN_CAP) { atomicAdd(&(bar)[XB_TMO], 1u); break; } } } } while (0)

struct XcdBarrier { unsigned* bar; unsigned x; volatile LAS unsigned* st; };

__device__ __forceinline__ XcdBarrier xcd_barrier_post(unsigned* bar, volatile LAS unsigned* st) {
    XcdBarrier b; b.bar = bar; b.x = xb_xcc_id(); b.st = st;
    if (threadIdx.x == 0) (void)xb_add(&bar[XB_XCNT(b.x)], 1u);
    return b;
}
__device__ __forceinline__ void xcd_barrier_complete(unsigned* bar, unsigned x, unsigned& nloc, unsigned& nx) {
    const unsigned G = gridDim.x * gridDim.y * gridDim.z;
    unsigned sum, cnt, mine, sp = 0u;
    for (;;) {
        sum = 0u; cnt = 0u; mine = 0u;
#pragma unroll
        for (unsigned j = 0; j < 16; ++j) { const unsigned c = xb_ld(&bar[XB_XCNT(j)]); sum += c; cnt += (c > 0u) ? 1u : 0u; mine = (j == x) ? c : mine; }
        if (sum == G) break;
        __builtin_amdgcn_s_sleep(1);
        if ((++sp & 255u) == 0u) { if (xb_ld(&bar[XB_TMO])) break; if (sp > XB_SPIN_CAP) { atomicAdd(&bar[XB_TMO], 1u); break; } }
    }
    nloc = mine > 0u ? mine : 1u; nx = cnt > 0u ? cnt : 1u;
}
__device__ __forceinline__ void xcd_barrier(const XcdBarrier& b) {
    asm volatile("s_waitcnt vmcnt(0)" ::: "memory");
    __syncthreads();
    if (threadIdx.x == 0) {
        unsigned* bar = b.bar;
        __builtin_amdgcn_s_waitcnt(0);
        unsigned nloc = b.st[0], nx = b.st[1];
        if (nloc == 0u) { xcd_barrier_complete(bar, b.x, nloc, nx); b.st[0] = nloc; b.st[1] = nx; }
        const unsigned old = xb_add(&bar[XB_XSUB(b.x)], 1u);
        const unsigned gen = old / nloc;
        if (old + 1u == (gen + 1u) * nloc) {
            __builtin_amdgcn_fence(__ATOMIC_RELEASE, "agent");
            asm volatile("s_waitcnt vmcnt(0)" ::: "memory");
            const unsigned og = xb_add(&bar[XB_TOP], 1u);
            const unsigned tg = og / nx;
            if (og + 1u == (tg + 1u) * nx) xb_add(&bar[XB_TOPGEN], 1u);
            else XB_SPIN(xb_ld(&bar[XB_TOPGEN]) == tg, bar);
            __builtin_amdgcn_fence(__ATOMIC_ACQUIRE, "agent");
            xb_add(&bar[XB_XGEN(b.x)], 1u);
            asm volatile("s_waitcnt vmcnt(0)" ::: "memory");
        } else {
            XB_SPIN(xb_ld(&bar[XB_XGEN(b.x)]) == gen, bar);
            __builtin_amdgcn_fence(__ATOMIC_ACQUIRE, "agent");
            asm volatile("s_waitcnt vmcnt(0)" ::: "memory");
        }
    }
    __syncthreads();
}

struct Args { const float* in[24]; float* out; unsigned char* ws; int ph_lo, ph_hi; };
struct Frame {
    const Args* a; float* out; unsigned char* ws; LAS unsigned char* lds;
    int tid, lane, wave, G;
};
DI const float* mod_lat(const Frame& F, int layer, int b) { return (const float*)(F.ws + WS_ADA) + ((size_t)layer * 33 + b) * 6144; }
DI const float* mod_ctx(const Frame& F, int layer) { return (const float*)(F.ws + WS_ADA) + ((size_t)layer * 33 + 32) * 6144; }

namespace pg8 {
constexpr int BM = 256, BK = 64, HALF = 128, HTB = HALF * BK * 2, STAGE_BYTES = 8 * HTB, NXCD = 8, WGM = 8;
__host__ __device__ __forceinline__ int lds_byte(int r, int c) { const int st = (r >> 4) * 2 + (c >> 5), rr = r & 15, cc = c & 31, ob = rr * 64 + cc * 2; return st * 1024 + (ob ^ (((ob >> 9) & 1) << 5)); }
__host__ __device__ __forceinline__ void stage_rc(int b, int& R, int& C) { const int st = b / 1024, sb = b % 1024, swz = sb ^ (((sb >> 9) & 1) << 5); R = (st >> 1) * 16 + swz / 64; C = (st & 1) * 32 + (swz % 64) / 2; }
__host__ __device__ __forceinline__ int perm32(int rho) { const int n = rho >> 4, i = rho & 15; return 8 * (i >> 2) + 4 * n + (i & 3); }

struct Unit { int pm, pn, kind; };

struct GridOrder {
    int nM, nN, nwg;
    DI void init(int nM_, int nN_) { nM = nM_; nN = nN_; nwg = nM * nN; }
    DI bool map(long L, int& pm, int& pn) const {
        if (L >= nwg) return false;
        int wgid = (int)L; { const int q = nwg / NXCD, r = nwg % NXCD, xcd = wgid % NXCD, off = wgid / NXCD; wgid = (xcd < r ? xcd * (q + 1) : r * (q + 1) + (xcd - r) * q) + off; }
        const int nig = WGM * nN, gid = wgid / nig, fm = gid * WGM, gsz = (nM - fm) < WGM ? (nM - fm) : WGM;
        pm = fm + ((wgid % nig) % gsz); pn = (wgid % nig) / gsz; return true;
    }
};

template <class Epi, class P, bool ALIGN_EPI>
DI void gemm_phase(LAS unsigned char* lds, const P& S, const Epi& E, const int tid) {
    const int wid = __builtin_amdgcn_readfirstlane(tid >> 6), lane = tid & 63, wr = wid >> 2, wc = wid & 3, fr = lane & 15, fq = lane >> 4;
    const int K = S.K, nt = K / BK;
    unsigned voffA[2], voffB[2];
#pragma unroll
    for (int i = 0; i < 2; ++i) { int R, C; stage_rc(tid * 16 + i * 8192, R, C); const int Rb = Epi::PERM ? ((R & ~31) + perm32(R & 31)) : R;
        voffA[i] = (unsigned)(R * K + C) * 2u; voffB[i] = (unsigned)(Rb * K + C) * 2u; }
    const size_t kstep = (size_t)(BK * 2);
    const size_t hstep = (size_t)HALF * K * 2;
    const unsigned ldsw = (unsigned)wid * 1024u;
    const int aoff = lds_byte(wr * 64 + fr, fq * 8), boff = lds_byte(wc * 32 + fr, fq * 8);
#define PG8_SA(b, h) (((b) * 2 + (h)) * HTB)
#define PG8_SB(b, h) ((4 + (b) * 2 + (h)) * HTB)
#define PG8_STAGE(bufoff, gbase, voff) do { _Pragma("unroll") for (int _i = 0; _i < 2; ++_i) \
        __builtin_amdgcn_global_load_lds((const unsigned*)((const char*)(gbase) + (voff)[_i]), (LAS unsigned*)(lds + (bufoff) + ldsw + _i * 8192), 16, 0, 0); } while (0)
#define PG8_LDA(dst, b, h) do { _Pragma("unroll") for (int m = 0; m < 4; ++m) _Pragma("unroll") for (int k = 0; k < 2; ++k) dst[m][k] = *(const LAS bf16x8*)(lds + PG8_SA(b, h) + aoff + m * 2048 + k * 1024); } while (0)
#define PG8_LDB(dst, b, h) do { _Pragma("unroll") for (int n = 0; n < 2; ++n) _Pragma("unroll") for (int k = 0; k < 2; ++k) dst[n][k] = *(const LAS bf16x8*)(lds + PG8_SB(b, h) + boff + n * 2048 + k * 1024); } while (0)
#define PG8_MMA(ai, bj, At, Bt) do { __builtin_amdgcn_s_setprio(1); _Pragma("unroll") for (int m = 0; m < 4; ++m) _Pragma("unroll") for (int n = 0; n < 2; ++n) _Pragma("unroll") for (int k = 0; k < 2; ++k) \
        acc[ai][bj][m][n] = __builtin_amdgcn_mfma_f32_16x16x32_bf16(Bt[n][k], At[m][k], acc[ai][bj][m][n], 0, 0, 0); __builtin_amdgcn_s_setprio(0); } while (0)
#define PG8_WAIT_V(n) asm volatile("s_waitcnt vmcnt(" #n ")" ::: "memory")
#define PG8_WAIT_L(n) asm volatile("s_waitcnt lgkmcnt(" #n ")" ::: "memory")
#define PG8_BAR __builtin_amdgcn_s_barrier()
#define PG8_SCHED __builtin_amdgcn_sched_barrier(0)
    Unit cur, nxt; int ui = 0;
    if (!S.next(0, cur)) return;
    f32x4 acc[2][2][4][2];
#pragma unroll
    for (int a = 0; a < 2; ++a)
#pragma unroll
        for (int b = 0; b < 2; ++b)
#pragma unroll
            for (int m = 0; m < 4; ++m)
#pragma unroll
                for (int n = 0; n < 2; ++n) acc[a][b][m][n] = (f32x4){0.f, 0.f, 0.f, 0.f};
    bf16x8 At[4][2], B0[2][2], B1[2][2];
    const char* cA = S.a_ptr(cur); const char* cB = S.b_ptr(cur);
    PG8_STAGE(PG8_SB(0, 0), cB, voffB); PG8_STAGE(PG8_SB(0, 1), cB + hstep, voffB); PG8_STAGE(PG8_SA(0, 0), cA, voffA); PG8_STAGE(PG8_SA(0, 1), cA + hstep, voffA);
    if (wr == 1) PG8_BAR;
    PG8_WAIT_V(2); PG8_BAR;
    PG8_STAGE(PG8_SB(1, 0), cB + kstep, voffB); PG8_STAGE(PG8_SA(1, 0), cA + kstep, voffA); PG8_STAGE(PG8_SB(1, 1), cB + hstep + kstep, voffB);
    PG8_WAIT_V(6); PG8_BAR;
    for (;;) {
        const bool has_next = S.next(ui + 1, nxt);
        const char* nA = has_next ? S.a_ptr(nxt) : cA; const char* nB = has_next ? S.b_ptr(nxt) : cB;
        for (int t = 0; t < nt; t += 2) {
            const bool last = (t == nt - 2);
            const char* a1 = cA + (size_t)(t + 1) * kstep;
            const char* a2 = last ? nA : cA + (size_t)(t + 2) * kstep; const char* b2 = last ? nB : cB + (size_t)(t + 2) * kstep;
            const char* a3 = a2 + kstep; const char* b3 = b2 + kstep;
            PG8_LDB(B0, 0, 0); PG8_LDB(B1, 0, 1); PG8_SCHED; PG8_LDA(At, 0, 0); PG8_STAGE(PG8_SA(1, 1), a1 + hstep, voffA);
            PG8_WAIT_V(8); PG8_WAIT_L(0); PG8_BAR; PG8_MMA(0, 0, At, B0); PG8_MMA(0, 1, At, B1); PG8_BAR; PG8_SCHED;
            PG8_LDA(At, 0, 1); PG8_STAGE(PG8_SB(0, 0), b2, voffB); PG8_STAGE(PG8_SB(0, 1), b2 + hstep, voffB); PG8_STAGE(PG8_SA(0, 0), a2, voffA);
            PG8_WAIT_V(8); PG8_WAIT_L(0); PG8_BAR; PG8_MMA(1, 0, At, B0); PG8_MMA(1, 1, At, B1); PG8_BAR; PG8_SCHED;
            PG8_LDB(B0, 1, 0); PG8_LDB(B1, 1, 1); PG8_SCHED; PG8_LDA(At, 1, 0); PG8_STAGE(PG8_SA(0, 1), a2 + hstep, voffA);
            PG8_WAIT_V(8); PG8_WAIT_L(0); PG8_BAR; PG8_MMA(0, 0, At, B0); PG8_MMA(0, 1, At, B1); PG8_BAR; PG8_SCHED;
            PG8_LDA(At, 1, 1); PG8_STAGE(PG8_SB(1, 0), b3, voffB); PG8_STAGE(PG8_SB(1, 1), b3 + hstep, voffB); PG8_STAGE(PG8_SA(1, 0), a3, voffA);
            PG8_WAIT_V(8); PG8_WAIT_L(0); PG8_BAR; PG8_MMA(1, 0, At, B0); PG8_MMA(1, 1, At, B1); PG8_BAR; PG8_SCHED;
        }
        if constexpr (ALIGN_EPI) { if (wr == 0) PG8_BAR; }
        E(acc, cur, wr, wc, fr, fq);
        if (!has_next) break;
#pragma unroll
        for (int a = 0; a < 2; ++a)
#pragma unroll
            for (int b = 0; b < 2; ++b)
#pragma unroll
                for (int m = 0; m < 4; ++m)
#pragma unroll
                    for (int n = 0; n < 2; ++n) acc[a][b][m][n] = (f32x4){0.f, 0.f, 0.f, 0.f};
        cur = nxt; cA = nA; cB = nB; ++ui;
        if constexpr (ALIGN_EPI) { if (wr == 1) PG8_BAR; }
    }
    PG8_WAIT_V(0);
    if constexpr (!ALIGN_EPI) { if (wr == 0) PG8_BAR; }
    PG8_BAR;
#undef PG8_SA
#undef PG8_SB
#undef PG8_STAGE
#undef PG8_LDA
#undef PG8_LDB
#undef PG8_MMA
#undef PG8_WAIT_V
#undef PG8_WAIT_L
#undef PG8_BAR
#undef PG8_SCHED
}
}
using pg8::Unit;

struct ProbQKV {
    int K; const char* abuf; const char* wqk; const char* wv; pg8::GridOrder go; int G, c;
    DI bool next(int i, Unit& u) const {
        const long L = (long)i * G + c;
        if (L < NTILE * 8) { u.kind = 0; return go.map(L, u.pm, u.pn); }
        const long r = L - NTILE * 8; if (r >= NTILE * 4) return false;
        u.kind = 1; u.pm = (int)(r & 3); u.pn = (int)(r >> 2); return true;
    }
    DI const char* a_ptr(const Unit& u) const { return (u.kind == 0 ? abuf : wv) + (size_t)u.pm * (256 * 1024 * 2); }
    DI const char* b_ptr(const Unit& u) const { return (u.kind == 0 ? wqk : abuf) + (size_t)u.pn * (256 * 1024 * 2); }
};
struct EpiQKV {
    static constexpr bool PERM = true;
    bf16_t* Q; bf16_t* Kb; bf16_t* VT; const float* gq; const float* gk; const float* cosT; const float* sinT;
    DI void operator()(const f32x4 (&acc)[2][2][4][2], const Unit& u, int wr, int wc, int fr, int fq) const {
        if (u.kind == 1) {
#pragma unroll
            for (int ai = 0; ai < 2; ++ai)
#pragma unroll
                for (int m = 0; m < 4; ++m) {
                    const int f = u.pm * 256 + ai * 128 + wr * 64 + m * 16 + fr;
                    bf16_t* rowp = VT + (size_t)f * T + (size_t)u.pn * 256 + wc * 32 + 8 * fq;
#pragma unroll
                    for (int bj = 0; bj < 2; ++bj) { const f32x4 v0 = acc[ai][bj][m][0], v1 = acc[ai][bj][m][1];
                        u32x4 w; w.x = pk_bf16(v0[0], v0[1]); w.y = pk_bf16(v0[2], v0[3]); w.z = pk_bf16(v1[0], v1[1]); w.w = pk_bf16(v1[2], v1[3]);
                        *(u32x4*)(rowp + bj * 128) = w; }
                }
            return;
        }
        const bool isK = u.pn >= 4; const int sub = 4 * (u.pn & 3) + wc;
        const int jj = u.pm % 9; const bool isctx = (jj == 0);
        const float* g = isK ? gk : gq; bf16_t* dst = isK ? Kb : Q;
        const float osc = isK ? 1.0f : 0.125f * LOG2E;
        f32x4 gv[2][2];
#pragma unroll
        for (int bj = 0; bj < 2; ++bj)
#pragma unroll
            for (int n = 0; n < 2; ++n) gv[bj][n] = *(const f32x4*)(g + 32 * bj + 8 * fq + 4 * n);
#pragma unroll
        for (int ai = 0; ai < 2; ++ai)
#pragma unroll
            for (int m = 0; m < 4; ++m) {
                const int rr = ai * 128 + wr * 64 + m * 16 + fr;
                float ss = 0.f;
#pragma unroll
                for (int bj = 0; bj < 2; ++bj)
#pragma unroll
                    for (int n = 0; n < 2; ++n) { const f32x4 x = acc[ai][bj][m][n]; ss += (x[0] * x[0] + x[1] * x[1]) + (x[2] * x[2] + x[3] * x[3]); }
                ss += __shfl_xor(ss, 16); ss += __shfl_xor(ss, 32);
                const float rstd = __builtin_amdgcn_rsqf(ss * (1.0f / 64.0f) + RMS_EPS) * osc;
                f32x4 x1[2], x2[2];
#pragma unroll
                for (int n = 0; n < 2; ++n) { x1[n] = acc[ai][0][m][n] * rstd * gv[0][n]; x2[n] = acc[ai][1][m][n] * rstd * gv[1][n]; }
                if (!isctx) {
                    const int t = (jj - 1) * 256 + rr;
#pragma unroll
                    for (int n = 0; n < 2; ++n) { const f32x4 c = *(const f32x4*)(cosT + t * 32 + 8 * fq + 4 * n), s = *(const f32x4*)(sinT + t * 32 + 8 * fq + 4 * n);
                        const f32x4 a = x1[n] * c - x2[n] * s, b = x1[n] * s + x2[n] * c; x1[n] = a; x2[n] = b; }
                }
                bf16_t* rowp = dst + (size_t)(u.pm * 256 + rr) * 1024 + 64 * sub + 8 * fq;
                u32x4 w; w.x = pk_bf16(x1[0][0], x1[0][1]); w.y = pk_bf16(x1[0][2], x1[0][3]); w.z = pk_bf16(x1[1][0], x1[1][1]); w.w = pk_bf16(x1[1][2], x1[1][3]);
                *(u32x4*)(rowp) = w;
                w.x = pk_bf16(x2[0][0], x2[0][1]); w.y = pk_bf16(x2[0][2], x2[0][3]); w.z = pk_bf16(x2[1][0], x2[1][1]); w.w = pk_bf16(x2[1][2], x2[1][3]);
                *(u32x4*)(rowp + 32) = w;
            }
    }
};

struct ProbDense {
    int K; const char* A0; const char* A1; int pm_split; const char* Bt; pg8::GridOrder go; int G, c;
    DI bool next(int i, Unit& u) const { u.kind = 0; return go.map((long)i * G + c, u.pm, u.pn); }
    DI const char* a_ptr(const Unit& u) const { return u.pm < pm_split ? A0 + (size_t)u.pm * 512 * K : A1 + (size_t)(u.pm - pm_split) * 512 * K; }
    DI const char* b_ptr(const Unit& u) const { return Bt + (size_t)u.pn * 512 * K; }
};

struct EpiWIN {
    static constexpr bool PERM = true;
    bf16_t* O; int pm0; const float* cosT; const float* sinT;
    DI void operator()(const f32x4 (&acc)[2][2][4][2], const Unit& u, int wr, int wc, int fr, int fq) const {
        const int gpm = pm0 + u.pm, jj = gpm % 9; const bool isctx = (jj == 0);
        const int kind = u.pn < 4 ? 0 : (u.pn < 8 ? 1 : (u.pn < 16 ? 2 : 3));
#pragma unroll
        for (int ai = 0; ai < 2; ++ai)
#pragma unroll
            for (int m = 0; m < 4; ++m) {
                const int rr = ai * 128 + wr * 64 + m * 16 + fr;
                f32x4 x1[2], x2[2];
#pragma unroll
                for (int n = 0; n < 2; ++n) { x1[n] = acc[ai][0][m][n]; x2[n] = acc[ai][1][m][n]; }
                if (kind <= 1) {
                    if (!isctx) {
                        const int t = (jj - 1) * 256 + rr;
#pragma unroll
                        for (int n = 0; n < 2; ++n) { const int fo = t * 128 + 32 * wc + 8 * fq + 4 * n; const f32x4 c = *(const f32x4*)(cosT + fo), s = *(const f32x4*)(sinT + fo);
                            const f32x4 a = x1[n] * c - x2[n] * s, b = x1[n] * s + x2[n] * c; x1[n] = a; x2[n] = b; }
                    }
                    if (kind == 1) {
#pragma unroll
                        for (int n = 0; n < 2; ++n) { x1[n] *= 0.0625f; x2[n] *= 0.0625f; }
                    }
                } else if (kind == 3) {
#pragma unroll
                    for (int n = 0; n < 2; ++n)
#pragma unroll
                        for (int j = 0; j < 4; ++j) { x1[n][j] = silu_f(x1[n][j]); x2[n][j] = silu_f(x2[n][j]); }
                }
                bf16_t* rowp = O + (size_t)(u.pm * 256 + rr) * 8192 + u.pn * 256 + wc * 32 + 8 * fq;
                u32x4 w; w.x = pk_bf16(x1[0][0], x1[0][1]); w.y = pk_bf16(x1[0][2], x1[0][3]); w.z = pk_bf16(x1[1][0], x1[1][1]); w.w = pk_bf16(x1[1][2], x1[1][3]);
                *(u32x4*)(rowp) = w;
                w.x = pk_bf16(x2[0][0], x2[0][1]); w.y = pk_bf16(x2[0][2], x2[0][3]); w.z = pk_bf16(x2[1][0], x2[1][1]); w.w = pk_bf16(x2[1][2], x2[1][3]);
                *(u32x4*)(rowp + 128) = w;
            }
    }
};

struct EpiResid {
    static constexpr bool PERM = false;
    const float* hin_ctx; const float* hin_lat; float* hout_ctx; float* hout_lat; const float* modbase;
    DI void operator()(const f32x4 (&acc)[2][2][4][2], const Unit& u, int wr, int wc, int fr, int fq) const {
        const int b = u.pm / 9, jj = u.pm % 9; const bool isctx = (jj == 0);
        const float* gate = modbase + (size_t)(isctx ? 32 : b) * 6144 + 2048;
        const int col0 = u.pn * 256 + wc * 32 + 4 * fq;
        f32x4 gv[2][2];
#pragma unroll
        for (int bj = 0; bj < 2; ++bj)
#pragma unroll
            for (int n = 0; n < 2; ++n) gv[bj][n] = *(const f32x4*)(gate + col0 + bj * 128 + n * 16);
        const size_t rbase = isctx ? (size_t)b * 256 : (size_t)b * 2048 + (size_t)(jj - 1) * 256;
        const float* hi = isctx ? hin_ctx : hin_lat; float* ho = isctx ? hout_ctx : hout_lat;
#pragma unroll
        for (int ai = 0; ai < 2; ++ai)
#pragma unroll
            for (int m = 0; m < 4; ++m) {
                const size_t off = (rbase + ai * 128 + wr * 64 + m * 16 + fr) * 1024 + col0;
#pragma unroll
                for (int bj = 0; bj < 2; ++bj)
#pragma unroll
                    for (int n = 0; n < 2; ++n) { const f32x4 hv = *(const f32x4*)(hi + off + bj * 128 + n * 16);
                        *(f32x4*)(ho + off + bj * 128 + n * 16) = hv + gv[bj][n] * acc[ai][bj][m][n]; }
            }
    }
};

struct ProbMoE {
    int K; const char* A; const char* W; const LAS int* tile_e; pg8::GridOrder go; int G, c;
    DI bool next(int i, Unit& u) const { u.kind = 0; return go.map((long)i * G + c, u.pm, u.pn); }
    DI const char* a_ptr(const Unit& u) const { return A + (size_t)u.pm * 512 * K; }
    DI const char* b_ptr(const Unit& u) const { return W + ((size_t)tile_e[u.pm] * 4 + u.pn) * 512 * K; }
};
struct EpiSwiGLU {
    static constexpr bool PERM = true;
    bf16_t* act;
    DI void operator()(const f32x4 (&acc)[2][2][4][2], const Unit& u, int wr, int wc, int fr, int fq) const {
#pragma unroll
        for (int ai = 0; ai < 2; ++ai)
#pragma unroll
            for (int m = 0; m < 4; ++m) {
                bf16_t* rowp = act + (size_t)(u.pm * 256 + ai * 128 + wr * 64 + m * 16 + fr) * 512 + u.pn * 128 + wc * 16 + 4 * fq;
#pragma unroll
                for (int bj = 0; bj < 2; ++bj) { const f32x4 g = acc[ai][bj][m][0], up = acc[ai][bj][m][1];
                    u32x2 w; w.x = pk_bf16(silu_f(g[0]) * up[0], silu_f(g[1]) * up[1]); w.y = pk_bf16(silu_f(g[2]) * up[2], silu_f(g[3]) * up[3]);
                    *(u32x2*)(rowp + bj * 64) = w; }
            }
    }
};
struct EpiDown {
    static constexpr bool PERM = true;
    bf16_t* y2; const int* rowmap; const float* wsel;
    DI void operator()(const f32x4 (&acc)[2][2][4][2], const Unit& u, int wr, int wc, int fr, int fq) const {
#pragma unroll
        for (int ai = 0; ai < 2; ++ai)
#pragma unroll
            for (int m = 0; m < 4; ++m) {
                const int row = u.pm * 256 + ai * 128 + wr * 64 + m * 16 + fr;
                const int dest = rowmap[row];
                if (dest >= 0) {
                    const float w = wsel[dest];
                    bf16_t* rowp = y2 + (size_t)dest * 1024 + u.pn * 256 + wc * 32 + 8 * fq;
#pragma unroll
                    for (int bj = 0; bj < 2; ++bj) { const f32x4 v0 = acc[ai][bj][m][0] * w, v1 = acc[ai][bj][m][1] * w;
                        u32x4 o; o.x = pk_bf16(v0[0], v0[1]); o.y = pk_bf16(v0[2], v0[3]); o.z = pk_bf16(v1[0], v1[1]); o.w = pk_bf16(v1[2], v1[3]);
                        *(u32x4*)(rowp + bj * 128) = o; }
                }
            }
    }
};

template <int MODE>
DI void transpose_tile(const Frame& F, const float* src, const float* src2, int ld, bf16_t* dst, int K, int k0, int n0) {
    LAS float* tl = (LAS float*)F.lds;
    __syncthreads();
#pragma unroll
    for (int i = 0; i < 8; ++i) {
        const int idx = F.tid + 512 * i, kk = idx >> 6, nn = idx & 63, np = n0 + nn;
        float v;
        if (MODE == 0) v = src[(size_t)(k0 + kk) * ld + np];
        else if (MODE == 1) { const int t = np >> 8, p = np & 255, bj = p >> 7, wc = (p >> 5) & 3, r = p & 31; v = src[(size_t)(k0 + kk) * ld + t * 256 + wc * 64 + bj * 32 + r]; }
        else { const int hid = 4 * (np >> 3) + (np & 3); v = ((np & 4) ? src2 : src)[(size_t)(k0 + kk) * ld + hid]; }
        tl[nn * 65 + kk] = v;
    }
    __syncthreads();
#pragma unroll
    for (int i = 0; i < 4; ++i) {
        const int idx = F.tid + 512 * i, nn = idx >> 5, kp = (idx & 31) * 2;
        *(unsigned*)(dst + (size_t)(n0 + nn) * K + k0 + kp) = pk_bf16(tl[nn * 65 + kp], tl[nn * 65 + kp + 1]);
    }
}
template <int MODE>
DI int transpose_mat(const Frame& F, const float* src, const float* src2, int ld, bf16_t* dst, int K, int Np, int u0, int u_first, int u_stride) {
    const int tk = K / 64, tn = Np / 64, ntl = tk * tn;
    int u = u_first; if (u < u0) { const int d = (u0 - u + u_stride - 1) / u_stride; u += d * u_stride; }
    for (; u < u0 + ntl; u += u_stride) { const int l = u - u0; transpose_tile<MODE>(F, src, src2, ld, dst, K, (l % tk) * 64, (l / tk) * 64); }
    return ntl;
}
DI void convert_moe_weights(const Frame& F, int layer) {
    const float* wg = F.a->in[21] + (size_t)layer * NEXP * DM * MOEH; const float* wu = F.a->in[22] + (size_t)layer * NEXP * DM * MOEH; const float* wd = F.a->in[23] + (size_t)layer * NEXP * MOEH * DM;
    bf16_t* WGU = (bf16_t*)(F.ws + WS_WGU); bf16_t* WD = (bf16_t*)(F.ws + WS_WD);
    int u0 = 0;
    for (int e = 0; e < NEXP; ++e) {
        u0 += transpose_mat<2>(F, wg + (size_t)e * DM * MOEH, wu + (size_t)e * DM * MOEH, MOEH, WGU + (size_t)e * 1024 * 1024, 1024, 1024, u0, blockIdx.x, F.G);
        u0 += transpose_mat<0>(F, wd + (size_t)e * MOEH * DM, nullptr, DM, WD + (size_t)e * 1024 * 512, 512, 1024, u0, blockIdx.x, F.G);
    }
}

DI void p0_prologue(const Frame& F) {
    {
        LAS float* red = (LAS float*)F.lds;
        for (int u = blockIdx.x; u < 4 * 96; u += F.G) {
            const int layer = u / 96, col0 = (u % 96) * 64;
            const float* W = F.a->in[6] + (size_t)layer * 1024 * 6144 + col0 + F.lane;
            const float* cp = F.lane < 32 ? F.a->in[1] + F.lane * 1024 : F.a->in[3];
            float acc[33];
#pragma unroll
            for (int r = 0; r < 33; ++r) acc[r] = 0.f;
            const int k0 = F.wave * 128;
            for (int k = k0; k < k0 + 128; ++k) {
                const float w = W[(size_t)k * 6144];
                const float sv = silu_f(cp[k]);
#pragma unroll
                for (int r = 0; r < 33; ++r) acc[r] += w * __builtin_bit_cast(float, __builtin_amdgcn_readlane(__builtin_bit_cast(int, sv), r));
            }
#pragma unroll
            for (int r = 0; r < 33; ++r) red[(F.wave * 33 + r) * 64 + F.lane] = acc[r];
            __syncthreads();
            float* outp = (float*)(F.ws + WS_ADA) + (size_t)layer * 33 * 6144;
            for (int idx = F.tid; idx < 33 * 64; idx += 512) { const int r = idx >> 6, cl = idx & 63; float v = 0.f;
#pragma unroll
                for (int w8 = 0; w8 < 8; ++w8) v += red[(w8 * 33 + r) * 64 + cl];
                outp[(size_t)r * 6144 + col0 + cl] = v + F.a->in[7][layer * 6144 + col0 + cl]; }
            __syncthreads();
        }
    }
    {
        float* cda = (float*)(F.ws + WS_ROPE + RP_CDA); float* sda = (float*)(F.ws + WS_ROPE + RP_SDA); float* crt = (float*)(F.ws + WS_ROPE + RP_CRT); float* srt = (float*)(F.ws + WS_ROPE + RP_SRT);
        const int gt = blockIdx.x * 512 + F.tid, gs = F.G * 512;
        for (int idx = gt; idx < 2048 * 32; idx += gs) { const int t = idx >> 5, f = idx & 31; const float pos = f < 16 ? (float)(t >> 6) : (float)(t & 63);
            const float inv = exp2f(-(float)(f & 15) * (13.287712379549449f / 16.0f)); const float a = pos * inv; cda[idx] = __cosf(a); sda[idx] = __sinf(a); }
        for (int idx = gt; idx < 2048 * 128; idx += gs) { const int t = idx >> 7, f = idx & 127; const float pos = f < 64 ? (float)(t >> 6) : (float)(t & 63);
            const float inv = exp2f(-(float)(f & 63) * (13.287712379549449f / 64.0f)); const float a = pos * inv; crt[idx] = __cosf(a); srt[idx] = __sinf(a); }
    }
    {
        int u0 = 0;
        for (int j = 0; j < 2; ++j) {
            const float* wqkv = F.a->in[8] + (size_t)j * 1024 * 3072;
            u0 += transpose_mat<1>(F, wqkv, nullptr, 3072, (bf16_t*)(F.ws + WS_WQK) + (size_t)j * 2048 * 1024, 1024, 2048, u0, blockIdx.x, F.G);
            u0 += transpose_mat<0>(F, wqkv + 2048, nullptr, 3072, (bf16_t*)(F.ws + WS_WV) + (size_t)j * 1024 * 1024, 1024, 1024, u0, blockIdx.x, F.G);
            u0 += transpose_mat<0>(F, F.a->in[13] + (size_t)j * 1024 * 1024, nullptr, 1024, (bf16_t*)(F.ws + WS_WODA) + (size_t)j * 1024 * 1024, 1024, 1024, u0, blockIdx.x, F.G);
            u0 += transpose_mat<0>(F, F.a->in[14] + (size_t)j * 1024 * 8192, nullptr, 8192, (bf16_t*)(F.ws + WS_WIN) + (size_t)j * 8192 * 1024, 1024, 8192, u0, blockIdx.x, F.G);
            u0 += transpose_mat<0>(F, F.a->in[16] + (size_t)j * 2048 * 1024, nullptr, 1024, (bf16_t*)(F.ws + WS_WORT) + (size_t)j * 1024 * 2048, 2048, 1024, u0, blockIdx.x, F.G);
        }
        convert_moe_weights(F, 0);
    }
}

template <bool SECOND>
DI void norm_phase(const Frame& F, int layer) {
    bf16_t* abuf = (bf16_t*)(F.ws + WS_ABUF);
    float* hctx = (float*)(F.ws + WS_HCTX);
    const bf16_t* y2 = (const bf16_t*)(F.ws + WS_PROJ + PJ_Y2);
    const float* ng = F.a->in[SECOND ? 5 : 4] + layer * 1024;
    LAS float* Wl = (LAS float*)F.lds;
    LAS int* lhist = (LAS int*)(F.lds + LDS_MISC + 1024);
    int* eid = (int*)(F.ws + WS_MISC + MS_EID); float* wsel = (float*)(F.ws + WS_MISC + MS_WSEL);
    if (SECOND) {
        const float* wgp = F.a->in[17] + (size_t)layer * 1024 * 4; const float* wep = F.a->in[19] + (size_t)layer * 1024 * 32;
        for (int idx = F.tid; idx < 1024 * 4; idx += 512) { const int k = idx >> 2, o = idx & 3; Wl[o * 1024 + k] = wgp[idx]; }
        for (int idx = F.tid; idx < 1024 * 32; idx += 512) { const int k = idx >> 5, o = idx & 31; Wl[(4 + o) * 1024 + k] = wep[idx]; }
        if (F.tid < 32) lhist[F.tid] = 0;
        __syncthreads();
    }
    const int lane = F.lane;
    for (int r = blockIdx.x * 8 + F.wave; r < T; r += F.G * 8) {
        const int b = r / NTOK, n = r % NTOK; const bool isctx = n < CTXL;
        const size_t hoff = isctx ? ((size_t)b * 256 + n) * 1024 : ((size_t)b * 2048 + (n - 256)) * 1024;
        const float* hin; float* hout = isctx ? hctx + hoff : F.out + hoff;
        if (layer == 0 && !SECOND) hin = isctx ? F.a->in[2] + hoff : F.a->in[0] + hoff; else hin = hout;
        const float* mod = isctx ? mod_ctx(F, layer) : mod_lat(F, layer, b);
        f32x4 x[4];
#pragma unroll
        for (int i = 0; i < 4; ++i) x[i] = *(const f32x4*)(hin + i * 256 + lane * 4);
        if (!SECOND && layer > 0) {
            const float* modp = isctx ? mod_ctx(F, layer - 1) : mod_lat(F, layer - 1, b);
#pragma unroll
            for (int i = 0; i < 4; ++i) {
                const u32x2 a = *(const u32x2*)(y2 + (size_t)(2 * r) * 1024 + i * 256 + lane * 4), c = *(const u32x2*)(y2 + (size_t)(2 * r + 1) * 1024 + i * 256 + lane * 4);
                const f32x4 g2 = *(const f32x4*)(modp + 5120 + i * 256 + lane * 4);
                x[i][0] += g2[0] * (bf_lo(a.x) + bf_lo(c.x)); x[i][1] += g2[1] * (bf_hi(a.x) + bf_hi(c.x)); x[i][2] += g2[2] * (bf_lo(a.y) + bf_lo(c.y)); x[i][3] += g2[3] * (bf_hi(a.y) + bf_hi(c.y));
                *(f32x4*)(hout + i * 256 + lane * 4) = x[i];
            }
        }
        float ss = 0.f;
#pragma unroll
        for (int i = 0; i < 4; ++i) ss += (x[i][0] * x[i][0] + x[i][1] * x[i][1]) + (x[i][2] * x[i][2] + x[i][3] * x[i][3]);
        ss = wave_sum(ss);
        const float rstd = 1.0f / sqrtf(ss * (1.0f / 1024.0f) + RMS_EPS);
        f32x4 v[4];
#pragma unroll
        for (int i = 0; i < 4; ++i) {
            const int c0 = i * 256 + lane * 4;
            const f32x4 g = *(const f32x4*)(ng + c0), sh = *(const f32x4*)(mod + (SECOND ? 3072 : 0) + c0), sc = *(const f32x4*)(mod + (SECOND ? 4096 : 1024) + c0);
            v[i] = (x[i] * rstd * g) * (sc + 1.0f) + sh;
            u32x2 w; w.x = pk_bf16(v[i][0], v[i][1]); w.y = pk_bf16(v[i][2], v[i][3]);
            *(u32x2*)(abuf + (size_t)r * 1024 + c0) = w;
        }
        if (SECOND) {
            float lg[36];
#pragma unroll
            for (int o = 0; o < 36; ++o) {
                float p = 0.f;
#pragma unroll
                for (int i = 0; i < 4; ++i) { const f32x4 w = *(const LAS f32x4*)(Wl + o * 1024 + i * 256 + lane * 4); p += (v[i][0] * w[0] + v[i][1] * w[1]) + (v[i][2] * w[2] + v[i][3] * w[3]); }
                lg[o] = wave_sum(p);
            }
            const float* bg = F.a->in[18] + layer * 4; const float* be = F.a->in[20] + layer * 32;
            float gl[4]; float gmax = -3.0e38f; int gi = 0;
#pragma unroll
            for (int o = 0; o < 4; ++o) { gl[o] = lg[o] + bg[o]; if (gl[o] > gmax) { gmax = gl[o]; gi = o; } }
            float gsum = 0.f;
#pragma unroll
            for (int o = 0; o < 4; ++o) gsum += __expf(gl[o] - gmax);
            const float psel = 1.0f / gsum;
            float el[8];
#pragma unroll
            for (int o = 0; o < 8; ++o) {
                float t = lg[4 + o];
#pragma unroll
                for (int g = 1; g < 4; ++g) t = (gi == g) ? lg[4 + g * 8 + o] : t;
                el[o] = t + be[gi * 8 + o];
            }
            float m1 = -3.0e38f, m2 = -3.0e38f; int i1 = 0, i2 = 0;
#pragma unroll
            for (int o = 0; o < 8; ++o) { if (el[o] > m1) { m1 = el[o]; i1 = o; } }
#pragma unroll
            for (int o = 0; o < 8; ++o) { if (o != i1 && el[o] > m2) { m2 = el[o]; i2 = o; } }
            const float e2 = __expf(m2 - m1), inv = 1.0f / (1.0f + e2);
            if (lane == 0) {
                eid[2 * r] = gi * 8 + i1; eid[2 * r + 1] = gi * 8 + i2; wsel[2 * r] = inv * psel; wsel[2 * r + 1] = e2 * inv * psel;
                __hip_atomic_fetch_add(&lhist[gi * 8 + i1], 1, __ATOMIC_RELAXED, __HIP_MEMORY_SCOPE_WORKGROUP); __hip_atomic_fetch_add(&lhist[gi * 8 + i2], 1, __ATOMIC_RELAXED, __HIP_MEMORY_SCOPE_WORKGROUP);
            }
        }
    }
    if (SECOND) {
        __syncthreads();
        if (F.tid < 32) { const int c = lhist[F.tid]; if (c) __hip_atomic_fetch_add((unsigned*)(F.ws + WS_CTL) + CW_CNT + layer * 64 + F.tid, (unsigned)c, __ATOMIC_RELAXED, __HIP_MEMORY_SCOPE_AGENT); }
    }
}

DI int build_segments(const Frame& F, int layer, LAS int* segs, LAS int* tile_e) {
    __syncthreads();
    if (F.tid == 0) {
        const unsigned* cnt = (const unsigned*)(F.ws + WS_CTL) + CW_CNT + layer * 64;
        int s = 0;
        for (int e = 0; e < 32; ++e) { segs[e] = s; const int c = (int)__hip_atomic_load(cnt + e, __ATOMIC_RELAXED, __HIP_MEMORY_SCOPE_AGENT); segs[40 + e] = c; s += (c + 255) & ~255; }
        segs[32] = s;
    }
    __syncthreads();
    const int ntl = segs[32] >> 8;
    if (tile_e) {
        for (int t = F.tid; t < ntl; t += 512) { int e = 0;
            for (int q = 1; q < 32; ++q) e = (segs[q] <= t * 256) ? q : e;
            tile_e[t] = e; }
        __syncthreads();
    }
    return ntl;
}

DI void sort_phase(const Frame& F, int layer) {
    LAS int* segs = (LAS int*)(F.lds + LDS_MISC + 2048);
    LAS int* lhist = (LAS int*)(F.lds + LDS_MISC + 1024);
    LAS int* lbase = (LAS int*)(F.lds + LDS_MISC + 1024 + 128);
    LAS int* lpos = (LAS int*)F.lds;
    build_segments(F, layer, segs, nullptr);
    const int* eid = (const int*)(F.ws + WS_MISC + MS_EID); int* rowmap = (int*)(F.ws + WS_MISC + MS_ROWMAP);
    const bf16_t* abuf = (const bf16_t*)(F.ws + WS_ABUF); bf16_t* sa = (bf16_t*)(F.ws + WS_PROJ + PJ_SA);
    const int RPB = (T + F.G - 1) / F.G;
    const int r0 = blockIdx.x * RPB, r1 = (r0 + RPB < T) ? r0 + RPB : T;
    const int na = r1 > r0 ? 2 * (r1 - r0) : 0;
    if (F.tid < 32) lhist[F.tid] = 0;
    __syncthreads();
    int ee[2], lp[2];
#pragma unroll
    for (int it = 0; it < 2; ++it) { const int a = F.tid + 512 * it; ee[it] = -1; lp[it] = 0;
        if (a < na) { ee[it] = eid[2 * r0 + a]; lp[it] = __hip_atomic_fetch_add(&lhist[ee[it]], 1, __ATOMIC_RELAXED, __HIP_MEMORY_SCOPE_WORKGROUP); } }
    __syncthreads();
    if (F.tid < 32) { const int c = lhist[F.tid];
        lbase[F.tid] = segs[F.tid] + (c ? (int)__hip_atomic_fetch_add((unsigned*)(F.ws + WS_CTL) + CW_CUR + layer * 64 + F.tid, (unsigned)c, __ATOMIC_RELAXED, __HIP_MEMORY_SCOPE_AGENT) : 0); }
    __syncthreads();
#pragma unroll
    for (int it = 0; it < 2; ++it) { const int a = F.tid + 512 * it;
        if (a < na) { const int pos = lbase[ee[it]] + lp[it]; lpos[a] = pos; rowmap[pos] = 2 * r0 + a; } }
    __syncthreads();
    for (int a = F.wave; a < na; a += 8) {
        const int pos = lpos[a]; const int r = r0 + (a >> 1);
        const u32x4 v0 = *(const u32x4*)(abuf + (size_t)r * 1024 + F.lane * 8), v1 = *(const u32x4*)(abuf + (size_t)r * 1024 + 512 + F.lane * 8);
        *(u32x4*)(sa + (size_t)pos * 1024 + F.lane * 8) = v0; *(u32x4*)(sa + (size_t)pos * 1024 + 512 + F.lane * 8) = v1;
    }
    if (blockIdx.x < 32) { const int e = blockIdx.x; for (int p = segs[e] + segs[40 + e] + F.tid; p < segs[e + 1]; p += 512) rowmap[p] = -1; }
    if (F.G < 32 && blockIdx.x == 0) { for (int e = F.G; e < 32; ++e) for (int p = segs[e] + segs[40 + e] + F.tid; p < segs[e + 1]; p += 512) rowmap[p] = -1; }
}

constexpr int AT_KROW = 272, AT_VROW = 136, AT_KB = 64 * AT_KROW, AT_VB = 128 * AT_VROW, AT_BUF = AT_KB + AT_VB;
DI void attn_phase(const Frame& F, int layer) {
    const int j = layer >> 1;
    const bf16_t* Qb = (const bf16_t*)(F.ws + WS_PROJ + PJ_Q); const bf16_t* Kb = (const bf16_t*)(F.ws + WS_PROJ + PJ_K); const bf16_t* VT = (const bf16_t*)(F.ws + WS_PROJ + PJ_VT);
    bf16_t* Ob = (bf16_t*)(F.ws + WS_OBUF);
    const int lane = F.lane, lr = lane & 31, lh = lane >> 5;
    const float* lam = F.a->in[11] + j * 256;
    float p01 = lam[lane] * lam[64 + lane], p23 = lam[128 + lane] * lam[192 + lane];
    p01 = wave_sum(p01); p23 = wave_sum(p23);
    const float lam_init = 0.8f - 0.6f * __expf(-0.3f * (float)layer);
    const float lam_full = __expf(p01) - __expf(p23) + lam_init;
    float mq = fabsf(F.a->in[9][j * 64 + lane]), mk = fabsf(F.a->in[10][j * 64 + lane]);
#pragma unroll
    for (int o = 32; o >= 1; o >>= 1) { mq = fmaxf(mq, __shfl_xor(mq, o)); mk = fmaxf(mk, __shfl_xor(mk, o)); }
    const float OFF = 8.0f * LOG2E * mq * mk;
    const float* gsub = F.a->in[12] + j * 128;
    const float osc = 1.0f - lam_init;

    for (int u = blockIdx.x; u < 2304; u += F.G) {
        int b, h, qb, nkt;
        if (u < 2048) { b = u >> 6; h = (u >> 3) & 7; qb = 1 + (u & 7); nkt = 36; } else { const int uu = u - 2048; b = uu >> 3; h = uu & 7; qb = 0; nkt = 4; }
        const size_t rowbase = (size_t)b * NTOK;
        const size_t qrow = rowbase + qb * 256 + F.wave * 32 + lr;
        __syncthreads();
        const int qlo = 2 * AT_BUF + F.wave * 8192 + lane * 16;
#pragma unroll
        for (int mp = 0; mp < 2; ++mp)
#pragma unroll
            for (int ks = 0; ks < 4; ++ks) *(LAS bf16x8*)(F.lds + qlo + (mp * 4 + ks) * 1024) = *(const bf16x8*)(Qb + qrow * 1024 + h * 128 + mp * 64 + ks * 16 + lh * 8);
        f32x16 O1[4], O2[4];
#pragma unroll
        for (int e = 0; e < 4; ++e)
#pragma unroll
            for (int i = 0; i < 16; ++i) { O1[e][i] = 0.f; O2[e][i] = 0.f; }
        float l1 = 0.f, l2 = 0.f;
        const unsigned kgo = (unsigned)((F.tid >> 4) * 1024 + (F.tid & 15) * 8), vgo = (unsigned)((F.tid >> 3) * T + (F.tid & 7) * 8);
        const int klo = (F.tid >> 4) * AT_KROW + (F.tid & 15) * 16, vlo = AT_KB + (F.tid >> 3) * AT_VROW + (F.tid & 7) * 16;
        const bf16_t* kbase = Kb + rowbase * 1024 + h * 128; const bf16_t* vbase = VT + (size_t)(h * 128) * T + rowbase;
        u32x4 sk[2], sv[2];
#pragma unroll
        for (int i = 0; i < 2; ++i) { sk[i] = *(const u32x4*)(kbase + (size_t)i * 32768 + kgo); sv[i] = *(const u32x4*)(vbase + (size_t)i * 64 * T + vgo); }
#pragma unroll
        for (int i = 0; i < 2; ++i) { *(LAS u32x4*)(F.lds + klo + i * 32 * AT_KROW) = sk[i]; *(LAS u32x2*)(F.lds + vlo + i * 64 * AT_VROW) = (u32x2){sv[i].x, sv[i].y}; *(LAS u32x2*)(F.lds + vlo + i * 64 * AT_VROW + 8) = (u32x2){sv[i].z, sv[i].w}; }
        __syncthreads();
        for (int t = 0; t < nkt; ++t) {
            const int cb = (t & 1) * AT_BUF, nb = ((t + 1) & 1) * AT_BUF;
            if (t + 1 < nkt) {
#pragma unroll
                for (int i = 0; i < 2; ++i) { sk[i] = *(const u32x4*)(kbase + (size_t)(t + 1) * 65536 + (size_t)i * 32768 + kgo); sv[i] = *(const u32x4*)(vbase + (size_t)i * 64 * T + (size_t)(t + 1) * 64 + vgo); }
            }
#pragma unroll 1
            for (int kb = 0; kb < 2; ++kb) {
                bf16x8 P[2][2];
#pragma unroll
                for (int mp = 0; mp < 2; ++mp) {
                    f32x16 S;
#pragma unroll
                    for (int i = 0; i < 16; ++i) S[i] = 0.f;
#pragma unroll
                    for (int ks = 0; ks < 4; ++ks) {
                        const bf16x8 kf = *(const LAS bf16x8*)(F.lds + cb + (kb * 32 + lr) * AT_KROW + (mp * 64 + ks * 16 + lh * 8) * 2);
                        const bf16x8 qf = *(const LAS bf16x8*)(F.lds + qlo + (mp * 4 + ks) * 1024);
                        S = __builtin_amdgcn_mfma_f32_32x32x16_bf16(kf, qf, S, 0, 0, 0);
                    }
                    float ps = 0.f;
#pragma unroll
                    for (int i = 0; i < 16; ++i) { S[i] = __builtin_amdgcn_exp2f(S[i] - OFF); ps += S[i]; }
                    if (mp == 0) l1 += ps; else l2 += ps;
#pragma unroll
                    for (int s = 0; s < 2; ++s) { u32x4 w; w.x = pk_bf16(S[8 * s], S[8 * s + 1]); w.y = pk_bf16(S[8 * s + 2], S[8 * s + 3]); w.z = pk_bf16(S[8 * s + 4], S[8 * s + 5]); w.w = pk_bf16(S[8 * s + 6], S[8 * s + 7]);
                        P[mp][s] = __builtin_bit_cast(bf16x8, w); }
                }
#pragma unroll
                for (int eb = 0; eb < 4; ++eb)
#pragma unroll
                    for (int s = 0; s < 2; ++s) {
                        const int vo = cb + AT_KB + (eb * 32 + lr) * AT_VROW + (kb * 32 + 16 * s + 4 * lh) * 2;
                        const s16x4 lo = *(const LAS s16x4*)(F.lds + vo), hi = *(const LAS s16x4*)(F.lds + vo + 16);
                        const bf16x8 vf = __builtin_shufflevector(lo, hi, 0, 1, 2, 3, 4, 5, 6, 7);
                        O1[eb] = __builtin_amdgcn_mfma_f32_32x32x16_bf16(vf, P[0][s], O1[eb], 0, 0, 0);
                        O2[eb] = __builtin_amdgcn_mfma_f32_32x32x16_bf16(vf, P[1][s], O2[eb], 0, 0, 0);
                        __builtin_amdgcn_sched_barrier(0);
                    }
            }
            if (t + 1 < nkt) {
#pragma unroll
                for (int i = 0; i < 2; ++i) { *(LAS u32x4*)(F.lds + nb + klo + i * 32 * AT_KROW) = sk[i]; *(LAS u32x2*)(F.lds + nb + vlo + i * 64 * AT_VROW) = (u32x2){sv[i].x, sv[i].y}; *(LAS u32x2*)(F.lds + nb + vlo + i * 64 * AT_VROW + 8) = (u32x2){sv[i].z, sv[i].w}; }
            }
            __syncthreads();
        }
        l1 += __shfl_xor(l1, 32); l2 += __shfl_xor(l2, 32);
        const float i1 = 1.0f / l1, i2 = lam_full / l2;
        float ss = 0.f;
#pragma unroll
        for (int e = 0; e < 4; ++e)
#pragma unroll
            for (int i = 0; i < 16; ++i) { const float o = O1[e][i] * i1 - O2[e][i] * i2; O1[e][i] = o; ss += o * o; }
        ss += __shfl_xor(ss, 32);
        const float rstd = __builtin_amdgcn_rsqf(ss * (1.0f / 128.0f) + RMS_EPS) * osc;
        bf16_t* orow = Ob + qrow * 1024 + h * 128;
#pragma unroll
        for (int e = 0; e < 4; ++e)
#pragma unroll
            for (int g4 = 0; g4 < 4; ++g4) {
                const int e0 = e * 32 + 8 * g4 + 4 * lh;
                const f32x4 gs = *(const f32x4*)(gsub + e0);
                u32x2 w; w.x = pk_bf16(O1[e][4 * g4] * rstd * gs[0], O1[e][4 * g4 + 1] * rstd * gs[1]); w.y = pk_bf16(O1[e][4 * g4 + 2] * rstd * gs[2], O1[e][4 * g4 + 3] * rstd * gs[3]);
                *(u32x2*)(orow + e0) = w;
            }
    }
    __syncthreads();
}

DI void scan_phase(const Frame& F, int layer, int hf) {
    const int j = layer >> 1;
    bf16_t* PJ = (bf16_t*)(F.ws + WS_PROJ);
    float* ssqb = (float*)(F.ws + WS_MISC + MS_SSQ);
    LAS float* qk = (LAS float*)F.lds;
    LAS float* yb = (LAS float*)(F.lds + 65536);
    LAS float* red = (LAS float*)(F.lds + 131072);
    const int el = F.tid & 255, dh = F.tid >> 8;
    for (int u = blockIdx.x; u < 256; u += F.G) {
        const int bl = u >> 4, h = (u >> 2) & 3, dir = (u >> 1) & 1, eh = u & 1;
        const float gamma = 1.0f - __expf(F.a->in[15][j * 8 + dir * 4 + h]);
        const size_t rb = (size_t)bl * NTOK;
        const int vcol = 2048 + h * 512 + eh * 256 + el, gcol = 4096 + dir * 2048 + h * 512 + eh * 256 + el;
        float s[128];
#pragma unroll
        for (int d = 0; d < 128; ++d) s[d] = 0.f;
        for (int c = 0; c < 72; ++c) {
            __syncthreads();
            {
                const int i = F.tid >> 4, part = F.tid & 15, p = c * 32 + i;
                const int n = dir == 0 ? p : (p < 256 ? 255 - p : 2559 - p);
                const bf16_t* src = PJ + (rb + n) * 8192 + (part < 8 ? h * 256 + part * 32 : 1024 + h * 256 + (part - 8) * 32);
#pragma unroll
                for (int q4 = 0; q4 < 4; ++q4) { const u32x4 w = *(const u32x4*)(src + q4 * 8);
                    LAS float* dp = qk + i * 512 + part * 32 + q4 * 8;
                    *(LAS f32x4*)(dp) = (f32x4){bf_lo(w.x), bf_hi(w.x), bf_lo(w.y), bf_hi(w.y)}; *(LAS f32x4*)(dp + 4) = (f32x4){bf_lo(w.z), bf_hi(w.z), bf_lo(w.w), bf_hi(w.w)}; }
            }
            __syncthreads();
            for (int i = 0; i < 32; ++i) {
                const int p = c * 32 + i; const int n = dir == 0 ? p : (p < 256 ? 255 - p : 2559 - p);
                const float v = bf_f(PJ[(rb + n) * 8192 + vcol]);
                float y = 0.f;
                const LAS float* qp = qk + i * 512 + dh * 128; const LAS float* kp = qp + 256;
#pragma unroll
                for (int d4 = 0; d4 < 32; ++d4) { const f32x4 k4 = *(const LAS f32x4*)(kp + 4 * d4), q4 = *(const LAS f32x4*)(qp + 4 * d4);
#pragma unroll
                    for (int jj = 0; jj < 4; ++jj) { s[4 * d4 + jj] = gamma * s[4 * d4 + jj] + k4[jj] * v; y += q4[jj] * s[4 * d4 + jj]; } }
                yb[(i * 2 + dh) * 256 + el] = y;
            }
            __syncthreads();
            for (int ii = 0; ii < 16; ++ii) {
                const int i = dh * 16 + ii, p = c * 32 + i; const int n = dir == 0 ? p : (p < 256 ? 255 - p : 2559 - p);
                const float y = yb[(i * 2) * 256 + el] + yb[(i * 2 + 1) * 256 + el];
                bf16_t* gp = PJ + (rb + n) * 8192 + gcol;
                const float z = y * bf_f(*gp);
                *gp = (bf16_t)(pk_bf16(z, 0.f) & 0xffffu);
                const float q = wave_sum(y * y);
                if (F.lane == 0) red[i * 8 + (F.wave & 3)] = q;
            }
            __syncthreads();
            if (F.tid < 32) { const int i = F.tid, p = c * 32 + i; const int n = dir == 0 ? p : (p < 256 ? 255 - p : 2559 - p);
                ssqb[(((size_t)eh * 2 + dir) * 36864 + rb + n) * 4 + h] = (red[i * 8] + red[i * 8 + 1]) + (red[i * 8 + 2] + red[i * 8 + 3]); }
        }
    }
    __syncthreads();
}

DI void comb_phase(const Frame& F, int hf) {
    const bf16_t* PJ = (const bf16_t*)(F.ws + WS_PROJ);
    const float* ssqb = (const float*)(F.ws + WS_MISC + MS_SSQ);
    bf16_t* O = (bf16_t*)(F.ws + (hf == 0 ? WS_OBUF : WS_ABUF));
    for (int r = blockIdx.x * 8 + F.wave; r < 36864; r += F.G * 8) {
#pragma unroll
        for (int i = 0; i < 4; ++i) {
            const float sf = ssqb[((size_t)(0 * 2 + 0) * 36864 + r) * 4 + i] + ssqb[((size_t)(1 * 2 + 0) * 36864 + r) * 4 + i];
            const float sb = ssqb[((size_t)(0 * 2 + 1) * 36864 + r) * 4 + i] + ssqb[((size_t)(1 * 2 + 1) * 36864 + r) * 4 + i];
            const float rf = 1.0f / sqrtf(sf * (1.0f / 512.0f) + RMS_EPS), rb = 1.0f / sqrtf(sb * (1.0f / 512.0f) + RMS_EPS);
            const int c = i * 512 + F.lane * 8;
            const u32x4 zf = *(const u32x4*)(PJ + (size_t)r * 8192 + 4096 + c), zb = *(const u32x4*)(PJ + (size_t)r * 8192 + 6144 + c);
            u32x4 w;
            w.x = pk_bf16(rf * bf_lo(zf.x) + rb * bf_lo(zb.x), rf * bf_hi(zf.x) + rb * bf_hi(zb.x));
            w.y = pk_bf16(rf * bf_lo(zf.y) + rb * bf_lo(zb.y), rf * bf_hi(zf.y) + rb * bf_hi(zb.y));
            w.z = pk_bf16(rf * bf_lo(zf.z) + rb * bf_lo(zb.z), rf * bf_hi(zf.z) + rb * bf_hi(zb.z));
            w.w = pk_bf16(rf * bf_lo(zf.w) + rb * bf_lo(zb.w), rf * bf_hi(zf.w) + rb * bf_hi(zb.w));
            *(u32x4*)(O + (size_t)r * 2048 + c) = w;
        }
    }
}

DI void final_phase(const Frame& F) {
    const bf16_t* y2 = (const bf16_t*)(F.ws + WS_PROJ + PJ_Y2);
    for (int r = blockIdx.x * 8 + F.wave; r < T; r += F.G * 8) {
        const int b = r / NTOK, n = r % NTOK; if (n < CTXL) continue;
        float* hp = F.out + ((size_t)b * 2048 + (n - 256)) * 1024; const float* modp = mod_lat(F, 3, b);
#pragma unroll
        for (int i = 0; i < 4; ++i) {
            f32x4 x = *(const f32x4*)(hp + i * 256 + F.lane * 4);
            const u32x2 a = *(const u32x2*)(y2 + (size_t)(2 * r) * 1024 + i * 256 + F.lane * 4), c = *(const u32x2*)(y2 + (size_t)(2 * r + 1) * 1024 + i * 256 + F.lane * 4);
            const f32x4 g2 = *(const f32x4*)(modp + 5120 + i * 256 + F.lane * 4);
            x[0] += g2[0] * (bf_lo(a.x) + bf_lo(c.x)); x[1] += g2[1] * (bf_hi(a.x) + bf_hi(c.x)); x[2] += g2[2] * (bf_lo(a.y) + bf_lo(c.y)); x[3] += g2[3] * (bf_hi(a.y) + bf_hi(c.y));
            *(f32x4*)(hp + i * 256 + F.lane * 4) = x;
        }
    }
}

constexpr int NPHASE = 50;
__global__ void __launch_bounds__(512, 2) fwd_kernel(Args args) {
    extern __shared__ __attribute__((aligned(16))) unsigned char lds_raw[];
    Frame F;
    F.a = &args;
    F.out = args.out; F.ws = args.ws; F.lds = (LAS unsigned char*)lds_raw;
    F.tid = threadIdx.x; F.lane = F.tid & 63; F.wave = __builtin_amdgcn_readfirstlane(F.tid >> 6); F.G = gridDim.x;
    const int lo = args.ph_lo, hi = args.ph_hi;
    volatile LAS unsigned* bst = (volatile LAS unsigned*)(F.lds + LDS_MISC);
    if (F.tid < 4) bst[F.tid] = 0u;
    __syncthreads();
    XcdBarrier bar; bar.bar = (unsigned*)(F.ws + WS_CTL) + CW_BAR; bar.x = 0; bar.st = bst;
    if (hi - lo > 1) bar = xcd_barrier_post((unsigned*)(F.ws + WS_CTL) + CW_BAR, bst);
#ifndef PH_MASK
#define PH_MASK 0xFFFFFFFFu
#endif
#define PHASE(site, p, ...) do { if (((PH_MASK >> (site)) & 1u) && lo <= (p) && (p) < hi) { F.ws = launder_p(args.ws); F.tid = launder((int)threadIdx.x); F.lane = F.tid & 63; F.wave = __builtin_amdgcn_readfirstlane(F.tid >> 6); __VA_ARGS__; if ((p) + 1 < hi) xcd_barrier(bar); } } while (0)

    PHASE(0, 0, p0_prologue(F));
    for (int layer = 0; layer < DEPTH; ++layer) {
        const int pb = 1 + 12 * layer, j = layer >> 1; const bool isRT = layer & 1;
        PHASE(1, pb + 0, { norm_phase<false>(F, layer); if (layer > 0) convert_moe_weights(F, layer); });
        if (!isRT) {
            PHASE(2, pb + 1, {
                ProbQKV S; S.K = 1024; S.abuf = (const char*)(F.ws + WS_ABUF); S.wqk = (const char*)(F.ws + WS_WQK) + (size_t)j * 2048 * 1024 * 2; S.wv = (const char*)(F.ws + WS_WV) + (size_t)j * 1024 * 1024 * 2;
                S.go.init(NTILE, 8); S.G = F.G; S.c = blockIdx.x;
                EpiQKV E{(bf16_t*)(F.ws + WS_PROJ + PJ_Q), (bf16_t*)(F.ws + WS_PROJ + PJ_K), (bf16_t*)(F.ws + WS_PROJ + PJ_VT), F.a->in[9] + j * 64, F.a->in[10] + j * 64,
                         (const float*)(F.ws + WS_ROPE + RP_CDA), (const float*)(F.ws + WS_ROPE + RP_SDA)};
                pg8::gemm_phase<EpiQKV, ProbQKV, true>(F.lds, S, E, F.tid);
            });
            PHASE(3, pb + 2, attn_phase(F, layer));
        } else {
            for (int hf = 0; hf < 2; ++hf) {
                PHASE(4, pb + 1 + 3 * hf, {
                    ProbDense S; S.K = 1024; S.A0 = (const char*)(F.ws + WS_ABUF) + (size_t)hf * 144 * 256 * 1024 * 2; S.A1 = S.A0; S.pm_split = 1 << 30; S.Bt = (const char*)(F.ws + WS_WIN) + (size_t)j * 8192 * 1024 * 2;
                    S.go.init(144, 32); S.G = F.G; S.c = blockIdx.x;
                    EpiWIN E{(bf16_t*)(F.ws + WS_PROJ), hf * 144, (const float*)(F.ws + WS_ROPE + RP_CRT), (const float*)(F.ws + WS_ROPE + RP_SRT)};
                    pg8::gemm_phase<EpiWIN, ProbDense, true>(F.lds, S, E, F.tid);
                });
                PHASE(5, pb + 2 + 3 * hf, scan_phase(F, layer, hf));
                PHASE(6, pb + 3 + 3 * hf, comb_phase(F, hf));
            }
        }
        PHASE(7, pb + 7, {
            ProbDense S; S.G = F.G; S.c = blockIdx.x; S.go.init(NTILE, 4);
            if (!isRT) { S.K = 1024; S.A0 = (const char*)(F.ws + WS_OBUF); S.A1 = S.A0; S.pm_split = 1 << 30; S.Bt = (const char*)(F.ws + WS_WODA) + (size_t)j * 1024 * 1024 * 2; }
            else { S.K = 2048; S.A0 = (const char*)(F.ws + WS_OBUF); S.A1 = (const char*)(F.ws + WS_ABUF); S.pm_split = 144; S.Bt = (const char*)(F.ws + WS_WORT) + (size_t)j * 1024 * 2048 * 2; }
            float* hctx = (float*)(F.ws + WS_HCTX);
            EpiResid E{layer == 0 ? F.a->in[2] : hctx, layer == 0 ? F.a->in[0] : F.out, hctx, F.out, (const float*)(F.ws + WS_ADA) + (size_t)layer * 33 * 6144};
            pg8::gemm_phase<EpiResid, ProbDense, true>(F.lds, S, E, F.tid);
        });
        PHASE(8, pb + 8, norm_phase<true>(F, layer));
        PHASE(9, pb + 9, sort_phase(F, layer));
        PHASE(10, pb + 10, {
            LAS int* segs = (LAS int*)(F.lds + LDS_MISC + 2048); LAS int* tile_e = (LAS int*)(F.lds + LDS_TILE_E);
            const int ntl = build_segments(F, layer, segs, tile_e);
            ProbMoE S; S.K = 1024; S.A = (const char*)(F.ws + WS_PROJ + PJ_SA); S.W = (const char*)(F.ws + WS_WGU); S.tile_e = tile_e; S.go.init(ntl, 4); S.G = F.G; S.c = blockIdx.x;
            EpiSwiGLU E{(bf16_t*)(F.ws + WS_PROJ + PJ_ACT)};
            pg8::gemm_phase<EpiSwiGLU, ProbMoE, true>(F.lds, S, E, F.tid);
        });
        PHASE(11, pb + 11, {
            LAS int* segs = (LAS int*)(F.lds + LDS_MISC + 2048); LAS int* tile_e = (LAS int*)(F.lds + LDS_TILE_E);
            const int ntl = build_segments(F, layer, segs, tile_e);
            ProbMoE S; S.K = 512; S.A = (const char*)(F.ws + WS_PROJ + PJ_ACT); S.W = (const char*)(F.ws + WS_WD); S.tile_e = tile_e; S.go.init(ntl, 4); S.G = F.G; S.c = blockIdx.x;
            EpiDown E{(bf16_t*)(F.ws + WS_PROJ + PJ_Y2), (const int*)(F.ws + WS_MISC + MS_ROWMAP), (const float*)(F.ws + WS_MISC + MS_WSEL)};
            pg8::gemm_phase<EpiDown, ProbMoE, true>(F.lds, S, E, F.tid);
        });
    }
    PHASE(12, 49, final_phase(F));
#undef PHASE
}

static bool phase_exists(int p) {
    if (p == 0 || p == 49) return true;
    const int layer = (p - 1) / 12, slot = (p - 1) % 12; const bool isRT = layer & 1;
    if (!isRT && slot >= 3 && slot <= 6) return false;
    return true;
}
extern "C" void kernel_launch(void* const* d_in, const int* in_sizes, int n_in, void* d_out, int out_size, void* d_ws, size_t ws_size, hipStream_t stream) {
    static int grid = 0;
    if (grid == 0) {
        if (n_in != 24 || ws_size < WS_END) { fprintf(stderr, "kernel_launch: need 24 inputs and >= %zu bytes of workspace (got %d, %zu)\n", (size_t)WS_END, n_in, ws_size); grid = -1; return; }
        int dev = 0, cus = 0, per_cu = 0;
        if (hipGetDevice(&dev) != hipSuccess || hipDeviceGetAttribute(&cus, hipDeviceAttributeMultiprocessorCount, dev) != hipSuccess) { grid = -1; return; }
        if (hipFuncSetAttribute((const void*)fwd_kernel, hipFuncAttributeMaxDynamicSharedMemorySize, LDS_BYTES) != hipSuccess) { fprintf(stderr, "kernel_launch: hipFuncSetAttribute failed\n"); grid = -1; return; }
        if (hipOccupancyMaxActiveBlocksPerMultiprocessor(&per_cu, (const void*)fwd_kernel, 512, LDS_BYTES) != hipSuccess || per_cu < 1) fprintf(stderr, "kernel_launch: occupancy query reports %d\n", per_cu);
        (void)hipGetLastError();
        grid = cus;
    }
    if (grid < 0) return;
    (void)hipMemsetAsync((char*)d_ws + WS_CTL, 0, 1 * MiB, stream);
    Args a{};
    for (int i = 0; i < 24; ++i) a.in[i] = (const float*)d_in[i];
    a.out = (float*)d_out; a.ws = (unsigned char*)d_ws;
#ifdef MULTI_LAUNCH
    for (int p = 0; p < NPHASE; ++p) { if (!phase_exists(p)) continue; a.ph_lo = p; a.ph_hi = p + 1; hipLaunchKernelGGL(fwd_kernel, dim3(grid), dim3(512), LDS_BYTES, stream, a); }
#else
    a.ph_lo = 0; a.ph_hi = NPHASE; hipLaunchKernelGGL(fwd_kernel, dim3(grid), dim3(512), LDS_BYTES, stream, a);
#endif
}
```

```cpp
#include <hip/hip_runtime.h>
#include <cstdio>
#include <cstdint>

#define LAS __attribute__((address_space(3)))
#define DI __device__ __forceinline__
typedef unsigned short bf16_t;
typedef short bf16x8 __attribute__((ext_vector_type(8)));
typedef short s16x4 __attribute__((ext_vector_type(4)));
typedef float f32x4 __attribute__((ext_vector_type(4)));
typedef float f32x2 __attribute__((ext_vector_type(2)));
typedef float f32x16 __attribute__((ext_vector_type(16)));
typedef unsigned u32x4 __attribute__((ext_vector_type(4)));
typedef unsigned u32x2 __attribute__((ext_vector_type(2)));
typedef __bf16 bf16x2_t __attribute__((ext_vector_type(2)));

DI unsigned pk_bf16(float lo, float hi) { f32x2 v = {lo, hi}; return __builtin_bit_cast(unsigned, __builtin_convertvector(v, bf16x2_t)); }
DI float bf_lo(unsigned u) { return __uint_as_float(u << 16); }
DI float bf_hi(unsigned u) { return __uint_as_float(u & 0xffff0000u); }
DI float bf_f(bf16_t v) { return __uint_as_float(((unsigned)v) << 16); }
DI unsigned char* launder_p(unsigned char* p) { asm volatile("" : "+s"(p)); return p; }
DI float shx(float v, int o, int lane) { return __builtin_bit_cast(float, __builtin_amdgcn_ds_bpermute((lane ^ o) << 2, __builtin_bit_cast(int, v))); }
DI float wave_sum(float v, int lane) {
#pragma unroll
    for (int o = 32; o >= 1; o >>= 1) v += shx(v, o, lane);
    return v;
}
DI int lane_id_asm() { int x; asm volatile("v_mbcnt_lo_u32_b32 %0, -1, 0\n\tv_mbcnt_hi_u32_b32 %0, -1, %0" : "=v"(x)); return x; }
DI int launder(int x) { asm volatile("" : "+v"(x)); return x; }
DI float silu_f(float x) { return x / (1.0f + __expf(-x)); }

constexpr int NB = 32, SEQ = 2048, CTXL = 256, NTOK = SEQ + CTXL, DM = 1024, DEPTH = 4;
constexpr int T = NB * NTOK;
constexpr int NTILE = T / 256;
constexpr int NEXP = 32, MOEH = 512;
constexpr int MAXROWS = 2 * T + NEXP * 256;
constexpr float RMS_EPS = 1e-6f;
constexpr float LOG2E = 1.4426950408889634f;

constexpr size_t MiB = 1ull << 20;
constexpr size_t WS_CTL = 0;
constexpr size_t WS_ADA = 1 * MiB;
constexpr size_t WS_ROPE = 5 * MiB;
constexpr size_t WS_MISC = 8 * MiB;
constexpr size_t WS_HCTX = 16 * MiB;
constexpr size_t WS_WQK = 48 * MiB;
constexpr size_t WS_WV = 56 * MiB;
constexpr size_t WS_WODA = 60 * MiB;
constexpr size_t WS_WIN = 64 * MiB;
constexpr size_t WS_WORT = 96 * MiB;
constexpr size_t WS_WGU = 104 * MiB;
constexpr size_t WS_WD = 168 * MiB;
constexpr size_t WS_ABUF = 200 * MiB;
constexpr size_t WS_OBUF = 344 * MiB;
constexpr size_t WS_PROJ = 488 * MiB;
constexpr size_t WS_END = 1064 * MiB;
constexpr size_t PJ_Q = 0, PJ_K = 144 * MiB, PJ_VT = 288 * MiB;
constexpr size_t PJ_SA = 0, PJ_ACT = 304 * MiB, PJ_Y2 = 0;
constexpr size_t PJ_RQ = 0, PJ_RG = 72 * MiB, PJ_RKT = 360 * MiB, PJ_RVT = 432 * MiB;
constexpr int HROWS = 36864;
constexpr size_t RP_CDA = 0, RP_SDA = 256 * 1024, RP_CRT = 512 * 1024, RP_SRT = 512 * 1024 + 1 * MiB;
constexpr size_t MS_EID = 0, MS_WSEL = 1 * MiB, MS_ROWMAP = 2 * MiB, MS_SSQ = 3 * MiB, MS_CRTT = 6 * MiB, MS_SRTT = 7 * MiB;
constexpr int CW_BAR = 0;
constexpr int CW_CNT = 4096;
constexpr int CW_CUR = 4096 + 256;

constexpr int LDS_BYTES = 155648;
constexpr int LDS_MISC = 147456;
constexpr int LDS_TILE_E = 131072;

#define XB_TMO      128
#define XB_XCNT(j)  (256  + 64 * (j))
#define XB_XSUB(j)  (1280 + 64 * (j))
#define XB_XGEN(j)  (2304 + 64 * (j))
#define XB_TOP      3328
#define XB_TOPGEN   3392
#define XCD_BAR_WORDS 3456
#define XB_SPIN_CAP (1u << 18)

__device__ __forceinline__ unsigned xb_ld(unsigned* p)              { return __hip_atomic_load(p, __ATOMIC_RELAXED, __HIP_MEMORY_SCOPE_AGENT); }
__device__ __forceinline__ unsigned xb_add(unsigned* p, unsigned v) { return __hip_atomic_fetch_add(p, v, __ATOMIC_RELAXED, __HIP_MEMORY_SCOPE_AGENT); }
__device__ __forceinline__ unsigned xb_xcc_id() { return (unsigned)__builtin_amdgcn_s_getreg((3 << 11) | 20) & 0xFu; }
#define XB_SPIN(cond, bar) do { unsigned _sp = 0; while (cond) { __builtin_amdgcn_s_sleep(1); \
    if ((++_sp & 255u) == 0u) { if (xb_ld(&(bar)[XB_TMO])) break; if (_sp > XB_SPIN_CAP) { atomicAdd(&(bar)[XB_TMO], 1u); break; } } } } while (0)

struct XcdBarrier { unsigned* bar; unsigned x; volatile LAS unsigned* st; };

__device__ __forceinline__ XcdBarrier xcd_barrier_post(unsigned* bar, volatile LAS unsigned* st) {
    XcdBarrier b; b.bar = bar; b.x = xb_xcc_id(); b.st = st;
    if (threadIdx.x == 0) (void)xb_add(&bar[XB_XCNT(b.x)], 1u);
    return b;
}
__device__ __forceinline__ void xcd_barrier_complete(unsigned* bar, unsigned x, unsigned& nloc, unsigned& nx) {
    const unsigned G = gridDim.x * gridDim.y * gridDim.z;
    unsigned sum, cnt, mine, sp = 0u;
    for (;;) {
        sum = 0u; cnt = 0u; mine = 0u;
#pragma unroll
        for (unsigned j = 0; j < 16; ++j) { const unsigned c = xb_ld(&bar[XB_XCNT(j)]); sum += c; cnt += (c > 0u) ? 1u : 0u; mine = (j == x) ? c : mine; }
        if (sum == G) break;
        __builtin_amdgcn_s_sleep(1);
        if ((++sp & 255u) == 0u) { if (xb_ld(&bar[XB_TMO])) break; if (sp > XB_SPIN_CAP) { atomicAdd(&bar[XB_TMO], 1u); break; } }
    }
    nloc = mine > 0u ? mine : 1u; nx = cnt > 0u ? cnt : 1u;
}
__device__ __forceinline__ void xcd_barrier(const XcdBarrier& b, const int tid0) {
    asm volatile("s_waitcnt vmcnt(0)" ::: "memory");
    __syncthreads();
    if (tid0 == 0) {
        unsigned* bar = (unsigned*)launder_p((unsigned char*)b.bar);
        __builtin_amdgcn_s_waitcnt(0);
        unsigned nloc = b.st[0], nx = b.st[1];
        if (nloc == 0u) { xcd_barrier_complete(bar, b.x, nloc, nx); b.st[0] = nloc; b.st[1] = nx; }
        const unsigned old = xb_add(&bar[XB_XSUB(b.x)], 1u);
        const unsigned gen = old / nloc;
        if (old + 1u == (gen + 1u) * nloc) {
            __builtin_amdgcn_fence(__ATOMIC_RELEASE, "agent");
            asm volatile("s_waitcnt vmcnt(0)" ::: "memory");
            const unsigned og = xb_add(&bar[XB_TOP], 1u);
            const unsigned tg = og / nx;
            if (og + 1u == (tg + 1u) * nx) xb_add(&bar[XB_TOPGEN], 1u);
            else XB_SPIN(xb_ld(&bar[XB_TOPGEN]) == tg, bar);
            __builtin_amdgcn_fence(__ATOMIC_ACQUIRE, "agent");
            xb_add(&bar[XB_XGEN(b.x)], 1u);
            asm volatile("s_waitcnt vmcnt(0)" ::: "memory");
        } else {
            XB_SPIN(xb_ld(&bar[XB_XGEN(b.x)]) == gen, bar);
            __builtin_amdgcn_fence(__ATOMIC_ACQUIRE, "agent");
            asm volatile("s_waitcnt vmcnt(0)" ::: "memory");
        }
    }
    __syncthreads();
}

struct Args { const float* in[24]; float* out; unsigned char* ws; int ph_lo, ph_hi; };
struct Frame {
    const Args* a; float* out; unsigned char* ws; LAS unsigned char* lds;
    int tid, lane, wave, G;
};
DI const float* mod_lat(const Frame& F, int layer, int b) { return (const float*)(F.ws + WS_ADA) + ((size_t)layer * 33 + b) * 6144; }
DI const float* mod_ctx(const Frame& F, int layer) { return (const float*)(F.ws + WS_ADA) + ((size_t)layer * 33 + 32) * 6144; }

namespace pg8 {
constexpr int BM = 256, BK = 64, HALF = 128, HTB = HALF * BK * 2, STAGE_BYTES = 8 * HTB, NXCD = 8, WGM = 8;
__host__ __device__ __forceinline__ int lds_byte(int r, int c) { const int st = (r >> 4) * 2 + (c >> 5), rr = r & 15, cc = c & 31, ob = rr * 64 + cc * 2; return st * 1024 + (ob ^ (((ob >> 9) & 1) << 5)); }
__host__ __device__ __forceinline__ void stage_rc(int b, int& R, int& C) { const int st = b / 1024, sb = b % 1024, swz = sb ^ (((sb >> 9) & 1) << 5); R = (st >> 1) * 16 + swz / 64; C = (st & 1) * 32 + (swz % 64) / 2; }
__host__ __device__ __forceinline__ int perm32(int rho) { const int n = rho >> 4, i = rho & 15; return 8 * (i >> 2) + 4 * n + (i & 3); }

struct Unit { int pm, pn, kind; };

struct GridOrder {
    int nM, nN, nwg;
    DI void init(int nM_, int nN_) { nM = nM_; nN = nN_; nwg = nM * nN; }
    DI bool map(long L, int& pm, int& pn) const {
        if (L >= nwg) return false;
        int wgid = (int)L; { const int q = nwg / NXCD, r = nwg % NXCD, xcd = wgid % NXCD, off = wgid / NXCD; wgid = (xcd < r ? xcd * (q + 1) : r * (q + 1) + (xcd - r) * q) + off; }
        const int nig = WGM * nN, gid = wgid / nig, fm = gid * WGM, gsz = (nM - fm) < WGM ? (nM - fm) : WGM;
        pm = fm + ((wgid % nig) % gsz); pn = (wgid % nig) / gsz; return true;
    }
};

template <class Epi, class P, bool ALIGN_EPI>
DI void gemm_phase(LAS unsigned char* lds, const P& S, const Epi& E, const int tid) {
    const int wid = __builtin_amdgcn_readfirstlane(tid >> 6), lane = tid & 63, wr = wid >> 2, wc = wid & 3, fr = lane & 15, fq = lane >> 4;
    const int K = S.K, nt = K / BK;
    unsigned voffA[2], voffB[2];
#pragma unroll
    for (int i = 0; i < 2; ++i) { int R, C; stage_rc(tid * 16 + i * 8192, R, C); const int Rb = Epi::PERM ? ((R & ~31) + perm32(R & 31)) : R;
        voffA[i] = (unsigned)(R * K + C) * 2u; voffB[i] = (unsigned)(Rb * K + C) * 2u; }
    const size_t kstep = (size_t)(BK * 2);
    const size_t hstep = (size_t)HALF * K * 2;
    const unsigned ldsw = (unsigned)wid * 1024u;
    const int aoff = lds_byte(wr * 64 + fr, fq * 8), boff = lds_byte(wc * 32 + fr, fq * 8);
#define PG8_SA(b, h) (((b) * 2 + (h)) * HTB)
#define PG8_SB(b, h) ((4 + (b) * 2 + (h)) * HTB)
#define PG8_STAGE(bufoff, gbase, voff) do { _Pragma("unroll") for (int _i = 0; _i < 2; ++_i) \
        __builtin_amdgcn_global_load_lds((const unsigned*)((const char*)(gbase) + (voff)[_i]), (LAS unsigned*)(lds + (bufoff) + ldsw + _i * 8192), 16, 0, 0); } while (0)
#define PG8_LDA(dst, b, h) do { _Pragma("unroll") for (int m = 0; m < 4; ++m) _Pragma("unroll") for (int k = 0; k < 2; ++k) dst[m][k] = *(const LAS bf16x8*)(lds + PG8_SA(b, h) + aoff + m * 2048 + k * 1024); } while (0)
#define PG8_LDB(dst, b, h) do { _Pragma("unroll") for (int n = 0; n < 2; ++n) _Pragma("unroll") for (int k = 0; k < 2; ++k) dst[n][k] = *(const LAS bf16x8*)(lds + PG8_SB(b, h) + boff + n * 2048 + k * 1024); } while (0)
#define PG8_MMA(ai, bj, At, Bt) do { __builtin_amdgcn_s_setprio(1); _Pragma("unroll") for (int m = 0; m < 4; ++m) _Pragma("unroll") for (int n = 0; n < 2; ++n) _Pragma("unroll") for (int k = 0; k < 2; ++k) \
        acc[ai][bj][m][n] = __builtin_amdgcn_mfma_f32_16x16x32_bf16(Bt[n][k], At[m][k], acc[ai][bj][m][n], 0, 0, 0); __builtin_amdgcn_s_setprio(0); } while (0)
#define PG8_WAIT_V(n) asm volatile("s_waitcnt vmcnt(" #n ")" ::: "memory")
#define PG8_WAIT_L(n) asm volatile("s_waitcnt lgkmcnt(" #n ")" ::: "memory")
#define PG8_BAR __builtin_amdgcn_s_barrier()
#define PG8_SCHED __builtin_amdgcn_sched_barrier(0)
    Unit cur, nxt; int ui = 0;
    if (!S.next(0, cur)) return;
    f32x4 acc[2][2][4][2];
#pragma unroll
    for (int a = 0; a < 2; ++a)
#pragma unroll
        for (int b = 0; b < 2; ++b)
#pragma unroll
            for (int m = 0; m < 4; ++m)
#pragma unroll
                for (int n = 0; n < 2; ++n) acc[a][b][m][n] = (f32x4){0.f, 0.f, 0.f, 0.f};
    bf16x8 At[4][2], B0[2][2], B1[2][2];
    const char* cA = S.a_ptr(cur); const char* cB = S.b_ptr(cur);
    PG8_STAGE(PG8_SB(0, 0), cB, voffB); PG8_STAGE(PG8_SB(0, 1), cB + hstep, voffB); PG8_STAGE(PG8_SA(0, 0), cA, voffA); PG8_STAGE(PG8_SA(0, 1), cA + hstep, voffA);
    if (wr == 1) PG8_BAR;
    PG8_WAIT_V(2); PG8_BAR;
    PG8_STAGE(PG8_SB(1, 0), cB + kstep, voffB); PG8_STAGE(PG8_SA(1, 0), cA + kstep, voffA); PG8_STAGE(PG8_SB(1, 1), cB + hstep + kstep, voffB);
    PG8_WAIT_V(6); PG8_BAR;
    for (;;) {
        const bool has_next = S.next(ui + 1, nxt);
        const char* nA = has_next ? S.a_ptr(nxt) : cA; const char* nB = has_next ? S.b_ptr(nxt) : cB;
        for (int t = 0; t < nt; t += 2) {
            const bool last = (t == nt - 2);
            const char* a1 = cA + (size_t)(t + 1) * kstep;
            const char* a2 = last ? nA : cA + (size_t)(t + 2) * kstep; const char* b2 = last ? nB : cB + (size_t)(t + 2) * kstep;
            const char* a3 = a2 + kstep; const char* b3 = b2 + kstep;
            PG8_LDB(B0, 0, 0); PG8_LDB(B1, 0, 1); PG8_SCHED; PG8_LDA(At, 0, 0); PG8_STAGE(PG8_SA(1, 1), a1 + hstep, voffA);
            PG8_WAIT_V(8); PG8_WAIT_L(0); PG8_BAR; PG8_MMA(0, 0, At, B0); PG8_MMA(0, 1, At, B1); PG8_BAR; PG8_SCHED;
            PG8_LDA(At, 0, 1); PG8_STAGE(PG8_SB(0, 0), b2, voffB); PG8_STAGE(PG8_SB(0, 1), b2 + hstep, voffB); PG8_STAGE(PG8_SA(0, 0), a2, voffA);
            PG8_WAIT_V(8); PG8_WAIT_L(0); PG8_BAR; PG8_MMA(1, 0, At, B0); PG8_MMA(1, 1, At, B1); PG8_BAR; PG8_SCHED;
            PG8_LDB(B0, 1, 0); PG8_LDB(B1, 1, 1); PG8_SCHED; PG8_LDA(At, 1, 0); PG8_STAGE(PG8_SA(0, 1), a2 + hstep, voffA);
            PG8_WAIT_V(8); PG8_WAIT_L(0); PG8_BAR; PG8_MMA(0, 0, At, B0); PG8_MMA(0, 1, At, B1); PG8_BAR; PG8_SCHED;
            PG8_LDA(At, 1, 1); PG8_STAGE(PG8_SB(1, 0), b3, voffB); PG8_STAGE(PG8_SB(1, 1), b3 + hstep, voffB); PG8_STAGE(PG8_SA(1, 0), a3, voffA);
            PG8_WAIT_V(8); PG8_WAIT_L(0); PG8_BAR; PG8_MMA(1, 0, At, B0); PG8_MMA(1, 1, At, B1); PG8_BAR; PG8_SCHED;
        }
        if constexpr (ALIGN_EPI) { if (wr == 0) PG8_BAR; }
        E(acc, cur, wr, wc, fr, fq);
        if (!has_next) break;
#pragma unroll
        for (int a = 0; a < 2; ++a)
#pragma unroll
            for (int b = 0; b < 2; ++b)
#pragma unroll
                for (int m = 0; m < 4; ++m)
#pragma unroll
                    for (int n = 0; n < 2; ++n) acc[a][b][m][n] = (f32x4){0.f, 0.f, 0.f, 0.f};
        cur = nxt; cA = nA; cB = nB; ++ui;
        if constexpr (ALIGN_EPI) { if (wr == 1) PG8_BAR; }
    }
    PG8_WAIT_V(0);
    if constexpr (!ALIGN_EPI) { if (wr == 0) PG8_BAR; }
    PG8_BAR;
#undef PG8_SA
#undef PG8_SB
#undef PG8_STAGE
#undef PG8_LDA
#undef PG8_LDB
#undef PG8_MMA
#undef PG8_WAIT_V
#undef PG8_WAIT_L
#undef PG8_BAR
#undef PG8_SCHED
}
}
using pg8::Unit;

struct ProbQKV {
    int K; const char* abuf; const char* wqk; const char* wv; pg8::GridOrder go; int G, c;
    DI bool next(int i, Unit& u) const {
        const long L = (long)i * G + c;
        if (L < NTILE * 8) { u.kind = 0; return go.map(L, u.pm, u.pn); }
        const long r = L - NTILE * 8; if (r >= NTILE * 4) return false;
        u.kind = 1; u.pm = (int)(r & 3); u.pn = (int)(r >> 2); return true;
    }
    DI const char* a_ptr(const Unit& u) const { return (u.kind == 0 ? abuf : wv) + (size_t)u.pm * (256 * 1024 * 2); }
    DI const char* b_ptr(const Unit& u) const { return (u.kind == 0 ? wqk : abuf) + (size_t)u.pn * (256 * 1024 * 2); }
};
struct EpiQKV {
    static constexpr bool PERM = true;
    bf16_t* Q; bf16_t* Kb; bf16_t* VT; const float* gq; const float* gk; const float* cosT; const float* sinT;
    DI void operator()(const f32x4 (&acc)[2][2][4][2], const Unit& u, int wr, int wc, int fr, int fq) const {
        if (u.kind == 1) {
#pragma unroll
            for (int ai = 0; ai < 2; ++ai)
#pragma unroll
                for (int m = 0; m < 4; ++m) {
                    const int f = u.pm * 256 + ai * 128 + wr * 64 + m * 16 + fr;
                    bf16_t* rowp = VT + (size_t)f * T + (size_t)u.pn * 256 + wc * 32 + 8 * fq;
#pragma unroll
                    for (int bj = 0; bj < 2; ++bj) { const f32x4 v0 = acc[ai][bj][m][0], v1 = acc[ai][bj][m][1];
                        u32x4 w; w.x = pk_bf16(v0[0], v0[1]); w.y = pk_bf16(v0[2], v0[3]); w.z = pk_bf16(v1[0], v1[1]); w.w = pk_bf16(v1[2], v1[3]);
                        *(u32x4*)(rowp + bj * 128) = w; }
                }
            return;
        }
        const bool isK = u.pn >= 4; const int sub = 4 * (u.pn & 3) + wc;
        const int jj = u.pm % 9; const bool isctx = (jj == 0);
        const float* g = isK ? gk : gq; bf16_t* dst = isK ? Kb : Q;
        const float osc = isK ? 1.0f : 0.125f * LOG2E;
        f32x4 gv[2][2];
#pragma unroll
        for (int bj = 0; bj < 2; ++bj)
#pragma unroll
            for (int n = 0; n < 2; ++n) gv[bj][n] = *(const f32x4*)(g + 32 * bj + 8 * fq + 4 * n);
#pragma unroll
        for (int ai = 0; ai < 2; ++ai)
#pragma unroll
            for (int m = 0; m < 4; ++m) {
                const int rr = ai * 128 + wr * 64 + m * 16 + fr;
                float ss = 0.f;
#pragma unroll
                for (int bj = 0; bj < 2; ++bj)
#pragma unroll
                    for (int n = 0; n < 2; ++n) { const f32x4 x = acc[ai][bj][m][n]; ss += (x[0] * x[0] + x[1] * x[1]) + (x[2] * x[2] + x[3] * x[3]); }
                { const int ln = fr + 16 * fq; ss += shx(ss, 16, ln); ss += shx(ss, 32, ln); }
                const float rstd = __builtin_amdgcn_rsqf(ss * (1.0f / 64.0f) + RMS_EPS) * osc;
                f32x4 x1[2], x2[2];
#pragma unroll
                for (int n = 0; n < 2; ++n) { x1[n] = acc[ai][0][m][n] * rstd * gv[0][n]; x2[n] = acc[ai][1][m][n] * rstd * gv[1][n]; }
                if (!isctx) {
                    const int t = (jj - 1) * 256 + rr;
#pragma unroll
                    for (int n = 0; n < 2; ++n) { const f32x4 c = *(const f32x4*)(cosT + t * 32 + 8 * fq + 4 * n), s = *(const f32x4*)(sinT + t * 32 + 8 * fq + 4 * n);
                        const f32x4 a = x1[n] * c - x2[n] * s, b = x1[n] * s + x2[n] * c; x1[n] = a; x2[n] = b; }
                }
                bf16_t* rowp = dst + (size_t)(u.pm * 256 + rr) * 1024 + 64 * sub + 8 * fq;
                u32x4 w; w.x = pk_bf16(x1[0][0], x1[0][1]); w.y = pk_bf16(x1[0][2], x1[0][3]); w.z = pk_bf16(x1[1][0], x1[1][1]); w.w = pk_bf16(x1[1][2], x1[1][3]);
                *(u32x4*)(rowp) = w;
                w.x = pk_bf16(x2[0][0], x2[0][1]); w.y = pk_bf16(x2[0][2], x2[0][3]); w.z = pk_bf16(x2[1][0], x2[1][1]); w.w = pk_bf16(x2[1][2], x2[1][3]);
                *(u32x4*)(rowp + 32) = w;
            }
    }
};

struct ProbDense {
    int K; const char* A0; const char* A1; int pm_split; const char* Bt; pg8::GridOrder go; int G, c;
    DI bool next(int i, Unit& u) const { u.kind = 0; return go.map((long)i * G + c, u.pm, u.pn); }
    DI const char* a_ptr(const Unit& u) const { return u.pm < pm_split ? A0 + (size_t)u.pm * 512 * K : A1 + (size_t)(u.pm - pm_split) * 512 * K; }
    DI const char* b_ptr(const Unit& u) const { return Bt + (size_t)u.pn * 512 * K; }
};

struct ProbWIN {
    int K; const char* abuf; const char* win; pg8::GridOrder go; int G, c;
    DI bool next(int i, Unit& u) const {
        const long L = (long)i * G + c;
        if (L < 144 * 20) { u.kind = 0; return go.map(L, u.pm, u.pn); }
        const long r = L - 144 * 20; if (r >= 144 * 12) return false;
        u.kind = 1; u.pm = (int)(r % 12); u.pn = (int)(r / 12); return true;
    }
    DI const char* a_ptr(const Unit& u) const { return u.kind == 0 ? abuf + (size_t)u.pm * (256 * 1024 * 2) : win + (size_t)(4 + u.pm) * (256 * 1024 * 2); }
    DI const char* b_ptr(const Unit& u) const { return u.kind == 0 ? win + (size_t)(u.pn < 4 ? u.pn : 12 + u.pn) * (256 * 1024 * 2) : abuf + (size_t)u.pn * (256 * 1024 * 2); }
};
struct EpiWIN {
    static constexpr bool PERM = true;
    bf16_t* RQ; bf16_t* RG; bf16_t* RKT; bf16_t* RVT; int pm0; const float* cosT; const float* sinT; const float* cosTT; const float* sinTT;
    DI void operator()(const f32x4 (&acc)[2][2][4][2], const Unit& u, int wr, int wc, int fr, int fq) const {
        if (u.kind == 0) {
            const int gpm = pm0 + u.pm, jj = gpm % 9; const bool isctx = (jj == 0); const bool isq = u.pn < 4;
#pragma unroll
            for (int ai = 0; ai < 2; ++ai)
#pragma unroll
                for (int m = 0; m < 4; ++m) {
                    const int rr = ai * 128 + wr * 64 + m * 16 + fr;
                    f32x4 x1[2], x2[2];
#pragma unroll
                    for (int n = 0; n < 2; ++n) { x1[n] = acc[ai][0][m][n]; x2[n] = acc[ai][1][m][n]; }
                    if (isq) {
                        if (!isctx) {
                            const int t = (jj - 1) * 256 + rr;
#pragma unroll
                            for (int n = 0; n < 2; ++n) { const int fo = t * 128 + 32 * wc + 8 * fq + 4 * n; const f32x4 c = *(const f32x4*)(cosT + fo), s = *(const f32x4*)(sinT + fo);
                                const f32x4 a = x1[n] * c - x2[n] * s, b = x1[n] * s + x2[n] * c; x1[n] = a; x2[n] = b; }
                        }
                    } else {
#pragma unroll
                        for (int n = 0; n < 2; ++n)
#pragma unroll
                            for (int j = 0; j < 4; ++j) { x1[n][j] = silu_f(x1[n][j]); x2[n][j] = silu_f(x2[n][j]); }
                    }
                    bf16_t* rowp = isq ? RQ + (size_t)(u.pm * 256 + rr) * 1024 + u.pn * 256 + wc * 32 + 8 * fq : RG + (size_t)(u.pm * 256 + rr) * 4096 + (u.pn - 4) * 256 + wc * 32 + 8 * fq;
                    u32x4 w; w.x = pk_bf16(x1[0][0], x1[0][1]); w.y = pk_bf16(x1[0][2], x1[0][3]); w.z = pk_bf16(x1[1][0], x1[1][1]); w.w = pk_bf16(x1[1][2], x1[1][3]);
                    *(u32x4*)(rowp) = w;
                    w.x = pk_bf16(x2[0][0], x2[0][1]); w.y = pk_bf16(x2[0][2], x2[0][3]); w.z = pk_bf16(x2[1][0], x2[1][1]); w.w = pk_bf16(x2[1][2], x2[1][3]);
                    *(u32x4*)(rowp + 128) = w;
                }
            return;
        }
        const int gpm = pm0 + u.pn, jj = gpm % 9; const bool isctx = (jj == 0); const bool isk = u.pm < 4;
        if (isk) {
#pragma unroll
            for (int m = 0; m < 4; ++m) {
                const int f = wr * 64 + m * 16 + fr;
#pragma unroll
                for (int bj = 0; bj < 2; ++bj) {
                    f32x4 x1[2], x2[2];
#pragma unroll
                    for (int n = 0; n < 2; ++n) { x1[n] = acc[0][bj][m][n] * 0.0625f; x2[n] = acc[1][bj][m][n] * 0.0625f; }
                    const int tl = bj * 128 + wc * 32 + 8 * fq;
                    if (!isctx) {
                        const int t = (jj - 1) * 256 + tl;
#pragma unroll
                        for (int n = 0; n < 2; ++n) { const f32x4 c = *(const f32x4*)(cosTT + f * 2048 + t + 4 * n), s = *(const f32x4*)(sinTT + f * 2048 + t + 4 * n);
                            const f32x4 a = x1[n] * c - x2[n] * s, b = x1[n] * s + x2[n] * c; x1[n] = a; x2[n] = b; }
                    }
                    bf16_t* p1 = RKT + (size_t)(u.pm * 256 + f) * HROWS + (size_t)u.pn * 256 + tl;
                    u32x4 w; w.x = pk_bf16(x1[0][0], x1[0][1]); w.y = pk_bf16(x1[0][2], x1[0][3]); w.z = pk_bf16(x1[1][0], x1[1][1]); w.w = pk_bf16(x1[1][2], x1[1][3]);
                    *(u32x4*)(p1) = w;
                    w.x = pk_bf16(x2[0][0], x2[0][1]); w.y = pk_bf16(x2[0][2], x2[0][3]); w.z = pk_bf16(x2[1][0], x2[1][1]); w.w = pk_bf16(x2[1][2], x2[1][3]);
                    *(u32x4*)(p1 + (size_t)128 * HROWS) = w;
                }
            }
        } else {
#pragma unroll
            for (int ai = 0; ai < 2; ++ai)
#pragma unroll
                for (int m = 0; m < 4; ++m) {
                    const int f = (u.pm - 4) * 256 + ai * 128 + wr * 64 + m * 16 + fr;
                    bf16_t* rowp = RVT + (size_t)f * HROWS + (size_t)u.pn * 256 + wc * 32 + 8 * fq;
#pragma unroll
                    for (int bj = 0; bj < 2; ++bj) { const f32x4 v0 = acc[ai][bj][m][0], v1 = acc[ai][bj][m][1];
                        u32x4 w; w.x = pk_bf16(v0[0], v0[1]); w.y = pk_bf16(v0[2], v0[3]); w.z = pk_bf16(v1[0], v1[1]); w.w = pk_bf16(v1[2], v1[3]);
                        *(u32x4*)(rowp + bj * 128) = w; }
                }
        }
    }
};

struct EpiResid {
    static constexpr bool PERM = false;
    const float* hin_ctx; const float* hin_lat; float* hout_ctx; float* hout_lat; const float* modbase;
    DI void operator()(const f32x4 (&acc)[2][2][4][2], const Unit& u, int wr, int wc, int fr, int fq) const {
        const int b = u.pm / 9, jj = u.pm % 9; const bool isctx = (jj == 0);
        const float* gate = modbase + (size_t)(isctx ? 32 : b) * 6144 + 2048;
        const int col0 = u.pn * 256 + wc * 32 + 4 * fq;
        f32x4 gv[2][2];
#pragma unroll
        for (int bj = 0; bj < 2; ++bj)
#pragma unroll
            for (int n = 0; n < 2; ++n) gv[bj][n] = *(const f32x4*)(gate + col0 + bj * 128 + n * 16);
        const size_t rbase = isctx ? (size_t)b * 256 : (size_t)b * 2048 + (size_t)(jj - 1) * 256;
        const float* hi = isctx ? hin_ctx : hin_lat; float* ho = isctx ? hout_ctx : hout_lat;
#pragma unroll
        for (int ai = 0; ai < 2; ++ai)
#pragma unroll
            for (int m = 0; m < 4; ++m) {
                const size_t off = (rbase + ai * 128 + wr * 64 + m * 16 + fr) * 1024 + col0;
#pragma unroll
                for (int bj = 0; bj < 2; ++bj)
#pragma unroll
                    for (int n = 0; n < 2; ++n) { const f32x4 hv = *(const f32x4*)(hi + off + bj * 128 + n * 16);
                        *(f32x4*)(ho + off + bj * 128 + n * 16) = hv + gv[bj][n] * acc[ai][bj][m][n]; }
            }
    }
};

struct ProbMoE {
    int K; const char* A; const char* W; const LAS int* tile_e; pg8::GridOrder go; int G, c;
    DI bool next(int i, Unit& u) const { u.kind = 0; return go.map((long)i * G + c, u.pm, u.pn); }
    DI const char* a_ptr(const Unit& u) const { return A + (size_t)u.pm * 512 * K; }
    DI const char* b_ptr(const Unit& u) const { return W + ((size_t)tile_e[u.pm] * 4 + u.pn) * 512 * K; }
};
struct EpiSwiGLU {
    static constexpr bool PERM = true;
    bf16_t* act;
    DI void operator()(const f32x4 (&acc)[2][2][4][2], const Unit& u, int wr, int wc, int fr, int fq) const {
#pragma unroll
        for (int ai = 0; ai < 2; ++ai)
#pragma unroll
            for (int m = 0; m < 4; ++m) {
                bf16_t* rowp = act + (size_t)(u.pm * 256 + ai * 128 + wr * 64 + m * 16 + fr) * 512 + u.pn * 128 + wc * 16 + 4 * fq;
#pragma unroll
                for (int bj = 0; bj < 2; ++bj) { const f32x4 g = acc[ai][bj][m][0], up = acc[ai][bj][m][1];
                    u32x2 w; w.x = pk_bf16(silu_f(g[0]) * up[0], silu_f(g[1]) * up[1]); w.y = pk_bf16(silu_f(g[2]) * up[2], silu_f(g[3]) * up[3]);
                    *(u32x2*)(rowp + bj * 64) = w; }
            }
    }
};
struct EpiDown {
    static constexpr bool PERM = true;
    bf16_t* y2; const int* rowmap; const float* wsel;
    DI void operator()(const f32x4 (&acc)[2][2][4][2], const Unit& u, int wr, int wc, int fr, int fq) const {
#pragma unroll
        for (int ai = 0; ai < 2; ++ai)
#pragma unroll
            for (int m = 0; m < 4; ++m) {
                const int row = u.pm * 256 + ai * 128 + wr * 64 + m * 16 + fr;
                const int dest = rowmap[row];
                if (dest >= 0) {
                    const float w = wsel[dest];
                    bf16_t* rowp = y2 + (size_t)dest * 1024 + u.pn * 256 + wc * 32 + 8 * fq;
#pragma unroll
                    for (int bj = 0; bj < 2; ++bj) { const f32x4 v0 = acc[ai][bj][m][0] * w, v1 = acc[ai][bj][m][1] * w;
                        u32x4 o; o.x = pk_bf16(v0[0], v0[1]); o.y = pk_bf16(v0[2], v0[3]); o.z = pk_bf16(v1[0], v1[1]); o.w = pk_bf16(v1[2], v1[3]);
                        *(u32x4*)(rowp + bj * 128) = o; }
                }
            }
    }
};

template <int MODE>
DI void transpose_tile(const Frame& F, const float* src, const float* src2, int ld, bf16_t* dst, int K, int k0, int n0) {
    LAS float* tl = (LAS float*)F.lds;
    __syncthreads();
#pragma unroll
    for (int i = 0; i < 8; ++i) {
        const int idx = F.tid + 512 * i, kk = idx >> 6, nn = idx & 63, np = n0 + nn;
        float v;
        if (MODE == 0) v = src[(size_t)(k0 + kk) * ld + np];
        else if (MODE == 1) { const int t = np >> 8, p = np & 255, bj = p >> 7, wc = (p >> 5) & 3, r = p & 31; v = src[(size_t)(k0 + kk) * ld + t * 256 + wc * 64 + bj * 32 + r]; }
        else { const int hid = 4 * (np >> 3) + (np & 3); v = ((np & 4) ? src2 : src)[(size_t)(k0 + kk) * ld + hid]; }
        tl[nn * 65 + kk] = v;
    }
    __syncthreads();
#pragma unroll
    for (int i = 0; i < 4; ++i) {
        const int idx = F.tid + 512 * i, nn = idx >> 5, kp = (idx & 31) * 2;
        *(unsigned*)(dst + (size_t)(n0 + nn) * K + k0 + kp) = pk_bf16(tl[nn * 65 + kp], tl[nn * 65 + kp + 1]);
    }
}
template <int MODE>
DI int transpose_mat(const Frame& F, const float* src, const float* src2, int ld, bf16_t* dst, int K, int Np, int u0, int u_first, int u_stride) {
    const int tk = K / 64, tn = Np / 64, ntl = tk * tn;
    int u = u_first; if (u < u0) { const int d = (u0 - u + u_stride - 1) / u_stride; u += d * u_stride; }
    for (; u < u0 + ntl; u += u_stride) { const int l = u - u0; transpose_tile<MODE>(F, src, src2, ld, dst, K, (l % tk) * 64, (l / tk) * 64); }
    return ntl;
}
DI void convert_moe_weights(const Frame& F, int layer) {
    const float* wg = F.a->in[21] + (size_t)layer * NEXP * DM * MOEH; const float* wu = F.a->in[22] + (size_t)layer * NEXP * DM * MOEH; const float* wd = F.a->in[23] + (size_t)layer * NEXP * MOEH * DM;
    bf16_t* WGU = (bf16_t*)(F.ws + WS_WGU); bf16_t* WD = (bf16_t*)(F.ws + WS_WD);
    int u0 = 0;
    for (int e = 0; e < NEXP; ++e) {
        u0 += transpose_mat<2>(F, wg + (size_t)e * DM * MOEH, wu + (size_t)e * DM * MOEH, MOEH, WGU + (size_t)e * 1024 * 1024, 1024, 1024, u0, blockIdx.x, F.G);
        u0 += transpose_mat<0>(F, wd + (size_t)e * MOEH * DM, nullptr, DM, WD + (size_t)e * 1024 * 512, 512, 1024, u0, blockIdx.x, F.G);
    }
}

DI void p0_prologue(const Frame& F) {
    {
        LAS float* red = (LAS float*)F.lds;
        for (int u = blockIdx.x; u < 4 * 96; u += F.G) {
            const int layer = u / 96, col0 = (u % 96) * 64;
            const float* W = F.a->in[6] + (size_t)layer * 1024 * 6144 + col0 + F.lane;
            const float* cp = F.lane < 32 ? F.a->in[1] + F.lane * 1024 : F.a->in[3];
            float acc[33];
#pragma unroll
            for (int r = 0; r < 33; ++r) acc[r] = 0.f;
            const int k0 = F.wave * 128;
            for (int k = k0; k < k0 + 128; ++k) {
                const float w = W[(size_t)k * 6144];
                const float sv = silu_f(cp[k]);
#pragma unroll
                for (int r = 0; r < 33; ++r) acc[r] += w * __builtin_bit_cast(float, __builtin_amdgcn_readlane(__builtin_bit_cast(int, sv), r));
            }
#pragma unroll
            for (int r = 0; r < 33; ++r) red[(F.wave * 33 + r) * 64 + F.lane] = acc[r];
            __syncthreads();
            float* outp = (float*)(F.ws + WS_ADA) + (size_t)layer * 33 * 6144;
            for (int idx = F.tid; idx < 33 * 64; idx += 512) { const int r = idx >> 6, cl = idx & 63; float v = 0.f;
#pragma unroll
                for (int w8 = 0; w8 < 8; ++w8) v += red[(w8 * 33 + r) * 64 + cl];
                outp[(size_t)r * 6144 + col0 + cl] = v + F.a->in[7][layer * 6144 + col0 + cl]; }
            __syncthreads();
        }
    }
    {
        float* cda = (float*)(F.ws + WS_ROPE + RP_CDA); float* sda = (float*)(F.ws + WS_ROPE + RP_SDA); float* crt = (float*)(F.ws + WS_ROPE + RP_CRT); float* srt = (float*)(F.ws + WS_ROPE + RP_SRT);
        const int gt = blockIdx.x * 512 + F.tid, gs = F.G * 512;
        for (int idx = gt; idx < 2048 * 32; idx += gs) { const int t = idx >> 5, f = idx & 31; const float pos = f < 16 ? (float)(t >> 6) : (float)(t & 63);
            const float inv = exp2f(-(float)(f & 15) * (13.287712379549449f / 16.0f)); const float a = pos * inv; cda[idx] = __cosf(a); sda[idx] = __sinf(a); }
        for (int idx = gt; idx < 2048 * 128; idx += gs) { const int t = idx >> 7, f = idx & 127; const float pos = f < 64 ? (float)(t >> 6) : (float)(t & 63);
            const float inv = exp2f(-(float)(f & 63) * (13.287712379549449f / 64.0f)); const float a = pos * inv; const float cv = __cosf(a), sv = __sinf(a); crt[idx] = cv; srt[idx] = sv;
            ((float*)(F.ws + WS_MISC + MS_CRTT))[f * 2048 + t] = cv; ((float*)(F.ws + WS_MISC + MS_SRTT))[f * 2048 + t] = sv; }
    }
    {
        int u0 = 0;
        for (int j = 0; j < 2; ++j) {
            const float* wqkv = F.a->in[8] + (size_t)j * 1024 * 3072;
            u0 += transpose_mat<1>(F, wqkv, nullptr, 3072, (bf16_t*)(F.ws + WS_WQK) + (size_t)j * 2048 * 1024, 1024, 2048, u0, blockIdx.x, F.G);
            u0 += transpose_mat<0>(F, wqkv + 2048, nullptr, 3072, (bf16_t*)(F.ws + WS_WV) + (size_t)j * 1024 * 1024, 1024, 1024, u0, blockIdx.x, F.G);
            u0 += transpose_mat<0>(F, F.a->in[13] + (size_t)j * 1024 * 1024, nullptr, 1024, (bf16_t*)(F.ws + WS_WODA) + (size_t)j * 1024 * 1024, 1024, 1024, u0, blockIdx.x, F.G);
            u0 += transpose_mat<0>(F, F.a->in[14] + (size_t)j * 1024 * 8192, nullptr, 8192, (bf16_t*)(F.ws + WS_WIN) + (size_t)j * 8192 * 1024, 1024, 8192, u0, blockIdx.x, F.G);
            u0 += transpose_mat<0>(F, F.a->in[16] + (size_t)j * 2048 * 1024, nullptr, 1024, (bf16_t*)(F.ws + WS_WORT) + (size_t)j * 1024 * 2048, 2048, 1024, u0, blockIdx.x, F.G);
        }
        convert_moe_weights(F, 0);
    }
}

template <bool SECOND>
DI void norm_phase(const Frame& F, int layer) {
    bf16_t* abuf = (bf16_t*)(F.ws + WS_ABUF);
    float* hctx = (float*)(F.ws + WS_HCTX);
    const bf16_t* y2 = (const bf16_t*)(F.ws + WS_PROJ + PJ_Y2);
    const float* ng = F.a->in[SECOND ? 5 : 4] + layer * 1024;
    LAS float* Wl = (LAS float*)F.lds;
    LAS int* lhist = (LAS int*)(F.lds + LDS_MISC + 1024);
    int* eid = (int*)(F.ws + WS_MISC + MS_EID); float* wsel = (float*)(F.ws + WS_MISC + MS_WSEL);
    if (SECOND) {
        const float* wgp = F.a->in[17] + (size_t)layer * 1024 * 4; const float* wep = F.a->in[19] + (size_t)layer * 1024 * 32;
        for (int idx = F.tid; idx < 1024 * 4; idx += 512) { const int k = idx >> 2, o = idx & 3; Wl[o * 1024 + k] = wgp[idx]; }
        for (int idx = F.tid; idx < 1024 * 32; idx += 512) { const int k = idx >> 5, o = idx & 31; Wl[(4 + o) * 1024 + k] = wep[idx]; }
        if (F.tid < 32) lhist[F.tid] = 0;
        __syncthreads();
    }
    const int lane = F.lane;
    for (int r = blockIdx.x * 8 + F.wave; r < T; r += F.G * 8) {
        const int b = r / NTOK, n = r % NTOK; const bool isctx = n < CTXL;
        const size_t hoff = isctx ? ((size_t)b * 256 + n) * 1024 : ((size_t)b * 2048 + (n - 256)) * 1024;
        const float* hin; float* hout = isctx ? hctx + hoff : F.out + hoff;
        if (layer == 0 && !SECOND) hin = isctx ? F.a->in[2] + hoff : F.a->in[0] + hoff; else hin = hout;
        const float* mod = isctx ? mod_ctx(F, layer) : mod_lat(F, layer, b);
        f32x4 x[4];
#pragma unroll
        for (int i = 0; i < 4; ++i) x[i] = *(const f32x4*)(hin + i * 256 + lane * 4);
        if (!SECOND && layer > 0) {
            const float* modp = isctx ? mod_ctx(F, layer - 1) : mod_lat(F, layer - 1, b);
#pragma unroll
            for (int i = 0; i < 4; ++i) {
                const u32x2 a = *(const u32x2*)(y2 + (size_t)(2 * r) * 1024 + i * 256 + lane * 4), c = *(const u32x2*)(y2 + (size_t)(2 * r + 1) * 1024 + i * 256 + lane * 4);
                const f32x4 g2 = *(const f32x4*)(modp + 5120 + i * 256 + lane * 4);
                x[i][0] += g2[0] * (bf_lo(a.x) + bf_lo(c.x)); x[i][1] += g2[1] * (bf_hi(a.x) + bf_hi(c.x)); x[i][2] += g2[2] * (bf_lo(a.y) + bf_lo(c.y)); x[i][3] += g2[3] * (bf_hi(a.y) + bf_hi(c.y));
                *(f32x4*)(hout + i * 256 + lane * 4) = x[i];
            }
        }
        float ss = 0.f;
#pragma unroll
        for (int i = 0; i < 4; ++i) ss += (x[i][0] * x[i][0] + x[i][1] * x[i][1]) + (x[i][2] * x[i][2] + x[i][3] * x[i][3]);
        ss = wave_sum(ss, lane);
        const float rstd = 1.0f / sqrtf(ss * (1.0f / 1024.0f) + RMS_EPS);
        f32x4 v[4];
#pragma unroll
        for (int i = 0; i < 4; ++i) {
            const int c0 = i * 256 + lane * 4;
            const f32x4 g = *(const f32x4*)(ng + c0), sh = *(const f32x4*)(mod + (SECOND ? 3072 : 0) + c0), sc = *(const f32x4*)(mod + (SECOND ? 4096 : 1024) + c0);
            v[i] = (x[i] * rstd * g) * (sc + 1.0f) + sh;
            u32x2 w; w.x = pk_bf16(v[i][0], v[i][1]); w.y = pk_bf16(v[i][2], v[i][3]);
            *(u32x2*)(abuf + (size_t)r * 1024 + c0) = w;
        }
        if (SECOND) {
            float lg[36];
#pragma unroll
            for (int o = 0; o < 36; ++o) {
                float p = 0.f;
#pragma unroll
                for (int i = 0; i < 4; ++i) { const f32x4 w = *(const LAS f32x4*)(Wl + o * 1024 + i * 256 + lane * 4); p += (v[i][0] * w[0] + v[i][1] * w[1]) + (v[i][2] * w[2] + v[i][3] * w[3]); }
                lg[o] = wave_sum(p, lane);
            }
            const float* bg = F.a->in[18] + layer * 4; const float* be = F.a->in[20] + layer * 32;
            float gl[4]; float gmax = -3.0e38f; int gi = 0;
#pragma unroll
            for (int o = 0; o < 4; ++o) { gl[o] = lg[o] + bg[o]; if (gl[o] > gmax) { gmax = gl[o]; gi = o; } }
            float gsum = 0.f;
#pragma unroll
            for (int o = 0; o < 4; ++o) gsum += __expf(gl[o] - gmax);
            const float psel = 1.0f / gsum;
            float el[8];
#pragma unroll
            for (int o = 0; o < 8; ++o) {
                float t = lg[4 + o];
#pragma unroll
                for (int g = 1; g < 4; ++g) t = (gi == g) ? lg[4 + g * 8 + o] : t;
                el[o] = t + be[gi * 8 + o];
            }
            float m1 = -3.0e38f, m2 = -3.0e38f; int i1 = 0, i2 = 0;
#pragma unroll
            for (int o = 0; o < 8; ++o) { if (el[o] > m1) { m1 = el[o]; i1 = o; } }
#pragma unroll
            for (int o = 0; o < 8; ++o) { if (o != i1 && el[o] > m2) { m2 = el[o]; i2 = o; } }
            const float e2 = __expf(m2 - m1), inv = 1.0f / (1.0f + e2);
            if (lane == 0) {
                eid[2 * r] = gi * 8 + i1; eid[2 * r + 1] = gi * 8 + i2; wsel[2 * r] = inv * psel; wsel[2 * r + 1] = e2 * inv * psel;
                __hip_atomic_fetch_add(&lhist[gi * 8 + i1], 1, __ATOMIC_RELAXED, __HIP_MEMORY_SCOPE_WORKGROUP); __hip_atomic_fetch_add(&lhist[gi * 8 + i2], 1, __ATOMIC_RELAXED, __HIP_MEMORY_SCOPE_WORKGROUP);
            }
        }
    }
    if (SECOND) {
        __syncthreads();
        if (F.tid < 32) { const int c = lhist[F.tid]; if (c) __hip_atomic_fetch_add((unsigned*)(F.ws + WS_CTL) + CW_CNT + layer * 64 + F.tid, (unsigned)c, __ATOMIC_RELAXED, __HIP_MEMORY_SCOPE_AGENT); }
    }
}

DI int build_segments(const Frame& F, int layer, LAS int* segs, LAS int* tile_e) {
    __syncthreads();
    if (F.tid == 0) {
        const unsigned* cnt = (const unsigned*)(F.ws + WS_CTL) + CW_CNT + layer * 64;
        int s = 0;
        for (int e = 0; e < 32; ++e) { segs[e] = s; const int c = (int)__hip_atomic_load(cnt + e, __ATOMIC_RELAXED, __HIP_MEMORY_SCOPE_AGENT); segs[40 + e] = c; s += (c + 255) & ~255; }
        segs[32] = s;
    }
    __syncthreads();
    const int ntl = segs[32] >> 8;
    if (tile_e) {
        for (int t = F.tid; t < ntl; t += 512) { int e = 0;
            for (int q = 1; q < 32; ++q) e = (segs[q] <= t * 256) ? q : e;
            tile_e[t] = e; }
        __syncthreads();
    }
    return ntl;
}

DI void sort_phase(const Frame& F, int layer) {
    LAS int* segs = (LAS int*)(F.lds + LDS_MISC + 2048);
    LAS int* lhist = (LAS int*)(F.lds + LDS_MISC + 1024);
    LAS int* lbase = (LAS int*)(F.lds + LDS_MISC + 1024 + 128);
    LAS int* lpos = (LAS int*)F.lds;
    build_segments(F, layer, segs, nullptr);
    const int* eid = (const int*)(F.ws + WS_MISC + MS_EID); int* rowmap = (int*)(F.ws + WS_MISC + MS_ROWMAP);
    const bf16_t* abuf = (const bf16_t*)(F.ws + WS_ABUF); bf16_t* sa = (bf16_t*)(F.ws + WS_PROJ + PJ_SA);
    const int RPB = (T + F.G - 1) / F.G;
    const int r0 = blockIdx.x * RPB, r1 = (r0 + RPB < T) ? r0 + RPB : T;
    const int na = r1 > r0 ? 2 * (r1 - r0) : 0;
    if (F.tid < 32) lhist[F.tid] = 0;
    __syncthreads();
    int ee[2], lp[2];
#pragma unroll
    for (int it = 0; it < 2; ++it) { const int a = F.tid + 512 * it; ee[it] = -1; lp[it] = 0;
        if (a < na) { ee[it] = eid[2 * r0 + a]; lp[it] = __hip_atomic_fetch_add(&lhist[ee[it]], 1, __ATOMIC_RELAXED, __HIP_MEMORY_SCOPE_WORKGROUP); } }
    __syncthreads();
    if (F.tid < 32) { const int c = lhist[F.tid];
        lbase[F.tid] = segs[F.tid] + (c ? (int)__hip_atomic_fetch_add((unsigned*)(F.ws + WS_CTL) + CW_CUR + layer * 64 + F.tid, (unsigned)c, __ATOMIC_RELAXED, __HIP_MEMORY_SCOPE_AGENT) : 0); }
    __syncthreads();
#pragma unroll
    for (int it = 0; it < 2; ++it) { const int a = F.tid + 512 * it;
        if (a < na) { const int pos = lbase[ee[it]] + lp[it]; lpos[a] = pos; rowmap[pos] = 2 * r0 + a; } }
    __syncthreads();
    for (int a = F.wave; a < na; a += 8) {
        const int pos = lpos[a]; const int r = r0 + (a >> 1);
        const u32x4 v0 = *(const u32x4*)(abuf + (size_t)r * 1024 + F.lane * 8), v1 = *(const u32x4*)(abuf + (size_t)r * 1024 + 512 + F.lane * 8);
        *(u32x4*)(sa + (size_t)pos * 1024 + F.lane * 8) = v0; *(u32x4*)(sa + (size_t)pos * 1024 + 512 + F.lane * 8) = v1;
    }
    if (blockIdx.x < 32) { const int e = blockIdx.x; for (int p = segs[e] + segs[40 + e] + F.tid; p < segs[e + 1]; p += 512) rowmap[p] = -1; }
    if (F.G < 32 && blockIdx.x == 0) { for (int e = F.G; e < 32; ++e) for (int p = segs[e] + segs[40 + e] + F.tid; p < segs[e + 1]; p += 512) rowmap[p] = -1; }
}

constexpr int AT_KROW = 272, AT_VROW = 136, AT_KB = 64 * AT_KROW, AT_VB = 128 * AT_VROW, AT_BUF = AT_KB + AT_VB;
DI void attn_phase(const Frame& F, int layer) {
    const int j = layer >> 1;
    const bf16_t* Qb = (const bf16_t*)(F.ws + WS_PROJ + PJ_Q); const bf16_t* Kb = (const bf16_t*)(F.ws + WS_PROJ + PJ_K); const bf16_t* VT = (const bf16_t*)(F.ws + WS_PROJ + PJ_VT);
    bf16_t* Ob = (bf16_t*)(F.ws + WS_OBUF);
    const int lane = F.lane, lr = lane & 31, lh = lane >> 5;
    const float* lam = F.a->in[11] + j * 256;
    float p01 = lam[lane] * lam[64 + lane], p23 = lam[128 + lane] * lam[192 + lane];
    p01 = wave_sum(p01, lane); p23 = wave_sum(p23, lane);
    const float lam_init = 0.8f - 0.6f * __expf(-0.3f * (float)layer);
    const float lam_full = __expf(p01) - __expf(p23) + lam_init;
    float mq = fabsf(F.a->in[9][j * 64 + lane]), mk = fabsf(F.a->in[10][j * 64 + lane]);
#pragma unroll
    for (int o = 32; o >= 1; o >>= 1) { mq = fmaxf(mq, shx(mq, o, lane)); mk = fmaxf(mk, shx(mk, o, lane)); }
    const float OFF = 8.0f * LOG2E * mq * mk;
    const float* gsub = F.a->in[12] + j * 128;
    const float osc = 1.0f - lam_init;

    for (int u = blockIdx.x; u < 2304; u += F.G) {
        int b, h, qb, nkt;
        if (u < 2048) { b = u >> 6; h = (u >> 3) & 7; qb = 1 + (u & 7); nkt = 36; } else { const int uu = u - 2048; b = uu >> 3; h = uu & 7; qb = 0; nkt = 4; }
        const size_t rowbase = (size_t)b * NTOK;
        const size_t qrow = rowbase + qb * 256 + F.wave * 32 + lr;
        __syncthreads();
        const int qlo = 2 * AT_BUF + F.wave * 8192 + lane * 16;
#pragma unroll
        for (int mp = 0; mp < 2; ++mp)
#pragma unroll
            for (int ks = 0; ks < 4; ++ks) *(LAS bf16x8*)(F.lds + qlo + (mp * 4 + ks) * 1024) = *(const bf16x8*)(Qb + qrow * 1024 + h * 128 + mp * 64 + ks * 16 + lh * 8);
        f32x16 O1[4], O2[4];
#pragma unroll
        for (int e = 0; e < 4; ++e)
#pragma unroll
            for (int i = 0; i < 16; ++i) { O1[e][i] = 0.f; O2[e][i] = 0.f; }
        float l1 = 0.f, l2 = 0.f;
        const unsigned kgo = (unsigned)((F.tid >> 4) * 1024 + (F.tid & 15) * 8), vgo = (unsigned)((F.tid >> 3) * T + (F.tid & 7) * 8);
        const int klo = (F.tid >> 4) * AT_KROW + (F.tid & 15) * 16, vlo = AT_KB + (F.tid >> 3) * AT_VROW + (F.tid & 7) * 16;
        const bf16_t* kbase = Kb + rowbase * 1024 + h * 128; const bf16_t* vbase = VT + (size_t)(h * 128) * T + rowbase;
        u32x4 sk[2], sv[2];
#pragma unroll
        for (int i = 0; i < 2; ++i) { sk[i] = *(const u32x4*)(kbase + (size_t)i * 32768 + kgo); sv[i] = *(const u32x4*)(vbase + (size_t)i * 64 * T + vgo); }
#pragma unroll
        for (int i = 0; i < 2; ++i) { *(LAS u32x4*)(F.lds + klo + i * 32 * AT_KROW) = sk[i]; *(LAS u32x2*)(F.lds + vlo + i * 64 * AT_VROW) = (u32x2){sv[i].x, sv[i].y}; *(LAS u32x2*)(F.lds + vlo + i * 64 * AT_VROW + 8) = (u32x2){sv[i].z, sv[i].w}; }
        __syncthreads();
        for (int t = 0; t < nkt; ++t) {
            const int cb = (t & 1) * AT_BUF, nb = ((t + 1) & 1) * AT_BUF;
            if (t + 1 < nkt) {
#pragma unroll
                for (int i = 0; i < 2; ++i) { sk[i] = *(const u32x4*)(kbase + (size_t)(t + 1) * 65536 + (size_t)i * 32768 + kgo); sv[i] = *(const u32x4*)(vbase + (size_t)i * 64 * T + (size_t)(t + 1) * 64 + vgo); }
            }
#pragma unroll 1
            for (int kb = 0; kb < 2; ++kb) {
                bf16x8 P[2][2];
#pragma unroll
                for (int mp = 0; mp < 2; ++mp) {
                    f32x16 S;
#pragma unroll
                    for (int i = 0; i < 16; ++i) S[i] = 0.f;
#pragma unroll
                    for (int ks = 0; ks < 4; ++ks) {
                        const bf16x8 kf = *(const LAS bf16x8*)(F.lds + cb + (kb * 32 + lr) * AT_KROW + (mp * 64 + ks * 16 + lh * 8) * 2);
                        const bf16x8 qf = *(const LAS bf16x8*)(F.lds + qlo + (mp * 4 + ks) * 1024);
                        S = __builtin_amdgcn_mfma_f32_32x32x16_bf16(kf, qf, S, 0, 0, 0);
                    }
                    float ps = 0.f;
#pragma unroll
                    for (int i = 0; i < 16; ++i) { S[i] = __builtin_amdgcn_exp2f(S[i] - OFF); ps += S[i]; }
                    if (mp == 0) l1 += ps; else l2 += ps;
#pragma unroll
                    for (int s = 0; s < 2; ++s) { u32x4 w; w.x = pk_bf16(S[8 * s], S[8 * s + 1]); w.y = pk_bf16(S[8 * s + 2], S[8 * s + 3]); w.z = pk_bf16(S[8 * s + 4], S[8 * s + 5]); w.w = pk_bf16(S[8 * s + 6], S[8 * s + 7]);
                        P[mp][s] = __builtin_bit_cast(bf16x8, w); }
                }
#pragma unroll
                for (int eb = 0; eb < 4; ++eb)
#pragma unroll
                    for (int s = 0; s < 2; ++s) {
                        const int vo = cb + AT_KB + (eb * 32 + lr) * AT_VROW + (kb * 32 + 16 * s + 4 * lh) * 2;
                        const s16x4 lo = *(const LAS s16x4*)(F.lds + vo), hi = *(const LAS s16x4*)(F.lds + vo + 16);
                        const bf16x8 vf = __builtin_shufflevector(lo, hi, 0, 1, 2, 3, 4, 5, 6, 7);
                        O1[eb] = __builtin_amdgcn_mfma_f32_32x32x16_bf16(vf, P[0][s], O1[eb], 0, 0, 0);
                        O2[eb] = __builtin_amdgcn_mfma_f32_32x32x16_bf16(vf, P[1][s], O2[eb], 0, 0, 0);
                        __builtin_amdgcn_sched_barrier(0);
                    }
            }
            if (t + 1 < nkt) {
#pragma unroll
                for (int i = 0; i < 2; ++i) { *(LAS u32x4*)(F.lds + nb + klo + i * 32 * AT_KROW) = sk[i]; *(LAS u32x2*)(F.lds + nb + vlo + i * 64 * AT_VROW) = (u32x2){sv[i].x, sv[i].y}; *(LAS u32x2*)(F.lds + nb + vlo + i * 64 * AT_VROW + 8) = (u32x2){sv[i].z, sv[i].w}; }
            }
            __syncthreads();
        }
        l1 += shx(l1, 32, lane); l2 += shx(l2, 32, lane);
        const float i1 = 1.0f / l1, i2 = lam_full / l2;
        float ss = 0.f;
#pragma unroll
        for (int e = 0; e < 4; ++e)
#pragma unroll
            for (int i = 0; i < 16; ++i) { const float o = O1[e][i] * i1 - O2[e][i] * i2; O1[e][i] = o; ss += o * o; }
        ss += shx(ss, 32, lane);
        const float rstd = __builtin_amdgcn_rsqf(ss * (1.0f / 128.0f) + RMS_EPS) * osc;
        bf16_t* orow = Ob + qrow * 1024 + h * 128;
#pragma unroll
        for (int e = 0; e < 4; ++e)
#pragma unroll
            for (int g4 = 0; g4 < 4; ++g4) {
                const int e0 = e * 32 + 8 * g4 + 4 * lh;
                const f32x4 gs = *(const f32x4*)(gsub + e0);
                u32x2 w; w.x = pk_bf16(O1[e][4 * g4] * rstd * gs[0], O1[e][4 * g4 + 1] * rstd * gs[1]); w.y = pk_bf16(O1[e][4 * g4 + 2] * rstd * gs[2], O1[e][4 * g4 + 3] * rstd * gs[3]);
                *(u32x2*)(orow + e0) = w;
            }
    }
    __syncthreads();
}

constexpr int SC_Q = 0, SC_QROW = 528, SC_K = 32 * SC_QROW, SC_V = SC_K + 16384, SC_BUF = SC_V + 16384, SC_S = 2 * SC_BUF, SC_SROW = 80, SC_RED = SC_S + 2 * 32 * SC_SROW, SC_Y = SC_RED + 1024, SC_YROW = 528;
DI void scan_phase(const Frame& F, int layer, int hf) {
    const int j = layer >> 1;
    const bf16_t* RQ = (const bf16_t*)(F.ws + WS_PROJ + PJ_RQ); bf16_t* RG = (bf16_t*)(F.ws + WS_PROJ + PJ_RG);
    const bf16_t* RKT = (const bf16_t*)(F.ws + WS_PROJ + PJ_RKT); const bf16_t* RVT = (const bf16_t*)(F.ws + WS_PROJ + PJ_RVT);
    float* ssqb = (float*)(F.ws + WS_MISC + MS_SSQ);
    const int tid = F.tid;
    for (int u = blockIdx.x; u < 256; u += F.G) {
        const int bl = u >> 4, h = (u >> 2) & 3, dir = (u >> 1) & 1, eh = u & 1;
        const float l2g = __log2f(1.0f - __expf(F.a->in[15][j * 8 + dir * 4 + h]));
        const float g32 = __builtin_amdgcn_exp2f(32.0f * l2g);
        const int sgn = dir ? -1 : 1, kd_a = dir ? 0 : 31, qd_a = dir ? 32 : 1;
        const size_t rb = (size_t)bl * NTOK;
        const bf16_t* qbase = RQ + rb * 1024 + h * 256;
        const bf16_t* ktbase = RKT + (size_t)(h * 256) * HROWS + rb;
        const bf16_t* vtbase = RVT + (size_t)(h * 512 + eh * 256) * HROWS + rb;
        bf16_t* gbase = RG + (rb + (tid >> 4)) * 4096 + dir * 2048 + h * 512 + eh * 256 + (tid & 15) * 16;
        const int qt = tid >> 5, qc = tid & 31;
        const unsigned qgo = (unsigned)(qt * 1024 + qc * 8);
        const int ql0 = SC_Q + qt * SC_QROW + qc * 16, ql1 = ql0 + 16 * SC_QROW;
        const int kd = tid >> 2, kc = tid & 3;
        const unsigned kgo = (unsigned)(kd * HROWS + kc * 8);
        const int kl = kd * 64 + (((kc ^ (kd >> 2)) & 3) << 4);
        f32x16 S[8];
#pragma unroll
        for (int d = 0; d < 8; ++d)
#pragma unroll
            for (int i = 0; i < 16; ++i) S[d][i] = 0.f;
        u32x4 sq[2], sk[2], sv[2];
        __syncthreads();
        {
            const int tok0 = dir ? 224 : 0;
#pragma unroll
            for (int i = 0; i < 2; ++i) { sq[i] = *(const u32x4*)(qbase + (size_t)(tok0 + 16 * i) * 1024 + qgo); sk[i] = *(const u32x4*)(ktbase + (size_t)i * 128 * HROWS + tok0 + kgo); sv[i] = *(const u32x4*)(vtbase + (size_t)i * 128 * HROWS + tok0 + kgo); }
            *(LAS u32x4*)(F.lds + ql0) = sq[0]; *(LAS u32x4*)(F.lds + ql1) = sq[1];
#pragma unroll
            for (int i = 0; i < 2; ++i) { *(LAS u32x4*)(F.lds + SC_K + kl + i * 8192) = sk[i]; *(LAS u32x4*)(F.lds + SC_V + kl + i * 8192) = sv[i]; }
        }
        __syncthreads();
        for (int ci = 0; ci < 72; ++ci) {
            const int tok0 = dir ? 32 * ((ci < 8 ? 7 : 79) - ci) : 32 * ci;
            const int t2 = launder(tid); const int lane = t2 & 63, lr = lane & 31, lh = lane >> 5, w = __builtin_amdgcn_readfirstlane(t2 >> 6), op = t2 >> 4, oc = t2 & 15;
            float l2c = l2g; asm volatile("" : "+v"(l2c));
            const int cb = (ci & 1) * SC_BUF, nb = SC_BUF - cb, sb = SC_S + (ci & 1) * 32 * SC_SROW;
            if (ci + 1 < 72) {
                const int cn = ci + 1; const int tn = dir ? 32 * ((cn < 8 ? 7 : 79) - cn) : 32 * cn;
#pragma unroll
                for (int i = 0; i < 2; ++i) { sq[i] = *(const u32x4*)(qbase + (size_t)(tn + 16 * i) * 1024 + qgo); sk[i] = *(const u32x4*)(ktbase + (size_t)i * 128 * HROWS + tn + kgo); sv[i] = *(const u32x4*)(vtbase + (size_t)i * 128 * HROWS + tn + kgo); }
            }
            const u32x4 gt0 = *(const u32x4*)(gbase + (size_t)tok0 * 4096), gt1 = *(const u32x4*)(gbase + (size_t)tok0 * 4096 + 8);
            if (w < 4) {
                const int p0 = 16 * (w >> 1), m0 = 16 * (w & 1);
                const int l15 = lane & 15, g4 = lane >> 4, tq = l15 >> 2, tp = l15 & 3;
                f32x4 sc = {0.f, 0.f, 0.f, 0.f};
                const bool dead = sgn * (p0 - m0) < 0;
                if (!dead) {
#pragma unroll
                    for (int ks = 0; ks < 8; ++ks) {
                        const int prow = p0 + l15, qchunk = 4 * ks + g4;
                        const bf16x8 af = *(const LAS bf16x8*)(F.lds + cb + SC_Q + prow * SC_QROW + qchunk * 16);
                        const int d0 = 32 * ks + 8 * g4 + tq, cc = (m0 >> 3) + (tp >> 1);
                        const s16x4 b0 = __builtin_amdgcn_ds_read_tr16_b64_v4i16((LAS s16x4*)(F.lds + cb + SC_K + d0 * 64 + (((cc ^ (d0 >> 2)) & 3) << 4) + 8 * (tp & 1)));
                        const s16x4 b1 = __builtin_amdgcn_ds_read_tr16_b64_v4i16((LAS s16x4*)(F.lds + cb + SC_K + (d0 + 4) * 64 + (((cc ^ ((d0 + 4) >> 2)) & 3) << 4) + 8 * (tp & 1)));
                        const bf16x8 bfr = __builtin_shufflevector(b0, b1, 0, 1, 2, 3, 4, 5, 6, 7);
                        sc = __builtin_amdgcn_mfma_f32_16x16x32_bf16(af, bfr, sc, 0, 0, 0);
                    }
                }
                const int mm = m0 + l15;
#pragma unroll
                for (int r = 0; r < 4; ++r) { const int pp = p0 + 4 * g4 + r; const int df = sgn * (pp - mm);
                    const float v = df >= 0 ? sc[r] * __builtin_amdgcn_exp2f((float)df * l2c) : 0.f;
                    *(LAS bf16_t*)(F.lds + sb + pp * SC_SROW + mm * 2) = (bf16_t)(pk_bf16(v, 0.f) & 0xffffu); }
            }
            __syncthreads();
            bf16x8 vf[2], vd[2];
            {
                const int e = 32 * w + lr;
#pragma unroll
                for (int ks = 0; ks < 2; ++ks) {
                    const int cc = 2 * ks + lh;
                    vf[ks] = *(const LAS bf16x8*)(F.lds + cb + SC_V + e * 64 + (((cc ^ (e >> 2)) & 3) << 4));
                    const u32x4 raw = __builtin_bit_cast(u32x4, vf[ks]); u32x4 o;
                    float kd8[8];
#pragma unroll
                    for (int jj = 0; jj < 8; ++jj) { const int t = 16 * ks + 8 * lh + jj; kd8[jj] = __builtin_amdgcn_exp2f((float)(kd_a - sgn * t) * l2c); }
                    o.x = pk_bf16(bf_lo(raw.x) * kd8[0], bf_hi(raw.x) * kd8[1]); o.y = pk_bf16(bf_lo(raw.y) * kd8[2], bf_hi(raw.y) * kd8[3]);
                    o.z = pk_bf16(bf_lo(raw.z) * kd8[4], bf_hi(raw.z) * kd8[5]); o.w = pk_bf16(bf_lo(raw.w) * kd8[6], bf_hi(raw.w) * kd8[7]);
                    vd[ks] = __builtin_bit_cast(bf16x8, o);
                }
            }
            f32x16 Y;
#pragma unroll
            for (int i = 0; i < 16; ++i) Y[i] = 0.f;
#pragma unroll
            for (int dt = 0; dt < 8; ++dt)
#pragma unroll
                for (int s = 0; s < 2; ++s) {
                    u32x4 pb; pb.x = pk_bf16(S[dt][8 * s], S[dt][8 * s + 1]); pb.y = pk_bf16(S[dt][8 * s + 2], S[dt][8 * s + 3]); pb.z = pk_bf16(S[dt][8 * s + 4], S[dt][8 * s + 5]); pb.w = pk_bf16(S[dt][8 * s + 6], S[dt][8 * s + 7]);
                    const int c0 = 4 * dt + 2 * s;
                    const s16x4 a0 = *(const LAS s16x4*)(F.lds + cb + SC_Q + lr * SC_QROW + c0 * 16 + 8 * lh);
                    const s16x4 a1 = *(const LAS s16x4*)(F.lds + cb + SC_Q + lr * SC_QROW + c0 * 16 + 16 + 8 * lh);
                    const bf16x8 af = __builtin_shufflevector(a0, a1, 0, 1, 2, 3, 4, 5, 6, 7);
                    Y = __builtin_amdgcn_mfma_f32_32x32x16_bf16(af, __builtin_bit_cast(bf16x8, pb), Y, 0, 0, 0);
                    __builtin_amdgcn_sched_barrier(0);
                }
#pragma unroll
            for (int r = 0; r < 16; ++r) { const int p = (r & 3) + 8 * (r >> 2) + 4 * lh; Y[r] *= __builtin_amdgcn_exp2f((float)(qd_a + sgn * p) * l2c); }
#pragma unroll
            for (int ks = 0; ks < 2; ++ks) {
                const bf16x8 sf = *(const LAS bf16x8*)(F.lds + sb + lr * SC_SROW + (16 * ks + 8 * lh) * 2);
                Y = __builtin_amdgcn_mfma_f32_32x32x16_bf16(sf, vf[ks], Y, 0, 0, 0);
            }
#pragma unroll
            for (int dt = 0; dt < 8; ++dt) {
#pragma unroll
                for (int i = 0; i < 16; ++i) S[dt][i] *= g32;
#pragma unroll
                for (int ks = 0; ks < 2; ++ks) {
                    const int d = 32 * dt + lr, cc = 2 * ks + lh;
                    const bf16x8 kf = *(const LAS bf16x8*)(F.lds + cb + SC_K + d * 64 + (((cc ^ (d >> 2)) & 3) << 4));
                    S[dt] = __builtin_amdgcn_mfma_f32_32x32x16_bf16(kf, vd[ks], S[dt], 0, 0, 0);
                }
                __builtin_amdgcn_sched_barrier(0);
            }
            float q2[16];
#pragma unroll
            for (int r = 0; r < 16; ++r) { const float y = Y[r]; q2[r] = y * y;
                *(LAS bf16_t*)(F.lds + SC_Y + ((r & 3) + 8 * (r >> 2) + 4 * lh) * SC_YROW + (w * 32 + lr) * 2) = (bf16_t)(pk_bf16(y, 0.f) & 0xffffu); }
            {
                float a8[8];
#pragma unroll
                for (int i = 0; i < 8; ++i) { const bool hi = lr & 16; const float keep = hi ? q2[i + 8] : q2[i], send = hi ? q2[i] : q2[i + 8]; a8[i] = keep + shx(send, 16, lane); }
                float a4[4];
#pragma unroll
                for (int i = 0; i < 4; ++i) { const bool hi = lr & 8; const float keep = hi ? a8[i + 4] : a8[i], send = hi ? a8[i] : a8[i + 4]; a4[i] = keep + shx(send, 8, lane); }
                float a2[2];
#pragma unroll
                for (int i = 0; i < 2; ++i) { const bool hi = lr & 4; const float keep = hi ? a4[i + 2] : a4[i], send = hi ? a4[i] : a4[i + 2]; a2[i] = keep + shx(send, 4, lane); }
                float a1; { const bool hi = lr & 2; const float keep = hi ? a2[1] : a2[0], send = hi ? a2[0] : a2[1]; a1 = keep + shx(send, 2, lane); }
                a1 += shx(a1, 1, lane);
                const int r = (lr >> 1) & 15, p = (r & 3) + 8 * (r >> 2) + 4 * lh;
                if (!(lr & 1)) *(LAS float*)(F.lds + SC_RED + (w * 32 + p) * 4) = a1;
            }
            if (ci + 1 < 72) {
                *(LAS u32x4*)(F.lds + nb + ql0) = sq[0]; *(LAS u32x4*)(F.lds + nb + ql1) = sq[1];
#pragma unroll
                for (int i = 0; i < 2; ++i) { *(LAS u32x4*)(F.lds + nb + SC_K + kl + i * 8192) = sk[i]; *(LAS u32x4*)(F.lds + nb + SC_V + kl + i * 8192) = sv[i]; }
            }
            __syncthreads();
            {
                const u32x4 y0 = *(const LAS u32x4*)(F.lds + SC_Y + op * SC_YROW + oc * 32), y1 = *(const LAS u32x4*)(F.lds + SC_Y + op * SC_YROW + oc * 32 + 16);
                u32x4 z0, z1;
                z0.x = pk_bf16(bf_lo(y0.x) * bf_lo(gt0.x), bf_hi(y0.x) * bf_hi(gt0.x)); z0.y = pk_bf16(bf_lo(y0.y) * bf_lo(gt0.y), bf_hi(y0.y) * bf_hi(gt0.y));
                z0.z = pk_bf16(bf_lo(y0.z) * bf_lo(gt0.z), bf_hi(y0.z) * bf_hi(gt0.z)); z0.w = pk_bf16(bf_lo(y0.w) * bf_lo(gt0.w), bf_hi(y0.w) * bf_hi(gt0.w));
                z1.x = pk_bf16(bf_lo(y1.x) * bf_lo(gt1.x), bf_hi(y1.x) * bf_hi(gt1.x)); z1.y = pk_bf16(bf_lo(y1.y) * bf_lo(gt1.y), bf_hi(y1.y) * bf_hi(gt1.y));
                z1.z = pk_bf16(bf_lo(y1.z) * bf_lo(gt1.z), bf_hi(y1.z) * bf_hi(gt1.z)); z1.w = pk_bf16(bf_lo(y1.w) * bf_lo(gt1.w), bf_hi(y1.w) * bf_hi(gt1.w));
                *(u32x4*)(gbase + (size_t)tok0 * 4096) = z0; *(u32x4*)(gbase + (size_t)tok0 * 4096 + 8) = z1;
            }
            if (tid < 32) { float s = 0.f;
#pragma unroll
                for (int ww = 0; ww < 8; ++ww) s += *(const LAS float*)(F.lds + SC_RED + (ww * 32 + tid) * 4);
                ssqb[(((size_t)eh * 2 + dir) * HROWS + rb + tok0 + tid) * 4 + h] = s; }
        }
    }
    __syncthreads();
}

DI void comb_phase(const Frame& F, int hf) {
    const bf16_t* PJ = (const bf16_t*)(F.ws + WS_PROJ + PJ_RG);
    const float* ssqb = (const float*)(F.ws + WS_MISC + MS_SSQ);
    bf16_t* O = (bf16_t*)(F.ws + (hf == 0 ? WS_OBUF : WS_ABUF));
    for (int r = blockIdx.x * 8 + F.wave; r < 36864; r += F.G * 8) {
#pragma unroll
        for (int i = 0; i < 4; ++i) {
            const float sf = ssqb[((size_t)(0 * 2 + 0) * 36864 + r) * 4 + i] + ssqb[((size_t)(1 * 2 + 0) * 36864 + r) * 4 + i];
            const float sb = ssqb[((size_t)(0 * 2 + 1) * 36864 + r) * 4 + i] + ssqb[((size_t)(1 * 2 + 1) * 36864 + r) * 4 + i];
            const float rf = 1.0f / sqrtf(sf * (1.0f / 512.0f) + RMS_EPS), rb = 1.0f / sqrtf(sb * (1.0f / 512.0f) + RMS_EPS);
            const int c = i * 512 + F.lane * 8;
            const u32x4 zf = *(const u32x4*)(PJ + (size_t)r * 4096 + c), zb = *(const u32x4*)(PJ + (size_t)r * 4096 + 2048 + c);
            u32x4 w;
            w.x = pk_bf16(rf * bf_lo(zf.x) + rb * bf_lo(zb.x), rf * bf_hi(zf.x) + rb * bf_hi(zb.x));
            w.y = pk_bf16(rf * bf_lo(zf.y) + rb * bf_lo(zb.y), rf * bf_hi(zf.y) + rb * bf_hi(zb.y));
            w.z = pk_bf16(rf * bf_lo(zf.z) + rb * bf_lo(zb.z), rf * bf_hi(zf.z) + rb * bf_hi(zb.z));
            w.w = pk_bf16(rf * bf_lo(zf.w) + rb * bf_lo(zb.w), rf * bf_hi(zf.w) + rb * bf_hi(zb.w));
            *(u32x4*)(O + (size_t)r * 2048 + c) = w;
        }
    }
}

DI void final_phase(const Frame& F) {
    const bf16_t* y2 = (const bf16_t*)(F.ws + WS_PROJ + PJ_Y2);
    for (int r = blockIdx.x * 8 + F.wave; r < T; r += F.G * 8) {
        const int b = r / NTOK, n = r % NTOK; if (n < CTXL) continue;
        float* hp = F.out + ((size_t)b * 2048 + (n - 256)) * 1024; const float* modp = mod_lat(F, 3, b);
#pragma unroll
        for (int i = 0; i < 4; ++i) {
            f32x4 x = *(const f32x4*)(hp + i * 256 + F.lane * 4);
            const u32x2 a = *(const u32x2*)(y2 + (size_t)(2 * r) * 1024 + i * 256 + F.lane * 4), c = *(const u32x2*)(y2 + (size_t)(2 * r + 1) * 1024 + i * 256 + F.lane * 4);
            const f32x4 g2 = *(const f32x4*)(modp + 5120 + i * 256 + F.lane * 4);
            x[0] += g2[0] * (bf_lo(a.x) + bf_lo(c.x)); x[1] += g2[1] * (bf_hi(a.x) + bf_hi(c.x)); x[2] += g2[2] * (bf_lo(a.y) + bf_lo(c.y)); x[3] += g2[3] * (bf_hi(a.y) + bf_hi(c.y));
            *(f32x4*)(hp + i * 256 + F.lane * 4) = x;
        }
    }
}

constexpr int NPHASE = 50;
__global__ void __launch_bounds__(512, 2) fwd_kernel(Args args) {
    extern __shared__ __attribute__((aligned(16))) unsigned char lds_raw[];
    Frame F;
    F.a = &args;
    F.out = args.out; F.ws = args.ws; F.lds = (LAS unsigned char*)lds_raw;
    F.tid = threadIdx.x; F.lane = F.tid & 63; F.wave = __builtin_amdgcn_readfirstlane(F.tid >> 6); F.G = gridDim.x;
    const int lo = args.ph_lo, hi = args.ph_hi;
    const int wave_s = __builtin_amdgcn_readfirstlane((int)threadIdx.x >> 6);
    volatile LAS unsigned* bst = (volatile LAS unsigned*)(F.lds + LDS_MISC);
    if (F.tid < 4) bst[F.tid] = 0u;
    __syncthreads();
    XcdBarrier bar; bar.bar = (unsigned*)(F.ws + WS_CTL) + CW_BAR; bar.x = 0; bar.st = bst;
    if (hi - lo > 1) bar = xcd_barrier_post((unsigned*)(F.ws + WS_CTL) + CW_BAR, bst);
#ifndef PH_MASK
#define PH_MASK 0xFFFFFFFFu
#endif
#define PHASE(site, p, ...) do { if (((PH_MASK >> (site)) & 1u) && lo <= (p) && (p) < hi) { F.ws = launder_p(args.ws); F.out = (float*)launder_p((unsigned char*)args.out); F.tid = (wave_s << 6) | lane_id_asm(); F.lane = F.tid & 63; F.wave = __builtin_amdgcn_readfirstlane(F.tid >> 6); __VA_ARGS__; if ((p) + 1 < hi) xcd_barrier(bar, F.tid); } } while (0)

    PHASE(0, 0, p0_prologue(F));
    for (int layer = 0; layer < DEPTH; ++layer) {
        const int pb = 1 + 12 * layer, j = layer >> 1; const bool isRT = layer & 1;
        PHASE(1, pb + 0, { norm_phase<false>(F, layer); if (layer > 0) convert_moe_weights(F, layer); });
        if (!isRT) {
            PHASE(2, pb + 1, {
                ProbQKV S; S.K = 1024; S.abuf = (const char*)(F.ws + WS_ABUF); S.wqk = (const char*)(F.ws + WS_WQK) + (size_t)j * 2048 * 1024 * 2; S.wv = (const char*)(F.ws + WS_WV) + (size_t)j * 1024 * 1024 * 2;
                S.go.init(NTILE, 8); S.G = F.G; S.c = blockIdx.x;
                EpiQKV E{(bf16_t*)(F.ws + WS_PROJ + PJ_Q), (bf16_t*)(F.ws + WS_PROJ + PJ_K), (bf16_t*)(F.ws + WS_PROJ + PJ_VT), F.a->in[9] + j * 64, F.a->in[10] + j * 64,
                         (const float*)(F.ws + WS_ROPE + RP_CDA), (const float*)(F.ws + WS_ROPE + RP_SDA)};
                pg8::gemm_phase<EpiQKV, ProbQKV, true>(F.lds, S, E, F.tid);
            });
            PHASE(3, pb + 2, attn_phase(F, layer));
        } else {
            for (int hf = 0; hf < 2; ++hf) {
                PHASE(4, pb + 1 + 3 * hf, {
                    ProbWIN S; S.K = 1024; S.abuf = (const char*)(F.ws + WS_ABUF) + (size_t)hf * 144 * 256 * 1024 * 2; S.win = (const char*)(F.ws + WS_WIN) + (size_t)j * 8192 * 1024 * 2;
                    S.go.init(144, 20); S.G = F.G; S.c = blockIdx.x;
                    EpiWIN E{(bf16_t*)(F.ws + WS_PROJ + PJ_RQ), (bf16_t*)(F.ws + WS_PROJ + PJ_RG), (bf16_t*)(F.ws + WS_PROJ + PJ_RKT), (bf16_t*)(F.ws + WS_PROJ + PJ_RVT), hf * 144,
                             (const float*)(F.ws + WS_ROPE + RP_CRT), (const float*)(F.ws + WS_ROPE + RP_SRT), (const float*)(F.ws + WS_MISC + MS_CRTT), (const float*)(F.ws + WS_MISC + MS_SRTT)};
                    pg8::gemm_phase<EpiWIN, ProbWIN, true>(F.lds, S, E, F.tid);
                });
                PHASE(5, pb + 2 + 3 * hf, scan_phase(F, layer, hf));
                PHASE(6, pb + 3 + 3 * hf, comb_phase(F, hf));
            }
        }
        PHASE(7, pb + 7, {
            ProbDense S; S.G = F.G; S.c = blockIdx.x; S.go.init(NTILE, 4);
            if (!isRT) { S.K = 1024; S.A0 = (const char*)(F.ws + WS_OBUF); S.A1 = S.A0; S.pm_split = 1 << 30; S.Bt = (const char*)(F.ws + WS_WODA) + (size_t)j * 1024 * 1024 * 2; }
            else { S.K = 2048; S.A0 = (const char*)(F.ws + WS_OBUF); S.A1 = (const char*)(F.ws + WS_ABUF); S.pm_split = 144; S.Bt = (const char*)(F.ws + WS_WORT) + (size_t)j * 1024 * 2048 * 2; }
            float* hctx = (float*)(F.ws + WS_HCTX);
            EpiResid E{layer == 0 ? F.a->in[2] : hctx, layer == 0 ? F.a->in[0] : F.out, hctx, F.out, (const float*)(F.ws + WS_ADA) + (size_t)layer * 33 * 6144};
            pg8::gemm_phase<EpiResid, ProbDense, true>(F.lds, S, E, F.tid);
        });
        PHASE(8, pb + 8, norm_phase<true>(F, layer));
        PHASE(9, pb + 9, sort_phase(F, layer));
        PHASE(10, pb + 10, {
            LAS int* segs = (LAS int*)(F.lds + LDS_MISC + 2048); LAS int* tile_e = (LAS int*)(F.lds + LDS_TILE_E);
            const int ntl = build_segments(F, layer, segs, tile_e);
            ProbMoE S; S.K = 1024; S.A = (const char*)(F.ws + WS_PROJ + PJ_SA); S.W = (const char*)(F.ws + WS_WGU); S.tile_e = tile_e; S.go.init(ntl, 4); S.G = F.G; S.c = blockIdx.x;
            EpiSwiGLU E{(bf16_t*)(F.ws + WS_PROJ + PJ_ACT)};
            pg8::gemm_phase<EpiSwiGLU, ProbMoE, true>(F.lds, S, E, F.tid);
        });
        PHASE(11, pb + 11, {
            LAS int* segs = (LAS int*)(F.lds + LDS_MISC + 2048); LAS int* tile_e = (LAS int*)(F.lds + LDS_TILE_E);
            const int ntl = build_segments(F, layer, segs, tile_e);
            ProbMoE S; S.K = 512; S.A = (const char*)(F.ws + WS_PROJ + PJ_ACT); S.W = (const char*)(F.ws + WS_WD); S.tile_e = tile_e; S.go.init(ntl, 4); S.G = F.G; S.c = blockIdx.x;
            EpiDown E{(bf16_t*)(F.ws + WS_PROJ + PJ_Y2), (const int*)(F.ws + WS_MISC + MS_ROWMAP), (const float*)(F.ws + WS_MISC + MS_WSEL)};
            pg8::gemm_phase<EpiDown, ProbMoE, true>(F.lds, S, E, F.tid);
        });
    }
    PHASE(12, 49, final_phase(F));
#undef PHASE
}

static bool phase_exists(int p) {
    if (p == 0 || p == 49) return true;
    const int layer = (p - 1) / 12, slot = (p - 1) % 12; const bool isRT = layer & 1;
    if (!isRT && slot >= 3 && slot <= 6) return false;
    return true;
}
extern "C" void kernel_launch(void* const* d_in, const int* in_sizes, int n_in, void* d_out, int out_size, void* d_ws, size_t ws_size, hipStream_t stream) {
    static int grid = 0;
    if (grid == 0) {
        if (n_in != 24 || ws_size < WS_END) { fprintf(stderr, "kernel_launch: need 24 inputs and >= %zu bytes of workspace (got %d, %zu)\n", (size_t)WS_END, n_in, ws_size); grid = -1; return; }
        int dev = 0, cus = 0, per_cu = 0;
        if (hipGetDevice(&dev) != hipSuccess || hipDeviceGetAttribute(&cus, hipDeviceAttributeMultiprocessorCount, dev) != hipSuccess) { grid = -1; return; }
        if (hipFuncSetAttribute((const void*)fwd_kernel, hipFuncAttributeMaxDynamicSharedMemorySize, LDS_BYTES) != hipSuccess) { fprintf(stderr, "kernel_launch: hipFuncSetAttribute failed\n"); grid = -1; return; }
        if (hipOccupancyMaxActiveBlocksPerMultiprocessor(&per_cu, (const void*)fwd_kernel, 512, LDS_BYTES) != hipSuccess || per_cu < 1) fprintf(stderr, "kernel_launch: occupancy query reports %d\n", per_cu);
        (void)hipGetLastError();
        grid = cus;
    }
    if (grid < 0) return;
    (void)hipMemsetAsync((char*)d_ws + WS_CTL, 0, 1 * MiB, stream);
    Args a{};
    for (int i = 0; i < 24; ++i) a.in[i] = (const float*)d_in[i];
    a.out = (float*)d_out; a.ws = (unsigned char*)d_ws;
#ifdef MULTI_LAUNCH
    for (int p = 0; p < NPHASE; ++p) { if (!phase_exists(p)) continue; a.ph_lo = p; a.ph_hi = p + 1; hipLaunchKernelGGL(fwd_kernel, dim3(grid), dim3(512), LDS_BYTES, stream, a); }
#else
    a.ph_lo = 0; a.ph_hi = NPHASE; hipLaunchKernelGGL(fwd_kernel, dim3(grid), dim3(512), LDS_BYTES, stream, a);
#endif
}
```

```cpp
#include <hip/hip_runtime.h>
#include <cstdio>
#include <cstdint>

#define LAS __attribute__((address_space(3)))
#define DI __device__ __forceinline__
typedef unsigned short bf16_t;
typedef short bf16x8 __attribute__((ext_vector_type(8)));
typedef short s16x4 __attribute__((ext_vector_type(4)));
typedef float f32x4 __attribute__((ext_vector_type(4)));
typedef float f32x2 __attribute__((ext_vector_type(2)));
typedef float f32x16 __attribute__((ext_vector_type(16)));
typedef unsigned u32x4 __attribute__((ext_vector_type(4)));
typedef unsigned u32x2 __attribute__((ext_vector_type(2)));
typedef __bf16 bf16x2_t __attribute__((ext_vector_type(2)));

#define GAS __attribute__((address_space(1)))
template <class V, class T> DI V ldg(const T* p) { return *(const GAS V*)(unsigned long long)p; }
template <class V, class T> DI void stg(T* p, V v) { *(GAS V*)(unsigned long long)p = v; }
DI unsigned pk_bf16(float lo, float hi) { f32x2 v = {lo, hi}; return __builtin_bit_cast(unsigned, __builtin_convertvector(v, bf16x2_t)); }
DI float bf_lo(unsigned u) { return __uint_as_float(u << 16); }
DI float bf_hi(unsigned u) { return __uint_as_float(u & 0xffff0000u); }
DI float bf_f(bf16_t v) { return __uint_as_float(((unsigned)v) << 16); }
DI unsigned char* launder_p(unsigned char* p) { asm volatile("" : "+s"(p)); return p; }
DI float shx(float v, int o, int lane) { return __builtin_bit_cast(float, __builtin_amdgcn_ds_bpermute((lane ^ o) << 2, __builtin_bit_cast(int, v))); }
DI float wave_sum(float v, int lane) {
#pragma unroll
    for (int o = 32; o >= 1; o >>= 1) v += shx(v, o, lane);
    return v;
}
DI int lane_id_asm() { int x; asm volatile("v_mbcnt_lo_u32_b32 %0, -1, 0\n\tv_mbcnt_hi_u32_b32 %0, -1, %0" : "=v"(x)); return x; }
DI int launder(int x) { asm volatile("" : "+v"(x)); return x; }
DI float silu_f(float x) { return x / (1.0f + __expf(-x)); }

constexpr int NB = 32, SEQ = 2048, CTXL = 256, NTOK = SEQ + CTXL, DM = 1024, DEPTH = 4;
constexpr int T = NB * NTOK;
constexpr int NTILE = T / 256;
constexpr int NEXP = 32, MOEH = 512;
constexpr int MAXROWS = 2 * T + NEXP * 256;
constexpr float RMS_EPS = 1e-6f;
constexpr float LOG2E = 1.4426950408889634f;

constexpr size_t MiB = 1ull << 20;
constexpr size_t WS_CTL = 0;
constexpr size_t WS_ADA = 1 * MiB;
constexpr size_t WS_ROPE = 5 * MiB;
constexpr size_t WS_MISC = 8 * MiB;
constexpr size_t WS_HCTX = 16 * MiB;
constexpr size_t WS_WQK = 48 * MiB;
constexpr size_t WS_WV = 56 * MiB;
constexpr size_t WS_WODA = 60 * MiB;
constexpr size_t WS_WIN = 64 * MiB;
constexpr size_t WS_WORT = 96 * MiB;
constexpr size_t WS_WGU = 104 * MiB;
constexpr size_t WS_WD = 168 * MiB;
constexpr size_t WS_ABUF = 200 * MiB;
constexpr size_t WS_OBUF = 344 * MiB;
constexpr size_t WS_PROJ = 488 * MiB;
constexpr size_t WS_END = 1064 * MiB;
constexpr size_t PJ_Q = 0, PJ_K = 144 * MiB, PJ_VT = 288 * MiB;
constexpr size_t PJ_SA = 0, PJ_ACT = 304 * MiB, PJ_Y2 = 0;
constexpr size_t PJ_RQ = 0, PJ_RG = 72 * MiB, PJ_RKT = 360 * MiB, PJ_RVT = 432 * MiB;
constexpr int HROWS = 36864;
constexpr size_t RP_CDA = 0, RP_SDA = 256 * 1024, RP_CRT = 512 * 1024, RP_SRT = 512 * 1024 + 1 * MiB;
constexpr size_t MS_EID = 0, MS_WSEL = 1 * MiB, MS_ROWMAP = 2 * MiB, MS_SSQ = 3 * MiB, MS_CRTT = 6 * MiB, MS_SRTT = 7 * MiB;
constexpr int CW_BAR = 0;
constexpr int CW_CNT = 4096;
constexpr int CW_CUR = 4096 + 256;

constexpr int LDS_BYTES = 155648;
constexpr int LDS_MISC = 147456;
constexpr int LDS_TILE_E = 131072;

#define XB_TMO      128
#define XB_XCNT(j)  (256  + 64 * (j))
#define XB_XSUB(j)  (1280 + 64 * (j))
#define XB_XGEN(j)  (2304 + 64 * (j))
#define XB_TOP      3328
#define XB_TOPGEN   3392
#define XCD_BAR_WORDS 3456
#define XB_SPIN_CAP (1u << 18)

__device__ __forceinline__ unsigned xb_ld(unsigned* p)              { return __hip_atomic_load(p, __ATOMIC_RELAXED, __HIP_MEMORY_SCOPE_AGENT); }
__device__ __forceinline__ unsigned xb_add(unsigned* p, unsigned v) { return __hip_atomic_fetch_add(p, v, __ATOMIC_RELAXED, __HIP_MEMORY_SCOPE_AGENT); }
__device__ __forceinline__ unsigned xb_xcc_id() { return (unsigned)__builtin_amdgcn_s_getreg((3 << 11) | 20) & 0xFu; }
#define XB_SPIN(cond, bar) do { unsigned _sp = 0; while (cond) { __builtin_amdgcn_s_sleep(1); \
    if ((++_sp & 255u) == 0u) { if (xb_ld(&(bar)[XB_TMO])) break; if (_sp > XB_SPIN_CAP) { atomicAdd(&(bar)[XB_TMO], 1u); break; } } } } while (0)

struct XcdBarrier { unsigned* bar; unsigned x; volatile LAS unsigned* st; };

__device__ __forceinline__ XcdBarrier xcd_barrier_post(unsigned* bar, volatile LAS unsigned* st) {
    XcdBarrier b; b.bar = bar; b.x = xb_xcc_id(); b.st = st;
    if (threadIdx.x == 0) (void)xb_add(&bar[XB_XCNT(b.x)], 1u);
    return b;
}
__device__ __forceinline__ void xcd_barrier_complete(unsigned* bar, unsigned x, unsigned& nloc, unsigned& nx) {
    const unsigned G = gridDim.x * gridDim.y * gridDim.z;
    unsigned sum, cnt, mine, sp = 0u;
    for (;;) {
        sum = 0u; cnt = 0u; mine = 0u;
#pragma unroll
        for (unsigned j = 0; j < 16; ++j) { const unsigned c = xb_ld(&bar[XB_XCNT(j)]); sum += c; cnt += (c > 0u) ? 1u : 0u; mine = (j == x) ? c : mine; }
        if (sum == G) break;
        __builtin_amdgcn_s_sleep(1);
        if ((++sp & 255u) == 0u) { if (xb_ld(&bar[XB_TMO])) break; if (sp > XB_SPIN_CAP) { atomicAdd(&bar[XB_TMO], 1u); break; } }
    }
    nloc = mine > 0u ? mine : 1u; nx = cnt > 0u ? cnt : 1u;
}
__device__ __forceinline__ void xcd_barrier(const XcdBarrier& b, const int tid0) {
    asm volatile("s_waitcnt vmcnt(0)" ::: "memory");
    __syncthreads();
    if (tid0 == 0) {
        unsigned* bar = (unsigned*)launder_p((unsigned char*)b.bar);
        __builtin_amdgcn_s_waitcnt(0);
        unsigned nloc = b.st[0], nx = b.st[1];
        if (nloc == 0u) { xcd_barrier_complete(bar, b.x, nloc, nx); b.st[0] = nloc; b.st[1] = nx; }
        const unsigned old = xb_add(&bar[XB_XSUB(b.x)], 1u);
        const unsigned gen = old / nloc;
        if (old + 1u == (gen + 1u) * nloc) {
            __builtin_amdgcn_fence(__ATOMIC_RELEASE, "agent");
            asm volatile("s_waitcnt vmcnt(0)" ::: "memory");
            const unsigned og = xb_add(&bar[XB_TOP], 1u);
            const unsigned tg = og / nx;
            if (og + 1u == (tg + 1u) * nx) xb_add(&bar[XB_TOPGEN], 1u);
            else XB_SPIN(xb_ld(&bar[XB_TOPGEN]) == tg, bar);
            __builtin_amdgcn_fence(__ATOMIC_ACQUIRE, "agent");
            xb_add(&bar[XB_XGEN(b.x)], 1u);
            asm volatile("s_waitcnt vmcnt(0)" ::: "memory");
        } else {
            XB_SPIN(xb_ld(&bar[XB_XGEN(b.x)]) == gen, bar);
            __builtin_amdgcn_fence(__ATOMIC_ACQUIRE, "agent");
            asm volatile("s_waitcnt vmcnt(0)" ::: "memory");
        }
    }
    __syncthreads();
}

struct Args { const float* in[24]; float* out; unsigned char* ws; int ph_lo, ph_hi; };
struct Frame {
    const Args* a; float* out; unsigned char* ws; LAS unsigned char* lds;
    int tid, lane, wave, G, bid;
};
DI const float* mod_lat(const Frame& F, int layer, int b) { return (const float*)(F.ws + WS_ADA) + ((size_t)layer * 33 + b) * 6144; }
DI const float* mod_ctx(const Frame& F, int layer) { return (const float*)(F.ws + WS_ADA) + ((size_t)layer * 33 + 32) * 6144; }

namespace pg8 {
constexpr int BM = 256, BK = 64, HALF = 128, HTB = HALF * BK * 2, STAGE_BYTES = 8 * HTB, NXCD = 8, WGM = 8;
__host__ __device__ __forceinline__ int lds_byte(int r, int c) { const int st = (r >> 4) * 2 + (c >> 5), rr = r & 15, cc = c & 31, ob = rr * 64 + cc * 2; return st * 1024 + (ob ^ (((ob >> 9) & 1) << 5)); }
__host__ __device__ __forceinline__ void stage_rc(int b, int& R, int& C) { const int st = b / 1024, sb = b % 1024, swz = sb ^ (((sb >> 9) & 1) << 5); R = (st >> 1) * 16 + swz / 64; C = (st & 1) * 32 + (swz % 64) / 2; }
__host__ __device__ __forceinline__ int perm32(int rho) { const int n = rho >> 4, i = rho & 15; return 8 * (i >> 2) + 4 * n + (i & 3); }

struct Unit { int pm, pn, kind; };

struct GridOrder {
    int nM, nN, nwg;
    DI void init(int nM_, int nN_) { nM = nM_; nN = nN_; nwg = nM * nN; }
    DI bool map(long L, int& pm, int& pn) const {
        if (L >= nwg) return false;
        int wgid = (int)L; { const int q = nwg / NXCD, r = nwg % NXCD, xcd = wgid % NXCD, off = wgid / NXCD; wgid = (xcd < r ? xcd * (q + 1) : r * (q + 1) + (xcd - r) * q) + off; }
        const int nig = WGM * nN, gid = wgid / nig, fm = gid * WGM, gsz = (nM - fm) < WGM ? (nM - fm) : WGM;
        pm = fm + ((wgid % nig) % gsz); pn = (wgid % nig) / gsz; return true;
    }
};

template <class Epi, class P, bool ALIGN_EPI>
DI void gemm_phase(LAS unsigned char* lds, const P& S, const Epi& E, const int tid, const int wid) {
    const int lane = tid & 63, wr = wid >> 2, wc = wid & 3, fr = lane & 15, fq = lane >> 4;
    const int K = S.K, nt = K / BK;
    unsigned voffA[2], voffB[2];
#pragma unroll
    for (int i = 0; i < 2; ++i) { int R, C; stage_rc(tid * 16 + i * 8192, R, C); const int Rb = Epi::PERM ? ((R & ~31) + perm32(R & 31)) : R;
        voffA[i] = (unsigned)(R * K + C) * 2u; voffB[i] = (unsigned)(Rb * K + C) * 2u; }
    const size_t kstep = (size_t)(BK * 2);
    const size_t hstep = (size_t)HALF * K * 2;
    const unsigned ldsw = (unsigned)wid * 1024u;
    const int aoff = lds_byte(wr * 64 + fr, fq * 8), boff = lds_byte(wc * 32 + fr, fq * 8);
#define PG8_SA(b, h) (((b) * 2 + (h)) * HTB)
#define PG8_SB(b, h) ((4 + (b) * 2 + (h)) * HTB)
#define PG8_STAGE(bufoff, gbase, voff) do { _Pragma("unroll") for (int _i = 0; _i < 2; ++_i) \
        __builtin_amdgcn_global_load_lds((const unsigned*)((const char*)(gbase) + (voff)[_i]), (LAS unsigned*)(lds + (bufoff) + ldsw + _i * 8192), 16, 0, 0); } while (0)
#define PG8_LDA(dst, b, h) do { _Pragma("unroll") for (int m = 0; m < 4; ++m) _Pragma("unroll") for (int k = 0; k < 2; ++k) dst[m][k] = *(const LAS bf16x8*)(lds + PG8_SA(b, h) + aoff + m * 2048 + k * 1024); } while (0)
#define PG8_LDB(dst, b, h) do { _Pragma("unroll") for (int n = 0; n < 2; ++n) _Pragma("unroll") for (int k = 0; k < 2; ++k) dst[n][k] = *(const LAS bf16x8*)(lds + PG8_SB(b, h) + boff + n * 2048 + k * 1024); } while (0)
#define PG8_MMA(ai, bj, At, Bt) do { __builtin_amdgcn_s_setprio(1); _Pragma("unroll") for (int m = 0; m < 4; ++m) _Pragma("unroll") for (int n = 0; n < 2; ++n) _Pragma("unroll") for (int k = 0; k < 2; ++k) \
        acc[ai][bj][m][n] = __builtin_amdgcn_mfma_f32_16x16x32_bf16(Bt[n][k], At[m][k], acc[ai][bj][m][n], 0, 0, 0); __builtin_amdgcn_s_setprio(0); } while (0)
#define PG8_WAIT_V(n) asm volatile("s_waitcnt vmcnt(" #n ")" ::: "memory")
#define PG8_WAIT_L(n) asm volatile("s_waitcnt lgkmcnt(" #n ")" ::: "memory")
#define PG8_BAR __builtin_amdgcn_s_barrier()
#define PG8_SCHED __builtin_amdgcn_sched_barrier(0)
    Unit cur, nxt; int ui = 0;
    if (!S.next(0, cur)) return;
    f32x4 acc[2][2][4][2];
#pragma unroll
    for (int a = 0; a < 2; ++a)
#pragma unroll
        for (int b = 0; b < 2; ++b)
#pragma unroll
            for (int m = 0; m < 4; ++m)
#pragma unroll
                for (int n = 0; n < 2; ++n) acc[a][b][m][n] = (f32x4){0.f, 0.f, 0.f, 0.f};
    bf16x8 At[4][2], B0[2][2], B1[2][2];
    const char* cA = S.a_ptr(cur); const char* cB = S.b_ptr(cur);
    PG8_STAGE(PG8_SB(0, 0), cB, voffB); PG8_STAGE(PG8_SB(0, 1), cB + hstep, voffB); PG8_STAGE(PG8_SA(0, 0), cA, voffA); PG8_STAGE(PG8_SA(0, 1), cA + hstep, voffA);
    if (wr == 1) PG8_BAR;
    PG8_WAIT_V(2); PG8_BAR;
    PG8_STAGE(PG8_SB(1, 0), cB + kstep, voffB); PG8_STAGE(PG8_SA(1, 0), cA + kstep, voffA); PG8_STAGE(PG8_SB(1, 1), cB + hstep + kstep, voffB);
    PG8_WAIT_V(6); PG8_BAR;
    for (;;) {
        const bool has_next = S.next(ui + 1, nxt);
        const char* nA = has_next ? S.a_ptr(nxt) : cA; const char* nB = has_next ? S.b_ptr(nxt) : cB;
        for (int t = 0; t < nt; t += 2) {
            const bool last = (t == nt - 2);
            const char* a1 = cA + (size_t)(t + 1) * kstep;
            const char* a2 = last ? nA : cA + (size_t)(t + 2) * kstep; const char* b2 = last ? nB : cB + (size_t)(t + 2) * kstep;
            const char* a3 = a2 + kstep; const char* b3 = b2 + kstep;
            PG8_LDB(B0, 0, 0); PG8_LDB(B1, 0, 1); PG8_SCHED; PG8_LDA(At, 0, 0); PG8_STAGE(PG8_SA(1, 1), a1 + hstep, voffA);
            PG8_WAIT_V(8); PG8_WAIT_L(0); PG8_BAR; PG8_MMA(0, 0, At, B0); PG8_MMA(0, 1, At, B1); PG8_BAR; PG8_SCHED;
            PG8_LDA(At, 0, 1); PG8_STAGE(PG8_SB(0, 0), b2, voffB); PG8_STAGE(PG8_SB(0, 1), b2 + hstep, voffB); PG8_STAGE(PG8_SA(0, 0), a2, voffA);
            PG8_WAIT_V(8); PG8_WAIT_L(0); PG8_BAR; PG8_MMA(1, 0, At, B0); PG8_MMA(1, 1, At, B1); PG8_BAR; PG8_SCHED;
            PG8_LDB(B0, 1, 0); PG8_LDB(B1, 1, 1); PG8_SCHED; PG8_LDA(At, 1, 0); PG8_STAGE(PG8_SA(0, 1), a2 + hstep, voffA);
            PG8_WAIT_V(8); PG8_WAIT_L(0); PG8_BAR; PG8_MMA(0, 0, At, B0); PG8_MMA(0, 1, At, B1); PG8_BAR; PG8_SCHED;
            PG8_LDA(At, 1, 1); PG8_STAGE(PG8_SB(1, 0), b3, voffB); PG8_STAGE(PG8_SB(1, 1), b3 + hstep, voffB); PG8_STAGE(PG8_SA(1, 0), a3, voffA);
            PG8_WAIT_V(8); PG8_WAIT_L(0); PG8_BAR; PG8_MMA(1, 0, At, B0); PG8_MMA(1, 1, At, B1); PG8_BAR; PG8_SCHED;
        }
        if constexpr (ALIGN_EPI) { if (wr == 0) PG8_BAR; }
        E(acc, cur, wr, wc, fr, fq);
        if (!has_next) break;
#pragma unroll
        for (int a = 0; a < 2; ++a)
#pragma unroll
            for (int b = 0; b < 2; ++b)
#pragma unroll
                for (int m = 0; m < 4; ++m)
#pragma unroll
                    for (int n = 0; n < 2; ++n) acc[a][b][m][n] = (f32x4){0.f, 0.f, 0.f, 0.f};
        cur = nxt; cA = nA; cB = nB; ++ui;
        if constexpr (ALIGN_EPI) { if (wr == 1) PG8_BAR; }
    }
    PG8_WAIT_V(0);
    if constexpr (!ALIGN_EPI) { if (wr == 0) PG8_BAR; }
    PG8_BAR;
#undef PG8_SA
#undef PG8_SB
#undef PG8_STAGE
#undef PG8_LDA
#undef PG8_LDB
#undef PG8_MMA
#undef PG8_WAIT_V
#undef PG8_WAIT_L
#undef PG8_BAR
#undef PG8_SCHED
}
}
using pg8::Unit;

struct ProbQKV {
    int K; const char* abuf; const char* wqk; const char* wv; pg8::GridOrder go; int G, c;
    DI bool next(int i, Unit& u) const {
        const long L = (long)i * G + c;
        if (L < NTILE * 8) { u.kind = 0; return go.map(L, u.pm, u.pn); }
        const long r = L - NTILE * 8; if (r >= NTILE * 4) return false;
        u.kind = 1; u.pm = (int)(r & 3); u.pn = (int)(r >> 2); return true;
    }
    DI const char* a_ptr(const Unit& u) const { return (u.kind == 0 ? abuf : wv) + (size_t)u.pm * (256 * 1024 * 2); }
    DI const char* b_ptr(const Unit& u) const { return (u.kind == 0 ? wqk : abuf) + (size_t)u.pn * (256 * 1024 * 2); }
};
struct EpiQKV {
    static constexpr bool PERM = true;
    bf16_t* Q; bf16_t* Kb; bf16_t* VT; const float* gq; const float* gk; const float* cosT; const float* sinT;
    DI void operator()(const f32x4 (&acc)[2][2][4][2], const Unit& u, int wr, int wc, int fr, int fq) const {
        if (u.kind == 1) {
#pragma unroll
            for (int ai = 0; ai < 2; ++ai)
#pragma unroll
                for (int m = 0; m < 4; ++m) {
                    const int f = u.pm * 256 + ai * 128 + wr * 64 + m * 16 + fr;
                    bf16_t* rowp = VT + (size_t)f * T + (size_t)u.pn * 256 + wc * 32 + 8 * fq;
#pragma unroll
                    for (int bj = 0; bj < 2; ++bj) { const f32x4 v0 = acc[ai][bj][m][0], v1 = acc[ai][bj][m][1];
                        u32x4 w; w.x = pk_bf16(v0[0], v0[1]); w.y = pk_bf16(v0[2], v0[3]); w.z = pk_bf16(v1[0], v1[1]); w.w = pk_bf16(v1[2], v1[3]);
                        stg<u32x4>(rowp + bj * 128, w); }
                }
            return;
        }
        const bool isK = u.pn >= 4; const int sub = 4 * (u.pn & 3) + wc;
        const int jj = u.pm % 9; const bool isctx = (jj == 0);
        const float* g = isK ? gk : gq; bf16_t* dst = isK ? Kb : Q;
        const float osc = isK ? 1.0f : 0.125f * LOG2E;
        f32x4 gv[2][2];
#pragma unroll
        for (int bj = 0; bj < 2; ++bj)
#pragma unroll
            for (int n = 0; n < 2; ++n) gv[bj][n] = ldg<f32x4>(g + 32 * bj + 8 * fq + 4 * n);
#pragma unroll
        for (int ai = 0; ai < 2; ++ai)
#pragma unroll
            for (int m = 0; m < 4; ++m) {
                const int rr = ai * 128 + wr * 64 + m * 16 + fr;
                float ss = 0.f;
#pragma unroll
                for (int bj = 0; bj < 2; ++bj)
#pragma unroll
                    for (int n = 0; n < 2; ++n) { const f32x4 x = acc[ai][bj][m][n]; ss += (x[0] * x[0] + x[1] * x[1]) + (x[2] * x[2] + x[3] * x[3]); }
                { const int ln = fr + 16 * fq; ss += shx(ss, 16, ln); ss += shx(ss, 32, ln); }
                const float rstd = __builtin_amdgcn_rsqf(ss * (1.0f / 64.0f) + RMS_EPS) * osc;
                f32x4 x1[2], x2[2];
#pragma unroll
                for (int n = 0; n < 2; ++n) { x1[n] = acc[ai][0][m][n] * rstd * gv[0][n]; x2[n] = acc[ai][1][m][n] * rstd * gv[1][n]; }
                if (!isctx) {
                    const int t = (jj - 1) * 256 + rr;
#pragma unroll
                    for (int n = 0; n < 2; ++n) { const f32x4 c = ldg<f32x4>(cosT + t * 32 + 8 * fq + 4 * n), s = ldg<f32x4>(sinT + t * 32 + 8 * fq + 4 * n);
                        const f32x4 a = x1[n] * c - x2[n] * s, b = x1[n] * s + x2[n] * c; x1[n] = a; x2[n] = b; }
                }
                bf16_t* rowp = dst + (size_t)(u.pm * 256 + rr) * 1024 + 64 * sub + 8 * fq;
                u32x4 w; w.x = pk_bf16(x1[0][0], x1[0][1]); w.y = pk_bf16(x1[0][2], x1[0][3]); w.z = pk_bf16(x1[1][0], x1[1][1]); w.w = pk_bf16(x1[1][2], x1[1][3]);
                stg<u32x4>(rowp, w);
                w.x = pk_bf16(x2[0][0], x2[0][1]); w.y = pk_bf16(x2[0][2], x2[0][3]); w.z = pk_bf16(x2[1][0], x2[1][1]); w.w = pk_bf16(x2[1][2], x2[1][3]);
                stg<u32x4>(rowp + 32, w);
            }
    }
};

struct ProbDense {
    int K; const char* A0; const char* A1; int pm_split; const char* Bt; pg8::GridOrder go; int G, c;
    DI bool next(int i, Unit& u) const { u.kind = 0; return go.map((long)i * G + c, u.pm, u.pn); }
    DI const char* a_ptr(const Unit& u) const { return u.pm < pm_split ? A0 + (size_t)u.pm * 512 * K : A1 + (size_t)(u.pm - pm_split) * 512 * K; }
    DI const char* b_ptr(const Unit& u) const { return Bt + (size_t)u.pn * 512 * K; }
};

struct ProbWIN {
    int K; const char* abuf; const char* win; pg8::GridOrder go; int G, c;
    DI bool next(int i, Unit& u) const {
        const long L = (long)i * G + c;
        if (L < 144 * 20) { u.kind = 0; return go.map(L, u.pm, u.pn); }
        const long r = L - 144 * 20; if (r >= 144 * 12) return false;
        u.kind = 1; u.pm = (int)(r % 12); u.pn = (int)(r / 12); return true;
    }
    DI const char* a_ptr(const Unit& u) const { return u.kind == 0 ? abuf + (size_t)u.pm * (256 * 1024 * 2) : win + (size_t)(4 + u.pm) * (256 * 1024 * 2); }
    DI const char* b_ptr(const Unit& u) const { return u.kind == 0 ? win + (size_t)(u.pn < 4 ? u.pn : 12 + u.pn) * (256 * 1024 * 2) : abuf + (size_t)u.pn * (256 * 1024 * 2); }
};
struct EpiWIN {
    static constexpr bool PERM = true;
    bf16_t* RQ; bf16_t* RG; bf16_t* RKT; bf16_t* RVT; int pm0; const float* cosT; const float* sinT; const float* cosTT; const float* sinTT;
    DI void operator()(const f32x4 (&acc)[2][2][4][2], const Unit& u, int wr, int wc, int fr, int fq) const {
        if (u.kind == 0) {
            const int gpm = pm0 + u.pm, jj = gpm % 9; const bool isctx = (jj == 0); const bool isq = u.pn < 4;
#pragma unroll
            for (int ai = 0; ai < 2; ++ai)
#pragma unroll
                for (int m = 0; m < 4; ++m) {
                    const int rr = ai * 128 + wr * 64 + m * 16 + fr;
                    f32x4 x1[2], x2[2];
#pragma unroll
                    for (int n = 0; n < 2; ++n) { x1[n] = acc[ai][0][m][n]; x2[n] = acc[ai][1][m][n]; }
                    if (isq) {
                        if (!isctx) {
                            const int t = (jj - 1) * 256 + rr;
#pragma unroll
                            for (int n = 0; n < 2; ++n) { const int fo = t * 128 + 32 * wc + 8 * fq + 4 * n; const f32x4 c = ldg<f32x4>(cosT + fo), s = ldg<f32x4>(sinT + fo);
                                const f32x4 a = x1[n] * c - x2[n] * s, b = x1[n] * s + x2[n] * c; x1[n] = a; x2[n] = b; }
                        }
                    } else {
#pragma unroll
                        for (int n = 0; n < 2; ++n)
#pragma unroll
                            for (int j = 0; j < 4; ++j) { x1[n][j] = silu_f(x1[n][j]); x2[n][j] = silu_f(x2[n][j]); }
                    }
                    bf16_t* rowp = isq ? RQ + (size_t)(u.pm * 256 + rr) * 1024 + u.pn * 256 + wc * 32 + 8 * fq : RG + (size_t)(u.pm * 256 + rr) * 4096 + (u.pn - 4) * 256 + wc * 32 + 8 * fq;
                    u32x4 w; w.x = pk_bf16(x1[0][0], x1[0][1]); w.y = pk_bf16(x1[0][2], x1[0][3]); w.z = pk_bf16(x1[1][0], x1[1][1]); w.w = pk_bf16(x1[1][2], x1[1][3]);
                    stg<u32x4>(rowp, w);
                    w.x = pk_bf16(x2[0][0], x2[0][1]); w.y = pk_bf16(x2[0][2], x2[0][3]); w.z = pk_bf16(x2[1][0], x2[1][1]); w.w = pk_bf16(x2[1][2], x2[1][3]);
                    stg<u32x4>(rowp + 128, w);
                }
            return;
        }
        const int gpm = pm0 + u.pn, jj = gpm % 9; const bool isctx = (jj == 0); const bool isk = u.pm < 4;
        if (isk) {
#pragma unroll
            for (int m = 0; m < 4; ++m) {
                const int f = wr * 64 + m * 16 + fr;
#pragma unroll
                for (int bj = 0; bj < 2; ++bj) {
                    f32x4 x1[2], x2[2];
#pragma unroll
                    for (int n = 0; n < 2; ++n) { x1[n] = acc[0][bj][m][n] * 0.0625f; x2[n] = acc[1][bj][m][n] * 0.0625f; }
                    const int tl = bj * 128 + wc * 32 + 8 * fq;
                    if (!isctx) {
                        const int t = (jj - 1) * 256 + tl;
#pragma unroll
                        for (int n = 0; n < 2; ++n) { const f32x4 c = ldg<f32x4>(cosTT + f * 2048 + t + 4 * n), s = ldg<f32x4>(sinTT + f * 2048 + t + 4 * n);
                            const f32x4 a = x1[n] * c - x2[n] * s, b = x1[n] * s + x2[n] * c; x1[n] = a; x2[n] = b; }
                    }
                    bf16_t* p1 = RKT + (size_t)(u.pm * 256 + f) * HROWS + (size_t)u.pn * 256 + tl;
                    u32x4 w; w.x = pk_bf16(x1[0][0], x1[0][1]); w.y = pk_bf16(x1[0][2], x1[0][3]); w.z = pk_bf16(x1[1][0], x1[1][1]); w.w = pk_bf16(x1[1][2], x1[1][3]);
                    stg<u32x4>(p1, w);
                    w.x = pk_bf16(x2[0][0], x2[0][1]); w.y = pk_bf16(x2[0][2], x2[0][3]); w.z = pk_bf16(x2[1][0], x2[1][1]); w.w = pk_bf16(x2[1][2], x2[1][3]);
                    stg<u32x4>(p1 + (size_t)128 * HROWS, w);
                }
            }
        } else {
#pragma unroll
            for (int ai = 0; ai < 2; ++ai)
#pragma unroll
                for (int m = 0; m < 4; ++m) {
                    const int f = (u.pm - 4) * 256 + ai * 128 + wr * 64 + m * 16 + fr;
                    bf16_t* rowp = RVT + (size_t)f * HROWS + (size_t)u.pn * 256 + wc * 32 + 8 * fq;
#pragma unroll
                    for (int bj = 0; bj < 2; ++bj) { const f32x4 v0 = acc[ai][bj][m][0], v1 = acc[ai][bj][m][1];
                        u32x4 w; w.x = pk_bf16(v0[0], v0[1]); w.y = pk_bf16(v0[2], v0[3]); w.z = pk_bf16(v1[0], v1[1]); w.w = pk_bf16(v1[2], v1[3]);
                        stg<u32x4>(rowp + bj * 128, w); }
                }
        }
    }
};

struct EpiResid {
    static constexpr bool PERM = false;
    const float* hin_ctx; const float* hin_lat; float* hout_ctx; float* hout_lat; const float* modbase;
    DI void operator()(const f32x4 (&acc)[2][2][4][2], const Unit& u, int wr, int wc, int fr, int fq) const {
        const int b = u.pm / 9, jj = u.pm % 9; const bool isctx = (jj == 0);
        const float* gate = modbase + (size_t)(isctx ? 32 : b) * 6144 + 2048;
        const int col0 = u.pn * 256 + wc * 32 + 4 * fq;
        f32x4 gv[2][2];
#pragma unroll
        for (int bj = 0; bj < 2; ++bj)
#pragma unroll
            for (int n = 0; n < 2; ++n) gv[bj][n] = ldg<f32x4>(gate + col0 + bj * 128 + n * 16);
        const size_t rbase = isctx ? (size_t)b * 256 : (size_t)b * 2048 + (size_t)(jj - 1) * 256;
        const float* hi = isctx ? hin_ctx : hin_lat; float* ho = isctx ? hout_ctx : hout_lat;
#pragma unroll
        for (int ai = 0; ai < 2; ++ai)
#pragma unroll
            for (int m = 0; m < 4; ++m) {
                const size_t off = (rbase + ai * 128 + wr * 64 + m * 16 + fr) * 1024 + col0;
#pragma unroll
                for (int bj = 0; bj < 2; ++bj)
#pragma unroll
                    for (int n = 0; n < 2; ++n) { const f32x4 hv = ldg<f32x4>(hi + off + bj * 128 + n * 16);
                        stg<f32x4>(ho + off + bj * 128 + n * 16, hv + gv[bj][n] * acc[ai][bj][m][n]); }
            }
    }
};

struct ProbMoE {
    int K; const char* A; const char* W; const LAS int* tile_e; pg8::GridOrder go; int G, c;
    DI bool next(int i, Unit& u) const { u.kind = 0; return go.map((long)i * G + c, u.pm, u.pn); }
    DI const char* a_ptr(const Unit& u) const { return A + (size_t)u.pm * 512 * K; }
    DI const char* b_ptr(const Unit& u) const { return W + ((size_t)tile_e[u.pm] * 4 + u.pn) * 512 * K; }
};
struct EpiSwiGLU {
    static constexpr bool PERM = true;
    bf16_t* act;
    DI void operator()(const f32x4 (&acc)[2][2][4][2], const Unit& u, int wr, int wc, int fr, int fq) const {
#pragma unroll
        for (int ai = 0; ai < 2; ++ai)
#pragma unroll
            for (int m = 0; m < 4; ++m) {
                bf16_t* rowp = act + (size_t)(u.pm * 256 + ai * 128 + wr * 64 + m * 16 + fr) * 512 + u.pn * 128 + wc * 16 + 4 * fq;
#pragma unroll
                for (int bj = 0; bj < 2; ++bj) { const f32x4 g = acc[ai][bj][m][0], up = acc[ai][bj][m][1];
                    u32x2 w; w.x = pk_bf16(silu_f(g[0]) * up[0], silu_f(g[1]) * up[1]); w.y = pk_bf16(silu_f(g[2]) * up[2], silu_f(g[3]) * up[3]);
                    stg<u32x2>(rowp + bj * 64, w); }
            }
    }
};
struct EpiDown {
    static constexpr bool PERM = true;
    bf16_t* y2; const int* rowmap; const float* wsel;
    DI void operator()(const f32x4 (&acc)[2][2][4][2], const Unit& u, int wr, int wc, int fr, int fq) const {
#pragma unroll
        for (int ai = 0; ai < 2; ++ai)
#pragma unroll
            for (int m = 0; m < 4; ++m) {
                const int row = u.pm * 256 + ai * 128 + wr * 64 + m * 16 + fr;
                const int dest = ldg<int>(rowmap + row);
                if (dest >= 0) {
                    const float w = ldg<float>(wsel + dest);
                    bf16_t* rowp = y2 + (size_t)dest * 1024 + u.pn * 256 + wc * 32 + 8 * fq;
#pragma unroll
                    for (int bj = 0; bj < 2; ++bj) { const f32x4 v0 = acc[ai][bj][m][0] * w, v1 = acc[ai][bj][m][1] * w;
                        u32x4 o; o.x = pk_bf16(v0[0], v0[1]); o.y = pk_bf16(v0[2], v0[3]); o.z = pk_bf16(v1[0], v1[1]); o.w = pk_bf16(v1[2], v1[3]);
                        stg<u32x4>(rowp + bj * 128, o); }
                }
            }
    }
};

template <int MODE>
DI void transpose_tile(const Frame& F, const float* src, const float* src2, int ld, bf16_t* dst, int K, int k0, int n0) {
    LAS float* tl = (LAS float*)F.lds;
    __syncthreads();
#pragma unroll
    for (int i = 0; i < 8; ++i) {
        const int idx = F.tid + 512 * i, kk = idx >> 6, nn = idx & 63, np = n0 + nn;
        float v;
        if (MODE == 0) v = ldg<float>(src + (size_t)(k0 + kk) * ld + np);
        else if (MODE == 1) { const int t = np >> 8, p = np & 255, bj = p >> 7, wc = (p >> 5) & 3, r = p & 31; v = ldg<float>(src + (size_t)(k0 + kk) * ld + t * 256 + wc * 64 + bj * 32 + r); }
        else { const int hid = 4 * (np >> 3) + (np & 3); v = ldg<float>(((np & 4) ? src2 : src) + (size_t)(k0 + kk) * ld + hid); }
        tl[nn * 65 + kk] = v;
    }
    __syncthreads();
#pragma unroll
    for (int i = 0; i < 4; ++i) {
        const int idx = F.tid + 512 * i, nn = idx >> 5, kp = (idx & 31) * 2;
        stg<unsigned>(dst + (size_t)(n0 + nn) * K + k0 + kp, pk_bf16(tl[nn * 65 + kp], tl[nn * 65 + kp + 1]));
    }
}
template <int MODE>
DI int transpose_mat(const Frame& F, const float* src, const float* src2, int ld, bf16_t* dst, int K, int Np, int u0, int u_first, int u_stride) {
    const int tk = K / 64, tn = Np / 64, ntl = tk * tn;
    int u = u_first; if (u < u0) { const int d = (u0 - u + u_stride - 1) / u_stride; u += d * u_stride; }
    for (; u < u0 + ntl; u += u_stride) { const int l = u - u0; transpose_tile<MODE>(F, src, src2, ld, dst, K, (l % tk) * 64, (l / tk) * 64); }
    return ntl;
}
DI void convert_moe_weights(const Frame& F, int layer) {
    const float* wg = F.a->in[21] + (size_t)layer * NEXP * DM * MOEH; const float* wu = F.a->in[22] + (size_t)layer * NEXP * DM * MOEH; const float* wd = F.a->in[23] + (size_t)layer * NEXP * MOEH * DM;
    bf16_t* WGU = (bf16_t*)(F.ws + WS_WGU); bf16_t* WD = (bf16_t*)(F.ws + WS_WD);
    int u0 = 0;
    for (int e = 0; e < NEXP; ++e) {
        u0 += transpose_mat<2>(F, wg + (size_t)e * DM * MOEH, wu + (size_t)e * DM * MOEH, MOEH, WGU + (size_t)e * 1024 * 1024, 1024, 1024, u0, F.bid, F.G);
        u0 += transpose_mat<0>(F, wd + (size_t)e * MOEH * DM, nullptr, DM, WD + (size_t)e * 1024 * 512, 512, 1024, u0, F.bid, F.G);
    }
}

DI void p0_prologue(const Frame& F) {
    {
        LAS float* red = (LAS float*)F.lds;
        for (int u = F.bid; u < 4 * 96; u += F.G) {
            const int layer = u / 96, col0 = (u % 96) * 64;
            const float* W = F.a->in[6] + (size_t)layer * 1024 * 6144 + col0 + F.lane;
            const float* cp = F.lane < 32 ? F.a->in[1] + F.lane * 1024 : F.a->in[3];
            float acc[33];
#pragma unroll
            for (int r = 0; r < 33; ++r) acc[r] = 0.f;
            const int k0 = F.wave * 128;
            for (int k = k0; k < k0 + 128; ++k) {
                const float w = ldg<float>(W + (size_t)k * 6144);
                const float sv = silu_f(ldg<float>(cp + k));
#pragma unroll
                for (int r = 0; r < 33; ++r) acc[r] += w * __builtin_bit_cast(float, __builtin_amdgcn_readlane(__builtin_bit_cast(int, sv), r));
            }
#pragma unroll
            for (int r = 0; r < 33; ++r) red[(F.wave * 33 + r) * 64 + F.lane] = acc[r];
            __syncthreads();
            float* outp = (float*)(F.ws + WS_ADA) + (size_t)layer * 33 * 6144;
            for (int idx = F.tid; idx < 33 * 64; idx += 512) { const int r = idx >> 6, cl = idx & 63; float v = 0.f;
#pragma unroll
                for (int w8 = 0; w8 < 8; ++w8) v += red[(w8 * 33 + r) * 64 + cl];
                stg<float>(outp + (size_t)r * 6144 + col0 + cl, v + ldg<float>(F.a->in[7] + layer * 6144 + col0 + cl)); }
            __syncthreads();
        }
    }
    {
        float* cda = (float*)(F.ws + WS_ROPE + RP_CDA); float* sda = (float*)(F.ws + WS_ROPE + RP_SDA); float* crt = (float*)(F.ws + WS_ROPE + RP_CRT); float* srt = (float*)(F.ws + WS_ROPE + RP_SRT);
        const int gt = F.bid * 512 + F.tid, gs = F.G * 512;
        for (int idx = gt; idx < 2048 * 32; idx += gs) { const int t = idx >> 5, f = idx & 31; const float pos = f < 16 ? (float)(t >> 6) : (float)(t & 63);
            const float inv = exp2f(-(float)(f & 15) * (13.287712379549449f / 16.0f)); const float a = pos * inv; stg<float>(cda + idx, __cosf(a)); stg<float>(sda + idx, __sinf(a)); }
        for (int idx = gt; idx < 2048 * 128; idx += gs) { const int t = idx >> 7, f = idx & 127; const float pos = f < 64 ? (float)(t >> 6) : (float)(t & 63);
            const float inv = exp2f(-(float)(f & 63) * (13.287712379549449f / 64.0f)); const float a = pos * inv; const float cv = __cosf(a), sv = __sinf(a); stg<float>(crt + idx, cv); stg<float>(srt + idx, sv);
            stg<float>((float*)(F.ws + WS_MISC + MS_CRTT) + f * 2048 + t, cv); stg<float>((float*)(F.ws + WS_MISC + MS_SRTT) + f * 2048 + t, sv); }
    }
    {
        int u0 = 0;
        for (int j = 0; j < 2; ++j) {
            const float* wqkv = F.a->in[8] + (size_t)j * 1024 * 3072;
            u0 += transpose_mat<1>(F, wqkv, nullptr, 3072, (bf16_t*)(F.ws + WS_WQK) + (size_t)j * 2048 * 1024, 1024, 2048, u0, F.bid, F.G);
            u0 += transpose_mat<0>(F, wqkv + 2048, nullptr, 3072, (bf16_t*)(F.ws + WS_WV) + (size_t)j * 1024 * 1024, 1024, 1024, u0, F.bid, F.G);
            u0 += transpose_mat<0>(F, F.a->in[13] + (size_t)j * 1024 * 1024, nullptr, 1024, (bf16_t*)(F.ws + WS_WODA) + (size_t)j * 1024 * 1024, 1024, 1024, u0, F.bid, F.G);
            u0 += transpose_mat<0>(F, F.a->in[14] + (size_t)j * 1024 * 8192, nullptr, 8192, (bf16_t*)(F.ws + WS_WIN) + (size_t)j * 8192 * 1024, 1024, 8192, u0, F.bid, F.G);
            u0 += transpose_mat<0>(F, F.a->in[16] + (size_t)j * 2048 * 1024, nullptr, 1024, (bf16_t*)(F.ws + WS_WORT) + (size_t)j * 1024 * 2048, 2048, 1024, u0, F.bid, F.G);
        }
        convert_moe_weights(F, 0);
    }
}

template <bool SECOND>
DI void norm_phase(const Frame& F, int layer) {
    bf16_t* abuf = (bf16_t*)(F.ws + WS_ABUF);
    float* hctx = (float*)(F.ws + WS_HCTX);
    const bf16_t* y2 = (const bf16_t*)(F.ws + WS_PROJ + PJ_Y2);
    const float* ng = F.a->in[SECOND ? 5 : 4] + layer * 1024;
    LAS float* Wl = (LAS float*)F.lds;
    LAS int* lhist = (LAS int*)(F.lds + LDS_MISC + 1024);
    int* eid = (int*)(F.ws + WS_MISC + MS_EID); float* wsel = (float*)(F.ws + WS_MISC + MS_WSEL);
    if (SECOND) {
        const float* wgp = F.a->in[17] + (size_t)layer * 1024 * 4; const float* wep = F.a->in[19] + (size_t)layer * 1024 * 32;
        for (int idx = F.tid; idx < 1024 * 4; idx += 512) { const int k = idx >> 2, o = idx & 3; Wl[o * 1024 + k] = wgp[idx]; }
        for (int idx = F.tid; idx < 1024 * 32; idx += 512) { const int k = idx >> 5, o = idx & 31; Wl[(4 + o) * 1024 + k] = wep[idx]; }
        if (F.tid < 32) lhist[F.tid] = 0;
        __syncthreads();
    }
    const int lane = F.lane;
    for (int r = F.bid * 8 + F.wave; r < T; r += F.G * 8) {
        const int b = r / NTOK, n = r % NTOK; const bool isctx = n < CTXL;
        const size_t hoff = isctx ? ((size_t)b * 256 + n) * 1024 : ((size_t)b * 2048 + (n - 256)) * 1024;
        const float* hin; float* hout = isctx ? hctx + hoff : F.out + hoff;
        if (layer == 0 && !SECOND) hin = isctx ? F.a->in[2] + hoff : F.a->in[0] + hoff; else hin = hout;
        const float* mod = isctx ? mod_ctx(F, layer) : mod_lat(F, layer, b);
        f32x4 x[4];
#pragma unroll
        for (int i = 0; i < 4; ++i) x[i] = ldg<f32x4>(hin + i * 256 + lane * 4);
        if (!SECOND && layer > 0) {
            const float* modp = isctx ? mod_ctx(F, layer - 1) : mod_lat(F, layer - 1, b);
#pragma unroll
            for (int i = 0; i < 4; ++i) {
                const u32x2 a = ldg<u32x2>(y2 + (size_t)(2 * r) * 1024 + i * 256 + lane * 4), c = ldg<u32x2>(y2 + (size_t)(2 * r + 1) * 1024 + i * 256 + lane * 4);
                const f32x4 g2 = ldg<f32x4>(modp + 5120 + i * 256 + lane * 4);
                x[i][0] += g2[0] * (bf_lo(a.x) + bf_lo(c.x)); x[i][1] += g2[1] * (bf_hi(a.x) + bf_hi(c.x)); x[i][2] += g2[2] * (bf_lo(a.y) + bf_lo(c.y)); x[i][3] += g2[3] * (bf_hi(a.y) + bf_hi(c.y));
                stg<f32x4>(hout + i * 256 + lane * 4, x[i]);
            }
        }
        float ss = 0.f;
#pragma unroll
        for (int i = 0; i < 4; ++i) ss += (x[i][0] * x[i][0] + x[i][1] * x[i][1]) + (x[i][2] * x[i][2] + x[i][3] * x[i][3]);
        ss = wave_sum(ss, lane);
        const float rstd = 1.0f / sqrtf(ss * (1.0f / 1024.0f) + RMS_EPS);
        f32x4 v[4];
#pragma unroll
        for (int i = 0; i < 4; ++i) {
            const int c0 = i * 256 + lane * 4;
            const f32x4 g = ldg<f32x4>(ng + c0), sh = ldg<f32x4>(mod + (SECOND ? 3072 : 0) + c0), sc = ldg<f32x4>(mod + (SECOND ? 4096 : 1024) + c0);
            v[i] = (x[i] * rstd * g) * (sc + 1.0f) + sh;
            u32x2 w; w.x = pk_bf16(v[i][0], v[i][1]); w.y = pk_bf16(v[i][2], v[i][3]);
            stg<u32x2>(abuf + (size_t)r * 1024 + c0, w);
        }
        if (SECOND) {
            const float* bg = F.a->in[18] + layer * 4; const float* be = F.a->in[20] + layer * 32;
            float gl[4]; float gmax = -3.0e38f; int gi = 0;
#pragma unroll
            for (int o = 0; o < 4; ++o) {
                float p = 0.f;
#pragma unroll
                for (int i = 0; i < 4; ++i) { const f32x4 w = *(const LAS f32x4*)(Wl + o * 1024 + i * 256 + lane * 4); p += (v[i][0] * w[0] + v[i][1] * w[1]) + (v[i][2] * w[2] + v[i][3] * w[3]); }
                gl[o] = wave_sum(p, lane) + ldg<float>(bg + o);
                if (gl[o] > gmax) { gmax = gl[o]; gi = o; }
            }
            gi = __builtin_amdgcn_readfirstlane(gi);
            float gsum = 0.f;
#pragma unroll
            for (int o = 0; o < 4; ++o) { gsum += __expf(gl[o] - gmax); asm volatile("" : "+v"(gsum)); }
            const float psel = __builtin_amdgcn_rcpf(gsum);
            float el[8];
#pragma unroll
            for (int o = 0; o < 8; ++o) {
                float p = 0.f;
                const LAS float* wr = Wl + (4 + gi * 8 + o) * 1024;
#pragma unroll
                for (int i = 0; i < 4; ++i) { const f32x4 w = *(const LAS f32x4*)(wr + i * 256 + lane * 4); p += (v[i][0] * w[0] + v[i][1] * w[1]) + (v[i][2] * w[2] + v[i][3] * w[3]); }
                el[o] = wave_sum(p, lane) + ldg<float>(be + gi * 8 + o);
            }
            float m1 = -3.0e38f, m2 = -3.0e38f; int i1 = 0, i2 = 0;
#pragma unroll
            for (int o = 0; o < 8; ++o) { if (el[o] > m1) { m1 = el[o]; i1 = o; } }
#pragma unroll
            for (int o = 0; o < 8; ++o) { if (o != i1 && el[o] > m2) { m2 = el[o]; i2 = o; } }
            const float e2 = __expf(m2 - m1), inv = __builtin_amdgcn_rcpf(1.0f + e2);
            if (lane == 0) {
                stg<int>(eid + 2 * r, gi * 8 + i1); stg<int>(eid + 2 * r + 1, gi * 8 + i2); stg<float>(wsel + 2 * r, inv * psel); stg<float>(wsel + 2 * r + 1, e2 * inv * psel);
                __hip_atomic_fetch_add(&lhist[gi * 8 + i1], 1, __ATOMIC_RELAXED, __HIP_MEMORY_SCOPE_WORKGROUP); __hip_atomic_fetch_add(&lhist[gi * 8 + i2], 1, __ATOMIC_RELAXED, __HIP_MEMORY_SCOPE_WORKGROUP);
            }
        }
    }
    if (SECOND) {
        __syncthreads();
        if (F.tid < 32) { const int c = lhist[F.tid]; if (c) __hip_atomic_fetch_add((unsigned*)(F.ws + WS_CTL) + CW_CNT + layer * 64 + F.tid, (unsigned)c, __ATOMIC_RELAXED, __HIP_MEMORY_SCOPE_AGENT); }
    }
}

DI int build_segments(const Frame& F, int layer, LAS int* segs, LAS int* tile_e) {
    __syncthreads();
    if (F.tid == 0) {
        const unsigned* cnt = (const unsigned*)(F.ws + WS_CTL) + CW_CNT + layer * 64;
        int s = 0;
        for (int e = 0; e < 32; ++e) { segs[e] = s; const int c = (int)__hip_atomic_load(cnt + e, __ATOMIC_RELAXED, __HIP_MEMORY_SCOPE_AGENT); segs[40 + e] = c; s += (c + 255) & ~255; }
        segs[32] = s;
    }
    __syncthreads();
    const int ntl = segs[32] >> 8;
    if (tile_e) {
        for (int t = F.tid; t < ntl; t += 512) { int e = 0;
            for (int q = 1; q < 32; ++q) e = (segs[q] <= t * 256) ? q : e;
            tile_e[t] = e; }
        __syncthreads();
    }
    return ntl;
}

DI void sort_phase(const Frame& F, int layer) {
    LAS int* segs = (LAS int*)(F.lds + LDS_MISC + 2048);
    LAS int* lhist = (LAS int*)(F.lds + LDS_MISC + 1024);
    LAS int* lbase = (LAS int*)(F.lds + LDS_MISC + 1024 + 128);
    LAS int* lpos = (LAS int*)F.lds;
    build_segments(F, layer, segs, nullptr);
    const int* eid = (const int*)(F.ws + WS_MISC + MS_EID); int* rowmap = (int*)(F.ws + WS_MISC + MS_ROWMAP);
    const bf16_t* abuf = (const bf16_t*)(F.ws + WS_ABUF); bf16_t* sa = (bf16_t*)(F.ws + WS_PROJ + PJ_SA);
    const int RPB = (T + F.G - 1) / F.G;
    const int r0 = F.bid * RPB, r1 = (r0 + RPB < T) ? r0 + RPB : T;
    const int na = r1 > r0 ? 2 * (r1 - r0) : 0;
    if (F.tid < 32) lhist[F.tid] = 0;
    __syncthreads();
    int ee[2], lp[2];
#pragma unroll
    for (int it = 0; it < 2; ++it) { const int a = F.tid + 512 * it; ee[it] = -1; lp[it] = 0;
        if (a < na) { ee[it] = ldg<int>(eid + 2 * r0 + a); lp[it] = __hip_atomic_fetch_add(&lhist[ee[it]], 1, __ATOMIC_RELAXED, __HIP_MEMORY_SCOPE_WORKGROUP); } }
    __syncthreads();
    if (F.tid < 32) { const int c = lhist[F.tid];
        lbase[F.tid] = segs[F.tid] + (c ? (int)__hip_atomic_fetch_add((unsigned*)(F.ws + WS_CTL) + CW_CUR + layer * 64 + F.tid, (unsigned)c, __ATOMIC_RELAXED, __HIP_MEMORY_SCOPE_AGENT) : 0); }
    __syncthreads();
#pragma unroll
    for (int it = 0; it < 2; ++it) { const int a = F.tid + 512 * it;
        if (a < na) { const int pos = lbase[ee[it]] + lp[it]; lpos[a] = pos; stg<int>(rowmap + pos, 2 * r0 + a); } }
    __syncthreads();
    for (int a = F.wave; a < na; a += 8) {
        const int pos = lpos[a]; const int r = r0 + (a >> 1);
        const u32x4 v0 = ldg<u32x4>(abuf + (size_t)r * 1024 + F.lane * 8), v1 = ldg<u32x4>(abuf + (size_t)r * 1024 + 512 + F.lane * 8);
        stg<u32x4>(sa + (size_t)pos * 1024 + F.lane * 8, v0); stg<u32x4>(sa + (size_t)pos * 1024 + 512 + F.lane * 8, v1);
    }
    if (F.bid < 32) { const int e = F.bid; for (int p = segs[e] + segs[40 + e] + F.tid; p < segs[e + 1]; p += 512) stg<int>(rowmap + p, -1); }
    if (F.G < 32 && F.bid == 0) { for (int e = F.G; e < 32; ++e) for (int p = segs[e] + segs[40 + e] + F.tid; p < segs[e + 1]; p += 512) stg<int>(rowmap + p, -1); }
}

constexpr int AT_KROW = 272, AT_VROW = 136, AT_KB = 64 * AT_KROW, AT_VB = 128 * AT_VROW, AT_BUF = AT_KB + AT_VB;
DI void attn_phase(const Frame& F, int layer) {
    const int j = layer >> 1;
    const bf16_t* Qb = (const bf16_t*)(F.ws + WS_PROJ + PJ_Q); const bf16_t* Kb = (const bf16_t*)(F.ws + WS_PROJ + PJ_K); const bf16_t* VT = (const bf16_t*)(F.ws + WS_PROJ + PJ_VT);
    bf16_t* Ob = (bf16_t*)(F.ws + WS_OBUF);
    const int lane = F.lane, lr = lane & 31, lh = lane >> 5;
    const float* lam = F.a->in[11] + j * 256;
    float p01 = ldg<float>(lam + lane) * ldg<float>(lam + 64 + lane), p23 = ldg<float>(lam + 128 + lane) * ldg<float>(lam + 192 + lane);
    p01 = wave_sum(p01, lane); p23 = wave_sum(p23, lane);
    const float lam_init = 0.8f - 0.6f * __expf(-0.3f * (float)layer);
    const float lam_full = __expf(p01) - __expf(p23) + lam_init;
    float mq = fabsf(ldg<float>(F.a->in[9] + j * 64 + lane)), mk = fabsf(ldg<float>(F.a->in[10] + j * 64 + lane));
#pragma unroll
    for (int o = 32; o >= 1; o >>= 1) { mq = fmaxf(mq, shx(mq, o, lane)); mk = fmaxf(mk, shx(mk, o, lane)); }
    const float OFF = 8.0f * LOG2E * mq * mk;
    const float* gsub = F.a->in[12] + j * 128;
    const float osc = 1.0f - lam_init;

    for (int u = F.bid; u < 2304; u += F.G) {
        int b, h, qb, nkt;
        if (u < 2048) {
            int bh;
            if (F.G == 256) { const int i = u >> 8, c = u & 255; bh = i * 32 + (c & 7) * 4 + (c >> 6); qb = 1 + ((c >> 3) & 7); } else { bh = u >> 3; qb = 1 + (u & 7); }
            b = bh >> 3; h = bh & 7; nkt = 36;
        } else { const int uu = u - 2048; b = uu >> 3; h = uu & 7; qb = 0; nkt = 4; }
        const size_t rowbase = (size_t)b * NTOK;
        const size_t qrow = rowbase + qb * 256 + F.wave * 32 + lr;
        __syncthreads();
        const int qlo = 2 * AT_BUF + F.wave * 8192 + lane * 16;
#pragma unroll
        for (int mp = 0; mp < 2; ++mp)
#pragma unroll
            for (int ks = 0; ks < 4; ++ks) *(LAS bf16x8*)(F.lds + qlo + (mp * 4 + ks) * 1024) = ldg<bf16x8>(Qb + qrow * 1024 + h * 128 + mp * 64 + ks * 16 + lh * 8);
        f32x16 O1[4], O2[4];
#pragma unroll
        for (int e = 0; e < 4; ++e)
#pragma unroll
            for (int i = 0; i < 16; ++i) { O1[e][i] = 0.f; O2[e][i] = 0.f; }
        float l1 = 0.f, l2 = 0.f;
        const unsigned kgo = (unsigned)((F.tid >> 4) * 1024 + (F.tid & 15) * 8), vgo = (unsigned)((F.tid >> 3) * T + (F.tid & 7) * 8);
        const int klo = (F.tid >> 4) * AT_KROW + (F.tid & 15) * 16, vlo = AT_KB + (F.tid >> 3) * AT_VROW + (F.tid & 7) * 16;
        const bf16_t* kbase = Kb + rowbase * 1024 + h * 128; const bf16_t* vbase = VT + (size_t)(h * 128) * T + rowbase;
        u32x4 sk[2], sv[2];
#pragma unroll
        for (int i = 0; i < 2; ++i) { sk[i] = ldg<u32x4>(kbase + (size_t)i * 32768 + kgo); sv[i] = ldg<u32x4>(vbase + (size_t)i * 64 * T + vgo); }
#pragma unroll
        for (int i = 0; i < 2; ++i) { *(LAS u32x4*)(F.lds + klo + i * 32 * AT_KROW) = sk[i]; *(LAS u32x2*)(F.lds + vlo + i * 64 * AT_VROW) = (u32x2){sv[i].x, sv[i].y}; *(LAS u32x2*)(F.lds + vlo + i * 64 * AT_VROW + 8) = (u32x2){sv[i].z, sv[i].w}; }
        __syncthreads();
        for (int t = 0; t < nkt; ++t) {
            const int cb = (t & 1) * AT_BUF, nb = ((t + 1) & 1) * AT_BUF;
            if (t + 1 < nkt) {
#pragma unroll
                for (int i = 0; i < 2; ++i) { sk[i] = ldg<u32x4>(kbase + (size_t)(t + 1) * 65536 + (size_t)i * 32768 + kgo); sv[i] = ldg<u32x4>(vbase + (size_t)i * 64 * T + (size_t)(t + 1) * 64 + vgo); }
            }
#pragma unroll 1
            for (int kb = 0; kb < 2; ++kb) {
                bf16x8 P[2][2];
#pragma unroll
                for (int mp = 0; mp < 2; ++mp) {
                    f32x16 S;
#pragma unroll
                    for (int i = 0; i < 16; ++i) S[i] = 0.f;
#pragma unroll
                    for (int ks = 0; ks < 4; ++ks) {
                        const bf16x8 kf = *(const LAS bf16x8*)(F.lds + cb + (kb * 32 + lr) * AT_KROW + (mp * 64 + ks * 16 + lh * 8) * 2);
                        const bf16x8 qf = *(const LAS bf16x8*)(F.lds + qlo + (mp * 4 + ks) * 1024);
                        S = __builtin_amdgcn_mfma_f32_32x32x16_bf16(kf, qf, S, 0, 0, 0);
                    }
                    float ps = 0.f;
#pragma unroll
                    for (int i = 0; i < 16; ++i) { S[i] = __builtin_amdgcn_exp2f(S[i] - OFF); ps += S[i]; }
                    if (mp == 0) l1 += ps; else l2 += ps;
#pragma unroll
                    for (int s = 0; s < 2; ++s) { u32x4 w; w.x = pk_bf16(S[8 * s], S[8 * s + 1]); w.y = pk_bf16(S[8 * s + 2], S[8 * s + 3]); w.z = pk_bf16(S[8 * s + 4], S[8 * s + 5]); w.w = pk_bf16(S[8 * s + 6], S[8 * s + 7]);
                        P[mp][s] = __builtin_bit_cast(bf16x8, w); }
                }
#pragma unroll
                for (int eb = 0; eb < 4; ++eb)
#pragma unroll
                    for (int s = 0; s < 2; ++s) {
                        const int vo = cb + AT_KB + (eb * 32 + lr) * AT_VROW + (kb * 32 + 16 * s + 4 * lh) * 2;
                        const s16x4 lo = *(const LAS s16x4*)(F.lds + vo), hi = *(const LAS s16x4*)(F.lds + vo + 16);
                        const bf16x8 vf = __builtin_shufflevector(lo, hi, 0, 1, 2, 3, 4, 5, 6, 7);
                        O1[eb] = __builtin_amdgcn_mfma_f32_32x32x16_bf16(vf, P[0][s], O1[eb], 0, 0, 0);
                        O2[eb] = __builtin_amdgcn_mfma_f32_32x32x16_bf16(vf, P[1][s], O2[eb], 0, 0, 0);
                        __builtin_amdgcn_sched_barrier(0);
                    }
            }
            if (t + 1 < nkt) {
#pragma unroll
                for (int i = 0; i < 2; ++i) { *(LAS u32x4*)(F.lds + nb + klo + i * 32 * AT_KROW) = sk[i]; *(LAS u32x2*)(F.lds + nb + vlo + i * 64 * AT_VROW) = (u32x2){sv[i].x, sv[i].y}; *(LAS u32x2*)(F.lds + nb + vlo + i * 64 * AT_VROW + 8) = (u32x2){sv[i].z, sv[i].w}; }
            }
            __syncthreads();
        }
        l1 += shx(l1, 32, lane); l2 += shx(l2, 32, lane);
        const float i1 = 1.0f / l1, i2 = lam_full / l2;
        float ss = 0.f;
#pragma unroll
        for (int e = 0; e < 4; ++e)
#pragma unroll
            for (int i = 0; i < 16; ++i) { const float o = O1[e][i] * i1 - O2[e][i] * i2; O1[e][i] = o; ss += o * o; }
        ss += shx(ss, 32, lane);
        const float rstd = __builtin_amdgcn_rsqf(ss * (1.0f / 128.0f) + RMS_EPS) * osc;
        bf16_t* orow = Ob + qrow * 1024 + h * 128;
#pragma unroll
        for (int e = 0; e < 4; ++e)
#pragma unroll
            for (int g4 = 0; g4 < 4; ++g4) {
                const int e0 = e * 32 + 8 * g4 + 4 * lh;
                const f32x4 gs = ldg<f32x4>(gsub + e0);
                u32x2 w; w.x = pk_bf16(O1[e][4 * g4] * rstd * gs[0], O1[e][4 * g4 + 1] * rstd * gs[1]); w.y = pk_bf16(O1[e][4 * g4 + 2] * rstd * gs[2], O1[e][4 * g4 + 3] * rstd * gs[3]);
                stg<u32x2>(orow + e0, w);
            }
    }
    __syncthreads();
}

constexpr int SC_Q = 0, SC_QROW = 528, SC_K = 32 * SC_QROW, SC_V = SC_K + 16384, SC_BUF = SC_V + 16384, SC_S = 2 * SC_BUF, SC_SROW = 80, SC_RED = SC_S + 2 * 32 * SC_SROW, SC_Y = SC_RED + 1024, SC_YROW = 528;
DI void scan_phase(const Frame& F, int layer, int hf) {
    const int j = layer >> 1;
    const bf16_t* RQ = (const bf16_t*)(F.ws + WS_PROJ + PJ_RQ); bf16_t* RG = (bf16_t*)(F.ws + WS_PROJ + PJ_RG);
    const bf16_t* RKT = (const bf16_t*)(F.ws + WS_PROJ + PJ_RKT); const bf16_t* RVT = (const bf16_t*)(F.ws + WS_PROJ + PJ_RVT);
    float* ssqb = (float*)(F.ws + WS_MISC + MS_SSQ);
    const int tid = F.tid;
    for (int u = F.bid; u < 256; u += F.G) {
        int bl, h, dir, eh;
        if (F.G == 256) { const int base = (u >> 5) * 8 + (u & 7), var = (u >> 3) & 3; bl = base >> 2; h = base & 3; dir = var >> 1; eh = var & 1; }
        else { bl = u >> 4; h = (u >> 2) & 3; dir = (u >> 1) & 1; eh = u & 1; }
        const float l2g = __log2f(1.0f - __expf(ldg<float>(F.a->in[15] + j * 8 + dir * 4 + h)));
        const float g32 = __builtin_amdgcn_exp2f(32.0f * l2g);
        const int sgn = dir ? -1 : 1, kd_a = dir ? 0 : 31, qd_a = dir ? 32 : 1;
        const size_t rb = (size_t)bl * NTOK;
        const bf16_t* qbase = RQ + rb * 1024 + h * 256;
        const bf16_t* ktbase = RKT + (size_t)(h * 256) * HROWS + rb;
        const bf16_t* vtbase = RVT + (size_t)(h * 512 + eh * 256) * HROWS + rb;
        bf16_t* gbase = RG + (rb + (tid >> 4)) * 4096 + dir * 2048 + h * 512 + eh * 256 + (tid & 15) * 16;
        const int qt = tid >> 5, qc = tid & 31;
        const unsigned qgo = (unsigned)(qt * 1024 + qc * 8);
        const int ql0 = SC_Q + qt * SC_QROW + qc * 16, ql1 = ql0 + 16 * SC_QROW;
        const int kd = tid >> 2, kc = tid & 3;
        const unsigned kgo = (unsigned)(kd * HROWS + kc * 8);
        const int kl = kd * 64 + (((kc ^ (kd >> 2)) & 3) << 4);
        f32x16 S[8];
#pragma unroll
        for (int d = 0; d < 8; ++d)
#pragma unroll
            for (int i = 0; i < 16; ++i) S[d][i] = 0.f;
        u32x4 sq[2], sk[2], sv[2];
        __syncthreads();
        {
            const int tok0 = dir ? 224 : 0;
#pragma unroll
            for (int i = 0; i < 2; ++i) { sq[i] = ldg<u32x4>(qbase + (size_t)(tok0 + 16 * i) * 1024 + qgo); sk[i] = ldg<u32x4>(ktbase + (size_t)i * 128 * HROWS + tok0 + kgo); sv[i] = ldg<u32x4>(vtbase + (size_t)i * 128 * HROWS + tok0 + kgo); }
            *(LAS u32x4*)(F.lds + ql0) = sq[0]; *(LAS u32x4*)(F.lds + ql1) = sq[1];
#pragma unroll
            for (int i = 0; i < 2; ++i) { *(LAS u32x4*)(F.lds + SC_K + kl + i * 8192) = sk[i]; *(LAS u32x4*)(F.lds + SC_V + kl + i * 8192) = sv[i]; }
        }
        __syncthreads();
        for (int ci = 0; ci < 72; ++ci) {
            const int tok0 = dir ? 32 * ((ci < 8 ? 7 : 79) - ci) : 32 * ci;
            const int t2 = launder(tid); const int lane = t2 & 63, lr = lane & 31, lh = lane >> 5, w = __builtin_amdgcn_readfirstlane(t2 >> 6), op = t2 >> 4, oc = t2 & 15;
            float l2c = l2g; asm volatile("" : "+v"(l2c));
            const int cb = (ci & 1) * SC_BUF, nb = SC_BUF - cb, sb = SC_S + (ci & 1) * 32 * SC_SROW;
            if (ci + 1 < 72) {
                const int cn = ci + 1; const int tn = dir ? 32 * ((cn < 8 ? 7 : 79) - cn) : 32 * cn;
#pragma unroll
                for (int i = 0; i < 2; ++i) { sq[i] = ldg<u32x4>(qbase + (size_t)(tn + 16 * i) * 1024 + qgo); sk[i] = ldg<u32x4>(ktbase + (size_t)i * 128 * HROWS + tn + kgo); sv[i] = ldg<u32x4>(vtbase + (size_t)i * 128 * HROWS + tn + kgo); }
            }
            const u32x4 gt0 = ldg<u32x4>(gbase + (size_t)tok0 * 4096), gt1 = ldg<u32x4>(gbase + (size_t)tok0 * 4096 + 8);
            if (w < 4) {
                const int p0 = 16 * (w >> 1), m0 = 16 * (w & 1);
                const int l15 = lane & 15, g4 = lane >> 4, tq = l15 >> 2, tp = l15 & 3;
                f32x4 sc = {0.f, 0.f, 0.f, 0.f};
                const bool dead = sgn * (p0 - m0) < 0;
                if (!dead) {
#pragma unroll
                    for (int ks = 0; ks < 8; ++ks) {
                        const int prow = p0 + l15, qchunk = 4 * ks + g4;
                        const bf16x8 af = *(const LAS bf16x8*)(F.lds + cb + SC_Q + prow * SC_QROW + qchunk * 16);
                        const int d0 = 32 * ks + 8 * g4 + tq, cc = (m0 >> 3) + (tp >> 1);
                        const s16x4 b0 = __builtin_amdgcn_ds_read_tr16_b64_v4i16((LAS s16x4*)(F.lds + cb + SC_K + d0 * 64 + (((cc ^ (d0 >> 2)) & 3) << 4) + 8 * (tp & 1)));
                        const s16x4 b1 = __builtin_amdgcn_ds_read_tr16_b64_v4i16((LAS s16x4*)(F.lds + cb + SC_K + (d0 + 4) * 64 + (((cc ^ ((d0 + 4) >> 2)) & 3) << 4) + 8 * (tp & 1)));
                        const bf16x8 bfr = __builtin_shufflevector(b0, b1, 0, 1, 2, 3, 4, 5, 6, 7);
                        sc = __builtin_amdgcn_mfma_f32_16x16x32_bf16(af, bfr, sc, 0, 0, 0);
                    }
                }
                const int mm = m0 + l15;
#pragma unroll
                for (int r = 0; r < 4; ++r) { const int pp = p0 + 4 * g4 + r; const int df = sgn * (pp - mm);
                    const float v = df >= 0 ? sc[r] * __builtin_amdgcn_exp2f((float)df * l2c) : 0.f;
                    *(LAS bf16_t*)(F.lds + sb + pp * SC_SROW + mm * 2) = (bf16_t)(pk_bf16(v, 0.f) & 0xffffu); }
            }
            __syncthreads();
            bf16x8 vf[2], vd[2];
            {
                const int e = 32 * w + lr;
#pragma unroll
                for (int ks = 0; ks < 2; ++ks) {
                    const int cc = 2 * ks + lh;
                    vf[ks] = *(const LAS bf16x8*)(F.lds + cb + SC_V + e * 64 + (((cc ^ (e >> 2)) & 3) << 4));
                    const u32x4 raw = __builtin_bit_cast(u32x4, vf[ks]); u32x4 o;
                    float kd8[8];
#pragma unroll
                    for (int jj = 0; jj < 8; ++jj) { const int t = 16 * ks + 8 * lh + jj; kd8[jj] = __builtin_amdgcn_exp2f((float)(kd_a - sgn * t) * l2c); }
                    o.x = pk_bf16(bf_lo(raw.x) * kd8[0], bf_hi(raw.x) * kd8[1]); o.y = pk_bf16(bf_lo(raw.y) * kd8[2], bf_hi(raw.y) * kd8[3]);
                    o.z = pk_bf16(bf_lo(raw.z) * kd8[4], bf_hi(raw.z) * kd8[5]); o.w = pk_bf16(bf_lo(raw.w) * kd8[6], bf_hi(raw.w) * kd8[7]);
                    vd[ks] = __builtin_bit_cast(bf16x8, o);
                }
            }
            f32x16 Y;
#pragma unroll
            for (int i = 0; i < 16; ++i) Y[i] = 0.f;
#pragma unroll
            for (int dt = 0; dt < 8; ++dt)
#pragma unroll
                for (int s = 0; s < 2; ++s) {
                    u32x4 pb; pb.x = pk_bf16(S[dt][8 * s], S[dt][8 * s + 1]); pb.y = pk_bf16(S[dt][8 * s + 2], S[dt][8 * s + 3]); pb.z = pk_bf16(S[dt][8 * s + 4], S[dt][8 * s + 5]); pb.w = pk_bf16(S[dt][8 * s + 6], S[dt][8 * s + 7]);
                    const int c0 = 4 * dt + 2 * s;
                    const s16x4 a0 = *(const LAS s16x4*)(F.lds + cb + SC_Q + lr * SC_QROW + c0 * 16 + 8 * lh);
                    const s16x4 a1 = *(const LAS s16x4*)(F.lds + cb + SC_Q + lr * SC_QROW + c0 * 16 + 16 + 8 * lh);
                    const bf16x8 af = __builtin_shufflevector(a0, a1, 0, 1, 2, 3, 4, 5, 6, 7);
                    Y = __builtin_amdgcn_mfma_f32_32x32x16_bf16(af, __builtin_bit_cast(bf16x8, pb), Y, 0, 0, 0);
                }
#pragma unroll
            for (int r = 0; r < 16; ++r) { const int p = (r & 3) + 8 * (r >> 2) + 4 * lh; Y[r] *= __builtin_amdgcn_exp2f((float)(qd_a + sgn * p) * l2c); }
#pragma unroll
            for (int ks = 0; ks < 2; ++ks) {
                const bf16x8 sf = *(const LAS bf16x8*)(F.lds + sb + lr * SC_SROW + (16 * ks + 8 * lh) * 2);
                Y = __builtin_amdgcn_mfma_f32_32x32x16_bf16(sf, vf[ks], Y, 0, 0, 0);
            }
#pragma unroll
            for (int dt = 0; dt < 8; ++dt) {
#pragma unroll
                for (int i = 0; i < 16; ++i) S[dt][i] *= g32;
#pragma unroll
                for (int ks = 0; ks < 2; ++ks) {
                    const int d = 32 * dt + lr, cc = 2 * ks + lh;
                    const bf16x8 kf = *(const LAS bf16x8*)(F.lds + cb + SC_K + d * 64 + (((cc ^ (d >> 2)) & 3) << 4));
                    S[dt] = __builtin_amdgcn_mfma_f32_32x32x16_bf16(kf, vd[ks], S[dt], 0, 0, 0);
                }
            }
            float q2[16];
#pragma unroll
            for (int r = 0; r < 16; ++r) { const float y = Y[r]; q2[r] = y * y;
                *(LAS bf16_t*)(F.lds + SC_Y + ((r & 3) + 8 * (r >> 2) + 4 * lh) * SC_YROW + (w * 32 + lr) * 2) = (bf16_t)(pk_bf16(y, 0.f) & 0xffffu); }
            {
                float a8[8];
#pragma unroll
                for (int i = 0; i < 8; ++i) { const bool hi = lr & 16; const float keep = hi ? q2[i + 8] : q2[i], send = hi ? q2[i] : q2[i + 8]; a8[i] = keep + shx(send, 16, lane); }
                float a4[4];
#pragma unroll
                for (int i = 0; i < 4; ++i) { const bool hi = lr & 8; const float keep = hi ? a8[i + 4] : a8[i], send = hi ? a8[i] : a8[i + 4]; a4[i] = keep + shx(send, 8, lane); }
                float a2[2];
#pragma unroll
                for (int i = 0; i < 2; ++i) { const bool hi = lr & 4; const float keep = hi ? a4[i + 2] : a4[i], send = hi ? a4[i] : a4[i + 2]; a2[i] = keep + shx(send, 4, lane); }
                float a1; { const bool hi = lr & 2; const float keep = hi ? a2[1] : a2[0], send = hi ? a2[0] : a2[1]; a1 = keep + shx(send, 2, lane); }
                a1 += shx(a1, 1, lane);
                const int r = (lr >> 1) & 15, p = (r & 3) + 8 * (r >> 2) + 4 * lh;
                if (!(lr & 1)) *(LAS float*)(F.lds + SC_RED + (w * 32 + p) * 4) = a1;
            }
            if (ci + 1 < 72) {
                *(LAS u32x4*)(F.lds + nb + ql0) = sq[0]; *(LAS u32x4*)(F.lds + nb + ql1) = sq[1];
#pragma unroll
                for (int i = 0; i < 2; ++i) { *(LAS u32x4*)(F.lds + nb + SC_K + kl + i * 8192) = sk[i]; *(LAS u32x4*)(F.lds + nb + SC_V + kl + i * 8192) = sv[i]; }
            }
            __syncthreads();
            {
                const u32x4 y0 = *(const LAS u32x4*)(F.lds + SC_Y + op * SC_YROW + oc * 32), y1 = *(const LAS u32x4*)(F.lds + SC_Y + op * SC_YROW + oc * 32 + 16);
                u32x4 z0, z1;
                z0.x = pk_bf16(bf_lo(y0.x) * bf_lo(gt0.x), bf_hi(y0.x) * bf_hi(gt0.x)); z0.y = pk_bf16(bf_lo(y0.y) * bf_lo(gt0.y), bf_hi(y0.y) * bf_hi(gt0.y));
                z0.z = pk_bf16(bf_lo(y0.z) * bf_lo(gt0.z), bf_hi(y0.z) * bf_hi(gt0.z)); z0.w = pk_bf16(bf_lo(y0.w) * bf_lo(gt0.w), bf_hi(y0.w) * bf_hi(gt0.w));
                z1.x = pk_bf16(bf_lo(y1.x) * bf_lo(gt1.x), bf_hi(y1.x) * bf_hi(gt1.x)); z1.y = pk_bf16(bf_lo(y1.y) * bf_lo(gt1.y), bf_hi(y1.y) * bf_hi(gt1.y));
                z1.z = pk_bf16(bf_lo(y1.z) * bf_lo(gt1.z), bf_hi(y1.z) * bf_hi(gt1.z)); z1.w = pk_bf16(bf_lo(y1.w) * bf_lo(gt1.w), bf_hi(y1.w) * bf_hi(gt1.w));
                stg<u32x4>(gbase + (size_t)tok0 * 4096, z0); stg<u32x4>(gbase + (size_t)tok0 * 4096 + 8, z1);
            }
            if (tid < 32) { float s = 0.f;
#pragma unroll
                for (int ww = 0; ww < 8; ++ww) s += *(const LAS float*)(F.lds + SC_RED + (ww * 32 + tid) * 4);
                stg<float>(ssqb + (((size_t)eh * 2 + dir) * HROWS + rb + tok0 + tid) * 4 + h, s); }
        }
    }
    __syncthreads();
}

DI void comb_phase(const Frame& F, int hf) {
    const bf16_t* PJ = (const bf16_t*)(F.ws + WS_PROJ + PJ_RG);
    const float* ssqb = (const float*)(F.ws + WS_MISC + MS_SSQ);
    bf16_t* O = (bf16_t*)(F.ws + (hf == 0 ? WS_OBUF : WS_ABUF));
    for (int r = F.bid * 8 + F.wave; r < 36864; r += F.G * 8) {
#pragma unroll
        for (int i = 0; i < 4; ++i) {
            const float sf = ldg<float>(ssqb + ((size_t)(0 * 2 + 0) * 36864 + r) * 4 + i) + ldg<float>(ssqb + ((size_t)(1 * 2 + 0) * 36864 + r) * 4 + i);
            const float sb = ldg<float>(ssqb + ((size_t)(0 * 2 + 1) * 36864 + r) * 4 + i) + ldg<float>(ssqb + ((size_t)(1 * 2 + 1) * 36864 + r) * 4 + i);
            const float rf = 1.0f / sqrtf(sf * (1.0f / 512.0f) + RMS_EPS), rb = 1.0f / sqrtf(sb * (1.0f / 512.0f) + RMS_EPS);
            const int c = i * 512 + F.lane * 8;
            const u32x4 zf = ldg<u32x4>(PJ + (size_t)r * 4096 + c), zb = ldg<u32x4>(PJ + (size_t)r * 4096 + 2048 + c);
            u32x4 w;
            w.x = pk_bf16(rf * bf_lo(zf.x) + rb * bf_lo(zb.x), rf * bf_hi(zf.x) + rb * bf_hi(zb.x));
            w.y = pk_bf16(rf * bf_lo(zf.y) + rb * bf_lo(zb.y), rf * bf_hi(zf.y) + rb * bf_hi(zb.y));
            w.z = pk_bf16(rf * bf_lo(zf.z) + rb * bf_lo(zb.z), rf * bf_hi(zf.z) + rb * bf_hi(zb.z));
            w.w = pk_bf16(rf * bf_lo(zf.w) + rb * bf_lo(zb.w), rf * bf_hi(zf.w) + rb * bf_hi(zb.w));
            stg<u32x4>(O + (size_t)r * 2048 + c, w);
        }
    }
}

DI void final_phase(const Frame& F) {
    const bf16_t* y2 = (const bf16_t*)(F.ws + WS_PROJ + PJ_Y2);
    for (int r = F.bid * 8 + F.wave; r < T; r += F.G * 8) {
        const int b = r / NTOK, n = r % NTOK; if (n < CTXL) continue;
        float* hp = F.out + ((size_t)b * 2048 + (n - 256)) * 1024; const float* modp = mod_lat(F, 3, b);
#pragma unroll
        for (int i = 0; i < 4; ++i) {
            f32x4 x = ldg<f32x4>(hp + i * 256 + F.lane * 4);
            const u32x2 a = ldg<u32x2>(y2 + (size_t)(2 * r) * 1024 + i * 256 + F.lane * 4), c = ldg<u32x2>(y2 + (size_t)(2 * r + 1) * 1024 + i * 256 + F.lane * 4);
            const f32x4 g2 = ldg<f32x4>(modp + 5120 + i * 256 + F.lane * 4);
            x[0] += g2[0] * (bf_lo(a.x) + bf_lo(c.x)); x[1] += g2[1] * (bf_hi(a.x) + bf_hi(c.x)); x[2] += g2[2] * (bf_lo(a.y) + bf_lo(c.y)); x[3] += g2[3] * (bf_hi(a.y) + bf_hi(c.y));
            stg<f32x4>(hp + i * 256 + F.lane * 4, x);
        }
    }
}

constexpr int NPHASE = 50;
__global__ void __launch_bounds__(512, 2) fwd_kernel(Args args) {
    extern __shared__ __attribute__((aligned(16))) unsigned char lds_raw[];
    Frame F;
    F.a = &args;
    F.out = args.out; F.ws = args.ws; F.lds = (LAS unsigned char*)lds_raw;
    F.tid = threadIdx.x; F.lane = F.tid & 63; F.wave = __builtin_amdgcn_readfirstlane(F.tid >> 6); F.G = gridDim.x;
    const int lo = args.ph_lo, hi = args.ph_hi;
    const int wave_s = __builtin_amdgcn_readfirstlane((int)threadIdx.x >> 6);
    volatile LAS unsigned* bst = (volatile LAS unsigned*)(F.lds + LDS_MISC);
    if (F.tid < 4) bst[F.tid] = 0u;
    __syncthreads();
    XcdBarrier bar; bar.bar = (unsigned*)(F.ws + WS_CTL) + CW_BAR; bar.x = 0; bar.st = bst;
    if (hi - lo > 1) bar = xcd_barrier_post((unsigned*)(F.ws + WS_CTL) + CW_BAR, bst);
#ifndef PH_MASK
#define PH_MASK 0xFFFFFFFFu
#endif
#define PHASE(site, p, ...) do { if (((PH_MASK >> (site)) & 1u) && lo <= (p) && (p) < hi) { F.ws = launder_p(args.ws); F.out = (float*)launder_p((unsigned char*)args.out); { int ws_ = wave_s, bi_ = (int)blockIdx.x; asm volatile("" : "+s"(ws_), "+s"(bi_)); F.wave = ws_; F.bid = bi_; } F.lane = lane_id_asm(); F.tid = (F.wave << 6) | F.lane; __VA_ARGS__; if ((p) + 1 < hi) xcd_barrier(bar, F.tid); } } while (0)

    PHASE(0, 0, p0_prologue(F));
    for (int layer = 0; layer < DEPTH; ++layer) {
        const int pb = 1 + 12 * layer, j = layer >> 1; const bool isRT = layer & 1;
        PHASE(1, pb + 0, { norm_phase<false>(F, layer); if (layer > 0) convert_moe_weights(F, layer); });
        if (!isRT) {
            PHASE(2, pb + 1, {
                ProbQKV S; S.K = 1024; S.abuf = (const char*)(F.ws + WS_ABUF); S.wqk = (const char*)(F.ws + WS_WQK) + (size_t)j * 2048 * 1024 * 2; S.wv = (const char*)(F.ws + WS_WV) + (size_t)j * 1024 * 1024 * 2;
                S.go.init(NTILE, 8); S.G = F.G; S.c = F.bid;
                EpiQKV E{(bf16_t*)(F.ws + WS_PROJ + PJ_Q), (bf16_t*)(F.ws + WS_PROJ + PJ_K), (bf16_t*)(F.ws + WS_PROJ + PJ_VT), F.a->in[9] + j * 64, F.a->in[10] + j * 64,
                         (const float*)(F.ws + WS_ROPE + RP_CDA), (const float*)(F.ws + WS_ROPE + RP_SDA)};
                pg8::gemm_phase<EpiQKV, ProbQKV, true>(F.lds, S, E, F.tid, F.wave);
            });
            PHASE(3, pb + 2, attn_phase(F, layer));
        } else {
            for (int hf = 0; hf < 2; ++hf) {
                PHASE(4, pb + 1 + 3 * hf, {
                    ProbWIN S; S.K = 1024; S.abuf = (const char*)(F.ws + WS_ABUF) + (size_t)hf * 144 * 256 * 1024 * 2; S.win = (const char*)(F.ws + WS_WIN) + (size_t)j * 8192 * 1024 * 2;
                    S.go.init(144, 20); S.G = F.G; S.c = F.bid;
                    EpiWIN E{(bf16_t*)(F.ws + WS_PROJ + PJ_RQ), (bf16_t*)(F.ws + WS_PROJ + PJ_RG), (bf16_t*)(F.ws + WS_PROJ + PJ_RKT), (bf16_t*)(F.ws + WS_PROJ + PJ_RVT), hf * 144,
                             (const float*)(F.ws + WS_ROPE + RP_CRT), (const float*)(F.ws + WS_ROPE + RP_SRT), (const float*)(F.ws + WS_MISC + MS_CRTT), (const float*)(F.ws + WS_MISC + MS_SRTT)};
                    pg8::gemm_phase<EpiWIN, ProbWIN, true>(F.lds, S, E, F.tid, F.wave);
                });
                PHASE(5, pb + 2 + 3 * hf, scan_phase(F, layer, hf));
                PHASE(6, pb + 3 + 3 * hf, comb_phase(F, hf));
            }
        }
        PHASE(7, pb + 7, {
            ProbDense S; S.G = F.G; S.c = F.bid; S.go.init(NTILE, 4);
            if (!isRT) { S.K = 1024; S.A0 = (const char*)(F.ws + WS_OBUF); S.A1 = S.A0; S.pm_split = 1 << 30; S.Bt = (const char*)(F.ws + WS_WODA) + (size_t)j * 1024 * 1024 * 2; }
            else { S.K = 2048; S.A0 = (const char*)(F.ws + WS_OBUF); S.A1 = (const char*)(F.ws + WS_ABUF); S.pm_split = 144; S.Bt = (const char*)(F.ws + WS_WORT) + (size_t)j * 1024 * 2048 * 2; }
            float* hctx = (float*)(F.ws + WS_HCTX);
            EpiResid E{layer == 0 ? F.a->in[2] : hctx, layer == 0 ? F.a->in[0] : F.out, hctx, F.out, (const float*)(F.ws + WS_ADA) + (size_t)layer * 33 * 6144};
            pg8::gemm_phase<EpiResid, ProbDense, true>(F.lds, S, E, F.tid, F.wave);
        });
        PHASE(8, pb + 8, norm_phase<true>(F, layer));
        PHASE(9, pb + 9, sort_phase(F, layer));
        PHASE(10, pb + 10, {
            LAS int* segs = (LAS int*)(F.lds + LDS_MISC + 2048); LAS int* tile_e = (LAS int*)(F.lds + LDS_TILE_E);
            const int ntl = build_segments(F, layer, segs, tile_e);
            ProbMoE S; S.K = 1024; S.A = (const char*)(F.ws + WS_PROJ + PJ_SA); S.W = (const char*)(F.ws + WS_WGU); S.tile_e = tile_e; S.go.init(ntl, 4); S.G = F.G; S.c = F.bid;
            EpiSwiGLU E{(bf16_t*)(F.ws + WS_PROJ + PJ_ACT)};
            pg8::gemm_phase<EpiSwiGLU, ProbMoE, true>(F.lds, S, E, F.tid, F.wave);
        });
        PHASE(11, pb + 11, {
            LAS int* segs = (LAS int*)(F.lds + LDS_MISC + 2048); LAS int* tile_e = (LAS int*)(F.lds + LDS_TILE_E);
            const int ntl = build_segments(F, layer, segs, tile_e);
            ProbMoE S; S.K = 512; S.A = (const char*)(F.ws + WS_PROJ + PJ_ACT); S.W = (const char*)(F.ws + WS_WD); S.tile_e = tile_e; S.go.init(ntl, 4); S.G = F.G; S.c = F.bid;
            EpiDown E{(bf16_t*)(F.ws + WS_PROJ + PJ_Y2), (const int*)(F.ws + WS_MISC + MS_ROWMAP), (const float*)(F.ws + WS_MISC + MS_WSEL)};
            pg8::gemm_phase<EpiDown, ProbMoE, true>(F.lds, S, E, F.tid, F.wave);
        });
    }
    PHASE(12, 49, final_phase(F));
#undef PHASE
}

static bool phase_exists(int p) {
    if (p == 0 || p == 49) return true;
    const int layer = (p - 1) / 12, slot = (p - 1) % 12; const bool isRT = layer & 1;
    if (!isRT && slot >= 3 && slot <= 6) return false;
    return true;
}
extern "C" void kernel_launch(void* const* d_in, const int* in_sizes, int n_in, void* d_out, int out_size, void* d_ws, size_t ws_size, hipStream_t stream) {
    static int grid = 0;
    if (grid == 0) {
        if (n_in != 24 || ws_size < WS_END) { fprintf(stderr, "kernel_launch: need 24 inputs and >= %zu bytes of workspace (got %d, %zu)\n", (size_t)WS_END, n_in, ws_size); grid = -1; return; }
        int dev = 0, cus = 0, per_cu = 0;
        if (hipGetDevice(&dev) != hipSuccess || hipDeviceGetAttribute(&cus, hipDeviceAttributeMultiprocessorCount, dev) != hipSuccess) { grid = -1; return; }
        if (hipFuncSetAttribute((const void*)fwd_kernel, hipFuncAttributeMaxDynamicSharedMemorySize, LDS_BYTES) != hipSuccess) { fprintf(stderr, "kernel_launch: hipFuncSetAttribute failed\n"); grid = -1; return; }
        if (hipOccupancyMaxActiveBlocksPerMultiprocessor(&per_cu, (const void*)fwd_kernel, 512, LDS_BYTES) != hipSuccess || per_cu < 1) fprintf(stderr, "kernel_launch: occupancy query reports %d\n", per_cu);
        (void)hipGetLastError();
        grid = cus;
    }
    if (grid < 0) return;
    (void)hipMemsetAsync((char*)d_ws + WS_CTL, 0, 1 * MiB, stream);
    Args a{};
    for (int i = 0; i < 24; ++i) a.in[i] = (const float*)d_in[i];
    a.out = (float*)d_out; a.ws = (unsigned char*)d_ws;
#ifdef MULTI_LAUNCH
    for (int p = 0; p < NPHASE; ++p) { if (!phase_exists(p)) continue; a.ph_lo = p; a.ph_hi = p + 1; hipLaunchKernelGGL(fwd_kernel, dim3(grid), dim3(512), LDS_BYTES, stream, a); }
#elif defined(PROBE_DUP_LO)
    a.ph_lo = 0; a.ph_hi = PROBE_DUP_HI; hipLaunchKernelGGL(fwd_kernel, dim3(grid), dim3(512), LDS_BYTES, stream, a);
    for (int p = PROBE_DUP_LO; p < PROBE_DUP_HI; ++p) { if (!phase_exists(p)) continue; a.ph_lo = p; a.ph_hi = p + 1; hipLaunchKernelGGL(fwd_kernel, dim3(grid), dim3(512), LDS_BYTES, stream, a); }
    (void)hipMemsetAsync((char*)d_ws + WS_CTL, 0, 16384, stream);
    a.ph_lo = PROBE_DUP_HI; a.ph_hi = NPHASE; hipLaunchKernelGGL(fwd_kernel, dim3(grid), dim3(512), LDS_BYTES, stream, a);
#else
    a.ph_lo = 0; a.ph_hi = NPHASE; hipLaunchKernelGGL(fwd_kernel, dim3(grid), dim3(512), LDS_BYTES, stream, a);
#endif
}
```

```cpp
#include <hip/hip_runtime.h>
#include <cstdio>
#include <cstdint>

#define LAS __attribute__((address_space(3)))
constexpr float LOG2E = 1.4426950408889634f;
#define DI __device__ __forceinline__
typedef unsigned short bf16_t;
typedef short bf16x8 __attribute__((ext_vector_type(8)));
typedef short s16x4 __attribute__((ext_vector_type(4)));
typedef float f32x4 __attribute__((ext_vector_type(4)));
typedef float f32x2 __attribute__((ext_vector_type(2)));
typedef float f32x16 __attribute__((ext_vector_type(16)));
typedef unsigned u32x4 __attribute__((ext_vector_type(4)));
typedef unsigned u32x2 __attribute__((ext_vector_type(2)));
typedef __bf16 bf16x2_t __attribute__((ext_vector_type(2)));

#define GAS __attribute__((address_space(1)))
template <class V, class T> DI V ldg(const T* p) { return *(const GAS V*)(unsigned long long)p; }
template <class V, class T> DI void stg(T* p, V v) { *(GAS V*)(unsigned long long)p = v; }
DI unsigned pk_bf16(float lo, float hi) { f32x2 v = {lo, hi}; return __builtin_bit_cast(unsigned, __builtin_convertvector(v, bf16x2_t)); }
DI float bf_lo(unsigned u) { return __uint_as_float(u << 16); }
DI float bf_hi(unsigned u) { return __uint_as_float(u & 0xffff0000u); }
DI float bf_f(bf16_t v) { return __uint_as_float(((unsigned)v) << 16); }
DI unsigned char* launder_p(unsigned char* p) { asm volatile("" : "+s"(p)); return p; }
DI float shx(float v, int o, int lane) { return __builtin_bit_cast(float, __builtin_amdgcn_ds_bpermute((lane ^ o) << 2, __builtin_bit_cast(int, v))); }
DI float wave_sum(float v, int lane) {
#pragma unroll
    for (int o = 32; o >= 1; o >>= 1) v += shx(v, o, lane);
    return v;
}
DI int lane_id_asm() { int x; asm volatile("v_mbcnt_lo_u32_b32 %0, -1, 0\n\tv_mbcnt_hi_u32_b32 %0, -1, %0" : "=v"(x)); return x; }
DI int launder(int x) { asm volatile("" : "+v"(x)); return x; }
DI float silu_f(float x) { return x * __builtin_amdgcn_rcpf(1.0f + __builtin_amdgcn_exp2f(-LOG2E * x)); }

constexpr int NB = 32, SEQ = 2048, CTXL = 256, NTOK = SEQ + CTXL, DM = 1024, DEPTH = 4;
constexpr int T = NB * NTOK;
constexpr int NTILE = T / 256;
constexpr int NEXP = 32, MOEH = 512;
constexpr int MAXROWS = 2 * T + NEXP * 256;
constexpr float RMS_EPS = 1e-6f;

constexpr size_t MiB = 1ull << 20;
constexpr size_t WS_CTL = 0;
constexpr size_t WS_ADA = 1 * MiB;
constexpr size_t WS_ROPE = 5 * MiB;
constexpr size_t WS_MISC = 8 * MiB;
constexpr size_t WS_HCTX = 16 * MiB;
constexpr size_t WS_WQK = 48 * MiB;
constexpr size_t WS_WV = 56 * MiB;
constexpr size_t WS_WODA = 60 * MiB;
constexpr size_t WS_WIN = 64 * MiB;
constexpr size_t WS_WORT = 96 * MiB;
constexpr size_t WS_WGU = 104 * MiB;
constexpr size_t WS_WD = 168 * MiB;
constexpr size_t WS_ABUF = 200 * MiB;
constexpr size_t WS_OBUF = 344 * MiB;
constexpr size_t WS_PROJ = 488 * MiB;
constexpr size_t WS_END = 1064 * MiB;
constexpr size_t PJ_Q = 0, PJ_K = 144 * MiB, PJ_VT = 288 * MiB;
constexpr size_t PJ_SA = 0, PJ_ACT = 304 * MiB, PJ_Y2 = 0;
constexpr size_t PJ_RQ = 0, PJ_RG = 72 * MiB, PJ_RKT = 360 * MiB, PJ_RVT = 432 * MiB;
constexpr int HROWS = 36864;
constexpr size_t RP_CDA = 0, RP_SDA = 256 * 1024, RP_CRT = 512 * 1024, RP_SRT = 512 * 1024 + 1 * MiB;
constexpr size_t MS_EID = 0, MS_WSEL = 1 * MiB, MS_ROWMAP = 2 * MiB, MS_SSQ = 3 * MiB, MS_CRTT = 6 * MiB, MS_SRTT = 7 * MiB;
constexpr int CW_BAR = 0;
constexpr int CW_CNT = 4096;
constexpr int CW_CUR = 4096 + 256;

constexpr int LDS_BYTES = 155648;
constexpr int LDS_MISC = 147456;
constexpr int LDS_TILE_E = 131072;

#define XB_TMO      128
#define XB_XCNT(j)  (256  + 64 * (j))
#define XB_XSUB(j)  (1280 + 64 * (j))
#define XB_XGEN(j)  (2304 + 64 * (j))
#define XB_TOP      3328
#define XB_TOPGEN   3392
#define XCD_BAR_WORDS 3456
#define XB_SPIN_CAP (1u << 18)

__device__ __forceinline__ unsigned xb_ld(unsigned* p)              { return __hip_atomic_load(p, __ATOMIC_RELAXED, __HIP_MEMORY_SCOPE_AGENT); }
__device__ __forceinline__ unsigned xb_add(unsigned* p, unsigned v) { return __hip_atomic_fetch_add(p, v, __ATOMIC_RELAXED, __HIP_MEMORY_SCOPE_AGENT); }
__device__ __forceinline__ unsigned xb_xcc_id() { return (unsigned)__builtin_amdgcn_s_getreg((3 << 11) | 20) & 0xFu; }
#define XB_SPIN(cond, bar) do { unsigned _sp = 0; while (cond) { __builtin_amdgcn_s_sleep(1); \
    if ((++_sp & 255u) == 0u) { if (xb_ld(&(bar)[XB_TMO])) break; if (_sp > XB_SPIN_CAP) { atomicAdd(&(bar)[XB_TMO], 1u); break; } } } } while (0)

struct XcdBarrier { unsigned* bar; unsigned x; volatile LAS unsigned* st; };

__device__ __forceinline__ XcdBarrier xcd_barrier_post(unsigned* bar, volatile LAS unsigned* st) {
    XcdBarrier b; b.bar = bar; b.x = xb_xcc_id(); b.st = st;
    if (threadIdx.x == 0) (void)xb_add(&bar[XB_XCNT(b.x)], 1u);
    return b;
}
__device__ __forceinline__ void xcd_barrier_complete(unsigned* bar, unsigned x, unsigned& nloc, unsigned& nx) {
    const unsigned G = gridDim.x * gridDim.y * gridDim.z;
    unsigned sum, cnt, mine, sp = 0u;
    for (;;) {
        sum = 0u; cnt = 0u; mine = 0u;
#pragma unroll
        for (unsigned j = 0; j < 16; ++j) { const unsigned c = xb_ld(&bar[XB_XCNT(j)]); sum += c; cnt += (c > 0u) ? 1u : 0u; mine = (j == x) ? c : mine; }
        if (sum == G) break;
        __builtin_amdgcn_s_sleep(1);
        if ((++sp & 255u) == 0u) { if (xb_ld(&bar[XB_TMO])) break; if (sp > XB_SPIN_CAP) { atomicAdd(&bar[XB_TMO], 1u); break; } }
    }
    nloc = mine > 0u ? mine : 1u; nx = cnt > 0u ? cnt : 1u;
}
__device__ __forceinline__ void xcd_barrier(const XcdBarrier& b, const int tid0) {
    asm volatile("s_waitcnt vmcnt(0)" ::: "memory");
    __syncthreads();
    if (tid0 == 0) {
        unsigned* bar = (unsigned*)launder_p((unsigned char*)b.bar);
        __builtin_amdgcn_s_waitcnt(0);
        unsigned nloc = b.st[0], nx = b.st[1];
        if (nloc == 0u) { xcd_barrier_complete(bar, b.x, nloc, nx); b.st[0] = nloc; b.st[1] = nx; }
        const unsigned old = xb_add(&bar[XB_XSUB(b.x)], 1u);
        const unsigned gen = old / nloc;
        if (old + 1u == (gen + 1u) * nloc) {
            __builtin_amdgcn_fence(__ATOMIC_RELEASE, "agent");
            asm volatile("s_waitcnt vmcnt(0)" ::: "memory");
            const unsigned og = xb_add(&bar[XB_TOP], 1u);
            const unsigned tg = og / nx;
            if (og + 1u == (tg + 1u) * nx) xb_add(&bar[XB_TOPGEN], 1u);
            else XB_SPIN(xb_ld(&bar[XB_TOPGEN]) == tg, bar);
            __builtin_amdgcn_fence(__ATOMIC_ACQUIRE, "agent");
            xb_add(&bar[XB_XGEN(b.x)], 1u);
            asm volatile("s_waitcnt vmcnt(0)" ::: "memory");
        } else {
            XB_SPIN(xb_ld(&bar[XB_XGEN(b.x)]) == gen, bar);
            __builtin_amdgcn_fence(__ATOMIC_ACQUIRE, "agent");
            asm volatile("s_waitcnt vmcnt(0)" ::: "memory");
        }
    }
    __syncthreads();
}

struct Args { const float* in[24]; float* out; unsigned char* ws; int ph_lo, ph_hi; };
struct Frame {
    const Args* a; float* out; unsigned char* ws; LAS unsigned char* lds;
    int tid, lane, wave, G, bid;
};
DI const float* mod_lat(const Frame& F, int layer, int b) { return (const float*)(F.ws + WS_ADA) + ((size_t)layer * 33 + b) * 6144; }
DI const float* mod_ctx(const Frame& F, int layer) { return (const float*)(F.ws + WS_ADA) + ((size_t)layer * 33 + 32) * 6144; }

namespace pg8 {
constexpr int BM = 256, BK = 64, HALF = 128, HTB = HALF * BK * 2, STAGE_BYTES = 8 * HTB, NXCD = 8, WGM = 8;
__host__ __device__ __forceinline__ int lds_byte(int r, int c) { const int st = (r >> 4) * 2 + (c >> 5), rr = r & 15, cc = c & 31, ob = rr * 64 + cc * 2; return st * 1024 + (ob ^ (((ob >> 9) & 1) << 5)); }
__host__ __device__ __forceinline__ void stage_rc(int b, int& R, int& C) { const int st = b / 1024, sb = b % 1024, swz = sb ^ (((sb >> 9) & 1) << 5); R = (st >> 1) * 16 + swz / 64; C = (st & 1) * 32 + (swz % 64) / 2; }
__host__ __device__ __forceinline__ int perm32(int rho) { const int n = rho >> 4, i = rho & 15; return 8 * (i >> 2) + 4 * n + (i & 3); }

struct Unit { int pm, pn, kind; };

struct GridOrder {
    int nM, nN, nwg;
    DI void init(int nM_, int nN_) { nM = nM_; nN = nN_; nwg = nM * nN; }
    DI bool map(long L, int& pm, int& pn) const {
        if (L >= nwg) return false;
        int wgid = (int)L; { const int q = nwg / NXCD, r = nwg % NXCD, xcd = wgid % NXCD, off = wgid / NXCD; wgid = (xcd < r ? xcd * (q + 1) : r * (q + 1) + (xcd - r) * q) + off; }
        const int nig = WGM * nN, gid = wgid / nig, fm = gid * WGM, gsz = (nM - fm) < WGM ? (nM - fm) : WGM;
        pm = fm + ((wgid % nig) % gsz); pn = (wgid % nig) / gsz; return true;
    }
};

template <class Epi, class P, bool ALIGN_EPI>
DI void gemm_phase(LAS unsigned char* lds, const P& S, const Epi& E, const int tid, const int wid) {
    const int lane = tid & 63, wr = wid >> 2, wc = wid & 3, fr = lane & 15, fq = lane >> 4;
    const int K = S.K, nt = K / BK;
    unsigned voffA[2], voffB[2];
#pragma unroll
    for (int i = 0; i < 2; ++i) { int R, C; stage_rc(tid * 16 + i * 8192, R, C); const int Rb = Epi::PERM ? ((R & ~31) + perm32(R & 31)) : R;
        voffA[i] = (unsigned)(R * K + C) * 2u; voffB[i] = (unsigned)(Rb * K + C) * 2u; }
    const size_t kstep = (size_t)(BK * 2);
    const size_t hstep = (size_t)HALF * K * 2;
    const unsigned ldsw = (unsigned)wid * 1024u;
    const int aoff = lds_byte(wr * 64 + fr, fq * 8), boff = lds_byte(wc * 32 + fr, fq * 8);
#define PG8_SA(b, h) (((b) * 2 + (h)) * HTB)
#define PG8_SB(b, h) ((4 + (b) * 2 + (h)) * HTB)
#define PG8_STAGE(bufoff, gbase, voff) do { _Pragma("unroll") for (int _i = 0; _i < 2; ++_i) \
        __builtin_amdgcn_global_load_lds((const unsigned*)((const char*)(gbase) + (voff)[_i]), (LAS unsigned*)(lds + (bufoff) + ldsw + _i * 8192), 16, 0, 0); } while (0)
#define PG8_LDA(dst, b, h) do { _Pragma("unroll") for (int m = 0; m < 4; ++m) _Pragma("unroll") for (int k = 0; k < 2; ++k) dst[m][k] = *(const LAS bf16x8*)(lds + PG8_SA(b, h) + aoff + m * 2048 + k * 1024); } while (0)
#define PG8_LDB(dst, b, h) do { _Pragma("unroll") for (int n = 0; n < 2; ++n) _Pragma("unroll") for (int k = 0; k < 2; ++k) dst[n][k] = *(const LAS bf16x8*)(lds + PG8_SB(b, h) + boff + n * 2048 + k * 1024); } while (0)
#define PG8_MMA(ai, bj, At, Bt) do { __builtin_amdgcn_s_setprio(1); _Pragma("unroll") for (int m = 0; m < 4; ++m) _Pragma("unroll") for (int n = 0; n < 2; ++n) _Pragma("unroll") for (int k = 0; k < 2; ++k) \
        acc[ai][bj][m][n] = __builtin_amdgcn_mfma_f32_16x16x32_bf16(Bt[n][k], At[m][k], acc[ai][bj][m][n], 0, 0, 0); __builtin_amdgcn_s_setprio(0); } while (0)
#define PG8_WAIT_V(n) asm volatile("s_waitcnt vmcnt(" #n ")" ::: "memory")
#define PG8_WAIT_L(n) asm volatile("s_waitcnt lgkmcnt(" #n ")" ::: "memory")
#define PG8_BAR __builtin_amdgcn_s_barrier()
#define PG8_SCHED __builtin_amdgcn_sched_barrier(0)
    Unit cur, nxt; int ui = 0;
    if (!S.next(0, cur)) return;
    f32x4 acc[2][2][4][2];
#pragma unroll
    for (int a = 0; a < 2; ++a)
#pragma unroll
        for (int b = 0; b < 2; ++b)
#pragma unroll
            for (int m = 0; m < 4; ++m)
#pragma unroll
                for (int n = 0; n < 2; ++n) acc[a][b][m][n] = (f32x4){0.f, 0.f, 0.f, 0.f};
    bf16x8 At[4][2], B0[2][2], B1[2][2];
    const char* cA = S.a_ptr(cur); const char* cB = S.b_ptr(cur);
    PG8_STAGE(PG8_SB(0, 0), cB, voffB); PG8_STAGE(PG8_SB(0, 1), cB + hstep, voffB); PG8_STAGE(PG8_SA(0, 0), cA, voffA); PG8_STAGE(PG8_SA(0, 1), cA + hstep, voffA);
    if (wr == 1) PG8_BAR;
    PG8_WAIT_V(2); PG8_BAR;
    PG8_STAGE(PG8_SB(1, 0), cB + kstep, voffB); PG8_STAGE(PG8_SA(1, 0), cA + kstep, voffA); PG8_STAGE(PG8_SB(1, 1), cB + hstep + kstep, voffB);
    PG8_WAIT_V(6); PG8_BAR;
    for (;;) {
        const bool has_next = S.next(ui + 1, nxt);
        const char* nA = has_next ? S.a_ptr(nxt) : cA; const char* nB = has_next ? S.b_ptr(nxt) : cB;
        for (int t = 0; t < nt; t += 2) {
            const bool last = (t == nt - 2);
            const char* a1 = cA + (size_t)(t + 1) * kstep;
            const char* a2 = last ? nA : cA + (size_t)(t + 2) * kstep; const char* b2 = last ? nB : cB + (size_t)(t + 2) * kstep;
            const char* a3 = a2 + kstep; const char* b3 = b2 + kstep;
            PG8_LDB(B0, 0, 0); PG8_LDB(B1, 0, 1); PG8_SCHED; PG8_LDA(At, 0, 0); PG8_STAGE(PG8_SA(1, 1), a1 + hstep, voffA);
            PG8_WAIT_V(8); PG8_WAIT_L(0); PG8_BAR; PG8_MMA(0, 0, At, B0); PG8_MMA(0, 1, At, B1); PG8_BAR; PG8_SCHED;
            PG8_LDA(At, 0, 1); PG8_STAGE(PG8_SB(0, 0), b2, voffB); PG8_STAGE(PG8_SB(0, 1), b2 + hstep, voffB); PG8_STAGE(PG8_SA(0, 0), a2, voffA);
            PG8_WAIT_V(8); PG8_WAIT_L(0); PG8_BAR; PG8_MMA(1, 0, At, B0); PG8_MMA(1, 1, At, B1); PG8_BAR; PG8_SCHED;
            PG8_LDB(B0, 1, 0); PG8_LDB(B1, 1, 1); PG8_SCHED; PG8_LDA(At, 1, 0); PG8_STAGE(PG8_SA(0, 1), a2 + hstep, voffA);
            PG8_WAIT_V(8); PG8_WAIT_L(0); PG8_BAR; PG8_MMA(0, 0, At, B0); PG8_MMA(0, 1, At, B1); PG8_BAR; PG8_SCHED;
            PG8_LDA(At, 1, 1); PG8_STAGE(PG8_SB(1, 0), b3, voffB); PG8_STAGE(PG8_SB(1, 1), b3 + hstep, voffB); PG8_STAGE(PG8_SA(1, 0), a3, voffA);
            PG8_WAIT_V(8); PG8_WAIT_L(0); PG8_BAR; PG8_MMA(1, 0, At, B0); PG8_MMA(1, 1, At, B1); PG8_BAR; PG8_SCHED;
        }
        if constexpr (ALIGN_EPI) { if (wr == 0) PG8_BAR; }
        E(acc, cur, wr, wc, fr, fq);
        if (!has_next) break;
#pragma unroll
        for (int a = 0; a < 2; ++a)
#pragma unroll
            for (int b = 0; b < 2; ++b)
#pragma unroll
                for (int m = 0; m < 4; ++m)
#pragma unroll
                    for (int n = 0; n < 2; ++n) acc[a][b][m][n] = (f32x4){0.f, 0.f, 0.f, 0.f};
        cur = nxt; cA = nA; cB = nB; ++ui;
        if constexpr (ALIGN_EPI) { if (wr == 1) PG8_BAR; }
    }
    PG8_WAIT_V(0);
    if constexpr (!ALIGN_EPI) { if (wr == 0) PG8_BAR; }
    PG8_BAR;
#undef PG8_SA
#undef PG8_SB
#undef PG8_STAGE
#undef PG8_LDA
#undef PG8_LDB
#undef PG8_MMA
#undef PG8_WAIT_V
#undef PG8_WAIT_L
#undef PG8_BAR
#undef PG8_SCHED
}
}
using pg8::Unit;

struct ProbQKV {
    int K; const char* abuf; const char* wqk; const char* wv; pg8::GridOrder go; int G, c;
    DI bool next(int i, Unit& u) const {
        const long L = (long)i * G + c;
        if (L < NTILE * 8) { u.kind = 0; return go.map(L, u.pm, u.pn); }
        const long r = L - NTILE * 8; if (r >= NTILE * 4) return false;
        u.kind = 1; u.pm = (int)(r & 3); u.pn = (int)(r >> 2); return true;
    }
    DI const char* a_ptr(const Unit& u) const { return (u.kind == 0 ? abuf : wv) + (size_t)u.pm * (256 * 1024 * 2); }
    DI const char* b_ptr(const Unit& u) const { return (u.kind == 0 ? wqk : abuf) + (size_t)u.pn * (256 * 1024 * 2); }
};
struct EpiQKV {
    static constexpr bool PERM = true;
    bf16_t* Q; bf16_t* Kb; bf16_t* VT; const float* gq; const float* gk; const float* cosT; const float* sinT;
    DI void operator()(const f32x4 (&acc)[2][2][4][2], const Unit& u, int wr, int wc, int fr, int fq) const {
        if (u.kind == 1) {
#pragma unroll
            for (int ai = 0; ai < 2; ++ai)
#pragma unroll
                for (int m = 0; m < 4; ++m) {
                    const int f = u.pm * 256 + ai * 128 + wr * 64 + m * 16 + fr;
                    bf16_t* rowp = VT + (size_t)f * T + (size_t)u.pn * 256 + wc * 32 + 8 * fq;
#pragma unroll
                    for (int bj = 0; bj < 2; ++bj) { const f32x4 v0 = acc[ai][bj][m][0], v1 = acc[ai][bj][m][1];
                        u32x4 w; w.x = pk_bf16(v0[0], v0[1]); w.y = pk_bf16(v0[2], v0[3]); w.z = pk_bf16(v1[0], v1[1]); w.w = pk_bf16(v1[2], v1[3]);
                        stg<u32x4>(rowp + bj * 128, w); }
                }
            return;
        }
        const bool isK = u.pn >= 4; const int sub = 4 * (u.pn & 3) + wc;
        const int jj = u.pm % 9; const bool isctx = (jj == 0);
        const float* g = isK ? gk : gq; bf16_t* dst = isK ? Kb : Q;
        const float osc = isK ? 1.0f : 0.125f * LOG2E;
        const int ln = fr + 16 * fq;
        f32x4 gv[2][2];
#pragma unroll
        for (int bj = 0; bj < 2; ++bj)
#pragma unroll
            for (int n = 0; n < 2; ++n) gv[bj][n] = ldg<f32x4>(g + 32 * bj + 8 * fq + 4 * n);
        float invf[8];
#pragma unroll
        for (int k = 0; k < 8; ++k) invf[k] = __builtin_amdgcn_exp2f(-(float)((8 * fq + k) & 15) * (13.287712379549449f / 16.0f)) * 0.15915494309189535f;
        const bool use_row = fq < 2;
        float ss[8];
#pragma unroll
        for (int ai = 0; ai < 2; ++ai)
#pragma unroll
            for (int m = 0; m < 4; ++m) { float s = 0.f;
#pragma unroll
                for (int bj = 0; bj < 2; ++bj)
#pragma unroll
                    for (int n = 0; n < 2; ++n) { const f32x4 x = acc[ai][bj][m][n]; s += (x[0] * x[0] + x[1] * x[1]) + (x[2] * x[2] + x[3] * x[3]); }
                ss[ai * 4 + m] = s; }
#pragma unroll
        for (int it = 0; it < 8; ++it) ss[it] += shx(ss[it], 16, ln);
#pragma unroll
        for (int it = 0; it < 8; ++it) ss[it] += shx(ss[it], 32, ln);
#pragma unroll
        for (int ai = 0; ai < 2; ++ai)
#pragma unroll
            for (int m = 0; m < 4; ++m) {
                const int rr = ai * 128 + wr * 64 + m * 16 + fr;
                const float rstd = __builtin_amdgcn_rsqf(ss[ai * 4 + m] * (1.0f / 64.0f) + RMS_EPS) * osc;
                f32x4 x1[2], x2[2];
#pragma unroll
                for (int n = 0; n < 2; ++n) { x1[n] = acc[ai][0][m][n] * rstd * gv[0][n]; x2[n] = acc[ai][1][m][n] * rstd * gv[1][n]; }
                if (!isctx) {
                    const int t = (jj - 1) * 256 + rr; const float pos = (float)(use_row ? (t >> 6) : (t & 63));
#pragma unroll
                    for (int n = 0; n < 2; ++n)
#pragma unroll
                        for (int j = 0; j < 4; ++j) { const float a = pos * invf[4 * n + j]; const float c = __builtin_amdgcn_cosf(a), s = __builtin_amdgcn_sinf(a);
                            const float p = x1[n][j], q = x2[n][j]; x1[n][j] = p * c - q * s; x2[n][j] = p * s + q * c; }
                }
                bf16_t* rowp = dst + (size_t)(u.pm * 256 + rr) * 1024 + 64 * sub + 8 * fq;
                u32x4 w; w.x = pk_bf16(x1[0][0], x1[0][1]); w.y = pk_bf16(x1[0][2], x1[0][3]); w.z = pk_bf16(x1[1][0], x1[1][1]); w.w = pk_bf16(x1[1][2], x1[1][3]);
                stg<u32x4>(rowp, w);
                w.x = pk_bf16(x2[0][0], x2[0][1]); w.y = pk_bf16(x2[0][2], x2[0][3]); w.z = pk_bf16(x2[1][0], x2[1][1]); w.w = pk_bf16(x2[1][2], x2[1][3]);
                stg<u32x4>(rowp + 32, w);
            }
    }
};

struct ProbDense {
    int K; const char* A0; const char* A1; int pm_split; const char* Bt; pg8::GridOrder go; int G, c;
    DI bool next(int i, Unit& u) const { u.kind = 0; return go.map((long)i * G + c, u.pm, u.pn); }
    DI const char* a_ptr(const Unit& u) const { return u.pm < pm_split ? A0 + (size_t)u.pm * 512 * K : A1 + (size_t)(u.pm - pm_split) * 512 * K; }
    DI const char* b_ptr(const Unit& u) const { return Bt + (size_t)u.pn * 512 * K; }
};

struct ProbWIN {
    int K; const char* abuf; const char* win; pg8::GridOrder go; int G, c;
    DI bool next(int i, Unit& u) const {
        const long L = (long)i * G + c;
        if (L < 144 * 20) { u.kind = 0; return go.map(L, u.pm, u.pn); }
        const long r = L - 144 * 20; if (r >= 144 * 12) return false;
        u.kind = 1; u.pm = (int)(r % 12); u.pn = (int)(r / 12); return true;
    }
    DI const char* a_ptr(const Unit& u) const { return u.kind == 0 ? abuf + (size_t)u.pm * (256 * 1024 * 2) : win + (size_t)(4 + u.pm) * (256 * 1024 * 2); }
    DI const char* b_ptr(const Unit& u) const { return u.kind == 0 ? win + (size_t)(u.pn < 4 ? u.pn : 12 + u.pn) * (256 * 1024 * 2) : abuf + (size_t)u.pn * (256 * 1024 * 2); }
};
struct EpiWIN {
    static constexpr bool PERM = true;
    bf16_t* RQ; bf16_t* RG; bf16_t* RKT; bf16_t* RVT; int pm0; const float* cosT; const float* sinT; const float* cosTT; const float* sinTT;
    DI void operator()(const f32x4 (&acc)[2][2][4][2], const Unit& u, int wr, int wc, int fr, int fq) const {
        if (u.kind == 0) {
            const int gpm = pm0 + u.pm, jj = gpm % 9; const bool isctx = (jj == 0); const bool isq = u.pn < 4;
            float invf[8];
#pragma unroll
            for (int k = 0; k < 8; ++k) invf[k] = __builtin_amdgcn_exp2f(-(float)((32 * wc + 8 * fq + k) & 63) * (13.287712379549449f / 64.0f)) * 0.15915494309189535f;
#pragma unroll
            for (int ai = 0; ai < 2; ++ai)
#pragma unroll
                for (int m = 0; m < 4; ++m) {
                    const int rr = ai * 128 + wr * 64 + m * 16 + fr;
                    f32x4 x1[2], x2[2];
#pragma unroll
                    for (int n = 0; n < 2; ++n) { x1[n] = acc[ai][0][m][n]; x2[n] = acc[ai][1][m][n]; }
                    if (isq) {
                        if (!isctx) {
                            const int t = (jj - 1) * 256 + rr; const float pos = (float)((wc < 2) ? (t >> 6) : (t & 63));
#pragma unroll
                            for (int n = 0; n < 2; ++n)
#pragma unroll
                                for (int j = 0; j < 4; ++j) { const float a = pos * invf[4 * n + j]; const float c = __builtin_amdgcn_cosf(a), s = __builtin_amdgcn_sinf(a);
                                    const float p = x1[n][j], q = x2[n][j]; x1[n][j] = p * c - q * s; x2[n][j] = p * s + q * c; }
                        }
                    } else {
#pragma unroll
                        for (int n = 0; n < 2; ++n)
#pragma unroll
                            for (int j = 0; j < 4; ++j) { x1[n][j] = silu_f(x1[n][j]); x2[n][j] = silu_f(x2[n][j]); }
                    }
                    bf16_t* rowp = isq ? RQ + (size_t)(u.pm * 256 + rr) * 1024 + u.pn * 256 + wc * 32 + 8 * fq : RG + (size_t)(u.pm * 256 + rr) * 4096 + (u.pn - 4) * 256 + wc * 32 + 8 * fq;
                    u32x4 w; w.x = pk_bf16(x1[0][0], x1[0][1]); w.y = pk_bf16(x1[0][2], x1[0][3]); w.z = pk_bf16(x1[1][0], x1[1][1]); w.w = pk_bf16(x1[1][2], x1[1][3]);
                    stg<u32x4>(rowp, w);
                    w.x = pk_bf16(x2[0][0], x2[0][1]); w.y = pk_bf16(x2[0][2], x2[0][3]); w.z = pk_bf16(x2[1][0], x2[1][1]); w.w = pk_bf16(x2[1][2], x2[1][3]);
                    stg<u32x4>(rowp + 128, w);
                }
            return;
        }
        const int gpm = pm0 + u.pn, jj = gpm % 9; const bool isctx = (jj == 0); const bool isk = u.pm < 4;
        if (isk) {
#pragma unroll
            for (int m = 0; m < 4; ++m) {
                const int f = wr * 64 + m * 16 + fr;
#pragma unroll
                for (int bj = 0; bj < 2; ++bj) {
                    f32x4 x1[2], x2[2];
#pragma unroll
                    for (int n = 0; n < 2; ++n) { x1[n] = acc[0][bj][m][n] * 0.0625f; x2[n] = acc[1][bj][m][n] * 0.0625f; }
                    const int tl = bj * 128 + wc * 32 + 8 * fq;
                    if (!isctx) {
                        const int t = (jj - 1) * 256 + tl;
                        const float ivf = __builtin_amdgcn_exp2f(-(float)(m * 16 + fr) * (13.287712379549449f / 64.0f)) * 0.15915494309189535f;
#pragma unroll
                        for (int n = 0; n < 2; ++n)
#pragma unroll
                            for (int j = 0; j < 4; ++j) { const int tt = t + 4 * n + j; const float a = (float)(wr == 0 ? (tt >> 6) : (tt & 63)) * ivf; const float c = __builtin_amdgcn_cosf(a), s = __builtin_amdgcn_sinf(a);
                                const float p = x1[n][j], q = x2[n][j]; x1[n][j] = p * c - q * s; x2[n][j] = p * s + q * c; }
                    }
                    bf16_t* p1 = RKT + (size_t)(u.pm * 256 + f) * HROWS + (size_t)u.pn * 256 + tl;
                    u32x4 w; w.x = pk_bf16(x1[0][0], x1[0][1]); w.y = pk_bf16(x1[0][2], x1[0][3]); w.z = pk_bf16(x1[1][0], x1[1][1]); w.w = pk_bf16(x1[1][2], x1[1][3]);
                    stg<u32x4>(p1, w);
                    w.x = pk_bf16(x2[0][0], x2[0][1]); w.y = pk_bf16(x2[0][2], x2[0][3]); w.z = pk_bf16(x2[1][0], x2[1][1]); w.w = pk_bf16(x2[1][2], x2[1][3]);
                    stg<u32x4>(p1 + (size_t)128 * HROWS, w);
                }
            }
        } else {
#pragma unroll
            for (int ai = 0; ai < 2; ++ai)
#pragma unroll
                for (int m = 0; m < 4; ++m) {
                    const int f = (u.pm - 4) * 256 + ai * 128 + wr * 64 + m * 16 + fr;
                    bf16_t* rowp = RVT + (size_t)f * HROWS + (size_t)u.pn * 256 + wc * 32 + 8 * fq;
#pragma unroll
                    for (int bj = 0; bj < 2; ++bj) { const f32x4 v0 = acc[ai][bj][m][0], v1 = acc[ai][bj][m][1];
                        u32x4 w; w.x = pk_bf16(v0[0], v0[1]); w.y = pk_bf16(v0[2], v0[3]); w.z = pk_bf16(v1[0], v1[1]); w.w = pk_bf16(v1[2], v1[3]);
                        stg<u32x4>(rowp + bj * 128, w); }
                }
        }
    }
};

struct EpiResid {
    static constexpr bool PERM = false;
    const float* hin_ctx; const float* hin_lat; float* hout_ctx; float* hout_lat; const float* modbase;
    DI void operator()(const f32x4 (&acc)[2][2][4][2], const Unit& u, int wr, int wc, int fr, int fq) const {
        const int b = u.pm / 9, jj = u.pm % 9; const bool isctx = (jj == 0);
        const float* gate = modbase + (size_t)(isctx ? 32 : b) * 6144 + 2048;
        const int col0 = u.pn * 256 + wc * 32 + 4 * fq;
        f32x4 gv[2][2];
#pragma unroll
        for (int bj = 0; bj < 2; ++bj)
#pragma unroll
            for (int n = 0; n < 2; ++n) gv[bj][n] = ldg<f32x4>(gate + col0 + bj * 128 + n * 16);
        const size_t rbase = isctx ? (size_t)b * 256 : (size_t)b * 2048 + (size_t)(jj - 1) * 256;
        const float* hi = isctx ? hin_ctx : hin_lat; float* ho = isctx ? hout_ctx : hout_lat;
#pragma unroll
        for (int ai = 0; ai < 2; ++ai) {
            f32x4 hv[4][2][2];
#pragma unroll
            for (int m = 0; m < 4; ++m) { const size_t off = (rbase + ai * 128 + wr * 64 + m * 16 + fr) * 1024 + col0;
#pragma unroll
                for (int bj = 0; bj < 2; ++bj)
#pragma unroll
                    for (int n = 0; n < 2; ++n) hv[m][bj][n] = ldg<f32x4>(hi + off + bj * 128 + n * 16); }
#pragma unroll
            for (int m = 0; m < 4; ++m) { const size_t off = (rbase + ai * 128 + wr * 64 + m * 16 + fr) * 1024 + col0;
#pragma unroll
                for (int bj = 0; bj < 2; ++bj)
#pragma unroll
                    for (int n = 0; n < 2; ++n) stg<f32x4>(ho + off + bj * 128 + n * 16, hv[m][bj][n] + gv[bj][n] * acc[ai][bj][m][n]); }
        }
    }
};

struct ProbMoE {
    int K; const char* A; const char* W; const LAS int* tile_e; pg8::GridOrder go; int G, c;
    DI bool next(int i, Unit& u) const { u.kind = 0; return go.map((long)i * G + c, u.pm, u.pn); }
    DI const char* a_ptr(const Unit& u) const { return A + (size_t)u.pm * 512 * K; }
    DI const char* b_ptr(const Unit& u) const { return W + ((size_t)tile_e[u.pm] * 4 + u.pn) * 512 * K; }
};
struct EpiSwiGLU {
    static constexpr bool PERM = true;
    bf16_t* act;
    DI void operator()(const f32x4 (&acc)[2][2][4][2], const Unit& u, int wr, int wc, int fr, int fq) const {
#pragma unroll
        for (int ai = 0; ai < 2; ++ai)
#pragma unroll
            for (int m = 0; m < 4; ++m) {
                bf16_t* rowp = act + (size_t)(u.pm * 256 + ai * 128 + wr * 64 + m * 16 + fr) * 512 + u.pn * 128 + wc * 16 + 4 * fq;
#pragma unroll
                for (int bj = 0; bj < 2; ++bj) { const f32x4 g = acc[ai][bj][m][0], up = acc[ai][bj][m][1];
                    u32x2 w; w.x = pk_bf16(silu_f(g[0]) * up[0], silu_f(g[1]) * up[1]); w.y = pk_bf16(silu_f(g[2]) * up[2], silu_f(g[3]) * up[3]);
                    stg<u32x2>(rowp + bj * 64, w); }
            }
    }
};
struct EpiDown {
    static constexpr bool PERM = true;
    bf16_t* y2; const int* rowmap; const float* wsel;
    DI void operator()(const f32x4 (&acc)[2][2][4][2], const Unit& u, int wr, int wc, int fr, int fq) const {
        int dest[8]; float wv[8];
#pragma unroll
        for (int it = 0; it < 8; ++it) dest[it] = ldg<int>(rowmap + u.pm * 256 + (it >> 2) * 128 + wr * 64 + (it & 3) * 16 + fr);
#pragma unroll
        for (int it = 0; it < 8; ++it) wv[it] = ldg<float>(wsel + (dest[it] >= 0 ? dest[it] : 0));
#pragma unroll
        for (int ai = 0; ai < 2; ++ai)
#pragma unroll
            for (int m = 0; m < 4; ++m) {
                const int d = dest[ai * 4 + m];
                if (d >= 0) {
                    const float w = wv[ai * 4 + m];
                    bf16_t* rowp = y2 + (size_t)d * 1024 + u.pn * 256 + wc * 32 + 8 * fq;
#pragma unroll
                    for (int bj = 0; bj < 2; ++bj) { const f32x4 v0 = acc[ai][bj][m][0] * w, v1 = acc[ai][bj][m][1] * w;
                        u32x4 o; o.x = pk_bf16(v0[0], v0[1]); o.y = pk_bf16(v0[2], v0[3]); o.z = pk_bf16(v1[0], v1[1]); o.w = pk_bf16(v1[2], v1[3]);
                        stg<u32x4>(rowp + bj * 128, o); }
                }
            }
    }
};

template <int MODE>
DI void transpose_tile(const Frame& F, const float* src, const float* src2, int ld, bf16_t* dst, int K, int k0, int n0) {
    LAS float* tl = (LAS float*)F.lds;
    __syncthreads();
#pragma unroll
    for (int i = 0; i < 8; ++i) {
        const int idx = F.tid + 512 * i, kk = idx >> 6, nn = idx & 63, np = n0 + nn;
        float v;
        if (MODE == 0) v = ldg<float>(src + (size_t)(k0 + kk) * ld + np);
        else if (MODE == 1) { const int t = np >> 8, p = np & 255, bj = p >> 7, wc = (p >> 5) & 3, r = p & 31; v = ldg<float>(src + (size_t)(k0 + kk) * ld + t * 256 + wc * 64 + bj * 32 + r); }
        else { const int hid = 4 * (np >> 3) + (np & 3); v = ldg<float>(((np & 4) ? src2 : src) + (size_t)(k0 + kk) * ld + hid); }
        tl[nn * 65 + kk] = v;
    }
    __syncthreads();
#pragma unroll
    for (int i = 0; i < 4; ++i) {
        const int idx = F.tid + 512 * i, nn = idx >> 5, kp = (idx & 31) * 2;
        stg<unsigned>(dst + (size_t)(n0 + nn) * K + k0 + kp, pk_bf16(tl[nn * 65 + kp], tl[nn * 65 + kp + 1]));
    }
}
template <int MODE>
DI int transpose_mat(const Frame& F, const float* src, const float* src2, int ld, bf16_t* dst, int K, int Np, int u0, int u_first, int u_stride) {
    const int tk = K / 64, tn = Np / 64, ntl = tk * tn;
    int u = u_first; if (u < u0) { const int d = (u0 - u + u_stride - 1) / u_stride; u += d * u_stride; }
    for (; u < u0 + ntl; u += u_stride) { const int l = u - u0; transpose_tile<MODE>(F, src, src2, ld, dst, K, (l % tk) * 64, (l / tk) * 64); }
    return ntl;
}
DI void convert_moe_weights(const Frame& F, int layer) {
    const float* wg = F.a->in[21] + (size_t)layer * NEXP * DM * MOEH; const float* wu = F.a->in[22] + (size_t)layer * NEXP * DM * MOEH; const float* wd = F.a->in[23] + (size_t)layer * NEXP * MOEH * DM;
    bf16_t* WGU = (bf16_t*)(F.ws + WS_WGU); bf16_t* WD = (bf16_t*)(F.ws + WS_WD);
    int u0 = 0;
    for (int e = 0; e < NEXP; ++e) {
        u0 += transpose_mat<2>(F, wg + (size_t)e * DM * MOEH, wu + (size_t)e * DM * MOEH, MOEH, WGU + (size_t)e * 1024 * 1024, 1024, 1024, u0, F.bid, F.G);
        u0 += transpose_mat<0>(F, wd + (size_t)e * MOEH * DM, nullptr, DM, WD + (size_t)e * 1024 * 512, 512, 1024, u0, F.bid, F.G);
    }
}

DI void p0_prologue(const Frame& F) {
    {
        LAS float* red = (LAS float*)F.lds;
        for (int u = F.bid; u < 4 * 96; u += F.G) {
            const int layer = u / 96, col0 = (u % 96) * 64;
            const float* W = F.a->in[6] + (size_t)layer * 1024 * 6144 + col0 + F.lane;
            const float* cp = F.lane < 32 ? F.a->in[1] + F.lane * 1024 : F.a->in[3];
            float acc[33];
#pragma unroll
            for (int r = 0; r < 33; ++r) acc[r] = 0.f;
            const int k0 = F.wave * 128;
            for (int k = k0; k < k0 + 128; ++k) {
                const float w = ldg<float>(W + (size_t)k * 6144);
                const float sv = silu_f(ldg<float>(cp + k));
#pragma unroll
                for (int r = 0; r < 33; ++r) acc[r] += w * __builtin_bit_cast(float, __builtin_amdgcn_readlane(__builtin_bit_cast(int, sv), r));
            }
#pragma unroll
            for (int r = 0; r < 33; ++r) red[(F.wave * 33 + r) * 64 + F.lane] = acc[r];
            __syncthreads();
            float* outp = (float*)(F.ws + WS_ADA) + (size_t)layer * 33 * 6144;
            for (int idx = F.tid; idx < 33 * 64; idx += 512) { const int r = idx >> 6, cl = idx & 63; float v = 0.f;
#pragma unroll
                for (int w8 = 0; w8 < 8; ++w8) v += red[(w8 * 33 + r) * 64 + cl];
                stg<float>(outp + (size_t)r * 6144 + col0 + cl, v + ldg<float>(F.a->in[7] + layer * 6144 + col0 + cl)); }
            __syncthreads();
        }
    }
    {
        float* cda = (float*)(F.ws + WS_ROPE + RP_CDA); float* sda = (float*)(F.ws + WS_ROPE + RP_SDA); float* crt = (float*)(F.ws + WS_ROPE + RP_CRT); float* srt = (float*)(F.ws + WS_ROPE + RP_SRT);
        const int gt = F.bid * 512 + F.tid, gs = F.G * 512;
        for (int idx = gt; idx < 2048 * 32; idx += gs) { const int t = idx >> 5, f = idx & 31; const float pos = f < 16 ? (float)(t >> 6) : (float)(t & 63);
            const float inv = exp2f(-(float)(f & 15) * (13.287712379549449f / 16.0f)); const float a = pos * inv; stg<float>(cda + idx, __cosf(a)); stg<float>(sda + idx, __sinf(a)); }
        for (int idx = gt; idx < 2048 * 128; idx += gs) { const int t = idx >> 7, f = idx & 127; const float pos = f < 64 ? (float)(t >> 6) : (float)(t & 63);
            const float inv = exp2f(-(float)(f & 63) * (13.287712379549449f / 64.0f)); const float a = pos * inv; const float cv = __cosf(a), sv = __sinf(a); stg<float>(crt + idx, cv); stg<float>(srt + idx, sv);
            stg<float>((float*)(F.ws + WS_MISC + MS_CRTT) + f * 2048 + t, cv); stg<float>((float*)(F.ws + WS_MISC + MS_SRTT) + f * 2048 + t, sv); }
    }
    {
        int u0 = 0;
        for (int j = 0; j < 2; ++j) {
            const float* wqkv = F.a->in[8] + (size_t)j * 1024 * 3072;
            u0 += transpose_mat<1>(F, wqkv, nullptr, 3072, (bf16_t*)(F.ws + WS_WQK) + (size_t)j * 2048 * 1024, 1024, 2048, u0, F.bid, F.G);
            u0 += transpose_mat<0>(F, wqkv + 2048, nullptr, 3072, (bf16_t*)(F.ws + WS_WV) + (size_t)j * 1024 * 1024, 1024, 1024, u0, F.bid, F.G);
            u0 += transpose_mat<0>(F, F.a->in[13] + (size_t)j * 1024 * 1024, nullptr, 1024, (bf16_t*)(F.ws + WS_WODA) + (size_t)j * 1024 * 1024, 1024, 1024, u0, F.bid, F.G);
            u0 += transpose_mat<0>(F, F.a->in[14] + (size_t)j * 1024 * 8192, nullptr, 8192, (bf16_t*)(F.ws + WS_WIN) + (size_t)j * 8192 * 1024, 1024, 8192, u0, F.bid, F.G);
            u0 += transpose_mat<0>(F, F.a->in[16] + (size_t)j * 2048 * 1024, nullptr, 1024, (bf16_t*)(F.ws + WS_WORT) + (size_t)j * 1024 * 2048, 2048, 1024, u0, F.bid, F.G);
        }
        convert_moe_weights(F, 0);
    }
}

template <bool SECOND>
DI void norm_phase(const Frame& F, int layer) {
    bf16_t* abuf = (bf16_t*)(F.ws + WS_ABUF);
    float* hctx = (float*)(F.ws + WS_HCTX);
    const bf16_t* y2 = (const bf16_t*)(F.ws + WS_PROJ + PJ_Y2);
    const float* ng = F.a->in[SECOND ? 5 : 4] + layer * 1024;
    LAS float* Wl = (LAS float*)F.lds;
    LAS int* lhist = (LAS int*)(F.lds + LDS_MISC + 1024);
    int* eid = (int*)(F.ws + WS_MISC + MS_EID); float* wsel = (float*)(F.ws + WS_MISC + MS_WSEL);
    if (SECOND) {
        const float* wgp = F.a->in[17] + (size_t)layer * 1024 * 4; const float* wep = F.a->in[19] + (size_t)layer * 1024 * 32;
        for (int idx = F.tid; idx < 1024 * 4; idx += 512) { const int k = idx >> 2, o = idx & 3; Wl[o * 1024 + k] = wgp[idx]; }
        for (int idx = F.tid; idx < 1024 * 32; idx += 512) { const int k = idx >> 5, o = idx & 31; Wl[(4 + o) * 1024 + k] = wep[idx]; }
        if (F.tid < 32) lhist[F.tid] = 0;
        __syncthreads();
    }
    const int lane = F.lane;
    for (int r = F.bid * 8 + F.wave; r < T; r += F.G * 8) {
        const int b = r / NTOK, n = r % NTOK; const bool isctx = n < CTXL;
        const size_t hoff = isctx ? ((size_t)b * 256 + n) * 1024 : ((size_t)b * 2048 + (n - 256)) * 1024;
        const float* hin; float* hout = isctx ? hctx + hoff : F.out + hoff;
        if (layer == 0 && !SECOND) hin = isctx ? F.a->in[2] + hoff : F.a->in[0] + hoff; else hin = hout;
        const float* mod = isctx ? mod_ctx(F, layer) : mod_lat(F, layer, b);
        f32x4 x[4];
#pragma unroll
        for (int i = 0; i < 4; ++i) x[i] = ldg<f32x4>(hin + i * 256 + lane * 4);
        if (!SECOND && layer > 0) {
            const float* modp = isctx ? mod_ctx(F, layer - 1) : mod_lat(F, layer - 1, b);
#pragma unroll
            for (int i = 0; i < 4; ++i) {
                const u32x2 a = ldg<u32x2>(y2 + (size_t)(2 * r) * 1024 + i * 256 + lane * 4), c = ldg<u32x2>(y2 + (size_t)(2 * r + 1) * 1024 + i * 256 + lane * 4);
                const f32x4 g2 = ldg<f32x4>(modp + 5120 + i * 256 + lane * 4);
                x[i][0] += g2[0] * (bf_lo(a.x) + bf_lo(c.x)); x[i][1] += g2[1] * (bf_hi(a.x) + bf_hi(c.x)); x[i][2] += g2[2] * (bf_lo(a.y) + bf_lo(c.y)); x[i][3] += g2[3] * (bf_hi(a.y) + bf_hi(c.y));
                stg<f32x4>(hout + i * 256 + lane * 4, x[i]);
            }
        }
        float ss = 0.f;
#pragma unroll
        for (int i = 0; i < 4; ++i) ss += (x[i][0] * x[i][0] + x[i][1] * x[i][1]) + (x[i][2] * x[i][2] + x[i][3] * x[i][3]);
        ss = wave_sum(ss, lane);
        const float rstd = 1.0f / sqrtf(ss * (1.0f / 1024.0f) + RMS_EPS);
        f32x4 v[4];
#pragma unroll
        for (int i = 0; i < 4; ++i) {
            const int c0 = i * 256 + lane * 4;
            const f32x4 g = ldg<f32x4>(ng + c0), sh = ldg<f32x4>(mod + (SECOND ? 3072 : 0) + c0), sc = ldg<f32x4>(mod + (SECOND ? 4096 : 1024) + c0);
            v[i] = (x[i] * rstd * g) * (sc + 1.0f) + sh;
            u32x2 w; w.x = pk_bf16(v[i][0], v[i][1]); w.y = pk_bf16(v[i][2], v[i][3]);
            stg<u32x2>(abuf + (size_t)r * 1024 + c0, w);
        }
        if (SECOND) {
            const float* bg = F.a->in[18] + layer * 4; const float* be = F.a->in[20] + layer * 32;
            float gl[4]; float gmax = -3.0e38f; int gi = 0;
#pragma unroll
            for (int o = 0; o < 4; ++o) {
                float p = 0.f;
#pragma unroll
                for (int i = 0; i < 4; ++i) { const f32x4 w = *(const LAS f32x4*)(Wl + o * 1024 + i * 256 + lane * 4); p += (v[i][0] * w[0] + v[i][1] * w[1]) + (v[i][2] * w[2] + v[i][3] * w[3]); }
                gl[o] = wave_sum(p, lane) + ldg<float>(bg + o);
                if (gl[o] > gmax) { gmax = gl[o]; gi = o; }
            }
            gi = __builtin_amdgcn_readfirstlane(gi);
            float gsum = 0.f;
#pragma unroll
            for (int o = 0; o < 4; ++o) { gsum += __expf(gl[o] - gmax); asm volatile("" : "+v"(gsum)); }
            const float psel = __builtin_amdgcn_rcpf(gsum);
            float el[8];
#pragma unroll
            for (int o = 0; o < 8; ++o) {
                float p = 0.f;
                const LAS float* wr = Wl + (4 + gi * 8 + o) * 1024;
#pragma unroll
                for (int i = 0; i < 4; ++i) { const f32x4 w = *(const LAS f32x4*)(wr + i * 256 + lane * 4); p += (v[i][0] * w[0] + v[i][1] * w[1]) + (v[i][2] * w[2] + v[i][3] * w[3]); }
                el[o] = wave_sum(p, lane) + ldg<float>(be + gi * 8 + o);
            }
            float m1 = -3.0e38f, m2 = -3.0e38f; int i1 = 0, i2 = 0;
#pragma unroll
            for (int o = 0; o < 8; ++o) { if (el[o] > m1) { m1 = el[o]; i1 = o; } }
#pragma unroll
            for (int o = 0; o < 8; ++o) { if (o != i1 && el[o] > m2) { m2 = el[o]; i2 = o; } }
            const float e2 = __expf(m2 - m1), inv = __builtin_amdgcn_rcpf(1.0f + e2);
            if (lane == 0) {
                stg<int>(eid + 2 * r, gi * 8 + i1); stg<int>(eid + 2 * r + 1, gi * 8 + i2); stg<float>(wsel + 2 * r, inv * psel); stg<float>(wsel + 2 * r + 1, e2 * inv * psel);
                __hip_atomic_fetch_add(&lhist[gi * 8 + i1], 1, __ATOMIC_RELAXED, __HIP_MEMORY_SCOPE_WORKGROUP); __hip_atomic_fetch_add(&lhist[gi * 8 + i2], 1, __ATOMIC_RELAXED, __HIP_MEMORY_SCOPE_WORKGROUP);
            }
        }
    }
    if (SECOND) {
        __syncthreads();
        if (F.tid < 32) { const int c = lhist[F.tid]; if (c) __hip_atomic_fetch_add((unsigned*)(F.ws + WS_CTL) + CW_CNT + layer * 64 + F.tid, (unsigned)c, __ATOMIC_RELAXED, __HIP_MEMORY_SCOPE_AGENT); }
    }
}

DI int build_segments(const Frame& F, int layer, LAS int* segs, LAS int* tile_e) {
    __syncthreads();
    if (F.tid == 0) {
        const unsigned* cnt = (const unsigned*)(F.ws + WS_CTL) + CW_CNT + layer * 64;
        int s = 0;
        for (int e = 0; e < 32; ++e) { segs[e] = s; const int c = (int)__hip_atomic_load(cnt + e, __ATOMIC_RELAXED, __HIP_MEMORY_SCOPE_AGENT); segs[40 + e] = c; s += (c + 255) & ~255; }
        segs[32] = s;
    }
    __syncthreads();
    const int ntl = segs[32] >> 8;
    if (tile_e) {
        for (int t = F.tid; t < ntl; t += 512) { int e = 0;
            for (int q = 1; q < 32; ++q) e = (segs[q] <= t * 256) ? q : e;
            tile_e[t] = e; }
        __syncthreads();
    }
    return ntl;
}

DI void sort_phase(const Frame& F, int layer) {
    LAS int* segs = (LAS int*)(F.lds + LDS_MISC + 2048);
    LAS int* lhist = (LAS int*)(F.lds + LDS_MISC + 1024);
    LAS int* lbase = (LAS int*)(F.lds + LDS_MISC + 1024 + 128);
    LAS int* lpos = (LAS int*)F.lds;
    build_segments(F, layer, segs, nullptr);
    const int* eid = (const int*)(F.ws + WS_MISC + MS_EID); int* rowmap = (int*)(F.ws + WS_MISC + MS_ROWMAP);
    const bf16_t* abuf = (const bf16_t*)(F.ws + WS_ABUF); bf16_t* sa = (bf16_t*)(F.ws + WS_PROJ + PJ_SA);
    const int RPB = (T + F.G - 1) / F.G;
    const int r0 = F.bid * RPB, r1 = (r0 + RPB < T) ? r0 + RPB : T;
    const int na = r1 > r0 ? 2 * (r1 - r0) : 0;
    if (F.tid < 32) lhist[F.tid] = 0;
    __syncthreads();
    int ee[2], lp[2];
#pragma unroll
    for (int it = 0; it < 2; ++it) { const int a = F.tid + 512 * it; ee[it] = -1; lp[it] = 0;
        if (a < na) { ee[it] = ldg<int>(eid + 2 * r0 + a); lp[it] = __hip_atomic_fetch_add(&lhist[ee[it]], 1, __ATOMIC_RELAXED, __HIP_MEMORY_SCOPE_WORKGROUP); } }
    __syncthreads();
    if (F.tid < 32) { const int c = lhist[F.tid];
        lbase[F.tid] = segs[F.tid] + (c ? (int)__hip_atomic_fetch_add((unsigned*)(F.ws + WS_CTL) + CW_CUR + layer * 64 + F.tid, (unsigned)c, __ATOMIC_RELAXED, __HIP_MEMORY_SCOPE_AGENT) : 0); }
    __syncthreads();
#pragma unroll
    for (int it = 0; it < 2; ++it) { const int a = F.tid + 512 * it;
        if (a < na) { const int pos = lbase[ee[it]] + lp[it]; lpos[a] = pos; stg<int>(rowmap + pos, 2 * r0 + a); } }
    __syncthreads();
    for (int a = F.wave; a < na; a += 8) {
        const int pos = lpos[a]; const int r = r0 + (a >> 1);
        const u32x4 v0 = ldg<u32x4>(abuf + (size_t)r * 1024 + F.lane * 8), v1 = ldg<u32x4>(abuf + (size_t)r * 1024 + 512 + F.lane * 8);
        stg<u32x4>(sa + (size_t)pos * 1024 + F.lane * 8, v0); stg<u32x4>(sa + (size_t)pos * 1024 + 512 + F.lane * 8, v1);
    }
    if (F.bid < 32) { const int e = F.bid; for (int p = segs[e] + segs[40 + e] + F.tid; p < segs[e + 1]; p += 512) stg<int>(rowmap + p, -1); }
    if (F.G < 32 && F.bid == 0) { for (int e = F.G; e < 32; ++e) for (int p = segs[e] + segs[40 + e] + F.tid; p < segs[e + 1]; p += 512) stg<int>(rowmap + p, -1); }
}

constexpr int AT_KROW = 272, AT_VROW = 136, AT_KB = 64 * AT_KROW, AT_VB = 128 * AT_VROW, AT_BUF = AT_KB + AT_VB;
DI void attn_phase(const Frame& F, int layer) {
    const int j = layer >> 1;
    const bf16_t* Qb = (const bf16_t*)(F.ws + WS_PROJ + PJ_Q); const bf16_t* Kb = (const bf16_t*)(F.ws + WS_PROJ + PJ_K); const bf16_t* VT = (const bf16_t*)(F.ws + WS_PROJ + PJ_VT);
    bf16_t* Ob = (bf16_t*)(F.ws + WS_OBUF);
    const int lane = F.lane, lr = lane & 31, lh = lane >> 5;
    const float* lam = F.a->in[11] + j * 256;
    float p01 = ldg<float>(lam + lane) * ldg<float>(lam + 64 + lane), p23 = ldg<float>(lam + 128 + lane) * ldg<float>(lam + 192 + lane);
    p01 = wave_sum(p01, lane); p23 = wave_sum(p23, lane);
    const float lam_init = 0.8f - 0.6f * __expf(-0.3f * (float)layer);
    const float lam_full = __expf(p01) - __expf(p23) + lam_init;
    float mq = fabsf(ldg<float>(F.a->in[9] + j * 64 + lane)), mk = fabsf(ldg<float>(F.a->in[10] + j * 64 + lane));
#pragma unroll
    for (int o = 32; o >= 1; o >>= 1) { mq = fmaxf(mq, shx(mq, o, lane)); mk = fmaxf(mk, shx(mk, o, lane)); }
    const float OFF = 8.0f * LOG2E * mq * mk;
    const float* gsub = F.a->in[12] + j * 128;
    const float osc = 1.0f - lam_init;

    for (int u = F.bid; u < 2304; u += F.G) {
        int b, h, qb, nkt;
        if (u < 2048) {
            int bh;
            if (F.G == 256) { const int i = u >> 8, c = u & 255; bh = i * 32 + (c & 7) * 4 + (c >> 6); qb = 1 + ((c >> 3) & 7); } else { bh = u >> 3; qb = 1 + (u & 7); }
            b = bh >> 3; h = bh & 7; nkt = 36;
        } else { const int uu = u - 2048; b = uu >> 3; h = uu & 7; qb = 0; nkt = 4; }
        const size_t rowbase = (size_t)b * NTOK;
        const size_t qrow = rowbase + qb * 256 + F.wave * 32 + lr;
        __syncthreads();
        const int qlo = 2 * AT_BUF + F.wave * 8192 + lane * 16;
#pragma unroll
        for (int mp = 0; mp < 2; ++mp)
#pragma unroll
            for (int ks = 0; ks < 4; ++ks) *(LAS bf16x8*)(F.lds + qlo + (mp * 4 + ks) * 1024) = ldg<bf16x8>(Qb + qrow * 1024 + h * 128 + mp * 64 + ks * 16 + lh * 8);
        f32x16 O1[4], O2[4];
#pragma unroll
        for (int e = 0; e < 4; ++e)
#pragma unroll
            for (int i = 0; i < 16; ++i) { O1[e][i] = 0.f; O2[e][i] = 0.f; }
        float l1 = 0.f, l2 = 0.f;
        const unsigned kgo = (unsigned)((F.tid >> 4) * 1024 + (F.tid & 15) * 8), vgo = (unsigned)((F.tid >> 3) * T + (F.tid & 7) * 8);
        const int klo = (F.tid >> 4) * AT_KROW + (F.tid & 15) * 16, vlo = AT_KB + (F.tid >> 3) * AT_VROW + (F.tid & 7) * 16;
        const bf16_t* kbase = Kb + rowbase * 1024 + h * 128; const bf16_t* vbase = VT + (size_t)(h * 128) * T + rowbase;
        u32x4 sk[2], sv[2];
#pragma unroll
        for (int i = 0; i < 2; ++i) { sk[i] = ldg<u32x4>(kbase + (size_t)i * 32768 + kgo); sv[i] = ldg<u32x4>(vbase + (size_t)i * 64 * T + vgo); }
#pragma unroll
        for (int i = 0; i < 2; ++i) { *(LAS u32x4*)(F.lds + klo + i * 32 * AT_KROW) = sk[i]; *(LAS u32x2*)(F.lds + vlo + i * 64 * AT_VROW) = (u32x2){sv[i].x, sv[i].y}; *(LAS u32x2*)(F.lds + vlo + i * 64 * AT_VROW + 8) = (u32x2){sv[i].z, sv[i].w}; }
        __syncthreads();
        for (int t = 0; t < nkt; ++t) {
            const int cb = (t & 1) * AT_BUF, nb = ((t + 1) & 1) * AT_BUF;
            if (t + 1 < nkt) {
#pragma unroll
                for (int i = 0; i < 2; ++i) { sk[i] = ldg<u32x4>(kbase + (size_t)(t + 1) * 65536 + (size_t)i * 32768 + kgo); sv[i] = ldg<u32x4>(vbase + (size_t)i * 64 * T + (size_t)(t + 1) * 64 + vgo); }
            }
#pragma unroll 1
            for (int kb = 0; kb < 2; ++kb) {
                bf16x8 P[2][2];
#pragma unroll
                for (int mp = 0; mp < 2; ++mp) {
                    f32x16 S;
#pragma unroll
                    for (int i = 0; i < 16; ++i) S[i] = 0.f;
#pragma unroll
                    for (int ks = 0; ks < 4; ++ks) {
                        const bf16x8 kf = *(const LAS bf16x8*)(F.lds + cb + (kb * 32 + lr) * AT_KROW + (mp * 64 + ks * 16 + lh * 8) * 2);
                        const bf16x8 qf = *(const LAS bf16x8*)(F.lds + qlo + (mp * 4 + ks) * 1024);
                        S = __builtin_amdgcn_mfma_f32_32x32x16_bf16(kf, qf, S, 0, 0, 0);
                    }
                    float ps = 0.f;
#pragma unroll
                    for (int i = 0; i < 16; ++i) { S[i] = __builtin_amdgcn_exp2f(S[i] - OFF); ps += S[i]; }
                    if (mp == 0) l1 += ps; else l2 += ps;
#pragma unroll
                    for (int s = 0; s < 2; ++s) { u32x4 w; w.x = pk_bf16(S[8 * s], S[8 * s + 1]); w.y = pk_bf16(S[8 * s + 2], S[8 * s + 3]); w.z = pk_bf16(S[8 * s + 4], S[8 * s + 5]); w.w = pk_bf16(S[8 * s + 6], S[8 * s + 7]);
                        P[mp][s] = __builtin_bit_cast(bf16x8, w); }
                }
#pragma unroll
                for (int eb = 0; eb < 4; ++eb)
#pragma unroll
                    for (int s = 0; s < 2; ++s) {
                        const int vo = cb + AT_KB + (eb * 32 + lr) * AT_VROW + (kb * 32 + 16 * s + 4 * lh) * 2;
                        const s16x4 lo = *(const LAS s16x4*)(F.lds + vo), hi = *(const LAS s16x4*)(F.lds + vo + 16);
                        const bf16x8 vf = __builtin_shufflevector(lo, hi, 0, 1, 2, 3, 4, 5, 6, 7);
                        O1[eb] = __builtin_amdgcn_mfma_f32_32x32x16_bf16(vf, P[0][s], O1[eb], 0, 0, 0);
                        O2[eb] = __builtin_amdgcn_mfma_f32_32x32x16_bf16(vf, P[1][s], O2[eb], 0, 0, 0);
                        __builtin_amdgcn_sched_barrier(0);
                    }
            }
            if (t + 1 < nkt) {
#pragma unroll
                for (int i = 0; i < 2; ++i) { *(LAS u32x4*)(F.lds + nb + klo + i * 32 * AT_KROW) = sk[i]; *(LAS u32x2*)(F.lds + nb + vlo + i * 64 * AT_VROW) = (u32x2){sv[i].x, sv[i].y}; *(LAS u32x2*)(F.lds + nb + vlo + i * 64 * AT_VROW + 8) = (u32x2){sv[i].z, sv[i].w}; }
            }
            __syncthreads();
        }
        l1 += shx(l1, 32, lane); l2 += shx(l2, 32, lane);
        const float i1 = 1.0f / l1, i2 = lam_full / l2;
        float ss = 0.f;
#pragma unroll
        for (int e = 0; e < 4; ++e)
#pragma unroll
            for (int i = 0; i < 16; ++i) { const float o = O1[e][i] * i1 - O2[e][i] * i2; O1[e][i] = o; ss += o * o; }
        ss += shx(ss, 32, lane);
        const float rstd = __builtin_amdgcn_rsqf(ss * (1.0f / 128.0f) + RMS_EPS) * osc;
        bf16_t* orow = Ob + qrow * 1024 + h * 128;
#pragma unroll
        for (int e = 0; e < 4; ++e)
#pragma unroll
            for (int g4 = 0; g4 < 4; ++g4) {
                const int e0 = e * 32 + 8 * g4 + 4 * lh;
                const f32x4 gs = ldg<f32x4>(gsub + e0);
                u32x2 w; w.x = pk_bf16(O1[e][4 * g4] * rstd * gs[0], O1[e][4 * g4 + 1] * rstd * gs[1]); w.y = pk_bf16(O1[e][4 * g4 + 2] * rstd * gs[2], O1[e][4 * g4 + 3] * rstd * gs[3]);
                stg<u32x2>(orow + e0, w);
            }
    }
    __syncthreads();
}

constexpr int SC_Q = 0, SC_QROW = 528, SC_K = 32 * SC_QROW, SC_V = SC_K + 16384, SC_BUF = SC_V + 16384, SC_S = 2 * SC_BUF, SC_SROW = 80, SC_RED = SC_S + 2 * 32 * SC_SROW, SC_Y = SC_RED + 1024, SC_YROW = 528;
DI void scan_phase(const Frame& F, int layer, int hf) {
    const int j = layer >> 1;
    const bf16_t* RQ = (const bf16_t*)(F.ws + WS_PROJ + PJ_RQ); bf16_t* RG = (bf16_t*)(F.ws + WS_PROJ + PJ_RG);
    const bf16_t* RKT = (const bf16_t*)(F.ws + WS_PROJ + PJ_RKT); const bf16_t* RVT = (const bf16_t*)(F.ws + WS_PROJ + PJ_RVT);
    float* ssqb = (float*)(F.ws + WS_MISC + MS_SSQ);
    const int tid = F.tid;
    for (int u = F.bid; u < 256; u += F.G) {
        int bl, h, dir, eh;
        if (F.G == 256) { const int base = (u >> 5) * 8 + (u & 7), var = (u >> 3) & 3; bl = base >> 2; h = base & 3; dir = var >> 1; eh = var & 1; }
        else { bl = u >> 4; h = (u >> 2) & 3; dir = (u >> 1) & 1; eh = u & 1; }
        const float l2g = __log2f(1.0f - __expf(ldg<float>(F.a->in[15] + j * 8 + dir * 4 + h)));
        const float g32 = __builtin_amdgcn_exp2f(32.0f * l2g);
        const int sgn = dir ? -1 : 1, kd_a = dir ? 0 : 31, qd_a = dir ? 32 : 1;
        const size_t rb = (size_t)bl * NTOK;
        const bf16_t* qbase = RQ + rb * 1024 + h * 256;
        const bf16_t* ktbase = RKT + (size_t)(h * 256) * HROWS + rb;
        const bf16_t* vtbase = RVT + (size_t)(h * 512 + eh * 256) * HROWS + rb;
        bf16_t* gbase = RG + (rb + (tid >> 4)) * 4096 + dir * 2048 + h * 512 + eh * 256 + (tid & 15) * 16;
        const int qt = tid >> 5, qc = tid & 31;
        const unsigned qgo = (unsigned)(qt * 1024 + qc * 8);
        const int ql0 = SC_Q + qt * SC_QROW + qc * 16, ql1 = ql0 + 16 * SC_QROW;
        const int kd = tid >> 2, kc = tid & 3;
        const unsigned kgo = (unsigned)(kd * HROWS + kc * 8);
        const int kl = kd * 64 + (((kc ^ (kd >> 2)) & 3) << 4);
        f32x16 S[8];
#pragma unroll
        for (int d = 0; d < 8; ++d)
#pragma unroll
            for (int i = 0; i < 16; ++i) S[d][i] = 0.f;
        u32x4 sq[2], sk[2], sv[2];
        __syncthreads();
        {
            const int tok0 = dir ? 224 : 0;
#pragma unroll
            for (int i = 0; i < 2; ++i) { sq[i] = ldg<u32x4>(qbase + (size_t)(tok0 + 16 * i) * 1024 + qgo); sk[i] = ldg<u32x4>(ktbase + (size_t)i * 128 * HROWS + tok0 + kgo); sv[i] = ldg<u32x4>(vtbase + (size_t)i * 128 * HROWS + tok0 + kgo); }
            *(LAS u32x4*)(F.lds + ql0) = sq[0]; *(LAS u32x4*)(F.lds + ql1) = sq[1];
#pragma unroll
            for (int i = 0; i < 2; ++i) { *(LAS u32x4*)(F.lds + SC_K + kl + i * 8192) = sk[i]; *(LAS u32x4*)(F.lds + SC_V + kl + i * 8192) = sv[i]; }
        }
        __syncthreads();
        for (int ci = 0; ci < 72; ++ci) {
            const int tok0 = dir ? 32 * ((ci < 8 ? 7 : 79) - ci) : 32 * ci;
            const int t2 = launder(tid); const int lane = t2 & 63, lr = lane & 31, lh = lane >> 5, w = __builtin_amdgcn_readfirstlane(t2 >> 6), op = t2 >> 4, oc = t2 & 15;
            float l2c = l2g; asm volatile("" : "+v"(l2c));
            const int cb = (ci & 1) * SC_BUF, nb = SC_BUF - cb, sb = SC_S + (ci & 1) * 32 * SC_SROW;
            if (ci + 1 < 72) {
                const int cn = ci + 1; const int tn = dir ? 32 * ((cn < 8 ? 7 : 79) - cn) : 32 * cn;
#pragma unroll
                for (int i = 0; i < 2; ++i) { sq[i] = ldg<u32x4>(qbase + (size_t)(tn + 16 * i) * 1024 + qgo); sk[i] = ldg<u32x4>(ktbase + (size_t)i * 128 * HROWS + tn + kgo); sv[i] = ldg<u32x4>(vtbase + (size_t)i * 128 * HROWS + tn + kgo); }
            }
            const u32x4 gt0 = ldg<u32x4>(gbase + (size_t)tok0 * 4096), gt1 = ldg<u32x4>(gbase + (size_t)tok0 * 4096 + 8);
            if (w < 4) {
                const int p0 = 16 * (w >> 1), m0 = 16 * (w & 1);
                const int l15 = lane & 15, g4 = lane >> 4, tq = l15 >> 2, tp = l15 & 3;
                f32x4 sc = {0.f, 0.f, 0.f, 0.f};
                const bool dead = sgn * (p0 - m0) < 0;
                if (!dead) {
#pragma unroll
                    for (int ks = 0; ks < 8; ++ks) {
                        const int prow = p0 + l15, qchunk = 4 * ks + g4;
                        const bf16x8 af = *(const LAS bf16x8*)(F.lds + cb + SC_Q + prow * SC_QROW + qchunk * 16);
                        const int d0 = 32 * ks + 8 * g4 + tq, cc = (m0 >> 3) + (tp >> 1);
                        const s16x4 b0 = __builtin_amdgcn_ds_read_tr16_b64_v4i16((LAS s16x4*)(F.lds + cb + SC_K + d0 * 64 + (((cc ^ (d0 >> 2)) & 3) << 4) + 8 * (tp & 1)));
                        const s16x4 b1 = __builtin_amdgcn_ds_read_tr16_b64_v4i16((LAS s16x4*)(F.lds + cb + SC_K + (d0 + 4) * 64 + (((cc ^ ((d0 + 4) >> 2)) & 3) << 4) + 8 * (tp & 1)));
                        const bf16x8 bfr = __builtin_shufflevector(b0, b1, 0, 1, 2, 3, 4, 5, 6, 7);
                        sc = __builtin_amdgcn_mfma_f32_16x16x32_bf16(af, bfr, sc, 0, 0, 0);
                    }
                }
                const int mm = m0 + l15;
#pragma unroll
                for (int r = 0; r < 4; ++r) { const int pp = p0 + 4 * g4 + r; const int df = sgn * (pp - mm);
                    const float v = df >= 0 ? sc[r] * __builtin_amdgcn_exp2f((float)df * l2c) : 0.f;
                    *(LAS bf16_t*)(F.lds + sb + pp * SC_SROW + mm * 2) = (bf16_t)(pk_bf16(v, 0.f) & 0xffffu); }
            }
            __syncthreads();
            bf16x8 vf[2], vd[2];
            {
                const int e = 32 * w + lr;
#pragma unroll
                for (int ks = 0; ks < 2; ++ks) {
                    const int cc = 2 * ks + lh;
                    vf[ks] = *(const LAS bf16x8*)(F.lds + cb + SC_V + e * 64 + (((cc ^ (e >> 2)) & 3) << 4));
                    const u32x4 raw = __builtin_bit_cast(u32x4, vf[ks]); u32x4 o;
                    float kd8[8];
#pragma unroll
                    for (int jj = 0; jj < 8; ++jj) { const int t = 16 * ks + 8 * lh + jj; kd8[jj] = __builtin_amdgcn_exp2f((float)(kd_a - sgn * t) * l2c); }
                    o.x = pk_bf16(bf_lo(raw.x) * kd8[0], bf_hi(raw.x) * kd8[1]); o.y = pk_bf16(bf_lo(raw.y) * kd8[2], bf_hi(raw.y) * kd8[3]);
                    o.z = pk_bf16(bf_lo(raw.z) * kd8[4], bf_hi(raw.z) * kd8[5]); o.w = pk_bf16(bf_lo(raw.w) * kd8[6], bf_hi(raw.w) * kd8[7]);
                    vd[ks] = __builtin_bit_cast(bf16x8, o);
                }
            }
            f32x16 Y;
#pragma unroll
            for (int i = 0; i < 16; ++i) Y[i] = 0.f;
#pragma unroll
            for (int dt = 0; dt < 8; ++dt)
#pragma unroll
                for (int s = 0; s < 2; ++s) {
                    u32x4 pb; pb.x = pk_bf16(S[dt][8 * s], S[dt][8 * s + 1]); pb.y = pk_bf16(S[dt][8 * s + 2], S[dt][8 * s + 3]); pb.z = pk_bf16(S[dt][8 * s + 4], S[dt][8 * s + 5]); pb.w = pk_bf16(S[dt][8 * s + 6], S[dt][8 * s + 7]);
                    const int c0 = 4 * dt + 2 * s;
                    const s16x4 a0 = *(const LAS s16x4*)(F.lds + cb + SC_Q + lr * SC_QROW + c0 * 16 + 8 * lh);
                    const s16x4 a1 = *(const LAS s16x4*)(F.lds + cb + SC_Q + lr * SC_QROW + c0 * 16 + 16 + 8 * lh);
                    const bf16x8 af = __builtin_shufflevector(a0, a1, 0, 1, 2, 3, 4, 5, 6, 7);
                    Y = __builtin_amdgcn_mfma_f32_32x32x16_bf16(af, __builtin_bit_cast(bf16x8, pb), Y, 0, 0, 0);
                }
#pragma unroll
            for (int r = 0; r < 16; ++r) { const int p = (r & 3) + 8 * (r >> 2) + 4 * lh; Y[r] *= __builtin_amdgcn_exp2f((float)(qd_a + sgn * p) * l2c); }
#pragma unroll
            for (int ks = 0; ks < 2; ++ks) {
                const bf16x8 sf = *(const LAS bf16x8*)(F.lds + sb + lr * SC_SROW + (16 * ks + 8 * lh) * 2);
                Y = __builtin_amdgcn_mfma_f32_32x32x16_bf16(sf, vf[ks], Y, 0, 0, 0);
            }
#pragma unroll
            for (int dt = 0; dt < 8; ++dt) {
#pragma unroll
                for (int i = 0; i < 16; ++i) S[dt][i] *= g32;
#pragma unroll
                for (int ks = 0; ks < 2; ++ks) {
                    const int d = 32 * dt + lr, cc = 2 * ks + lh;
                    const bf16x8 kf = *(const LAS bf16x8*)(F.lds + cb + SC_K + d * 64 + (((cc ^ (d >> 2)) & 3) << 4));
                    S[dt] = __builtin_amdgcn_mfma_f32_32x32x16_bf16(kf, vd[ks], S[dt], 0, 0, 0);
                }
            }
            float q2[16];
#pragma unroll
            for (int r = 0; r < 16; ++r) { const float y = Y[r]; q2[r] = y * y;
                *(LAS bf16_t*)(F.lds + SC_Y + ((r & 3) + 8 * (r >> 2) + 4 * lh) * SC_YROW + (w * 32 + lr) * 2) = (bf16_t)(pk_bf16(y, 0.f) & 0xffffu); }
            {
                float a8[8];
#pragma unroll
                for (int i = 0; i < 8; ++i) { const bool hi = lr & 16; const float keep = hi ? q2[i + 8] : q2[i], send = hi ? q2[i] : q2[i + 8]; a8[i] = keep + shx(send, 16, lane); }
                float a4[4];
#pragma unroll
                for (int i = 0; i < 4; ++i) { const bool hi = lr & 8; const float keep = hi ? a8[i + 4] : a8[i], send = hi ? a8[i] : a8[i + 4]; a4[i] = keep + shx(send, 8, lane); }
                float a2[2];
#pragma unroll
                for (int i = 0; i < 2; ++i) { const bool hi = lr & 4; const float keep = hi ? a4[i + 2] : a4[i], send = hi ? a4[i] : a4[i + 2]; a2[i] = keep + shx(send, 4, lane); }
                float a1; { const bool hi = lr & 2; const float keep = hi ? a2[1] : a2[0], send = hi ? a2[0] : a2[1]; a1 = keep + shx(send, 2, lane); }
                a1 += shx(a1, 1, lane);
                const int r = (lr >> 1) & 15, p = (r & 3) + 8 * (r >> 2) + 4 * lh;
                if (!(lr & 1)) *(LAS float*)(F.lds + SC_RED + (w * 32 + p) * 4) = a1;
            }
            if (ci + 1 < 72) {
                *(LAS u32x4*)(F.lds + nb + ql0) = sq[0]; *(LAS u32x4*)(F.lds + nb + ql1) = sq[1];
#pragma unroll
                for (int i = 0; i < 2; ++i) { *(LAS u32x4*)(F.lds + nb + SC_K + kl + i * 8192) = sk[i]; *(LAS u32x4*)(F.lds + nb + SC_V + kl + i * 8192) = sv[i]; }
            }
            __syncthreads();
            {
                const u32x4 y0 = *(const LAS u32x4*)(F.lds + SC_Y + op * SC_YROW + oc * 32), y1 = *(const LAS u32x4*)(F.lds + SC_Y + op * SC_YROW + oc * 32 + 16);
                u32x4 z0, z1;
                z0.x = pk_bf16(bf_lo(y0.x) * bf_lo(gt0.x), bf_hi(y0.x) * bf_hi(gt0.x)); z0.y = pk_bf16(bf_lo(y0.y) * bf_lo(gt0.y), bf_hi(y0.y) * bf_hi(gt0.y));
                z0.z = pk_bf16(bf_lo(y0.z) * bf_lo(gt0.z), bf_hi(y0.z) * bf_hi(gt0.z)); z0.w = pk_bf16(bf_lo(y0.w) * bf_lo(gt0.w), bf_hi(y0.w) * bf_hi(gt0.w));
                z1.x = pk_bf16(bf_lo(y1.x) * bf_lo(gt1.x), bf_hi(y1.x) * bf_hi(gt1.x)); z1.y = pk_bf16(bf_lo(y1.y) * bf_lo(gt1.y), bf_hi(y1.y) * bf_hi(gt1.y));
                z1.z = pk_bf16(bf_lo(y1.z) * bf_lo(gt1.z), bf_hi(y1.z) * bf_hi(gt1.z)); z1.w = pk_bf16(bf_lo(y1.w) * bf_lo(gt1.w), bf_hi(y1.w) * bf_hi(gt1.w));
                stg<u32x4>(gbase + (size_t)tok0 * 4096, z0); stg<u32x4>(gbase + (size_t)tok0 * 4096 + 8, z1);
            }
            if (tid < 32) { float s = 0.f;
#pragma unroll
                for (int ww = 0; ww < 8; ++ww) s += *(const LAS float*)(F.lds + SC_RED + (ww * 32 + tid) * 4);
                stg<float>(ssqb + (((size_t)eh * 2 + dir) * HROWS + rb + tok0 + tid) * 4 + h, s); }
        }
    }
    __syncthreads();
}

DI void comb_phase(const Frame& F, int hf) {
    const bf16_t* PJ = (const bf16_t*)(F.ws + WS_PROJ + PJ_RG);
    const float* ssqb = (const float*)(F.ws + WS_MISC + MS_SSQ);
    bf16_t* O = (bf16_t*)(F.ws + (hf == 0 ? WS_OBUF : WS_ABUF));
    for (int r = F.bid * 8 + F.wave; r < 36864; r += F.G * 8) {
#pragma unroll
        for (int i = 0; i < 4; ++i) {
            const float sf = ldg<float>(ssqb + ((size_t)(0 * 2 + 0) * 36864 + r) * 4 + i) + ldg<float>(ssqb + ((size_t)(1 * 2 + 0) * 36864 + r) * 4 + i);
            const float sb = ldg<float>(ssqb + ((size_t)(0 * 2 + 1) * 36864 + r) * 4 + i) + ldg<float>(ssqb + ((size_t)(1 * 2 + 1) * 36864 + r) * 4 + i);
            const float rf = 1.0f / sqrtf(sf * (1.0f / 512.0f) + RMS_EPS), rb = 1.0f / sqrtf(sb * (1.0f / 512.0f) + RMS_EPS);
            const int c = i * 512 + F.lane * 8;
            const u32x4 zf = ldg<u32x4>(PJ + (size_t)r * 4096 + c), zb = ldg<u32x4>(PJ + (size_t)r * 4096 + 2048 + c);
            u32x4 w;
            w.x = pk_bf16(rf * bf_lo(zf.x) + rb * bf_lo(zb.x), rf * bf_hi(zf.x) + rb * bf_hi(zb.x));
            w.y = pk_bf16(rf * bf_lo(zf.y) + rb * bf_lo(zb.y), rf * bf_hi(zf.y) + rb * bf_hi(zb.y));
            w.z = pk_bf16(rf * bf_lo(zf.z) + rb * bf_lo(zb.z), rf * bf_hi(zf.z) + rb * bf_hi(zb.z));
            w.w = pk_bf16(rf * bf_lo(zf.w) + rb * bf_lo(zb.w), rf * bf_hi(zf.w) + rb * bf_hi(zb.w));
            stg<u32x4>(O + (size_t)r * 2048 + c, w);
        }
    }
}

DI void final_phase(const Frame& F) {
    const bf16_t* y2 = (const bf16_t*)(F.ws + WS_PROJ + PJ_Y2);
    for (int r = F.bid * 8 + F.wave; r < T; r += F.G * 8) {
        const int b = r / NTOK, n = r % NTOK; if (n < CTXL) continue;
        float* hp = F.out + ((size_t)b * 2048 + (n - 256)) * 1024; const float* modp = mod_lat(F, 3, b);
#pragma unroll
        for (int i = 0; i < 4; ++i) {
            f32x4 x = ldg<f32x4>(hp + i * 256 + F.lane * 4);
            const u32x2 a = ldg<u32x2>(y2 + (size_t)(2 * r) * 1024 + i * 256 + F.lane * 4), c = ldg<u32x2>(y2 + (size_t)(2 * r + 1) * 1024 + i * 256 + F.lane * 4);
            const f32x4 g2 = ldg<f32x4>(modp + 5120 + i * 256 + F.lane * 4);
            x[0] += g2[0] * (bf_lo(a.x) + bf_lo(c.x)); x[1] += g2[1] * (bf_hi(a.x) + bf_hi(c.x)); x[2] += g2[2] * (bf_lo(a.y) + bf_lo(c.y)); x[3] += g2[3] * (bf_hi(a.y) + bf_hi(c.y));
            stg<f32x4>(hp + i * 256 + F.lane * 4, x);
        }
    }
}

constexpr int NPHASE = 50;
__global__ void __launch_bounds__(512, 2) fwd_kernel(Args args) {
    extern __shared__ __attribute__((aligned(16))) unsigned char lds_raw[];
    Frame F;
    F.a = &args;
    F.out = args.out; F.ws = args.ws; F.lds = (LAS unsigned char*)lds_raw;
    F.tid = threadIdx.x; F.lane = F.tid & 63; F.wave = __builtin_amdgcn_readfirstlane(F.tid >> 6); F.G = gridDim.x;
    const int lo = args.ph_lo, hi = args.ph_hi;
    const int wave_s = __builtin_amdgcn_readfirstlane((int)threadIdx.x >> 6);
    volatile LAS unsigned* bst = (volatile LAS unsigned*)(F.lds + LDS_MISC);
    if (F.tid < 4) bst[F.tid] = 0u;
    __syncthreads();
    XcdBarrier bar; bar.bar = (unsigned*)(F.ws + WS_CTL) + CW_BAR; bar.x = 0; bar.st = bst;
    if (hi - lo > 1) bar = xcd_barrier_post((unsigned*)(F.ws + WS_CTL) + CW_BAR, bst);
#ifndef PH_MASK
#define PH_MASK 0xFFFFFFFFu
#endif
#define PHASE(site, p, ...) do { if (((PH_MASK >> (site)) & 1u) && lo <= (p) && (p) < hi) { F.ws = launder_p(args.ws); F.out = (float*)launder_p((unsigned char*)args.out); { int ws_ = wave_s, bi_ = (int)blockIdx.x; asm volatile("" : "+s"(ws_), "+s"(bi_)); F.wave = ws_; F.bid = bi_; } F.lane = lane_id_asm(); F.tid = (F.wave << 6) | F.lane; __VA_ARGS__; if ((p) + 1 < hi) xcd_barrier(bar, (wave_s << 6) | lane_id_asm()); } } while (0)

    PHASE(0, 0, p0_prologue(F));
    for (int layer = 0; layer < DEPTH; ++layer) {
        const int pb = 1 + 12 * layer, j = layer >> 1; const bool isRT = layer & 1;
        PHASE(1, pb + 0, { norm_phase<false>(F, layer); if (layer > 0) convert_moe_weights(F, layer); });
        if (!isRT) {
            PHASE(2, pb + 1, {
                ProbQKV S; S.K = 1024; S.abuf = (const char*)(F.ws + WS_ABUF); S.wqk = (const char*)(F.ws + WS_WQK) + (size_t)j * 2048 * 1024 * 2; S.wv = (const char*)(F.ws + WS_WV) + (size_t)j * 1024 * 1024 * 2;
                S.go.init(NTILE, 8); S.G = F.G; S.c = F.bid;
                EpiQKV E{(bf16_t*)(F.ws + WS_PROJ + PJ_Q), (bf16_t*)(F.ws + WS_PROJ + PJ_K), (bf16_t*)(F.ws + WS_PROJ + PJ_VT), F.a->in[9] + j * 64, F.a->in[10] + j * 64,
                         (const float*)(F.ws + WS_ROPE + RP_CDA), (const float*)(F.ws + WS_ROPE + RP_SDA)};
                pg8::gemm_phase<EpiQKV, ProbQKV, true>(F.lds, S, E, F.tid, F.wave);
            });
            PHASE(3, pb + 2, attn_phase(F, layer));
        } else {
            for (int hf = 0; hf < 2; ++hf) {
                PHASE(4, pb + 1 + 3 * hf, {
                    ProbWIN S; S.K = 1024; S.abuf = (const char*)(F.ws + WS_ABUF) + (size_t)hf * 144 * 256 * 1024 * 2; S.win = (const char*)(F.ws + WS_WIN) + (size_t)j * 8192 * 1024 * 2;
                    S.go.init(144, 20); S.G = F.G; S.c = F.bid;
                    EpiWIN E{(bf16_t*)(F.ws + WS_PROJ + PJ_RQ), (bf16_t*)(F.ws + WS_PROJ + PJ_RG), (bf16_t*)(F.ws + WS_PROJ + PJ_RKT), (bf16_t*)(F.ws + WS_PROJ + PJ_RVT), hf * 144,
                             (const float*)(F.ws + WS_ROPE + RP_CRT), (const float*)(F.ws + WS_ROPE + RP_SRT), (const float*)(F.ws + WS_MISC + MS_CRTT), (const float*)(F.ws + WS_MISC + MS_SRTT)};
                    pg8::gemm_phase<EpiWIN, ProbWIN, true>(F.lds, S, E, F.tid, F.wave);
                });
                PHASE(5, pb + 2 + 3 * hf, scan_phase(F, layer, hf));
                PHASE(6, pb + 3 + 3 * hf, comb_phase(F, hf));
            }
        }
        PHASE(7, pb + 7, {
            ProbDense S; S.G = F.G; S.c = F.bid; S.go.init(NTILE, 4);
            if (!isRT) { S.K = 1024; S.A0 = (const char*)(F.ws + WS_OBUF); S.A1 = S.A0; S.pm_split = 1 << 30; S.Bt = (const char*)(F.ws + WS_WODA) + (size_t)j * 1024 * 1024 * 2; }
            else { S.K = 2048; S.A0 = (const char*)(F.ws + WS_OBUF); S.A1 = (const char*)(F.ws + WS_ABUF); S.pm_split = 144; S.Bt = (const char*)(F.ws + WS_WORT) + (size_t)j * 1024 * 2048 * 2; }
            float* hctx = (float*)(F.ws + WS_HCTX);
            EpiResid E{layer == 0 ? F.a->in[2] : hctx, layer == 0 ? F.a->in[0] : F.out, hctx, F.out, (const float*)(F.ws + WS_ADA) + (size_t)layer * 33 * 6144};
            pg8::gemm_phase<EpiResid, ProbDense, true>(F.lds, S, E, F.tid, F.wave);
        });
        PHASE(8, pb + 8, norm_phase<true>(F, layer));
        PHASE(9, pb + 9, sort_phase(F, layer));
        PHASE(10, pb + 10, {
            LAS int* segs = (LAS int*)(F.lds + LDS_MISC + 2048); LAS int* tile_e = (LAS int*)(F.lds + LDS_TILE_E);
            const int ntl = build_segments(F, layer, segs, tile_e);
            ProbMoE S; S.K = 1024; S.A = (const char*)(F.ws + WS_PROJ + PJ_SA); S.W = (const char*)(F.ws + WS_WGU); S.tile_e = tile_e; S.go.init(ntl, 4); S.G = F.G; S.c = F.bid;
            EpiSwiGLU E{(bf16_t*)(F.ws + WS_PROJ + PJ_ACT)};
            pg8::gemm_phase<EpiSwiGLU, ProbMoE, true>(F.lds, S, E, F.tid, F.wave);
        });
        PHASE(11, pb + 11, {
            LAS int* segs = (LAS int*)(F.lds + LDS_MISC + 2048); LAS int* tile_e = (LAS int*)(F.lds + LDS_TILE_E);
            const int ntl = build_segments(F, layer, segs, tile_e);
            ProbMoE S; S.K = 512; S.A = (const char*)(F.ws + WS_PROJ + PJ_ACT); S.W = (const char*)(F.ws + WS_WD); S.tile_e = tile_e; S.go.init(ntl, 4); S.G = F.G; S.c = F.bid;
            EpiDown E{(bf16_t*)(F.ws + WS_PROJ + PJ_Y2), (const int*)(F.ws + WS_MISC + MS_ROWMAP), (const float*)(F.ws + WS_MISC + MS_WSEL)};
            pg8::gemm_phase<EpiDown, ProbMoE, true>(F.lds, S, E, F.tid, F.wave);
        });
    }
    PHASE(12, 49, final_phase(F));
#undef PHASE
}

static bool phase_exists(int p) {
    if (p == 0 || p == 49) return true;
    const int layer = (p - 1) / 12, slot = (p - 1) % 12; const bool isRT = layer & 1;
    if (!isRT && slot >= 3 && slot <= 6) return false;
    return true;
}
extern "C" void kernel_launch(void* const* d_in, const int* in_sizes, int n_in, void* d_out, int out_size, void* d_ws, size_t ws_size, hipStream_t stream) {
    static int grid = 0;
    if (grid == 0) {
        if (n_in != 24 || ws_size < WS_END) { fprintf(stderr, "kernel_launch: need 24 inputs and >= %zu bytes of workspace (got %d, %zu)\n", (size_t)WS_END, n_in, ws_size); grid = -1; return; }
        int dev = 0, cus = 0, per_cu = 0;
        if (hipGetDevice(&dev) != hipSuccess || hipDeviceGetAttribute(&cus, hipDeviceAttributeMultiprocessorCount, dev) != hipSuccess) { grid = -1; return; }
        if (hipFuncSetAttribute((const void*)fwd_kernel, hipFuncAttributeMaxDynamicSharedMemorySize, LDS_BYTES) != hipSuccess) { fprintf(stderr, "kernel_launch: hipFuncSetAttribute failed\n"); grid = -1; return; }
        if (hipOccupancyMaxActiveBlocksPerMultiprocessor(&per_cu, (const void*)fwd_kernel, 512, LDS_BYTES) != hipSuccess || per_cu < 1) fprintf(stderr, "kernel_launch: occupancy query reports %d\n", per_cu);
        (void)hipGetLastError();
        grid = cus;
    }
    if (grid < 0) return;
    (void)hipMemsetAsync((char*)d_ws + WS_CTL, 0, 1 * MiB, stream);
    Args a{};
    for (int i = 0; i < 24; ++i) a.in[i] = (const float*)d_in[i];
    a.out = (float*)d_out; a.ws = (unsigned char*)d_ws;
#ifdef MULTI_LAUNCH
    for (int p = 0; p < NPHASE; ++p) { if (!phase_exists(p)) continue; a.ph_lo = p; a.ph_hi = p + 1; hipLaunchKernelGGL(fwd_kernel, dim3(grid), dim3(512), LDS_BYTES, stream, a); }
#elif defined(PROBE_DUP_LO)
    a.ph_lo = 0; a.ph_hi = PROBE_DUP_HI; hipLaunchKernelGGL(fwd_kernel, dim3(grid), dim3(512), LDS_BYTES, stream, a);
    for (int p = PROBE_DUP_LO; p < PROBE_DUP_HI; ++p) { if (!phase_exists(p)) continue; a.ph_lo = p; a.ph_hi = p + 1; hipLaunchKernelGGL(fwd_kernel, dim3(grid), dim3(512), LDS_BYTES, stream, a); }
    (void)hipMemsetAsync((char*)d_ws + WS_CTL, 0, 16384, stream);
    a.ph_lo = PROBE_DUP_HI; a.ph_hi = NPHASE; hipLaunchKernelGGL(fwd_kernel, dim3(grid), dim3(512), LDS_BYTES, stream, a);
#else
    a.ph_lo = 0; a.ph_hi = NPHASE; hipLaunchKernelGGL(fwd_kernel, dim3(grid), dim3(512), LDS_BYTES, stream, a);
#endif
}
```

```cpp
#include <hip/hip_runtime.h>
#include <cstdio>
#include <cstdint>

#define LAS __attribute__((address_space(3)))
constexpr float LOG2E = 1.4426950408889634f;
#define DI __device__ __forceinline__
typedef unsigned short bf16_t;
typedef short bf16x8 __attribute__((ext_vector_type(8)));
typedef short s16x4 __attribute__((ext_vector_type(4)));
typedef float f32x4 __attribute__((ext_vector_type(4)));
typedef float f32x2 __attribute__((ext_vector_type(2)));
typedef float f32x16 __attribute__((ext_vector_type(16)));
typedef unsigned u32x4 __attribute__((ext_vector_type(4)));
typedef unsigned u32x2 __attribute__((ext_vector_type(2)));
typedef __bf16 bf16x2_t __attribute__((ext_vector_type(2)));

#define GAS __attribute__((address_space(1)))
template <class V, class T> DI V ldg(const T* p) { return *(const GAS V*)(unsigned long long)p; }
template <class V, class T> DI void stg(T* p, V v) { *(GAS V*)(unsigned long long)p = v; }
DI unsigned pk_bf16(float lo, float hi) { f32x2 v = {lo, hi}; return __builtin_bit_cast(unsigned, __builtin_convertvector(v, bf16x2_t)); }
DI float bf_lo(unsigned u) { return __uint_as_float(u << 16); }
DI float bf_hi(unsigned u) { return __uint_as_float(u & 0xffff0000u); }
DI float bf_f(bf16_t v) { return __uint_as_float(((unsigned)v) << 16); }
DI unsigned char* launder_p(unsigned char* p) { asm volatile("" : "+s"(p)); return p; }
DI float shx(float v, int o, int lane) { return __builtin_bit_cast(float, __builtin_amdgcn_ds_bpermute((lane ^ o) << 2, __builtin_bit_cast(int, v))); }
DI float wave_sum(float v, int lane) {
#pragma unroll
    for (int o = 32; o >= 1; o >>= 1) v += shx(v, o, lane);
    return v;
}
DI int lane_id_asm() { int x; asm volatile("v_mbcnt_lo_u32_b32 %0, -1, 0\n\tv_mbcnt_hi_u32_b32 %0, -1, %0" : "=v"(x)); return x; }
DI int launder(int x) { asm volatile("" : "+v"(x)); return x; }
DI float silu_f(float x) { return x * __builtin_amdgcn_rcpf(1.0f + __builtin_amdgcn_exp2f(-LOG2E * x)); }

constexpr int NB = 32, SEQ = 2048, CTXL = 256, NTOK = SEQ + CTXL, DM = 1024, DEPTH = 4;
constexpr int T = NB * NTOK;
constexpr int NTILE = T / 256;
constexpr int NEXP = 32, MOEH = 512;
constexpr int MAXROWS = 2 * T + NEXP * 256;
constexpr float RMS_EPS = 1e-6f;

constexpr size_t MiB = 1ull << 20;
constexpr size_t WS_CTL = 0;
constexpr size_t WS_ADA = 1 * MiB;
constexpr size_t WS_ROPE = 5 * MiB;
constexpr size_t WS_MISC = 8 * MiB;
constexpr size_t WS_HCTX = 16 * MiB;
constexpr size_t WS_WQK = 48 * MiB;
constexpr size_t WS_WV = 56 * MiB;
constexpr size_t WS_WODA = 60 * MiB;
constexpr size_t WS_WIN = 64 * MiB;
constexpr size_t WS_WORT = 96 * MiB;
constexpr size_t WS_WGU = 104 * MiB;
constexpr size_t WS_WD = 168 * MiB;
constexpr size_t WS_ABUF = 200 * MiB;
constexpr size_t WS_OBUF = 344 * MiB;
constexpr size_t WS_PROJ = 488 * MiB;
constexpr size_t WS_HB = 1064 * MiB;
constexpr size_t WS_END = 1208 * MiB;
constexpr size_t PJ_Q = 0, PJ_K = 144 * MiB, PJ_VT = 288 * MiB;
constexpr size_t PJ_SA = 0, PJ_ACT = 304 * MiB, PJ_Y2 = 0;
constexpr size_t PJ_RQ = 0, PJ_RG = 72 * MiB, PJ_RKT = 360 * MiB, PJ_RVT = 432 * MiB;
constexpr int HROWS = 36864;
constexpr size_t RP_CDA = 0, RP_SDA = 256 * 1024, RP_CRT = 512 * 1024, RP_SRT = 512 * 1024 + 1 * MiB;
constexpr size_t MS_EID = 0, MS_WSEL = 1 * MiB, MS_ROWMAP = 2 * MiB, MS_SSQ = 3 * MiB, MS_CRTT = 6 * MiB, MS_SRTT = 7 * MiB;
constexpr int CW_BAR = 0;
constexpr int CW_CNT = 4096;
constexpr int CW_CUR = 4096 + 256;

constexpr int LDS_BYTES = 155648;
constexpr int LDS_MISC = 147456;
constexpr int LDS_TILE_E = 131072;

#define XB_TMO      128
#define XB_XCNT(j)  (256  + 64 * (j))
#define XB_XSUB(j)  (1280 + 64 * (j))
#define XB_XGEN(j)  (2304 + 64 * (j))
#define XB_TOP      3328
#define XB_TOPGEN   3392
#define XCD_BAR_WORDS 3456
#define XB_SPIN_CAP (1u << 18)

__device__ __forceinline__ unsigned xb_ld(unsigned* p)              { return __hip_atomic_load(p, __ATOMIC_RELAXED, __HIP_MEMORY_SCOPE_AGENT); }
__device__ __forceinline__ unsigned xb_add(unsigned* p, unsigned v) { return __hip_atomic_fetch_add(p, v, __ATOMIC_RELAXED, __HIP_MEMORY_SCOPE_AGENT); }
__device__ __forceinline__ unsigned xb_xcc_id() { return (unsigned)__builtin_amdgcn_s_getreg((3 << 11) | 20) & 0xFu; }
#define XB_SPIN(cond, bar) do { unsigned _sp = 0; while (cond) { __builtin_amdgcn_s_sleep(1); \
    if ((++_sp & 255u) == 0u) { if (xb_ld(&(bar)[XB_TMO])) break; if (_sp > XB_SPIN_CAP) { atomicAdd(&(bar)[XB_TMO], 1u); break; } } } } while (0)

struct XcdBarrier { unsigned* bar; unsigned x; volatile LAS unsigned* st; };

__device__ __forceinline__ XcdBarrier xcd_barrier_post(unsigned* bar, volatile LAS unsigned* st) {
    XcdBarrier b; b.bar = bar; b.x = xb_xcc_id(); b.st = st;
    if (threadIdx.x == 0) (void)xb_add(&bar[XB_XCNT(b.x)], 1u);
    return b;
}
__device__ __forceinline__ void xcd_barrier_complete(unsigned* bar, unsigned x, unsigned& nloc, unsigned& nx) {
    const unsigned G = gridDim.x * gridDim.y * gridDim.z;
    unsigned sum, cnt, mine, sp = 0u;
    for (;;) {
        sum = 0u; cnt = 0u; mine = 0u;
#pragma unroll
        for (unsigned j = 0; j < 16; ++j) { const unsigned c = xb_ld(&bar[XB_XCNT(j)]); sum += c; cnt += (c > 0u) ? 1u : 0u; mine = (j == x) ? c : mine; }
        if (sum == G) break;
        __builtin_amdgcn_s_sleep(1);
        if ((++sp & 255u) == 0u) { if (xb_ld(&bar[XB_TMO])) break; if (sp > XB_SPIN_CAP) { atomicAdd(&bar[XB_TMO], 1u); break; } }
    }
    nloc = mine > 0u ? mine : 1u; nx = cnt > 0u ? cnt : 1u;
}
__device__ __forceinline__ void xcd_barrier(const XcdBarrier& b, const int tid0) {
    asm volatile("s_waitcnt vmcnt(0)" ::: "memory");
    __syncthreads();
    if (tid0 == 0) {
        unsigned* bar = (unsigned*)launder_p((unsigned char*)b.bar);
        __builtin_amdgcn_s_waitcnt(0);
        unsigned nloc = b.st[0], nx = b.st[1];
        if (nloc == 0u) { xcd_barrier_complete(bar, b.x, nloc, nx); b.st[0] = nloc; b.st[1] = nx; }
        const unsigned old = xb_add(&bar[XB_XSUB(b.x)], 1u);
        const unsigned gen = old / nloc;
        if (old + 1u == (gen + 1u) * nloc) {
            __builtin_amdgcn_fence(__ATOMIC_RELEASE, "agent");
            asm volatile("s_waitcnt vmcnt(0)" ::: "memory");
            const unsigned og = xb_add(&bar[XB_TOP], 1u);
            const unsigned tg = og / nx;
            if (og + 1u == (tg + 1u) * nx) xb_add(&bar[XB_TOPGEN], 1u);
            else XB_SPIN(xb_ld(&bar[XB_TOPGEN]) == tg, bar);
            __builtin_amdgcn_fence(__ATOMIC_ACQUIRE, "agent");
            xb_add(&bar[XB_XGEN(b.x)], 1u);
            asm volatile("s_waitcnt vmcnt(0)" ::: "memory");
        } else {
            XB_SPIN(xb_ld(&bar[XB_XGEN(b.x)]) == gen, bar);
            __builtin_amdgcn_fence(__ATOMIC_ACQUIRE, "agent");
            asm volatile("s_waitcnt vmcnt(0)" ::: "memory");
        }
    }
    __syncthreads();
}

struct Args { const float* in[24]; float* out; unsigned char* ws; int ph_lo, ph_hi; };
struct Frame {
    const Args* a; float* out; unsigned char* ws; LAS unsigned char* lds;
    int tid, lane, wave, G, bid;
};
DI const float* mod_lat(const Frame& F, int layer, int b) { return (const float*)(F.ws + WS_ADA) + ((size_t)layer * 33 + b) * 6144; }
DI const float* mod_ctx(const Frame& F, int layer) { return (const float*)(F.ws + WS_ADA) + ((size_t)layer * 33 + 32) * 6144; }

namespace pg8 {
constexpr int BM = 256, BK = 64, HALF = 128, HTB = HALF * BK * 2, STAGE_BYTES = 8 * HTB, NXCD = 8, WGM = 8;
__host__ __device__ __forceinline__ int lds_byte(int r, int c) { const int st = (r >> 4) * 2 + (c >> 5), rr = r & 15, cc = c & 31, ob = rr * 64 + cc * 2; return st * 1024 + (ob ^ (((ob >> 9) & 1) << 5)); }
__host__ __device__ __forceinline__ void stage_rc(int b, int& R, int& C) { const int st = b / 1024, sb = b % 1024, swz = sb ^ (((sb >> 9) & 1) << 5); R = (st >> 1) * 16 + swz / 64; C = (st & 1) * 32 + (swz % 64) / 2; }
__host__ __device__ __forceinline__ int perm32(int rho) { const int n = rho >> 4, i = rho & 15; return 8 * (i >> 2) + 4 * n + (i & 3); }

struct Unit { int pm, pn, kind; };

struct GridOrder {
    int nM, nN, nwg;
    DI void init(int nM_, int nN_) { nM = nM_; nN = nN_; nwg = nM * nN; }
    DI bool map(long L, int& pm, int& pn) const {
        if (L >= nwg) return false;
        int wgid = (int)L; { const int q = nwg / NXCD, r = nwg % NXCD, xcd = wgid % NXCD, off = wgid / NXCD; wgid = (xcd < r ? xcd * (q + 1) : r * (q + 1) + (xcd - r) * q) + off; }
        const int nig = WGM * nN, gid = wgid / nig, fm = gid * WGM, gsz = (nM - fm) < WGM ? (nM - fm) : WGM;
        pm = fm + ((wgid % nig) % gsz); pn = (wgid % nig) / gsz; return true;
    }
};

template <class Epi, class P, bool ALIGN_EPI>
DI void gemm_phase(LAS unsigned char* lds, const P& S, const Epi& E, const int tid, const int wid) {
    const int lane = tid & 63, wr = wid >> 2, wc = wid & 3, fr = lane & 15, fq = lane >> 4;
    const int K = S.K, nt = K / BK;
    unsigned voffA[2], voffB[2];
#pragma unroll
    for (int i = 0; i < 2; ++i) { int R, C; stage_rc(tid * 16 + i * 8192, R, C); const int Rb = Epi::PERM ? ((R & ~31) + perm32(R & 31)) : R;
        voffA[i] = (unsigned)(R * K + C) * 2u; voffB[i] = (unsigned)(Rb * K + C) * 2u; }
    const size_t kstep = (size_t)(BK * 2);
    const size_t hstep = (size_t)HALF * K * 2;
    const unsigned ldsw = (unsigned)wid * 1024u;
    const int aoff = lds_byte(wr * 64 + fr, fq * 8), boff = lds_byte(wc * 32 + fr, fq * 8);
#define PG8_SA(b, h) (((b) * 2 + (h)) * HTB)
#define PG8_SB(b, h) ((4 + (b) * 2 + (h)) * HTB)
#define PG8_STAGE(bufoff, gbase, voff) do { _Pragma("unroll") for (int _i = 0; _i < 2; ++_i) \
        __builtin_amdgcn_global_load_lds((const unsigned*)((const char*)(gbase) + (voff)[_i]), (LAS unsigned*)(lds + (bufoff) + ldsw + _i * 8192), 16, 0, 0); } while (0)
#define PG8_LDA(dst, b, h) do { _Pragma("unroll") for (int m = 0; m < 4; ++m) _Pragma("unroll") for (int k = 0; k < 2; ++k) dst[m][k] = *(const LAS bf16x8*)(lds + PG8_SA(b, h) + aoff + m * 2048 + k * 1024); } while (0)
#define PG8_LDB(dst, b, h) do { _Pragma("unroll") for (int n = 0; n < 2; ++n) _Pragma("unroll") for (int k = 0; k < 2; ++k) dst[n][k] = *(const LAS bf16x8*)(lds + PG8_SB(b, h) + boff + n * 2048 + k * 1024); } while (0)
#define PG8_MMA(ai, bj, At, Bt) do { __builtin_amdgcn_s_setprio(1); _Pragma("unroll") for (int m = 0; m < 4; ++m) _Pragma("unroll") for (int n = 0; n < 2; ++n) _Pragma("unroll") for (int k = 0; k < 2; ++k) \
        acc[ai][bj][m][n] = __builtin_amdgcn_mfma_f32_16x16x32_bf16(Bt[n][k], At[m][k], acc[ai][bj][m][n], 0, 0, 0); __builtin_amdgcn_s_setprio(0); } while (0)
#define PG8_WAIT_V(n) asm volatile("s_waitcnt vmcnt(" #n ")" ::: "memory")
#define PG8_WAIT_L(n) asm volatile("s_waitcnt lgkmcnt(" #n ")" ::: "memory")
#define PG8_BAR __builtin_amdgcn_s_barrier()
#define PG8_SCHED __builtin_amdgcn_sched_barrier(0)
    Unit cur, nxt; int ui = 0;
    if (!S.next(0, cur)) return;
    unsigned gaC[2][2], gaN[2][2]; int gR[2], gC[2];
    if constexpr (P::GATHER) {
#pragma unroll
        for (int i = 0; i < 2; ++i) { stage_rc(tid * 16 + i * 8192, gR[i], gC[i]); }
#pragma unroll
        for (int h = 0; h < 2; ++h)
#pragma unroll
            for (int i = 0; i < 2; ++i) { gaC[h][i] = (unsigned)(S.rowtok[0 * 256 + h * 128 + gR[i]] * K + gC[i]) * 2u; gaN[h][i] = gaC[h][i]; }
    }
#define PG8_STAGE_A(bufoff, h, usen, kofs, dense) do { if constexpr (P::GATHER) { const unsigned _v[2] = {(usen) ? gaN[h][0] : gaC[h][0], (usen) ? gaN[h][1] : gaC[h][1]}; PG8_STAGE(bufoff, S.A + (kofs), _v); } \
        else { PG8_STAGE(bufoff, dense, voffA); } } while (0)
    f32x4 acc[2][2][4][2];
#pragma unroll
    for (int a = 0; a < 2; ++a)
#pragma unroll
        for (int b = 0; b < 2; ++b)
#pragma unroll
            for (int m = 0; m < 4; ++m)
#pragma unroll
                for (int n = 0; n < 2; ++n) acc[a][b][m][n] = (f32x4){0.f, 0.f, 0.f, 0.f};
    bf16x8 At[4][2], B0[2][2], B1[2][2];
    const char* cA = S.a_ptr(cur); const char* cB = S.b_ptr(cur);
    PG8_STAGE(PG8_SB(0, 0), cB, voffB); PG8_STAGE(PG8_SB(0, 1), cB + hstep, voffB); PG8_STAGE_A(PG8_SA(0, 0), 0, false, 0, cA); PG8_STAGE_A(PG8_SA(0, 1), 1, false, 0, cA + hstep);
    if (wr == 1) PG8_BAR;
    PG8_WAIT_V(2); PG8_BAR;
    PG8_STAGE(PG8_SB(1, 0), cB + kstep, voffB); PG8_STAGE_A(PG8_SA(1, 0), 0, false, kstep, cA + kstep); PG8_STAGE(PG8_SB(1, 1), cB + hstep + kstep, voffB);
    PG8_WAIT_V(6); PG8_BAR;
    for (;;) {
        const bool has_next = S.next(ui + 1, nxt);
        const char* nA = has_next ? S.a_ptr(nxt) : cA; const char* nB = has_next ? S.b_ptr(nxt) : cB;
        if constexpr (P::GATHER) { if (has_next) {
#pragma unroll
            for (int h = 0; h < 2; ++h)
#pragma unroll
                for (int i = 0; i < 2; ++i) gaN[h][i] = (unsigned)(S.rowtok[(ui + 1) * 256 + h * 128 + gR[i]] * K + gC[i]) * 2u; } }
        for (int t = 0; t < nt; t += 2) {
            const bool last = (t == nt - 2);
            const size_t k1 = (size_t)(t + 1) * kstep, k2 = last ? 0 : (size_t)(t + 2) * kstep, k3 = k2 + kstep;
            const char* a1 = cA + k1;
            const char* a2 = (last ? nA : cA) + k2; const char* b2 = last ? nB : cB + (size_t)(t + 2) * kstep;
            const char* a3 = a2 + kstep; const char* b3 = b2 + kstep;
            PG8_LDB(B0, 0, 0); PG8_LDB(B1, 0, 1); PG8_SCHED; PG8_LDA(At, 0, 0); PG8_STAGE_A(PG8_SA(1, 1), 1, false, k1, a1 + hstep);
            PG8_WAIT_V(8); PG8_WAIT_L(0); PG8_BAR; PG8_MMA(0, 0, At, B0); PG8_MMA(0, 1, At, B1); PG8_BAR; PG8_SCHED;
            PG8_LDA(At, 0, 1); PG8_STAGE(PG8_SB(0, 0), b2, voffB); PG8_STAGE(PG8_SB(0, 1), b2 + hstep, voffB); PG8_STAGE_A(PG8_SA(0, 0), 0, last, k2, a2);
            PG8_WAIT_V(8); PG8_WAIT_L(0); PG8_BAR; PG8_MMA(1, 0, At, B0); PG8_MMA(1, 1, At, B1); PG8_BAR; PG8_SCHED;
            PG8_LDB(B0, 1, 0); PG8_LDB(B1, 1, 1); PG8_SCHED; PG8_LDA(At, 1, 0); PG8_STAGE_A(PG8_SA(0, 1), 1, last, k2, a2 + hstep);
            PG8_WAIT_V(8); PG8_WAIT_L(0); PG8_BAR; PG8_MMA(0, 0, At, B0); PG8_MMA(0, 1, At, B1); PG8_BAR; PG8_SCHED;
            PG8_LDA(At, 1, 1); PG8_STAGE(PG8_SB(1, 0), b3, voffB); PG8_STAGE(PG8_SB(1, 1), b3 + hstep, voffB); PG8_STAGE_A(PG8_SA(1, 0), 0, last, k3, a3);
            PG8_WAIT_V(8); PG8_WAIT_L(0); PG8_BAR; PG8_MMA(1, 0, At, B0); PG8_MMA(1, 1, At, B1); PG8_BAR; PG8_SCHED;
        }
        if constexpr (ALIGN_EPI) { if (wr == 0) PG8_BAR; }
        { const int l2 = lane_id_asm(); E(acc, cur, wr, wc, l2 & 15, l2 >> 4); }
        if (!has_next) break;
#pragma unroll
        for (int a = 0; a < 2; ++a)
#pragma unroll
            for (int b = 0; b < 2; ++b)
#pragma unroll
                for (int m = 0; m < 4; ++m)
#pragma unroll
                    for (int n = 0; n < 2; ++n) acc[a][b][m][n] = (f32x4){0.f, 0.f, 0.f, 0.f};
        cur = nxt; cA = nA; cB = nB; ++ui;
        if constexpr (P::GATHER) {
#pragma unroll
            for (int h = 0; h < 2; ++h)
#pragma unroll
                for (int i = 0; i < 2; ++i) gaC[h][i] = gaN[h][i]; }
        if constexpr (ALIGN_EPI) { if (wr == 1) PG8_BAR; }
    }
    PG8_WAIT_V(0);
    if constexpr (!ALIGN_EPI) { if (wr == 0) PG8_BAR; }
    PG8_BAR;
#undef PG8_SA
#undef PG8_SB
#undef PG8_STAGE
#undef PG8_STAGE_A
#undef PG8_LDA
#undef PG8_LDB
#undef PG8_MMA
#undef PG8_WAIT_V
#undef PG8_WAIT_L
#undef PG8_BAR
#undef PG8_SCHED
}
}
using pg8::Unit;

struct ProbQKV {
    static constexpr bool GATHER = false;
    int K; const char* abuf; const char* wqk; const char* wv; pg8::GridOrder go; int G, c;
    DI bool next(int i, Unit& u) const {
        const long L = (long)i * G + c;
        if (L < NTILE * 8) { u.kind = 0; return go.map(L, u.pm, u.pn); }
        const long r = L - NTILE * 8; if (r >= NTILE * 4) return false;
        u.kind = 1; u.pm = (int)(r & 3); u.pn = (int)(r >> 2); return true;
    }
    DI const char* a_ptr(const Unit& u) const { return (u.kind == 0 ? abuf : wv) + (size_t)u.pm * (256 * 1024 * 2); }
    DI const char* b_ptr(const Unit& u) const { return (u.kind == 0 ? wqk : abuf) + (size_t)u.pn * (256 * 1024 * 2); }
};
struct EpiQKV {
    static constexpr bool PERM = true;
    bf16_t* Q; bf16_t* Kb; bf16_t* VT; const float* gq; const float* gk; const float* cosT; const float* sinT;
    DI void operator()(const f32x4 (&acc)[2][2][4][2], const Unit& u, int wr, int wc, int fr, int fq) const {
        if (u.kind == 1) {
#pragma unroll
            for (int ai = 0; ai < 2; ++ai)
#pragma unroll
                for (int m = 0; m < 4; ++m) {
                    const int f = u.pm * 256 + ai * 128 + wr * 64 + m * 16 + fr;
                    bf16_t* rowp = VT + (size_t)f * T + (size_t)u.pn * 256 + wc * 32 + 8 * fq;
#pragma unroll
                    for (int bj = 0; bj < 2; ++bj) { const f32x4 v0 = acc[ai][bj][m][0], v1 = acc[ai][bj][m][1];
                        u32x4 w; w.x = pk_bf16(v0[0], v0[1]); w.y = pk_bf16(v0[2], v0[3]); w.z = pk_bf16(v1[0], v1[1]); w.w = pk_bf16(v1[2], v1[3]);
                        stg<u32x4>(rowp + bj * 128, w); }
                }
            return;
        }
        const bool isK = u.pn >= 4; const int sub = 4 * (u.pn & 3) + wc;
        const int jj = u.pm % 9; const bool isctx = (jj == 0);
        const float* g = isK ? gk : gq; bf16_t* dst = isK ? Kb : Q;
        const float osc = isK ? 1.0f : 0.125f * LOG2E;
        const int ln = fr + 16 * fq;
        f32x4 gv[2][2];
#pragma unroll
        for (int bj = 0; bj < 2; ++bj)
#pragma unroll
            for (int n = 0; n < 2; ++n) gv[bj][n] = ldg<f32x4>(g + 32 * bj + 8 * fq + 4 * n);
        float invf[8];
#pragma unroll
        for (int k = 0; k < 8; ++k) invf[k] = __builtin_amdgcn_exp2f(-(float)((8 * fq + k) & 15) * (13.287712379549449f / 16.0f)) * 0.15915494309189535f;
        const bool use_row = fq < 2;
        float ss[8];
#pragma unroll
        for (int ai = 0; ai < 2; ++ai)
#pragma unroll
            for (int m = 0; m < 4; ++m) { float s = 0.f;
#pragma unroll
                for (int bj = 0; bj < 2; ++bj)
#pragma unroll
                    for (int n = 0; n < 2; ++n) { const f32x4 x = acc[ai][bj][m][n]; s += (x[0] * x[0] + x[1] * x[1]) + (x[2] * x[2] + x[3] * x[3]); }
                ss[ai * 4 + m] = s; }
#pragma unroll
        for (int it = 0; it < 8; ++it) ss[it] += shx(ss[it], 16, ln);
#pragma unroll
        for (int it = 0; it < 8; ++it) ss[it] += shx(ss[it], 32, ln);
#pragma unroll
        for (int ai = 0; ai < 2; ++ai)
#pragma unroll
            for (int m = 0; m < 4; ++m) {
                const int rr = ai * 128 + wr * 64 + m * 16 + fr;
                const float rstd = __builtin_amdgcn_rsqf(ss[ai * 4 + m] * (1.0f / 64.0f) + RMS_EPS) * osc;
                f32x4 x1[2], x2[2];
#pragma unroll
                for (int n = 0; n < 2; ++n) { x1[n] = acc[ai][0][m][n] * rstd * gv[0][n]; x2[n] = acc[ai][1][m][n] * rstd * gv[1][n]; }
                if (!isctx) {
                    const int t = (jj - 1) * 256 + rr; const float pos = (float)(use_row ? (t >> 6) : (t & 63));
#pragma unroll
                    for (int n = 0; n < 2; ++n)
#pragma unroll
                        for (int j = 0; j < 4; ++j) { const float a = pos * invf[4 * n + j]; const float c = __builtin_amdgcn_cosf(a), s = __builtin_amdgcn_sinf(a);
                            const float p = x1[n][j], q = x2[n][j]; x1[n][j] = p * c - q * s; x2[n][j] = p * s + q * c; }
                }
                bf16_t* rowp = dst + (size_t)(u.pm * 256 + rr) * 1024 + 64 * sub + 8 * fq;
                u32x4 w; w.x = pk_bf16(x1[0][0], x1[0][1]); w.y = pk_bf16(x1[0][2], x1[0][3]); w.z = pk_bf16(x1[1][0], x1[1][1]); w.w = pk_bf16(x1[1][2], x1[1][3]);
                stg<u32x4>(rowp, w);
                w.x = pk_bf16(x2[0][0], x2[0][1]); w.y = pk_bf16(x2[0][2], x2[0][3]); w.z = pk_bf16(x2[1][0], x2[1][1]); w.w = pk_bf16(x2[1][2], x2[1][3]);
                stg<u32x4>(rowp + 32, w);
            }
    }
};

struct ProbDense {
    static constexpr bool GATHER = false;
    int K; const char* A0; const char* A1; int pm_split; const char* Bt; pg8::GridOrder go; int G, c;
    DI bool next(int i, Unit& u) const { u.kind = 0; return go.map((long)i * G + c, u.pm, u.pn); }
    DI const char* a_ptr(const Unit& u) const { return u.pm < pm_split ? A0 + (size_t)u.pm * 512 * K : A1 + (size_t)(u.pm - pm_split) * 512 * K; }
    DI const char* b_ptr(const Unit& u) const { return Bt + (size_t)u.pn * 512 * K; }
};

struct ProbWIN {
    static constexpr bool GATHER = false;
    int K; const char* abuf; const char* win; pg8::GridOrder go; int G, c;
    DI bool next(int i, Unit& u) const {
        const long L = (long)i * G + c;
        if (L < 144 * 20) { u.kind = 0; return go.map(L, u.pm, u.pn); }
        const long r = L - 144 * 20; if (r >= 144 * 12) return false;
        u.kind = 1; u.pm = (int)(r % 12); u.pn = (int)(r / 12); return true;
    }
    DI const char* a_ptr(const Unit& u) const { return u.kind == 0 ? abuf + (size_t)u.pm * (256 * 1024 * 2) : win + (size_t)(4 + u.pm) * (256 * 1024 * 2); }
    DI const char* b_ptr(const Unit& u) const { return u.kind == 0 ? win + (size_t)(u.pn < 4 ? u.pn : 12 + u.pn) * (256 * 1024 * 2) : abuf + (size_t)u.pn * (256 * 1024 * 2); }
};
struct EpiWIN {
    static constexpr bool PERM = true;
    bf16_t* RQ; bf16_t* RG; bf16_t* RKT; bf16_t* RVT; int pm0; const float* cosT; const float* sinT; const float* cosTT; const float* sinTT;
    DI void operator()(const f32x4 (&acc)[2][2][4][2], const Unit& u, int wr, int wc, int fr, int fq) const {
        if (u.kind == 0) {
            const int gpm = pm0 + u.pm, jj = gpm % 9; const bool isctx = (jj == 0); const bool isq = u.pn < 4;
            float invf[8];
#pragma unroll
            for (int k = 0; k < 8; ++k) invf[k] = __builtin_amdgcn_exp2f(-(float)((32 * wc + 8 * fq + k) & 63) * (13.287712379549449f / 64.0f)) * 0.15915494309189535f;
#pragma unroll
            for (int ai = 0; ai < 2; ++ai)
#pragma unroll
                for (int m = 0; m < 4; ++m) {
                    const int rr = ai * 128 + wr * 64 + m * 16 + fr;
                    f32x4 x1[2], x2[2];
#pragma unroll
                    for (int n = 0; n < 2; ++n) { x1[n] = acc[ai][0][m][n]; x2[n] = acc[ai][1][m][n]; }
                    if (isq) {
                        if (!isctx) {
                            const int t = (jj - 1) * 256 + rr; const float pos = (float)((wc < 2) ? (t >> 6) : (t & 63));
#pragma unroll
                            for (int n = 0; n < 2; ++n)
#pragma unroll
                                for (int j = 0; j < 4; ++j) { const float a = pos * invf[4 * n + j]; const float c = __builtin_amdgcn_cosf(a), s = __builtin_amdgcn_sinf(a);
                                    const float p = x1[n][j], q = x2[n][j]; x1[n][j] = p * c - q * s; x2[n][j] = p * s + q * c; }
                        }
                    } else {
#pragma unroll
                        for (int n = 0; n < 2; ++n)
#pragma unroll
                            for (int j = 0; j < 4; ++j) { x1[n][j] = silu_f(x1[n][j]); x2[n][j] = silu_f(x2[n][j]); }
                    }
                    bf16_t* rowp = isq ? RQ + (size_t)(u.pm * 256 + rr) * 1024 + u.pn * 256 + wc * 32 + 8 * fq : RG + (size_t)(u.pm * 256 + rr) * 4096 + (u.pn - 4) * 256 + wc * 32 + 8 * fq;
                    u32x4 w; w.x = pk_bf16(x1[0][0], x1[0][1]); w.y = pk_bf16(x1[0][2], x1[0][3]); w.z = pk_bf16(x1[1][0], x1[1][1]); w.w = pk_bf16(x1[1][2], x1[1][3]);
                    stg<u32x4>(rowp, w);
                    w.x = pk_bf16(x2[0][0], x2[0][1]); w.y = pk_bf16(x2[0][2], x2[0][3]); w.z = pk_bf16(x2[1][0], x2[1][1]); w.w = pk_bf16(x2[1][2], x2[1][3]);
                    stg<u32x4>(rowp + 128, w);
                }
            return;
        }
        const int gpm = pm0 + u.pn, jj = gpm % 9; const bool isctx = (jj == 0); const bool isk = u.pm < 4;
        if (isk) {
#pragma unroll
            for (int m = 0; m < 4; ++m) {
                const int f = wr * 64 + m * 16 + fr;
#pragma unroll
                for (int bj = 0; bj < 2; ++bj) {
                    f32x4 x1[2], x2[2];
#pragma unroll
                    for (int n = 0; n < 2; ++n) { x1[n] = acc[0][bj][m][n] * 0.0625f; x2[n] = acc[1][bj][m][n] * 0.0625f; }
                    const int tl = bj * 128 + wc * 32 + 8 * fq;
                    if (!isctx) {
                        const int t = (jj - 1) * 256 + tl;
                        const float ivf = __builtin_amdgcn_exp2f(-(float)(m * 16 + fr) * (13.287712379549449f / 64.0f)) * 0.15915494309189535f;
#pragma unroll
                        for (int n = 0; n < 2; ++n)
#pragma unroll
                            for (int j = 0; j < 4; ++j) { const int tt = t + 4 * n + j; const float a = (float)(wr == 0 ? (tt >> 6) : (tt & 63)) * ivf; const float c = __builtin_amdgcn_cosf(a), s = __builtin_amdgcn_sinf(a);
                                const float p = x1[n][j], q = x2[n][j]; x1[n][j] = p * c - q * s; x2[n][j] = p * s + q * c; }
                    }
                    bf16_t* p1 = RKT + ((size_t)(u.pn * 8 + 4 * bj + wc) * 1024 + (u.pm * 256 + f)) * 32 + 8 * fq;
                    u32x4 w; w.x = pk_bf16(x1[0][0], x1[0][1]); w.y = pk_bf16(x1[0][2], x1[0][3]); w.z = pk_bf16(x1[1][0], x1[1][1]); w.w = pk_bf16(x1[1][2], x1[1][3]);
                    stg<u32x4>(p1, w);
                    w.x = pk_bf16(x2[0][0], x2[0][1]); w.y = pk_bf16(x2[0][2], x2[0][3]); w.z = pk_bf16(x2[1][0], x2[1][1]); w.w = pk_bf16(x2[1][2], x2[1][3]);
                    stg<u32x4>(p1 + 128 * 32, w);
                }
            }
        } else {
#pragma unroll
            for (int ai = 0; ai < 2; ++ai)
#pragma unroll
                for (int m = 0; m < 4; ++m) {
                    const int f = (u.pm - 4) * 256 + ai * 128 + wr * 64 + m * 16 + fr;
#pragma unroll
                    for (int bj = 0; bj < 2; ++bj) { const f32x4 v0 = acc[ai][bj][m][0], v1 = acc[ai][bj][m][1];
                        u32x4 w; w.x = pk_bf16(v0[0], v0[1]); w.y = pk_bf16(v0[2], v0[3]); w.z = pk_bf16(v1[0], v1[1]); w.w = pk_bf16(v1[2], v1[3]);
                        stg<u32x4>(RVT + ((size_t)(u.pn * 8 + 4 * bj + wc) * 2048 + f) * 32 + 8 * fq, w); }
                }
        }
    }
};

struct EpiResid {
    static constexpr bool PERM = true;
    const float* xin_ctx; const float* xin_lat; bf16_t* hb; const float* modbase; int first;
    DI void operator()(const f32x4 (&acc)[2][2][4][2], const Unit& u, int wr, int wc, int fr, int fq) const {
        const int b = u.pm / 9, jj = u.pm % 9; const bool isctx = (jj == 0);
        const float* gate = modbase + (size_t)(isctx ? 32 : b) * 6144 + 2048;
        const int col0 = u.pn * 256 + wc * 32 + 8 * fq;
        f32x4 gv[2][2];
#pragma unroll
        for (int bj = 0; bj < 2; ++bj)
#pragma unroll
            for (int n = 0; n < 2; ++n) gv[bj][n] = ldg<f32x4>(gate + col0 + bj * 128 + n * 4);
        const size_t rbase = isctx ? (size_t)b * 256 : (size_t)b * 2048 + (size_t)(jj - 1) * 256;
        const float* xi = isctx ? xin_ctx : xin_lat;
#pragma unroll
        for (int ai = 0; ai < 2; ++ai) {
            f32x4 hv[4][2][2];
#pragma unroll
            for (int m = 0; m < 4; ++m) { const int rr = ai * 128 + wr * 64 + m * 16 + fr;
#pragma unroll
                for (int bj = 0; bj < 2; ++bj) {
                    if (first) { const float* p = xi + (rbase + rr) * 1024 + col0 + bj * 128; hv[m][bj][0] = ldg<f32x4>(p); hv[m][bj][1] = ldg<f32x4>(p + 4); }
                    else { const u32x4 w = ldg<u32x4>(hb + (size_t)(u.pm * 256 + rr) * 1024 + col0 + bj * 128);
                        hv[m][bj][0] = (f32x4){bf_lo(w.x), bf_hi(w.x), bf_lo(w.y), bf_hi(w.y)}; hv[m][bj][1] = (f32x4){bf_lo(w.z), bf_hi(w.z), bf_lo(w.w), bf_hi(w.w)}; }
                } }
#pragma unroll
            for (int m = 0; m < 4; ++m) { const int rr = ai * 128 + wr * 64 + m * 16 + fr;
#pragma unroll
                for (int bj = 0; bj < 2; ++bj) { const f32x4 v0 = hv[m][bj][0] + gv[bj][0] * acc[ai][bj][m][0], v1 = hv[m][bj][1] + gv[bj][1] * acc[ai][bj][m][1];
                    u32x4 w; w.x = pk_bf16(v0[0], v0[1]); w.y = pk_bf16(v0[2], v0[3]); w.z = pk_bf16(v1[0], v1[1]); w.w = pk_bf16(v1[2], v1[3]);
                    stg<u32x4>(hb + (size_t)(u.pm * 256 + rr) * 1024 + col0 + bj * 128, w); } }
        }
    }
};

template <bool GATHER_>
struct ProbMoE {
    static constexpr bool GATHER = GATHER_;
    int K; const char* A; const char* W; const LAS int* tile_e; const LAS int* rowtok; pg8::GridOrder go; int G, c;
    DI bool next(int i, Unit& u) const { u.kind = 0; return go.map((long)i * G + c, u.pm, u.pn); }
    DI const char* a_ptr(const Unit& u) const { return GATHER ? A : A + (size_t)u.pm * 512 * K; }
    DI const char* b_ptr(const Unit& u) const { return W + ((size_t)tile_e[u.pm] * 4 + u.pn) * 512 * K; }
};
struct EpiSwiGLU {
    static constexpr bool PERM = true;
    bf16_t* act;
    DI void operator()(const f32x4 (&acc)[2][2][4][2], const Unit& u, int wr, int wc, int fr, int fq) const {
#pragma unroll
        for (int ai = 0; ai < 2; ++ai)
#pragma unroll
            for (int m = 0; m < 4; ++m) {
                bf16_t* rowp = act + (size_t)(u.pm * 256 + ai * 128 + wr * 64 + m * 16 + fr) * 512 + u.pn * 128 + wc * 16 + 4 * fq;
#pragma unroll
                for (int bj = 0; bj < 2; ++bj) { const f32x4 g = acc[ai][bj][m][0], up = acc[ai][bj][m][1];
                    u32x2 w; w.x = pk_bf16(silu_f(g[0]) * up[0], silu_f(g[1]) * up[1]); w.y = pk_bf16(silu_f(g[2]) * up[2], silu_f(g[3]) * up[3]);
                    stg<u32x2>(rowp + bj * 64, w); }
            }
    }
};
struct EpiDown {
    static constexpr bool PERM = true;
    bf16_t* y2; const int* rowmap; const float* wsel;
    DI void operator()(const f32x4 (&acc)[2][2][4][2], const Unit& u, int wr, int wc, int fr, int fq) const {
        int dest[8]; float wv[8];
#pragma unroll
        for (int it = 0; it < 8; ++it) dest[it] = ldg<int>(rowmap + u.pm * 256 + (it >> 2) * 128 + wr * 64 + (it & 3) * 16 + fr);
#pragma unroll
        for (int it = 0; it < 8; ++it) wv[it] = ldg<float>(wsel + (dest[it] >= 0 ? dest[it] : 0));
#pragma unroll
        for (int ai = 0; ai < 2; ++ai)
#pragma unroll
            for (int m = 0; m < 4; ++m) {
                const int d = dest[ai * 4 + m];
                if (d >= 0) {
                    const float w = wv[ai * 4 + m];
                    bf16_t* rowp = y2 + (size_t)d * 1024 + u.pn * 256 + wc * 32 + 8 * fq;
#pragma unroll
                    for (int bj = 0; bj < 2; ++bj) { const f32x4 v0 = acc[ai][bj][m][0] * w, v1 = acc[ai][bj][m][1] * w;
                        u32x4 o; o.x = pk_bf16(v0[0], v0[1]); o.y = pk_bf16(v0[2], v0[3]); o.z = pk_bf16(v1[0], v1[1]); o.w = pk_bf16(v1[2], v1[3]);
                        stg<u32x4>(rowp + bj * 128, o); }
                }
            }
    }
};

template <int MODE>
DI void transpose_tile(const Frame& F, const float* src, const float* src2, int ld, bf16_t* dst, int K, int k0, int n0) {
    LAS float* tl = (LAS float*)F.lds;
    __syncthreads();
#pragma unroll
    for (int i = 0; i < 8; ++i) {
        const int idx = F.tid + 512 * i, kk = idx >> 6, nn = idx & 63, np = n0 + nn;
        float v;
        if (MODE == 0) v = ldg<float>(src + (size_t)(k0 + kk) * ld + np);
        else if (MODE == 1) { const int t = np >> 8, p = np & 255, bj = p >> 7, wc = (p >> 5) & 3, r = p & 31; v = ldg<float>(src + (size_t)(k0 + kk) * ld + t * 256 + wc * 64 + bj * 32 + r); }
        else { const int hid = 4 * (np >> 3) + (np & 3); v = ldg<float>(((np & 4) ? src2 : src) + (size_t)(k0 + kk) * ld + hid); }
        tl[nn * 65 + kk] = v;
    }
    __syncthreads();
#pragma unroll
    for (int i = 0; i < 4; ++i) {
        const int idx = F.tid + 512 * i, nn = idx >> 5, kp = (idx & 31) * 2;
        stg<unsigned>(dst + (size_t)(n0 + nn) * K + k0 + kp, pk_bf16(tl[nn * 65 + kp], tl[nn * 65 + kp + 1]));
    }
}
template <int MODE>
DI int transpose_mat(const Frame& F, const float* src, const float* src2, int ld, bf16_t* dst, int K, int Np, int u0, int u_first, int u_stride) {
    const int tk = K / 64, tn = Np / 64, ntl = tk * tn;
    int u = u_first; if (u < u0) { const int d = (u0 - u + u_stride - 1) / u_stride; u += d * u_stride; }
    for (; u < u0 + ntl; u += u_stride) { const int l = u - u0; transpose_tile<MODE>(F, src, src2, ld, dst, K, (l % tk) * 64, (l / tk) * 64); }
    return ntl;
}
DI void convert_moe_weights(const Frame& F, int layer) {
    const float* wg = F.a->in[21] + (size_t)layer * NEXP * DM * MOEH; const float* wu = F.a->in[22] + (size_t)layer * NEXP * DM * MOEH; const float* wd = F.a->in[23] + (size_t)layer * NEXP * MOEH * DM;
    bf16_t* WGU = (bf16_t*)(F.ws + WS_WGU); bf16_t* WD = (bf16_t*)(F.ws + WS_WD);
    int u0 = 0;
    for (int e = 0; e < NEXP; ++e) {
        u0 += transpose_mat<2>(F, wg + (size_t)e * DM * MOEH, wu + (size_t)e * DM * MOEH, MOEH, WGU + (size_t)e * 1024 * 1024, 1024, 1024, u0, F.bid, F.G);
        u0 += transpose_mat<0>(F, wd + (size_t)e * MOEH * DM, nullptr, DM, WD + (size_t)e * 1024 * 512, 512, 1024, u0, F.bid, F.G);
    }
}

DI void p0_prologue(const Frame& F) {
    {
        LAS float* red = (LAS float*)F.lds;
        for (int u = F.bid; u < 4 * 96; u += F.G) {
            const int layer = u / 96, col0 = (u % 96) * 64;
            const float* W = F.a->in[6] + (size_t)layer * 1024 * 6144 + col0 + F.lane;
            const float* cp = F.lane < 32 ? F.a->in[1] + F.lane * 1024 : F.a->in[3];
            float acc[33];
#pragma unroll
            for (int r = 0; r < 33; ++r) acc[r] = 0.f;
            const int k0 = F.wave * 128;
            for (int k = k0; k < k0 + 128; ++k) {
                const float w = ldg<float>(W + (size_t)k * 6144);
                const float sv = silu_f(ldg<float>(cp + k));
#pragma unroll
                for (int r = 0; r < 33; ++r) acc[r] += w * __builtin_bit_cast(float, __builtin_amdgcn_readlane(__builtin_bit_cast(int, sv), r));
            }
#pragma unroll
            for (int r = 0; r < 33; ++r) red[(F.wave * 33 + r) * 64 + F.lane] = acc[r];
            __syncthreads();
            float* outp = (float*)(F.ws + WS_ADA) + (size_t)layer * 33 * 6144;
            for (int idx = F.tid; idx < 33 * 64; idx += 512) { const int r = idx >> 6, cl = idx & 63; float v = 0.f;
#pragma unroll
                for (int w8 = 0; w8 < 8; ++w8) v += red[(w8 * 33 + r) * 64 + cl];
                stg<float>(outp + (size_t)r * 6144 + col0 + cl, v + ldg<float>(F.a->in[7] + layer * 6144 + col0 + cl)); }
            __syncthreads();
        }
    }
    {
        float* cda = (float*)(F.ws + WS_ROPE + RP_CDA); float* sda = (float*)(F.ws + WS_ROPE + RP_SDA); float* crt = (float*)(F.ws + WS_ROPE + RP_CRT); float* srt = (float*)(F.ws + WS_ROPE + RP_SRT);
        const int gt = F.bid * 512 + F.tid, gs = F.G * 512;
        for (int idx = gt; idx < 2048 * 32; idx += gs) { const int t = idx >> 5, f = idx & 31; const float pos = f < 16 ? (float)(t >> 6) : (float)(t & 63);
            const float inv = exp2f(-(float)(f & 15) * (13.287712379549449f / 16.0f)); const float a = pos * inv; stg<float>(cda + idx, __cosf(a)); stg<float>(sda + idx, __sinf(a)); }
        for (int idx = gt; idx < 2048 * 128; idx += gs) { const int t = idx >> 7, f = idx & 127; const float pos = f < 64 ? (float)(t >> 6) : (float)(t & 63);
            const float inv = exp2f(-(float)(f & 63) * (13.287712379549449f / 64.0f)); const float a = pos * inv; const float cv = __cosf(a), sv = __sinf(a); stg<float>(crt + idx, cv); stg<float>(srt + idx, sv);
            stg<float>((float*)(F.ws + WS_MISC + MS_CRTT) + f * 2048 + t, cv); stg<float>((float*)(F.ws + WS_MISC + MS_SRTT) + f * 2048 + t, sv); }
    }
    {
        int u0 = 0;
        for (int j = 0; j < 2; ++j) {
            const float* wqkv = F.a->in[8] + (size_t)j * 1024 * 3072;
            u0 += transpose_mat<1>(F, wqkv, nullptr, 3072, (bf16_t*)(F.ws + WS_WQK) + (size_t)j * 2048 * 1024, 1024, 2048, u0, F.bid, F.G);
            u0 += transpose_mat<0>(F, wqkv + 2048, nullptr, 3072, (bf16_t*)(F.ws + WS_WV) + (size_t)j * 1024 * 1024, 1024, 1024, u0, F.bid, F.G);
            u0 += transpose_mat<0>(F, F.a->in[13] + (size_t)j * 1024 * 1024, nullptr, 1024, (bf16_t*)(F.ws + WS_WODA) + (size_t)j * 1024 * 1024, 1024, 1024, u0, F.bid, F.G);
            u0 += transpose_mat<0>(F, F.a->in[14] + (size_t)j * 1024 * 8192, nullptr, 8192, (bf16_t*)(F.ws + WS_WIN) + (size_t)j * 8192 * 1024, 1024, 8192, u0, F.bid, F.G);
            u0 += transpose_mat<0>(F, F.a->in[16] + (size_t)j * 2048 * 1024, nullptr, 1024, (bf16_t*)(F.ws + WS_WORT) + (size_t)j * 1024 * 2048, 2048, 1024, u0, F.bid, F.G);
        }
        convert_moe_weights(F, 0);
    }
}

template <bool SECOND>
DI void norm_phase(const Frame& F, int layer) {
    bf16_t* abuf = (bf16_t*)(F.ws + WS_ABUF);
    bf16_t* hb = (bf16_t*)(F.ws + WS_HB);
    const bf16_t* y2 = (const bf16_t*)(F.ws + WS_PROJ + PJ_Y2);
    const float* ng = F.a->in[SECOND ? 5 : 4] + layer * 1024;
    LAS float* Wl = (LAS float*)F.lds;
    LAS int* lhist = (LAS int*)(F.lds + LDS_MISC + 1024);
    int* eid = (int*)(F.ws + WS_MISC + MS_EID); float* wsel = (float*)(F.ws + WS_MISC + MS_WSEL);
    if (SECOND) {
        const float* wgp = F.a->in[17] + (size_t)layer * 1024 * 4; const float* wep = F.a->in[19] + (size_t)layer * 1024 * 32;
        for (int idx = F.tid; idx < 1024 * 4; idx += 512) { const int k = idx >> 2, o = idx & 3; Wl[o * 1024 + k] = ldg<float>(wgp + idx); }
        for (int idx = F.tid; idx < 1024 * 32; idx += 512) { const int k = idx >> 5, o = idx & 31; Wl[(4 + o) * 1024 + k] = ldg<float>(wep + idx); }
        if (F.tid < 32) lhist[F.tid] = 0;
        __syncthreads();
    }
    const int lane = F.lane;
    for (int r = F.bid * 8 + F.wave; r < T; r += F.G * 8) {
        const int b = r / NTOK, n = r % NTOK; const bool isctx = n < CTXL;
        const size_t hoff = isctx ? ((size_t)b * 256 + n) * 1024 : ((size_t)b * 2048 + (n - 256)) * 1024;
        bf16_t* hrow = hb + (size_t)r * 1024;
        const float* mod = isctx ? mod_ctx(F, layer) : mod_lat(F, layer, b);
        f32x4 x[4];
        if (layer == 0 && !SECOND) { const float* hin = isctx ? F.a->in[2] + hoff : F.a->in[0] + hoff;
#pragma unroll
            for (int i = 0; i < 4; ++i) x[i] = ldg<f32x4>(hin + i * 256 + lane * 4);
        } else {
#pragma unroll
            for (int i = 0; i < 4; ++i) { const u32x2 w = ldg<u32x2>(hrow + i * 256 + lane * 4); x[i] = (f32x4){bf_lo(w.x), bf_hi(w.x), bf_lo(w.y), bf_hi(w.y)}; }
        }
        if (!SECOND && layer > 0) {
            const float* modp = isctx ? mod_ctx(F, layer - 1) : mod_lat(F, layer - 1, b);
#pragma unroll
            for (int i = 0; i < 4; ++i) {
                const u32x2 a = ldg<u32x2>(y2 + (size_t)(2 * r) * 1024 + i * 256 + lane * 4), c = ldg<u32x2>(y2 + (size_t)(2 * r + 1) * 1024 + i * 256 + lane * 4);
                const f32x4 g2 = ldg<f32x4>(modp + 5120 + i * 256 + lane * 4);
                x[i][0] += g2[0] * (bf_lo(a.x) + bf_lo(c.x)); x[i][1] += g2[1] * (bf_hi(a.x) + bf_hi(c.x)); x[i][2] += g2[2] * (bf_lo(a.y) + bf_lo(c.y)); x[i][3] += g2[3] * (bf_hi(a.y) + bf_hi(c.y));
                { u32x2 w; w.x = pk_bf16(x[i][0], x[i][1]); w.y = pk_bf16(x[i][2], x[i][3]); stg<u32x2>(hrow + i * 256 + lane * 4, w); }
            }
        }
        float ss = 0.f;
#pragma unroll
        for (int i = 0; i < 4; ++i) ss += (x[i][0] * x[i][0] + x[i][1] * x[i][1]) + (x[i][2] * x[i][2] + x[i][3] * x[i][3]);
        ss = wave_sum(ss, lane);
        const float rstd = 1.0f / sqrtf(ss * (1.0f / 1024.0f) + RMS_EPS);
        f32x4 v[4];
#pragma unroll
        for (int i = 0; i < 4; ++i) {
            const int c0 = i * 256 + lane * 4;
            const f32x4 g = ldg<f32x4>(ng + c0), sh = ldg<f32x4>(mod + (SECOND ? 3072 : 0) + c0), sc = ldg<f32x4>(mod + (SECOND ? 4096 : 1024) + c0);
            v[i] = (x[i] * rstd * g) * (sc + 1.0f) + sh;
            u32x2 w; w.x = pk_bf16(v[i][0], v[i][1]); w.y = pk_bf16(v[i][2], v[i][3]);
            stg<u32x2>(abuf + (size_t)r * 1024 + c0, w);
        }
        if (SECOND) {
            const float* bg = F.a->in[18] + layer * 4; const float* be = F.a->in[20] + layer * 32;
            float gl[4]; float gmax = -3.0e38f; int gi = 0;
#pragma unroll
            for (int o = 0; o < 4; ++o) {
                float p = 0.f;
#pragma unroll
                for (int i = 0; i < 4; ++i) { const f32x4 w = *(const LAS f32x4*)(Wl + o * 1024 + i * 256 + lane * 4); p += (v[i][0] * w[0] + v[i][1] * w[1]) + (v[i][2] * w[2] + v[i][3] * w[3]); }
                gl[o] = wave_sum(p, lane) + ldg<float>(bg + o);
                if (gl[o] > gmax) { gmax = gl[o]; gi = o; }
            }
            gi = __builtin_amdgcn_readfirstlane(gi);
            float gsum = 0.f;
#pragma unroll
            for (int o = 0; o < 4; ++o) { gsum += __expf(gl[o] - gmax); asm volatile("" : "+v"(gsum)); }
            const float psel = __builtin_amdgcn_rcpf(gsum);
            float el[8];
#pragma unroll
            for (int o = 0; o < 8; ++o) {
                float p = 0.f;
                const LAS float* wr = Wl + (4 + gi * 8 + o) * 1024;
#pragma unroll
                for (int i = 0; i < 4; ++i) { const f32x4 w = *(const LAS f32x4*)(wr + i * 256 + lane * 4); p += (v[i][0] * w[0] + v[i][1] * w[1]) + (v[i][2] * w[2] + v[i][3] * w[3]); }
                el[o] = wave_sum(p, lane) + ldg<float>(be + gi * 8 + o);
            }
            float m1 = -3.0e38f, m2 = -3.0e38f; int i1 = 0, i2 = 0;
#pragma unroll
            for (int o = 0; o < 8; ++o) { if (el[o] > m1) { m1 = el[o]; i1 = o; } }
#pragma unroll
            for (int o = 0; o < 8; ++o) { if (o != i1 && el[o] > m2) { m2 = el[o]; i2 = o; } }
            const float e2 = __expf(m2 - m1), inv = __builtin_amdgcn_rcpf(1.0f + e2);
            if (lane == 0) {
                stg<int>(eid + 2 * r, gi * 8 + i1); stg<int>(eid + 2 * r + 1, gi * 8 + i2); stg<float>(wsel + 2 * r, inv * psel); stg<float>(wsel + 2 * r + 1, e2 * inv * psel);
                __hip_atomic_fetch_add(&lhist[gi * 8 + i1], 1, __ATOMIC_RELAXED, __HIP_MEMORY_SCOPE_WORKGROUP); __hip_atomic_fetch_add(&lhist[gi * 8 + i2], 1, __ATOMIC_RELAXED, __HIP_MEMORY_SCOPE_WORKGROUP);
            }
        }
    }
    if (SECOND) {
        __syncthreads();
        if (F.tid < 32) { const int c = lhist[F.tid]; if (c) __hip_atomic_fetch_add((unsigned*)(F.ws + WS_CTL) + CW_CNT + layer * 64 + F.tid, (unsigned)c, __ATOMIC_RELAXED, __HIP_MEMORY_SCOPE_AGENT); }
    }
}

DI int build_segments(const Frame& F, int layer, LAS int* segs, LAS int* tile_e) {
    __syncthreads();
    if (F.tid == 0) {
        const unsigned* cnt = (const unsigned*)(F.ws + WS_CTL) + CW_CNT + layer * 64;
        int s = 0;
        for (int e = 0; e < 32; ++e) { segs[e] = s; const int c = (int)__hip_atomic_load(cnt + e, __ATOMIC_RELAXED, __HIP_MEMORY_SCOPE_AGENT); segs[40 + e] = c; s += (c + 255) & ~255; }
        segs[32] = s;
    }
    __syncthreads();
    const int ntl = segs[32] >> 8;
    if (tile_e) {
        for (int t = F.tid; t < ntl; t += 512) { int e = 0;
            for (int q = 1; q < 32; ++q) e = (segs[q] <= t * 256) ? q : e;
            tile_e[t] = e; }
        __syncthreads();
    }
    return ntl;
}

DI void sort_phase(const Frame& F, int layer) {
    LAS int* segs = (LAS int*)(F.lds + LDS_MISC + 2048);
    LAS int* lhist = (LAS int*)(F.lds + LDS_MISC + 1024);
    LAS int* lbase = (LAS int*)(F.lds + LDS_MISC + 1024 + 128);
    LAS int* lpos = (LAS int*)F.lds;
    build_segments(F, layer, segs, nullptr);
    const int* eid = (const int*)(F.ws + WS_MISC + MS_EID); int* rowmap = (int*)(F.ws + WS_MISC + MS_ROWMAP);
    const bf16_t* abuf = (const bf16_t*)(F.ws + WS_ABUF); bf16_t* sa = (bf16_t*)(F.ws + WS_PROJ + PJ_SA);
    const int RPB = (T + F.G - 1) / F.G;
    const int r0 = F.bid * RPB, r1 = (r0 + RPB < T) ? r0 + RPB : T;
    const int na = r1 > r0 ? 2 * (r1 - r0) : 0;
    if (F.tid < 32) lhist[F.tid] = 0;
    __syncthreads();
    int ee[2], lp[2];
#pragma unroll
    for (int it = 0; it < 2; ++it) { const int a = F.tid + 512 * it; ee[it] = -1; lp[it] = 0;
        if (a < na) { ee[it] = ldg<int>(eid + 2 * r0 + a); lp[it] = __hip_atomic_fetch_add(&lhist[ee[it]], 1, __ATOMIC_RELAXED, __HIP_MEMORY_SCOPE_WORKGROUP); } }
    __syncthreads();
    if (F.tid < 32) { const int c = lhist[F.tid];
        lbase[F.tid] = segs[F.tid] + (c ? (int)__hip_atomic_fetch_add((unsigned*)(F.ws + WS_CTL) + CW_CUR + layer * 64 + F.tid, (unsigned)c, __ATOMIC_RELAXED, __HIP_MEMORY_SCOPE_AGENT) : 0); }
    __syncthreads();
#pragma unroll
    for (int it = 0; it < 2; ++it) { const int a = F.tid + 512 * it;
        if (a < na) { const int pos = lbase[ee[it]] + lp[it]; lpos[a] = pos; stg<int>(rowmap + pos, 2 * r0 + a); } }
    __syncthreads();
    if (F.bid < 32) { const int e = F.bid; for (int p = segs[e] + segs[40 + e] + F.tid; p < segs[e + 1]; p += 512) stg<int>(rowmap + p, -1); }
    if (F.G < 32 && F.bid == 0) { for (int e = F.G; e < 32; ++e) for (int p = segs[e] + segs[40 + e] + F.tid; p < segs[e + 1]; p += 512) stg<int>(rowmap + p, -1); }
}

constexpr int AT_KROW = 272, AT_VROW = 136, AT_KB = 64 * AT_KROW, AT_VB = 128 * AT_VROW, AT_BUF = AT_KB + AT_VB;
DI void attn_phase(const Frame& F, int layer) {
    const int j = layer >> 1;
    const bf16_t* Qb = (const bf16_t*)(F.ws + WS_PROJ + PJ_Q); const bf16_t* Kb = (const bf16_t*)(F.ws + WS_PROJ + PJ_K); const bf16_t* VT = (const bf16_t*)(F.ws + WS_PROJ + PJ_VT);
    bf16_t* Ob = (bf16_t*)(F.ws + WS_OBUF);
    const int lane = F.lane, lr = lane & 31, lh = lane >> 5;
    const float* lam = F.a->in[11] + j * 256;
    float p01 = ldg<float>(lam + lane) * ldg<float>(lam + 64 + lane), p23 = ldg<float>(lam + 128 + lane) * ldg<float>(lam + 192 + lane);
    p01 = wave_sum(p01, lane); p23 = wave_sum(p23, lane);
    const float lam_init = 0.8f - 0.6f * __expf(-0.3f * (float)layer);
    const float lam_full = __expf(p01) - __expf(p23) + lam_init;
    float mq = fabsf(ldg<float>(F.a->in[9] + j * 64 + lane)), mk = fabsf(ldg<float>(F.a->in[10] + j * 64 + lane));
#pragma unroll
    for (int o = 32; o >= 1; o >>= 1) { mq = fmaxf(mq, shx(mq, o, lane)); mk = fmaxf(mk, shx(mk, o, lane)); }
    const float OFF = 8.0f * LOG2E * mq * mk;
    const float* gsub = F.a->in[12] + j * 128;
    const float osc = 1.0f - lam_init;

    for (int u = F.bid; u < 2304; u += F.G) {
        int b, h, qb, nkt;
        if (u < 2048) {
            int bh;
            if (F.G == 256) { const int i = u >> 8, c = u & 255; bh = i * 32 + (c & 7) * 4 + (c >> 6); qb = 1 + ((c >> 3) & 7); } else { bh = u >> 3; qb = 1 + (u & 7); }
            b = bh >> 3; h = bh & 7; nkt = 36;
        } else { const int uu = u - 2048; b = uu >> 3; h = uu & 7; qb = 0; nkt = 4; }
        const size_t rowbase = (size_t)b * NTOK;
        const size_t qrow = rowbase + qb * 256 + F.wave * 32 + lr;
        __syncthreads();
        const int qlo = 2 * AT_BUF + F.wave * 8192 + lane * 16;
#pragma unroll
        for (int mp = 0; mp < 2; ++mp)
#pragma unroll
            for (int ks = 0; ks < 4; ++ks) *(LAS bf16x8*)(F.lds + qlo + (mp * 4 + ks) * 1024) = ldg<bf16x8>(Qb + qrow * 1024 + h * 128 + mp * 64 + ks * 16 + lh * 8);
        f32x16 O1[4], O2[4];
#pragma unroll
        for (int e = 0; e < 4; ++e)
#pragma unroll
            for (int i = 0; i < 16; ++i) { O1[e][i] = 0.f; O2[e][i] = 0.f; }
        float l1 = 0.f, l2 = 0.f;
        const unsigned kgo = (unsigned)((F.tid >> 4) * 1024 + (F.tid & 15) * 8), vgo = (unsigned)((F.tid >> 3) * T + (F.tid & 7) * 8);
        const int klo = (F.tid >> 4) * AT_KROW + (F.tid & 15) * 16, vlo = AT_KB + (F.tid >> 3) * AT_VROW + (F.tid & 7) * 16;
        const bf16_t* kbase = Kb + rowbase * 1024 + h * 128; const bf16_t* vbase = VT + (size_t)(h * 128) * T + rowbase;
        u32x4 sk[2], sv[2];
#pragma unroll
        for (int i = 0; i < 2; ++i) { sk[i] = ldg<u32x4>(kbase + (size_t)i * 32768 + kgo); sv[i] = ldg<u32x4>(vbase + (size_t)i * 64 * T + vgo); }
#pragma unroll
        for (int i = 0; i < 2; ++i) { *(LAS u32x4*)(F.lds + klo + i * 32 * AT_KROW) = sk[i]; *(LAS u32x2*)(F.lds + vlo + i * 64 * AT_VROW) = (u32x2){sv[i].x, sv[i].y}; *(LAS u32x2*)(F.lds + vlo + i * 64 * AT_VROW + 8) = (u32x2){sv[i].z, sv[i].w}; }
        __syncthreads();
        for (int t = 0; t < nkt; ++t) {
            const int cb = (t & 1) * AT_BUF, nb = ((t + 1) & 1) * AT_BUF;
            if (t + 1 < nkt) {
#pragma unroll
                for (int i = 0; i < 2; ++i) { sk[i] = ldg<u32x4>(kbase + (size_t)(t + 1) * 65536 + (size_t)i * 32768 + kgo); sv[i] = ldg<u32x4>(vbase + (size_t)i * 64 * T + (size_t)(t + 1) * 64 + vgo); }
            }
#pragma unroll 1
            for (int kb = 0; kb < 2; ++kb) {
                bf16x8 P[2][2];
#pragma unroll
                for (int mp = 0; mp < 2; ++mp) {
                    f32x16 S;
#pragma unroll
                    for (int i = 0; i < 16; ++i) S[i] = 0.f;
#pragma unroll
                    for (int ks = 0; ks < 4; ++ks) {
                        const bf16x8 kf = *(const LAS bf16x8*)(F.lds + cb + (kb * 32 + lr) * AT_KROW + (mp * 64 + ks * 16 + lh * 8) * 2);
                        const bf16x8 qf = *(const LAS bf16x8*)(F.lds + qlo + (mp * 4 + ks) * 1024);
                        S = __builtin_amdgcn_mfma_f32_32x32x16_bf16(kf, qf, S, 0, 0, 0);
                    }
                    float ps = 0.f;
#pragma unroll
                    for (int i = 0; i < 16; ++i) { S[i] = __builtin_amdgcn_exp2f(S[i] - OFF); ps += S[i]; }
                    if (mp == 0) l1 += ps; else l2 += ps;
#pragma unroll
                    for (int s = 0; s < 2; ++s) { u32x4 w; w.x = pk_bf16(S[8 * s], S[8 * s + 1]); w.y = pk_bf16(S[8 * s + 2], S[8 * s + 3]); w.z = pk_bf16(S[8 * s + 4], S[8 * s + 5]); w.w = pk_bf16(S[8 * s + 6], S[8 * s + 7]);
                        P[mp][s] = __builtin_bit_cast(bf16x8, w); }
                }
#pragma unroll
                for (int eb = 0; eb < 4; ++eb)
#pragma unroll
                    for (int s = 0; s < 2; ++s) {
                        const int vo = cb + AT_KB + (eb * 32 + lr) * AT_VROW + (kb * 32 + 16 * s + 4 * lh) * 2;
                        const s16x4 lo = *(const LAS s16x4*)(F.lds + vo), hi = *(const LAS s16x4*)(F.lds + vo + 16);
                        const bf16x8 vf = __builtin_shufflevector(lo, hi, 0, 1, 2, 3, 4, 5, 6, 7);
                        O1[eb] = __builtin_amdgcn_mfma_f32_32x32x16_bf16(vf, P[0][s], O1[eb], 0, 0, 0);
                        O2[eb] = __builtin_amdgcn_mfma_f32_32x32x16_bf16(vf, P[1][s], O2[eb], 0, 0, 0);
                        __builtin_amdgcn_sched_barrier(0);
                    }
            }
            if (t + 1 < nkt) {
#pragma unroll
                for (int i = 0; i < 2; ++i) { *(LAS u32x4*)(F.lds + nb + klo + i * 32 * AT_KROW) = sk[i]; *(LAS u32x2*)(F.lds + nb + vlo + i * 64 * AT_VROW) = (u32x2){sv[i].x, sv[i].y}; *(LAS u32x2*)(F.lds + nb + vlo + i * 64 * AT_VROW + 8) = (u32x2){sv[i].z, sv[i].w}; }
            }
            __syncthreads();
        }
        l1 += shx(l1, 32, lane); l2 += shx(l2, 32, lane);
        const float i1 = 1.0f / l1, i2 = lam_full / l2;
        float ss = 0.f;
#pragma unroll
        for (int e = 0; e < 4; ++e)
#pragma unroll
            for (int i = 0; i < 16; ++i) { const float o = O1[e][i] * i1 - O2[e][i] * i2; O1[e][i] = o; ss += o * o; }
        ss += shx(ss, 32, lane);
        const float rstd = __builtin_amdgcn_rsqf(ss * (1.0f / 128.0f) + RMS_EPS) * osc;
        bf16_t* orow = Ob + qrow * 1024 + h * 128;
#pragma unroll
        for (int e = 0; e < 4; ++e)
#pragma unroll
            for (int g4 = 0; g4 < 4; ++g4) {
                const int e0 = e * 32 + 8 * g4 + 4 * lh;
                const f32x4 gs = ldg<f32x4>(gsub + e0);
                u32x2 w; w.x = pk_bf16(O1[e][4 * g4] * rstd * gs[0], O1[e][4 * g4 + 1] * rstd * gs[1]); w.y = pk_bf16(O1[e][4 * g4 + 2] * rstd * gs[2], O1[e][4 * g4 + 3] * rstd * gs[3]);
                stg<u32x2>(orow + e0, w);
            }
    }
    __syncthreads();
}

constexpr int SC_Q = 0, SC_QROW = 528, SC_K = 32 * SC_QROW, SC_V = SC_K + 16384, SC_BUF = SC_V + 16384, SC_S = 2 * SC_BUF, SC_SROW = 80, SC_RED = SC_S + 2 * 32 * SC_SROW, SC_Y = SC_RED + 1024, SC_YROW = 528;
DI void scan_phase(const Frame& F, int layer, int hf) {
    const int j = layer >> 1;
    const bf16_t* RQ = (const bf16_t*)(F.ws + WS_PROJ + PJ_RQ); bf16_t* RG = (bf16_t*)(F.ws + WS_PROJ + PJ_RG);
    const bf16_t* RKT = (const bf16_t*)(F.ws + WS_PROJ + PJ_RKT); const bf16_t* RVT = (const bf16_t*)(F.ws + WS_PROJ + PJ_RVT);
    float* ssqb = (float*)(F.ws + WS_MISC + MS_SSQ);
    const int tid = F.tid;
    for (int u = F.bid; u < 256; u += F.G) {
        int bl, h, dir, eh;
        if (F.G == 256) { const int base = (u >> 5) * 8 + (u & 7), var = (u >> 3) & 3; bl = base >> 2; h = base & 3; dir = var >> 1; eh = var & 1; }
        else { bl = u >> 4; h = (u >> 2) & 3; dir = (u >> 1) & 1; eh = u & 1; }
        const float l2g = __log2f(1.0f - __expf(ldg<float>(F.a->in[15] + j * 8 + dir * 4 + h)));
        const float g32 = __builtin_amdgcn_exp2f(32.0f * l2g);
        const int sgn = dir ? -1 : 1, kd_a = dir ? 0 : 31, qd_a = dir ? 32 : 1;
        const size_t rb = (size_t)bl * NTOK;
        const bf16_t* qbase = RQ + rb * 1024 + h * 256;
        const bf16_t* ktbase = RKT + ((size_t)(rb >> 5) * 1024 + h * 256) * 32;
        const bf16_t* vtbase = RVT + ((size_t)(rb >> 5) * 2048 + h * 512 + eh * 256) * 32;
        bf16_t* gbase = RG + (rb + (tid >> 4)) * 4096 + dir * 2048 + h * 512 + eh * 256 + (tid & 15) * 16;
        const int qt = tid >> 5, qc = tid & 31;
        const unsigned qgo = (unsigned)(qt * 1024 + qc * 8);
        const int ql0 = SC_Q + qt * SC_QROW + qc * 16, ql1 = ql0 + 16 * SC_QROW;
        const int kd = tid >> 2, kc = tid & 3;
        const unsigned kgo = (unsigned)(kd * 32 + kc * 8);
        const int kl = kd * 64 + (((kc ^ (kd >> 2)) & 3) << 4);
        f32x16 S[8];
#pragma unroll
        for (int d = 0; d < 8; ++d)
#pragma unroll
            for (int i = 0; i < 16; ++i) S[d][i] = 0.f;
        u32x4 sq[2], sk[2], sv[2];
        __syncthreads();
        {
            const int tok0 = dir ? 224 : 0;
#pragma unroll
            for (int i = 0; i < 2; ++i) { sq[i] = ldg<u32x4>(qbase + (size_t)(tok0 + 16 * i) * 1024 + qgo); sk[i] = ldg<u32x4>(ktbase + (size_t)tok0 * 1024 + i * 4096 + kgo); sv[i] = ldg<u32x4>(vtbase + (size_t)tok0 * 2048 + i * 4096 + kgo); }
            *(LAS u32x4*)(F.lds + ql0) = sq[0]; *(LAS u32x4*)(F.lds + ql1) = sq[1];
#pragma unroll
            for (int i = 0; i < 2; ++i) { *(LAS u32x4*)(F.lds + SC_K + kl + i * 8192) = sk[i]; *(LAS u32x4*)(F.lds + SC_V + kl + i * 8192) = sv[i]; }
        }
        __syncthreads();
        for (int ci = 0; ci < 72; ++ci) {
            const int tok0 = dir ? 32 * ((ci < 8 ? 7 : 79) - ci) : 32 * ci;
            const int t2 = launder(tid); const int lane = t2 & 63, lr = lane & 31, lh = lane >> 5, w = __builtin_amdgcn_readfirstlane(t2 >> 6), op = t2 >> 4, oc = t2 & 15;
            float l2c = l2g; asm volatile("" : "+v"(l2c));
            const int cb = (ci & 1) * SC_BUF, nb = SC_BUF - cb, sb = SC_S + (ci & 1) * 32 * SC_SROW;
            if (ci + 1 < 72) {
                const int cn = ci + 1; const int tn = dir ? 32 * ((cn < 8 ? 7 : 79) - cn) : 32 * cn;
#pragma unroll
                for (int i = 0; i < 2; ++i) { sq[i] = ldg<u32x4>(qbase + (size_t)(tn + 16 * i) * 1024 + qgo); sk[i] = ldg<u32x4>(ktbase + (size_t)tn * 1024 + i * 4096 + kgo); sv[i] = ldg<u32x4>(vtbase + (size_t)tn * 2048 + i * 4096 + kgo); }
            }
            const u32x4 gt0 = ldg<u32x4>(gbase + (size_t)tok0 * 4096), gt1 = ldg<u32x4>(gbase + (size_t)tok0 * 4096 + 8);
            if (w < 4) {
                const int p0 = 16 * (w >> 1), m0 = 16 * (w & 1);
                const int l15 = lane & 15, g4 = lane >> 4, tq = l15 >> 2, tp = l15 & 3;
                f32x4 sc = {0.f, 0.f, 0.f, 0.f};
                const bool dead = sgn * (p0 - m0) < 0;
                if (!dead) {
#pragma unroll
                    for (int ks = 0; ks < 8; ++ks) {
                        const int prow = p0 + l15, qchunk = 4 * ks + g4;
                        const bf16x8 af = *(const LAS bf16x8*)(F.lds + cb + SC_Q + prow * SC_QROW + qchunk * 16);
                        const int d0 = 32 * ks + 8 * g4 + tq, cc = (m0 >> 3) + (tp >> 1);
                        const s16x4 b0 = __builtin_amdgcn_ds_read_tr16_b64_v4i16((LAS s16x4*)(F.lds + cb + SC_K + d0 * 64 + (((cc ^ (d0 >> 2)) & 3) << 4) + 8 * (tp & 1)));
                        const s16x4 b1 = __builtin_amdgcn_ds_read_tr16_b64_v4i16((LAS s16x4*)(F.lds + cb + SC_K + (d0 + 4) * 64 + (((cc ^ ((d0 + 4) >> 2)) & 3) << 4) + 8 * (tp & 1)));
                        const bf16x8 bfr = __builtin_shufflevector(b0, b1, 0, 1, 2, 3, 4, 5, 6, 7);
                        sc = __builtin_amdgcn_mfma_f32_16x16x32_bf16(af, bfr, sc, 0, 0, 0);
                    }
                }
                const int mm = m0 + l15;
#pragma unroll
                for (int r = 0; r < 4; ++r) { const int pp = p0 + 4 * g4 + r; const int df = sgn * (pp - mm);
                    const float v = df >= 0 ? sc[r] * __builtin_amdgcn_exp2f((float)df * l2c) : 0.f;
                    *(LAS bf16_t*)(F.lds + sb + pp * SC_SROW + mm * 2) = (bf16_t)(pk_bf16(v, 0.f) & 0xffffu); }
            }
            __syncthreads();
            bf16x8 vf[2], vd[2];
            {
                const int e = 32 * w + lr;
#pragma unroll
                for (int ks = 0; ks < 2; ++ks) {
                    const int cc = 2 * ks + lh;
                    vf[ks] = *(const LAS bf16x8*)(F.lds + cb + SC_V + e * 64 + (((cc ^ (e >> 2)) & 3) << 4));
                    const u32x4 raw = __builtin_bit_cast(u32x4, vf[ks]); u32x4 o;
                    float kd8[8];
#pragma unroll
                    for (int jj = 0; jj < 8; ++jj) { const int t = 16 * ks + 8 * lh + jj; kd8[jj] = __builtin_amdgcn_exp2f((float)(kd_a - sgn * t) * l2c); }
                    o.x = pk_bf16(bf_lo(raw.x) * kd8[0], bf_hi(raw.x) * kd8[1]); o.y = pk_bf16(bf_lo(raw.y) * kd8[2], bf_hi(raw.y) * kd8[3]);
                    o.z = pk_bf16(bf_lo(raw.z) * kd8[4], bf_hi(raw.z) * kd8[5]); o.w = pk_bf16(bf_lo(raw.w) * kd8[6], bf_hi(raw.w) * kd8[7]);
                    vd[ks] = __builtin_bit_cast(bf16x8, o);
                }
            }
            f32x16 Y;
#pragma unroll
            for (int i = 0; i < 16; ++i) Y[i] = 0.f;
#pragma unroll
            for (int dt = 0; dt < 8; ++dt)
#pragma unroll
                for (int s = 0; s < 2; ++s) {
                    u32x4 pb; pb.x = pk_bf16(S[dt][8 * s], S[dt][8 * s + 1]); pb.y = pk_bf16(S[dt][8 * s + 2], S[dt][8 * s + 3]); pb.z = pk_bf16(S[dt][8 * s + 4], S[dt][8 * s + 5]); pb.w = pk_bf16(S[dt][8 * s + 6], S[dt][8 * s + 7]);
                    const int c0 = 4 * dt + 2 * s;
                    const s16x4 a0 = *(const LAS s16x4*)(F.lds + cb + SC_Q + lr * SC_QROW + c0 * 16 + 8 * lh);
                    const s16x4 a1 = *(const LAS s16x4*)(F.lds + cb + SC_Q + lr * SC_QROW + c0 * 16 + 16 + 8 * lh);
                    const bf16x8 af = __builtin_shufflevector(a0, a1, 0, 1, 2, 3, 4, 5, 6, 7);
                    Y = __builtin_amdgcn_mfma_f32_32x32x16_bf16(af, __builtin_bit_cast(bf16x8, pb), Y, 0, 0, 0);
                }
#pragma unroll
            for (int r = 0; r < 16; ++r) { const int p = (r & 3) + 8 * (r >> 2) + 4 * lh; Y[r] *= __builtin_amdgcn_exp2f((float)(qd_a + sgn * p) * l2c); }
#pragma unroll
            for (int ks = 0; ks < 2; ++ks) {
                const bf16x8 sf = *(const LAS bf16x8*)(F.lds + sb + lr * SC_SROW + (16 * ks + 8 * lh) * 2);
                Y = __builtin_amdgcn_mfma_f32_32x32x16_bf16(sf, vf[ks], Y, 0, 0, 0);
            }
#pragma unroll
            for (int dt = 0; dt < 8; ++dt) {
#pragma unroll
                for (int i = 0; i < 16; ++i) S[dt][i] *= g32;
#pragma unroll
                for (int ks = 0; ks < 2; ++ks) {
                    const int d = 32 * dt + lr, cc = 2 * ks + lh;
                    const bf16x8 kf = *(const LAS bf16x8*)(F.lds + cb + SC_K + d * 64 + (((cc ^ (d >> 2)) & 3) << 4));
                    S[dt] = __builtin_amdgcn_mfma_f32_32x32x16_bf16(kf, vd[ks], S[dt], 0, 0, 0);
                }
            }
            float q2[16];
#pragma unroll
            for (int r = 0; r < 16; ++r) { const float y = Y[r]; q2[r] = y * y;
                *(LAS bf16_t*)(F.lds + SC_Y + ((r & 3) + 8 * (r >> 2) + 4 * lh) * SC_YROW + (w * 32 + lr) * 2) = (bf16_t)(pk_bf16(y, 0.f) & 0xffffu); }
            {
                float a8[8];
#pragma unroll
                for (int i = 0; i < 8; ++i) { const bool hi = lr & 16; const float keep = hi ? q2[i + 8] : q2[i], send = hi ? q2[i] : q2[i + 8]; a8[i] = keep + shx(send, 16, lane); }
                float a4[4];
#pragma unroll
                for (int i = 0; i < 4; ++i) { const bool hi = lr & 8; const float keep = hi ? a8[i + 4] : a8[i], send = hi ? a8[i] : a8[i + 4]; a4[i] = keep + shx(send, 8, lane); }
                float a2[2];
#pragma unroll
                for (int i = 0; i < 2; ++i) { const bool hi = lr & 4; const float keep = hi ? a4[i + 2] : a4[i], send = hi ? a4[i] : a4[i + 2]; a2[i] = keep + shx(send, 4, lane); }
                float a1; { const bool hi = lr & 2; const float keep = hi ? a2[1] : a2[0], send = hi ? a2[0] : a2[1]; a1 = keep + shx(send, 2, lane); }
                a1 += shx(a1, 1, lane);
                const int r = (lr >> 1) & 15, p = (r & 3) + 8 * (r >> 2) + 4 * lh;
                if (!(lr & 1)) *(LAS float*)(F.lds + SC_RED + (w * 32 + p) * 4) = a1;
            }
            if (ci + 1 < 72) {
                *(LAS u32x4*)(F.lds + nb + ql0) = sq[0]; *(LAS u32x4*)(F.lds + nb + ql1) = sq[1];
#pragma unroll
                for (int i = 0; i < 2; ++i) { *(LAS u32x4*)(F.lds + nb + SC_K + kl + i * 8192) = sk[i]; *(LAS u32x4*)(F.lds + nb + SC_V + kl + i * 8192) = sv[i]; }
            }
            __syncthreads();
            {
                const u32x4 y0 = *(const LAS u32x4*)(F.lds + SC_Y + op * SC_YROW + oc * 32), y1 = *(const LAS u32x4*)(F.lds + SC_Y + op * SC_YROW + oc * 32 + 16);
                u32x4 z0, z1;
                z0.x = pk_bf16(bf_lo(y0.x) * bf_lo(gt0.x), bf_hi(y0.x) * bf_hi(gt0.x)); z0.y = pk_bf16(bf_lo(y0.y) * bf_lo(gt0.y), bf_hi(y0.y) * bf_hi(gt0.y));
                z0.z = pk_bf16(bf_lo(y0.z) * bf_lo(gt0.z), bf_hi(y0.z) * bf_hi(gt0.z)); z0.w = pk_bf16(bf_lo(y0.w) * bf_lo(gt0.w), bf_hi(y0.w) * bf_hi(gt0.w));
                z1.x = pk_bf16(bf_lo(y1.x) * bf_lo(gt1.x), bf_hi(y1.x) * bf_hi(gt1.x)); z1.y = pk_bf16(bf_lo(y1.y) * bf_lo(gt1.y), bf_hi(y1.y) * bf_hi(gt1.y));
                z1.z = pk_bf16(bf_lo(y1.z) * bf_lo(gt1.z), bf_hi(y1.z) * bf_hi(gt1.z)); z1.w = pk_bf16(bf_lo(y1.w) * bf_lo(gt1.w), bf_hi(y1.w) * bf_hi(gt1.w));
                stg<u32x4>(gbase + (size_t)tok0 * 4096, z0); stg<u32x4>(gbase + (size_t)tok0 * 4096 + 8, z1);
            }
            if (tid < 32) { float s = 0.f;
#pragma unroll
                for (int ww = 0; ww < 8; ++ww) s += *(const LAS float*)(F.lds + SC_RED + (ww * 32 + tid) * 4);
                stg<float>(ssqb + (((size_t)eh * 2 + dir) * HROWS + rb + tok0 + tid) * 4 + h, s); }
        }
    }
    __syncthreads();
}

DI void comb_phase(const Frame& F, int hf) {
    const bf16_t* PJ = (const bf16_t*)(F.ws + WS_PROJ + PJ_RG);
    const float* ssqb = (const float*)(F.ws + WS_MISC + MS_SSQ);
    bf16_t* O = (bf16_t*)(F.ws + (hf == 0 ? WS_OBUF : WS_ABUF));
    for (int r = F.bid * 8 + F.wave; r < 36864; r += F.G * 8) {
#pragma unroll
        for (int i = 0; i < 4; ++i) {
            const float sf = ldg<float>(ssqb + ((size_t)(0 * 2 + 0) * 36864 + r) * 4 + i) + ldg<float>(ssqb + ((size_t)(1 * 2 + 0) * 36864 + r) * 4 + i);
            const float sb = ldg<float>(ssqb + ((size_t)(0 * 2 + 1) * 36864 + r) * 4 + i) + ldg<float>(ssqb + ((size_t)(1 * 2 + 1) * 36864 + r) * 4 + i);
            const float rf = 1.0f / sqrtf(sf * (1.0f / 512.0f) + RMS_EPS), rb = 1.0f / sqrtf(sb * (1.0f / 512.0f) + RMS_EPS);
            const int c = i * 512 + F.lane * 8;
            const u32x4 zf = ldg<u32x4>(PJ + (size_t)r * 4096 + c), zb = ldg<u32x4>(PJ + (size_t)r * 4096 + 2048 + c);
            u32x4 w;
            w.x = pk_bf16(rf * bf_lo(zf.x) + rb * bf_lo(zb.x), rf * bf_hi(zf.x) + rb * bf_hi(zb.x));
            w.y = pk_bf16(rf * bf_lo(zf.y) + rb * bf_lo(zb.y), rf * bf_hi(zf.y) + rb * bf_hi(zb.y));
            w.z = pk_bf16(rf * bf_lo(zf.z) + rb * bf_lo(zb.z), rf * bf_hi(zf.z) + rb * bf_hi(zb.z));
            w.w = pk_bf16(rf * bf_lo(zf.w) + rb * bf_lo(zb.w), rf * bf_hi(zf.w) + rb * bf_hi(zb.w));
            stg<u32x4>(O + (size_t)r * 2048 + c, w);
        }
    }
}

DI void final_phase(const Frame& F) {
    const bf16_t* y2 = (const bf16_t*)(F.ws + WS_PROJ + PJ_Y2);
    for (int r = F.bid * 8 + F.wave; r < T; r += F.G * 8) {
        const int b = r / NTOK, n = r % NTOK; if (n < CTXL) continue;
        float* hp = F.out + ((size_t)b * 2048 + (n - 256)) * 1024; const float* modp = mod_lat(F, 3, b);
        const bf16_t* hrow = (const bf16_t*)(F.ws + WS_HB) + (size_t)r * 1024;
#pragma unroll
        for (int i = 0; i < 4; ++i) {
            const u32x2 hw = ldg<u32x2>(hrow + i * 256 + F.lane * 4); f32x4 x = {bf_lo(hw.x), bf_hi(hw.x), bf_lo(hw.y), bf_hi(hw.y)};
            const u32x2 a = ldg<u32x2>(y2 + (size_t)(2 * r) * 1024 + i * 256 + F.lane * 4), c = ldg<u32x2>(y2 + (size_t)(2 * r + 1) * 1024 + i * 256 + F.lane * 4);
            const f32x4 g2 = ldg<f32x4>(modp + 5120 + i * 256 + F.lane * 4);
            x[0] += g2[0] * (bf_lo(a.x) + bf_lo(c.x)); x[1] += g2[1] * (bf_hi(a.x) + bf_hi(c.x)); x[2] += g2[2] * (bf_lo(a.y) + bf_lo(c.y)); x[3] += g2[3] * (bf_hi(a.y) + bf_hi(c.y));
            stg<f32x4>(hp + i * 256 + F.lane * 4, x);
        }
    }
}

constexpr int NPHASE = 50;
__global__ void __launch_bounds__(512, 2) fwd_kernel(Args args) {
    extern __shared__ __attribute__((aligned(16))) unsigned char lds_raw[];
    Frame F;
    F.a = &args;
    F.out = args.out; F.ws = args.ws; F.lds = (LAS unsigned char*)lds_raw;
    F.tid = threadIdx.x; F.lane = F.tid & 63; F.wave = __builtin_amdgcn_readfirstlane(F.tid >> 6); F.G = gridDim.x;
    const int lo = args.ph_lo, hi = args.ph_hi;
    const int wave_s = __builtin_amdgcn_readfirstlane((int)threadIdx.x >> 6);
    volatile LAS unsigned* bst = (volatile LAS unsigned*)(F.lds + LDS_MISC);
    if (F.tid < 4) bst[F.tid] = 0u;
    __syncthreads();
    XcdBarrier bar; bar.bar = (unsigned*)(F.ws + WS_CTL) + CW_BAR; bar.x = 0; bar.st = bst;
    if (hi - lo > 1) bar = xcd_barrier_post((unsigned*)(F.ws + WS_CTL) + CW_BAR, bst);
#ifndef PH_MASK
#define PH_MASK 0xFFFFFFFFu
#endif
#define PHASE(site, p, ...) do { if (((PH_MASK >> (site)) & 1u) && lo <= (p) && (p) < hi) { F.ws = launder_p(args.ws); F.out = (float*)launder_p((unsigned char*)args.out); { int ws_ = wave_s, bi_ = (int)blockIdx.x; asm volatile("" : "+s"(ws_), "+s"(bi_)); F.wave = ws_; F.bid = bi_; } F.lane = lane_id_asm(); F.tid = (F.wave << 6) | F.lane; __VA_ARGS__; if ((p) + 1 < hi) xcd_barrier(bar, (wave_s << 6) | lane_id_asm()); } } while (0)

    PHASE(0, 0, p0_prologue(F));
    for (int layer = 0; layer < DEPTH; ++layer) {
        const int pb = 1 + 12 * layer, j = layer >> 1; const bool isRT = layer & 1;
        PHASE(1, pb + 0, { norm_phase<false>(F, layer); if (layer > 0) convert_moe_weights(F, layer); });
        if (!isRT) {
            PHASE(2, pb + 1, {
                ProbQKV S; S.K = 1024; S.abuf = (const char*)(F.ws + WS_ABUF); S.wqk = (const char*)(F.ws + WS_WQK) + (size_t)j * 2048 * 1024 * 2; S.wv = (const char*)(F.ws + WS_WV) + (size_t)j * 1024 * 1024 * 2;
                S.go.init(NTILE, 8); S.G = F.G; S.c = F.bid;
                EpiQKV E{(bf16_t*)(F.ws + WS_PROJ + PJ_Q), (bf16_t*)(F.ws + WS_PROJ + PJ_K), (bf16_t*)(F.ws + WS_PROJ + PJ_VT), F.a->in[9] + j * 64, F.a->in[10] + j * 64,
                         (const float*)(F.ws + WS_ROPE + RP_CDA), (const float*)(F.ws + WS_ROPE + RP_SDA)};
                pg8::gemm_phase<EpiQKV, ProbQKV, true>(F.lds, S, E, F.tid, F.wave);
            });
            PHASE(3, pb + 2, attn_phase(F, layer));
        } else {
            for (int hf = 0; hf < 2; ++hf) {
                PHASE(4, pb + 1 + 3 * hf, {
                    ProbWIN S; S.K = 1024; S.abuf = (const char*)(F.ws + WS_ABUF) + (size_t)hf * 144 * 256 * 1024 * 2; S.win = (const char*)(F.ws + WS_WIN) + (size_t)j * 8192 * 1024 * 2;
                    S.go.init(144, 20); S.G = F.G; S.c = F.bid;
                    EpiWIN E{(bf16_t*)(F.ws + WS_PROJ + PJ_RQ), (bf16_t*)(F.ws + WS_PROJ + PJ_RG), (bf16_t*)(F.ws + WS_PROJ + PJ_RKT), (bf16_t*)(F.ws + WS_PROJ + PJ_RVT), hf * 144,
                             (const float*)(F.ws + WS_ROPE + RP_CRT), (const float*)(F.ws + WS_ROPE + RP_SRT), (const float*)(F.ws + WS_MISC + MS_CRTT), (const float*)(F.ws + WS_MISC + MS_SRTT)};
                    pg8::gemm_phase<EpiWIN, ProbWIN, true>(F.lds, S, E, F.tid, F.wave);
                });
                PHASE(5, pb + 2 + 3 * hf, scan_phase(F, layer, hf));
                PHASE(6, pb + 3 + 3 * hf, comb_phase(F, hf));
            }
        }
        PHASE(7, pb + 7, {
            ProbDense S; S.G = F.G; S.c = F.bid; S.go.init(NTILE, 4);
            if (!isRT) { S.K = 1024; S.A0 = (const char*)(F.ws + WS_OBUF); S.A1 = S.A0; S.pm_split = 1 << 30; S.Bt = (const char*)(F.ws + WS_WODA) + (size_t)j * 1024 * 1024 * 2; }
            else { S.K = 2048; S.A0 = (const char*)(F.ws + WS_OBUF); S.A1 = (const char*)(F.ws + WS_ABUF); S.pm_split = 144; S.Bt = (const char*)(F.ws + WS_WORT) + (size_t)j * 1024 * 2048 * 2; }
            EpiResid E{F.a->in[2], F.a->in[0], (bf16_t*)(F.ws + WS_HB), (const float*)(F.ws + WS_ADA) + (size_t)layer * 33 * 6144, layer == 0 ? 1 : 0};
            pg8::gemm_phase<EpiResid, ProbDense, true>(F.lds, S, E, F.tid, F.wave);
        });
        PHASE(8, pb + 8, norm_phase<true>(F, layer));
        PHASE(9, pb + 9, sort_phase(F, layer));
        PHASE(10, pb + 10, {
            LAS int* segs = (LAS int*)(F.lds + LDS_MISC + 2048); LAS int* tile_e = (LAS int*)(F.lds + LDS_TILE_E);
            const int ntl = build_segments(F, layer, segs, tile_e);
            ProbMoE<true> S; S.K = 1024; S.A = (const char*)(F.ws + WS_ABUF); S.W = (const char*)(F.ws + WS_WGU); S.tile_e = tile_e; S.go.init(ntl, 4); S.G = F.G; S.c = F.bid;
            LAS int* rowtok = (LAS int*)(F.lds + LDS_TILE_E + 4096); S.rowtok = rowtok;
            { const int* rowmap = (const int*)(F.ws + WS_MISC + MS_ROWMAP); Unit uu;
              for (int i = 0; i < 11 && S.next(i, uu); ++i) { if (F.tid < 256) { const int d = ldg<int>(rowmap + uu.pm * 256 + F.tid); rowtok[i * 256 + F.tid] = d >= 0 ? (d >> 1) : 0; } }
              __syncthreads(); }
            EpiSwiGLU E{(bf16_t*)(F.ws + WS_PROJ + PJ_ACT)};
            pg8::gemm_phase<EpiSwiGLU, ProbMoE<true>, true>(F.lds, S, E, F.tid, F.wave);
        });
        PHASE(11, pb + 11, {
            LAS int* segs = (LAS int*)(F.lds + LDS_MISC + 2048); LAS int* tile_e = (LAS int*)(F.lds + LDS_TILE_E);
            const int ntl = build_segments(F, layer, segs, tile_e);
            ProbMoE<false> S; S.K = 512; S.A = (const char*)(F.ws + WS_PROJ + PJ_ACT); S.W = (const char*)(F.ws + WS_WD); S.tile_e = tile_e; S.rowtok = tile_e; S.go.init(ntl, 4); S.G = F.G; S.c = F.bid;
            EpiDown E{(bf16_t*)(F.ws + WS_PROJ + PJ_Y2), (const int*)(F.ws + WS_MISC + MS_ROWMAP), (const float*)(F.ws + WS_MISC + MS_WSEL)};
            pg8::gemm_phase<EpiDown, ProbMoE<false>, true>(F.lds, S, E, F.tid, F.wave);
        });
    }
    PHASE(12, 49, final_phase(F));
#undef PHASE
}

static bool phase_exists(int p) {
    if (p == 0 || p == 49) return true;
    const int layer = (p - 1) / 12, slot = (p - 1) % 12; const bool isRT = layer & 1;
    if (!isRT && slot >= 3 && slot <= 6) return false;
    return true;
}
extern "C" void kernel_launch(void* const* d_in, const int* in_sizes, int n_in, void* d_out, int out_size, void* d_ws, size_t ws_size, hipStream_t stream) {
    static int grid = 0;
    if (grid == 0) {
        if (n_in != 24 || ws_size < WS_END) { fprintf(stderr, "kernel_launch: need 24 inputs and >= %zu bytes of workspace (got %d, %zu)\n", (size_t)WS_END, n_in, ws_size); grid = -1; return; }
        int dev = 0, cus = 0, per_cu = 0;
        if (hipGetDevice(&dev) != hipSuccess || hipDeviceGetAttribute(&cus, hipDeviceAttributeMultiprocessorCount, dev) != hipSuccess) { grid = -1; return; }
        if (hipFuncSetAttribute((const void*)fwd_kernel, hipFuncAttributeMaxDynamicSharedMemorySize, LDS_BYTES) != hipSuccess) { fprintf(stderr, "kernel_launch: hipFuncSetAttribute failed\n"); grid = -1; return; }
        if (hipOccupancyMaxActiveBlocksPerMultiprocessor(&per_cu, (const void*)fwd_kernel, 512, LDS_BYTES) != hipSuccess || per_cu < 1) fprintf(stderr, "kernel_launch: occupancy query reports %d\n", per_cu);
        (void)hipGetLastError();
        grid = cus;
    }
    if (grid < 0) return;
    (void)hipMemsetAsync((char*)d_ws + WS_CTL, 0, 1 * MiB, stream);
    Args a{};
    for (int i = 0; i < 24; ++i) a.in[i] = (const float*)d_in[i];
    a.out = (float*)d_out; a.ws = (unsigned char*)d_ws;
#ifdef MULTI_LAUNCH
    for (int p = 0; p < NPHASE; ++p) { if (!phase_exists(p)) continue; a.ph_lo = p; a.ph_hi = p + 1; hipLaunchKernelGGL(fwd_kernel, dim3(grid), dim3(512), LDS_BYTES, stream, a); }
#elif defined(PROBE_DUP_LO)
    a.ph_lo = 0; a.ph_hi = PROBE_DUP_HI; hipLaunchKernelGGL(fwd_kernel, dim3(grid), dim3(512), LDS_BYTES, stream, a);
    for (int p = PROBE_DUP_LO; p < PROBE_DUP_HI; ++p) { if (!phase_exists(p)) continue; a.ph_lo = p; a.ph_hi = p + 1; hipLaunchKernelGGL(fwd_kernel, dim3(grid), dim3(512), LDS_BYTES, stream, a); }
    (void)hipMemsetAsync((char*)d_ws + WS_CTL, 0, 16384, stream);
    a.ph_lo = PROBE_DUP_HI; a.ph_hi = NPHASE; hipLaunchKernelGGL(fwd_kernel, dim3(grid), dim3(512), LDS_BYTES, stream, a);
#else
    a.ph_lo = 0; a.ph_hi = NPHASE; hipLaunchKernelGGL(fwd_kernel, dim3(grid), dim3(512), LDS_BYTES, stream, a);
#endif
}
```

```cpp
#include <hip/hip_runtime.h>
#include <cstdio>
#include <cstdint>

#define LAS __attribute__((address_space(3)))
constexpr float LOG2E = 1.4426950408889634f;
#define DI __device__ __forceinline__
typedef unsigned short bf16_t;
typedef short bf16x8 __attribute__((ext_vector_type(8)));
typedef short s16x4 __attribute__((ext_vector_type(4)));
typedef float f32x4 __attribute__((ext_vector_type(4)));
typedef float f32x2 __attribute__((ext_vector_type(2)));
typedef float f32x16 __attribute__((ext_vector_type(16)));
typedef unsigned u32x4 __attribute__((ext_vector_type(4)));
typedef unsigned u32x2 __attribute__((ext_vector_type(2)));
typedef __bf16 bf16x2_t __attribute__((ext_vector_type(2)));

#define GAS __attribute__((address_space(1)))
template <class V, class T> DI V ldg(const T* p) { return *(const GAS V*)(unsigned long long)p; }
template <class V, class T> DI void stg(T* p, V v) { *(GAS V*)(unsigned long long)p = v; }
DI unsigned pk_bf16(float lo, float hi) { f32x2 v = {lo, hi}; return __builtin_bit_cast(unsigned, __builtin_convertvector(v, bf16x2_t)); }
DI float bf_lo(unsigned u) { return __uint_as_float(u << 16); }
DI float bf_hi(unsigned u) { return __uint_as_float(u & 0xffff0000u); }
DI float bf_f(bf16_t v) { return __uint_as_float(((unsigned)v) << 16); }
DI unsigned char* launder_p(unsigned char* p) { asm volatile("" : "+s"(p)); return p; }
DI float shx(float v, int o, int lane) { return __builtin_bit_cast(float, __builtin_amdgcn_ds_bpermute((lane ^ o) << 2, __builtin_bit_cast(int, v))); }
DI float wave_sum(float v, int lane) {
#pragma unroll
    for (int o = 32; o >= 1; o >>= 1) v += shx(v, o, lane);
    return v;
}
DI int lane_id_asm() { int x; asm volatile("v_mbcnt_lo_u32_b32 %0, -1, 0\n\tv_mbcnt_hi_u32_b32 %0, -1, %0" : "=v"(x)); return x; }
DI int launder(int x) { asm volatile("" : "+v"(x)); return x; }
DI float silu_f(float x) { return x * __builtin_amdgcn_rcpf(1.0f + __builtin_amdgcn_exp2f(-LOG2E * x)); }

constexpr int NB = 32, SEQ = 2048, CTXL = 256, NTOK = SEQ + CTXL, DM = 1024, DEPTH = 4;
constexpr int T = NB * NTOK;
constexpr int NTILE = T / 256;
constexpr int NEXP = 32, MOEH = 512;
constexpr int MAXROWS = 2 * T + NEXP * 256;
constexpr float RMS_EPS = 1e-6f;

constexpr size_t MiB = 1ull << 20;
constexpr size_t WS_CTL = 0;
constexpr size_t WS_ADA = 1 * MiB;
constexpr size_t WS_ROPE = 5 * MiB;
constexpr size_t WS_MISC = 8 * MiB;
constexpr size_t WS_HCTX = 16 * MiB;
constexpr size_t WS_WQK = 48 * MiB;
constexpr size_t WS_WV = 56 * MiB;
constexpr size_t WS_WODA = 60 * MiB;
constexpr size_t WS_WIN = 64 * MiB;
constexpr size_t WS_WORT = 96 * MiB;
constexpr size_t WS_WGU = 104 * MiB;
constexpr size_t WS_WD = 168 * MiB;
constexpr size_t WS_ABUF = 200 * MiB;
constexpr size_t WS_OBUF = 344 * MiB;
constexpr size_t WS_PROJ = 488 * MiB;
constexpr size_t WS_HB = 1064 * MiB;
constexpr size_t WS_END = 1208 * MiB;
constexpr size_t PJ_Q = 0, PJ_K = 144 * MiB, PJ_VT = 288 * MiB;
constexpr size_t PJ_SA = 0, PJ_ACT = 304 * MiB, PJ_Y2 = 0;
constexpr size_t PJ_RQ = 0, PJ_RG = 72 * MiB, PJ_RKT = 360 * MiB, PJ_RVT = 432 * MiB;
constexpr int HROWS = 36864;
constexpr size_t RP_CDA = 0, RP_SDA = 256 * 1024, RP_CRT = 512 * 1024, RP_SRT = 512 * 1024 + 1 * MiB;
constexpr size_t MS_EID = 0, MS_WSEL = 1 * MiB, MS_ROWMAP = 2 * MiB, MS_SSQ = 3 * MiB, MS_CRTT = 6 * MiB, MS_SRTT = 7 * MiB;
constexpr int CW_BAR = 0;
constexpr int CW_CNT = 4096;
constexpr int CW_CUR = 4096 + 256;

constexpr int LDS_BYTES = 155648;
constexpr int LDS_MISC = 147456;
constexpr int LDS_TILE_E = 131072;

#define XB_TMO      128
#define XB_XCNT(j)  (256  + 64 * (j))
#define XB_XSUB(j)  (1280 + 64 * (j))
#define XB_XGEN(j)  (2304 + 64 * (j))
#define XB_TOP      3328
#define XB_TOPGEN   3392
#define XCD_BAR_WORDS 3456
#define XB_SPIN_CAP (1u << 18)

__device__ __forceinline__ unsigned xb_ld(unsigned* p)              { return __hip_atomic_load(p, __ATOMIC_RELAXED, __HIP_MEMORY_SCOPE_AGENT); }
__device__ __forceinline__ unsigned xb_add(unsigned* p, unsigned v) { return __hip_atomic_fetch_add(p, v, __ATOMIC_RELAXED, __HIP_MEMORY_SCOPE_AGENT); }
__device__ __forceinline__ unsigned xb_xcc_id() { return (unsigned)__builtin_amdgcn_s_getreg((3 << 11) | 20) & 0xFu; }
#define XB_SPIN(cond, bar) do { unsigned _sp = 0; while (cond) { __builtin_amdgcn_s_sleep(1); \
    if ((++_sp & 255u) == 0u) { if (xb_ld(&(bar)[XB_TMO])) break; if (_sp > XB_SPIN_CAP) { atomicAdd(&(bar)[XB_TMO], 1u); break; } } } } while (0)

struct XcdBarrier { unsigned* bar; unsigned x; volatile LAS unsigned* st; };

__device__ __forceinline__ XcdBarrier xcd_barrier_post(unsigned* bar, volatile LAS unsigned* st) {
    XcdBarrier b; b.bar = bar; b.x = xb_xcc_id(); b.st = st;
    if (threadIdx.x == 0) (void)xb_add(&bar[XB_XCNT(b.x)], 1u);
    return b;
}
__device__ __forceinline__ void xcd_barrier_complete(unsigned* bar, unsigned x, unsigned& nloc, unsigned& nx) {
    const unsigned G = gridDim.x * gridDim.y * gridDim.z;
    unsigned sum, cnt, mine, sp = 0u;
    for (;;) {
        sum = 0u; cnt = 0u; mine = 0u;
#pragma unroll
        for (unsigned j = 0; j < 16; ++j) { const unsigned c = xb_ld(&bar[XB_XCNT(j)]); sum += c; cnt += (c > 0u) ? 1u : 0u; mine = (j == x) ? c : mine; }
        if (sum == G) break;
        __builtin_amdgcn_s_sleep(1);
        if ((++sp & 255u) == 0u) { if (xb_ld(&bar[XB_TMO])) break; if (sp > XB_SPIN_CAP) { atomicAdd(&bar[XB_TMO], 1u); break; } }
    }
    nloc = mine > 0u ? mine : 1u; nx = cnt > 0u ? cnt : 1u;
}
__device__ __forceinline__ void xcd_barrier(const XcdBarrier& b, const int tid0) {
    asm volatile("s_waitcnt vmcnt(0)" ::: "memory");
    __syncthreads();
    if (tid0 == 0) {
        unsigned* bar = (unsigned*)launder_p((unsigned char*)b.bar);
        __builtin_amdgcn_s_waitcnt(0);
        unsigned nloc = b.st[0], nx = b.st[1];
        if (nloc == 0u) { xcd_barrier_complete(bar, b.x, nloc, nx); b.st[0] = nloc; b.st[1] = nx; }
        const unsigned old = xb_add(&bar[XB_XSUB(b.x)], 1u);
        const unsigned gen = old / nloc;
        if (old + 1u == (gen + 1u) * nloc) {
            __builtin_amdgcn_fence(__ATOMIC_RELEASE, "agent");
            asm volatile("s_waitcnt vmcnt(0)" ::: "memory");
            const unsigned og = xb_add(&bar[XB_TOP], 1u);
            const unsigned tg = og / nx;
            if (og + 1u == (tg + 1u) * nx) xb_add(&bar[XB_TOPGEN], 1u);
            else XB_SPIN(xb_ld(&bar[XB_TOPGEN]) == tg, bar);
            __builtin_amdgcn_fence(__ATOMIC_ACQUIRE, "agent");
            xb_add(&bar[XB_XGEN(b.x)], 1u);
            asm volatile("s_waitcnt vmcnt(0)" ::: "memory");
        } else {
            XB_SPIN(xb_ld(&bar[XB_XGEN(b.x)]) == gen, bar);
            __builtin_amdgcn_fence(__ATOMIC_ACQUIRE, "agent");
            asm volatile("s_waitcnt vmcnt(0)" ::: "memory");
        }
    }
    __syncthreads();
}

struct Args { const float* in[24]; float* out; unsigned char* ws; int ph_lo, ph_hi; };
struct Frame {
    const Args* a; float* out; unsigned char* ws; LAS unsigned char* lds;
    int tid, lane, wave, G, bid;
};
DI const float* mod_lat(const Frame& F, int layer, int b) { return (const float*)(F.ws + WS_ADA) + ((size_t)layer * 33 + b) * 6144; }
DI const float* mod_ctx(const Frame& F, int layer) { return (const float*)(F.ws + WS_ADA) + ((size_t)layer * 33 + 32) * 6144; }

namespace pg8 {
constexpr int BM = 256, BK = 64, HALF = 128, HTB = HALF * BK * 2, STAGE_BYTES = 8 * HTB, NXCD = 8, WGM = 8;
__host__ __device__ __forceinline__ int lds_byte(int r, int c) { const int st = (r >> 4) * 2 + (c >> 5), rr = r & 15, cc = c & 31, ob = rr * 64 + cc * 2; return st * 1024 + (ob ^ (((ob >> 9) & 1) << 5)); }
__host__ __device__ __forceinline__ void stage_rc(int b, int& R, int& C) { const int st = b / 1024, sb = b % 1024, swz = sb ^ (((sb >> 9) & 1) << 5); R = (st >> 1) * 16 + swz / 64; C = (st & 1) * 32 + (swz % 64) / 2; }
__host__ __device__ __forceinline__ int perm32(int rho) { const int n = rho >> 4, i = rho & 15; return 8 * (i >> 2) + 4 * n + (i & 3); }

struct Unit { int pm, pn, kind; };

struct GridOrder {
    int nM, nN, nwg;
    DI void init(int nM_, int nN_) { nM = nM_; nN = nN_; nwg = nM * nN; }
    DI bool map(long L, int& pm, int& pn) const {
        if (L >= nwg) return false;
        int wgid = (int)L; { const int q = nwg / NXCD, r = nwg % NXCD, xcd = wgid % NXCD, off = wgid / NXCD; wgid = (xcd < r ? xcd * (q + 1) : r * (q + 1) + (xcd - r) * q) + off; }
        const int nig = WGM * nN, gid = wgid / nig, fm = gid * WGM, gsz = (nM - fm) < WGM ? (nM - fm) : WGM;
        pm = fm + ((wgid % nig) % gsz); pn = (wgid % nig) / gsz; return true;
    }
};

template <class Epi, class P, bool ALIGN_EPI>
DI void gemm_phase(LAS unsigned char* lds, const P& S, const Epi& E, const int tid, const int wid) {
    const int lane = tid & 63, wr = wid >> 2, wc = wid & 3, fr = lane & 15, fq = lane >> 4;
    const int K = S.K, nt = K / BK;
    unsigned voffA[2], voffB[2];
#pragma unroll
    for (int i = 0; i < 2; ++i) { int R, C; stage_rc(tid * 16 + i * 8192, R, C); const int Rb = Epi::PERM ? ((R & ~31) + perm32(R & 31)) : R;
        voffA[i] = (unsigned)(R * K + C) * 2u; voffB[i] = (unsigned)(Rb * K + C) * 2u; }
    const size_t kstep = (size_t)(BK * 2);
    const size_t hstep = (size_t)HALF * K * 2;
    const unsigned ldsw = (unsigned)wid * 1024u;
    const int aoff = lds_byte(wr * 64 + fr, fq * 8), boff = lds_byte(wc * 32 + fr, fq * 8);
#define PG8_SA(b, h) (((b) * 2 + (h)) * HTB)
#define PG8_SB(b, h) ((4 + (b) * 2 + (h)) * HTB)
#define PG8_STAGE(bufoff, gbase, voff) do { _Pragma("unroll") for (int _i = 0; _i < 2; ++_i) \
        __builtin_amdgcn_global_load_lds((const unsigned*)((const char*)(gbase) + (voff)[_i]), (LAS unsigned*)(lds + (bufoff) + ldsw + _i * 8192), 16, 0, 0); } while (0)
#define PG8_LDA(dst, b, h) do { _Pragma("unroll") for (int m = 0; m < 4; ++m) _Pragma("unroll") for (int k = 0; k < 2; ++k) dst[m][k] = *(const LAS bf16x8*)(lds + PG8_SA(b, h) + aoff + m * 2048 + k * 1024); } while (0)
#define PG8_LDB(dst, b, h) do { _Pragma("unroll") for (int n = 0; n < 2; ++n) _Pragma("unroll") for (int k = 0; k < 2; ++k) dst[n][k] = *(const LAS bf16x8*)(lds + PG8_SB(b, h) + boff + n * 2048 + k * 1024); } while (0)
#define PG8_MMA(ai, bj, At, Bt) do { __builtin_amdgcn_s_setprio(1); _Pragma("unroll") for (int m = 0; m < 4; ++m) _Pragma("unroll") for (int n = 0; n < 2; ++n) _Pragma("unroll") for (int k = 0; k < 2; ++k) \
        acc[ai][bj][m][n] = __builtin_amdgcn_mfma_f32_16x16x32_bf16(Bt[n][k], At[m][k], acc[ai][bj][m][n], 0, 0, 0); __builtin_amdgcn_s_setprio(0); } while (0)
#define PG8_WAIT_V(n) asm volatile("s_waitcnt vmcnt(" #n ")" ::: "memory")
#define PG8_WAIT_L(n) asm volatile("s_waitcnt lgkmcnt(" #n ")" ::: "memory")
#define PG8_BAR __builtin_amdgcn_s_barrier()
#define PG8_SCHED __builtin_amdgcn_sched_barrier(0)
    Unit cur, nxt; int ui = 0;
    if (!S.next(0, cur)) return;
    unsigned gaC[2][2], gaN[2][2]; int gR[2], gC[2];
    if constexpr (P::GATHER) {
#pragma unroll
        for (int i = 0; i < 2; ++i) { stage_rc(tid * 16 + i * 8192, gR[i], gC[i]); }
#pragma unroll
        for (int h = 0; h < 2; ++h)
#pragma unroll
            for (int i = 0; i < 2; ++i) { gaC[h][i] = (unsigned)(S.rowtok[0 * 256 + h * 128 + gR[i]] * K + gC[i]) * 2u; gaN[h][i] = gaC[h][i]; }
    }
#define PG8_STAGE_A(bufoff, h, usen, kofs, dense) do { if constexpr (P::GATHER) { const unsigned _v[2] = {(usen) ? gaN[h][0] : gaC[h][0], (usen) ? gaN[h][1] : gaC[h][1]}; PG8_STAGE(bufoff, S.A + (kofs), _v); } \
        else { PG8_STAGE(bufoff, dense, voffA); } } while (0)
    f32x4 acc[2][2][4][2];
#pragma unroll
    for (int a = 0; a < 2; ++a)
#pragma unroll
        for (int b = 0; b < 2; ++b)
#pragma unroll
            for (int m = 0; m < 4; ++m)
#pragma unroll
                for (int n = 0; n < 2; ++n) acc[a][b][m][n] = (f32x4){0.f, 0.f, 0.f, 0.f};
    bf16x8 At[4][2], B0[2][2], B1[2][2];
    const char* cA = S.a_ptr(cur); const char* cB = S.b_ptr(cur);
    PG8_STAGE(PG8_SB(0, 0), cB, voffB); PG8_STAGE(PG8_SB(0, 1), cB + hstep, voffB); PG8_STAGE_A(PG8_SA(0, 0), 0, false, 0, cA); PG8_STAGE_A(PG8_SA(0, 1), 1, false, 0, cA + hstep);
    if (wr == 1) PG8_BAR;
    PG8_WAIT_V(2); PG8_BAR;
    PG8_STAGE(PG8_SB(1, 0), cB + kstep, voffB); PG8_STAGE_A(PG8_SA(1, 0), 0, false, kstep, cA + kstep); PG8_STAGE(PG8_SB(1, 1), cB + hstep + kstep, voffB);
    PG8_WAIT_V(6); PG8_BAR;
    for (;;) {
        const bool has_next = S.next(ui + 1, nxt);
        const char* nA = has_next ? S.a_ptr(nxt) : cA; const char* nB = has_next ? S.b_ptr(nxt) : cB;
        if constexpr (P::GATHER) { if (has_next) {
#pragma unroll
            for (int h = 0; h < 2; ++h)
#pragma unroll
                for (int i = 0; i < 2; ++i) gaN[h][i] = (unsigned)(S.rowtok[(ui + 1) * 256 + h * 128 + gR[i]] * K + gC[i]) * 2u; } }
        for (int t = 0; t < nt; t += 2) {
            const bool last = (t == nt - 2);
            const size_t k1 = (size_t)(t + 1) * kstep, k2 = last ? 0 : (size_t)(t + 2) * kstep, k3 = k2 + kstep;
            const char* a1 = cA + k1;
            const char* a2 = (last ? nA : cA) + k2; const char* b2 = last ? nB : cB + (size_t)(t + 2) * kstep;
            const char* a3 = a2 + kstep; const char* b3 = b2 + kstep;
            PG8_LDB(B0, 0, 0); PG8_LDB(B1, 0, 1); PG8_SCHED; PG8_LDA(At, 0, 0); PG8_STAGE_A(PG8_SA(1, 1), 1, false, k1, a1 + hstep);
            PG8_WAIT_V(8); PG8_WAIT_L(0); PG8_BAR; PG8_MMA(0, 0, At, B0); PG8_MMA(0, 1, At, B1); PG8_BAR; PG8_SCHED;
            PG8_LDA(At, 0, 1); PG8_STAGE(PG8_SB(0, 0), b2, voffB); PG8_STAGE(PG8_SB(0, 1), b2 + hstep, voffB); PG8_STAGE_A(PG8_SA(0, 0), 0, last, k2, a2);
            PG8_WAIT_V(8); PG8_WAIT_L(0); PG8_BAR; PG8_MMA(1, 0, At, B0); PG8_MMA(1, 1, At, B1); PG8_BAR; PG8_SCHED;
            PG8_LDB(B0, 1, 0); PG8_LDB(B1, 1, 1); PG8_SCHED; PG8_LDA(At, 1, 0); PG8_STAGE_A(PG8_SA(0, 1), 1, last, k2, a2 + hstep);
            PG8_WAIT_V(8); PG8_WAIT_L(0); PG8_BAR; PG8_MMA(0, 0, At, B0); PG8_MMA(0, 1, At, B1); PG8_BAR; PG8_SCHED;
            PG8_LDA(At, 1, 1); PG8_STAGE(PG8_SB(1, 0), b3, voffB); PG8_STAGE(PG8_SB(1, 1), b3 + hstep, voffB); PG8_STAGE_A(PG8_SA(1, 0), 0, last, k3, a3);
            PG8_WAIT_V(8); PG8_WAIT_L(0); PG8_BAR; PG8_MMA(1, 0, At, B0); PG8_MMA(1, 1, At, B1); PG8_BAR; PG8_SCHED;
        }
        if constexpr (ALIGN_EPI) { if (wr == 0) PG8_BAR; }
        { const int l2 = lane_id_asm(); E(acc, cur, wr, wc, l2 & 15, l2 >> 4); }
        if (!has_next) break;
#pragma unroll
        for (int a = 0; a < 2; ++a)
#pragma unroll
            for (int b = 0; b < 2; ++b)
#pragma unroll
                for (int m = 0; m < 4; ++m)
#pragma unroll
                    for (int n = 0; n < 2; ++n) acc[a][b][m][n] = (f32x4){0.f, 0.f, 0.f, 0.f};
        cur = nxt; cA = nA; cB = nB; ++ui;
        if constexpr (P::GATHER) {
#pragma unroll
            for (int h = 0; h < 2; ++h)
#pragma unroll
                for (int i = 0; i < 2; ++i) gaC[h][i] = gaN[h][i]; }
        if constexpr (ALIGN_EPI) { if (wr == 1) PG8_BAR; }
    }
    PG8_WAIT_V(0);
    if constexpr (!ALIGN_EPI) { if (wr == 0) PG8_BAR; }
    PG8_BAR;
#undef PG8_SA
#undef PG8_SB
#undef PG8_STAGE
#undef PG8_STAGE_A
#undef PG8_LDA
#undef PG8_LDB
#undef PG8_MMA
#undef PG8_WAIT_V
#undef PG8_WAIT_L
#undef PG8_BAR
#undef PG8_SCHED
}
}
using pg8::Unit;

struct ProbQKV {
    static constexpr bool GATHER = false;
    int K; const char* abuf; const char* wqk; const char* wv; pg8::GridOrder go; int G, c;
    DI bool next(int i, Unit& u) const {
        const long L = (long)i * G + c;
        if (L < NTILE * 8) { u.kind = 0; return go.map(L, u.pm, u.pn); }
        const long r = L - NTILE * 8; if (r >= NTILE * 4) return false;
        u.kind = 1; u.pm = (int)(r & 3); u.pn = (int)(r >> 2); return true;
    }
    DI const char* a_ptr(const Unit& u) const { return (u.kind == 0 ? abuf : wv) + (size_t)u.pm * (256 * 1024 * 2); }
    DI const char* b_ptr(const Unit& u) const { return (u.kind == 0 ? wqk : abuf) + (size_t)u.pn * (256 * 1024 * 2); }
};
struct EpiQKV {
    static constexpr bool PERM = true;
    bf16_t* Q; bf16_t* Kb; bf16_t* VT; const float* gq; const float* gk; const float* cosT; const float* sinT;
    DI void operator()(const f32x4 (&acc)[2][2][4][2], const Unit& u, int wr, int wc, int fr, int fq) const {
        if (u.kind == 1) {
#pragma unroll
            for (int ai = 0; ai < 2; ++ai)
#pragma unroll
                for (int m = 0; m < 4; ++m) {
                    const int f = u.pm * 256 + ai * 128 + wr * 64 + m * 16 + fr;
                    bf16_t* rowp = VT + (size_t)f * T + (size_t)u.pn * 256 + wc * 32 + 8 * fq;
#pragma unroll
                    for (int bj = 0; bj < 2; ++bj) { const f32x4 v0 = acc[ai][bj][m][0], v1 = acc[ai][bj][m][1];
                        u32x4 w; w.x = pk_bf16(v0[0], v0[1]); w.y = pk_bf16(v0[2], v0[3]); w.z = pk_bf16(v1[0], v1[1]); w.w = pk_bf16(v1[2], v1[3]);
                        stg<u32x4>(rowp + bj * 128, w); }
                }
            return;
        }
        const bool isK = u.pn >= 4; const int sub = 4 * (u.pn & 3) + wc;
        const int jj = u.pm % 9; const bool isctx = (jj == 0);
        const float* g = isK ? gk : gq; bf16_t* dst = isK ? Kb : Q;
        const float osc = isK ? 1.0f : 0.125f * LOG2E;
        const int ln = fr + 16 * fq;
        f32x4 gv[2][2];
#pragma unroll
        for (int bj = 0; bj < 2; ++bj)
#pragma unroll
            for (int n = 0; n < 2; ++n) gv[bj][n] = ldg<f32x4>(g + 32 * bj + 8 * fq + 4 * n);
        float invf[8];
#pragma unroll
        for (int k = 0; k < 8; ++k) invf[k] = __builtin_amdgcn_exp2f(-(float)((8 * fq + k) & 15) * (13.287712379549449f / 16.0f)) * 0.15915494309189535f;
        const bool use_row = fq < 2;
        float ss[8];
#pragma unroll
        for (int ai = 0; ai < 2; ++ai)
#pragma unroll
            for (int m = 0; m < 4; ++m) { float s = 0.f;
#pragma unroll
                for (int bj = 0; bj < 2; ++bj)
#pragma unroll
                    for (int n = 0; n < 2; ++n) { const f32x4 x = acc[ai][bj][m][n]; s += (x[0] * x[0] + x[1] * x[1]) + (x[2] * x[2] + x[3] * x[3]); }
                ss[ai * 4 + m] = s; }
#pragma unroll
        for (int it = 0; it < 8; ++it) ss[it] += shx(ss[it], 16, ln);
#pragma unroll
        for (int it = 0; it < 8; ++it) ss[it] += shx(ss[it], 32, ln);
#pragma unroll
        for (int ai = 0; ai < 2; ++ai)
#pragma unroll
            for (int m = 0; m < 4; ++m) {
                const int rr = ai * 128 + wr * 64 + m * 16 + fr;
                const float rstd = __builtin_amdgcn_rsqf(ss[ai * 4 + m] * (1.0f / 64.0f) + RMS_EPS) * osc;
                f32x4 x1[2], x2[2];
#pragma unroll
                for (int n = 0; n < 2; ++n) { x1[n] = acc[ai][0][m][n] * rstd * gv[0][n]; x2[n] = acc[ai][1][m][n] * rstd * gv[1][n]; }
                if (!isctx) {
                    const int t = (jj - 1) * 256 + rr; const float pos = (float)(use_row ? (t >> 6) : (t & 63));
#pragma unroll
                    for (int n = 0; n < 2; ++n)
#pragma unroll
                        for (int j = 0; j < 4; ++j) { const float a = pos * invf[4 * n + j]; const float c = __builtin_amdgcn_cosf(a), s = __builtin_amdgcn_sinf(a);
                            const float p = x1[n][j], q = x2[n][j]; x1[n][j] = p * c - q * s; x2[n][j] = p * s + q * c; }
                }
                bf16_t* rowp = dst + (size_t)(u.pm * 256 + rr) * 1024 + 64 * sub + 8 * fq;
                u32x4 w; w.x = pk_bf16(x1[0][0], x1[0][1]); w.y = pk_bf16(x1[0][2], x1[0][3]); w.z = pk_bf16(x1[1][0], x1[1][1]); w.w = pk_bf16(x1[1][2], x1[1][3]);
                stg<u32x4>(rowp, w);
                w.x = pk_bf16(x2[0][0], x2[0][1]); w.y = pk_bf16(x2[0][2], x2[0][3]); w.z = pk_bf16(x2[1][0], x2[1][1]); w.w = pk_bf16(x2[1][2], x2[1][3]);
                stg<u32x4>(rowp + 32, w);
            }
    }
};

struct ProbDense {
    static constexpr bool GATHER = false;
    int K; const char* A0; const char* A1; int pm_split; const char* Bt; pg8::GridOrder go; int G, c;
    DI bool next(int i, Unit& u) const { u.kind = 0; return go.map((long)i * G + c, u.pm, u.pn); }
    DI const char* a_ptr(const Unit& u) const { return u.pm < pm_split ? A0 + (size_t)u.pm * 512 * K : A1 + (size_t)(u.pm - pm_split) * 512 * K; }
    DI const char* b_ptr(const Unit& u) const { return Bt + (size_t)u.pn * 512 * K; }
};

struct ProbWIN {
    static constexpr bool GATHER = false;
    int K; const char* abuf; const char* win; pg8::GridOrder go; int G, c;
    DI bool next(int i, Unit& u) const {
        const long L = (long)i * G + c;
        if (L < 144 * 20) { u.kind = 0; return go.map(L, u.pm, u.pn); }
        const long r = L - 144 * 20; if (r >= 144 * 12) return false;
        u.kind = 1; u.pm = (int)(r % 12); u.pn = (int)(r / 12); return true;
    }
    DI const char* a_ptr(const Unit& u) const { return u.kind == 0 ? abuf + (size_t)u.pm * (256 * 1024 * 2) : win + (size_t)(4 + u.pm) * (256 * 1024 * 2); }
    DI const char* b_ptr(const Unit& u) const { return u.kind == 0 ? win + (size_t)(u.pn < 4 ? u.pn : 12 + u.pn) * (256 * 1024 * 2) : abuf + (size_t)u.pn * (256 * 1024 * 2); }
};
struct EpiWIN {
    static constexpr bool PERM = true;
    bf16_t* RQ; bf16_t* RG; bf16_t* RKT; bf16_t* RVT; int pm0; const float* cosT; const float* sinT; const float* cosTT; const float* sinTT;
    DI void operator()(const f32x4 (&acc)[2][2][4][2], const Unit& u, int wr, int wc, int fr, int fq) const {
        if (u.kind == 0) {
            const int gpm = pm0 + u.pm, jj = gpm % 9; const bool isctx = (jj == 0); const bool isq = u.pn < 4;
            float invf[8];
#pragma unroll
            for (int k = 0; k < 8; ++k) invf[k] = __builtin_amdgcn_exp2f(-(float)((32 * wc + 8 * fq + k) & 63) * (13.287712379549449f / 64.0f)) * 0.15915494309189535f;
#pragma unroll
            for (int ai = 0; ai < 2; ++ai)
#pragma unroll
                for (int m = 0; m < 4; ++m) {
                    const int rr = ai * 128 + wr * 64 + m * 16 + fr;
                    f32x4 x1[2], x2[2];
#pragma unroll
                    for (int n = 0; n < 2; ++n) { x1[n] = acc[ai][0][m][n]; x2[n] = acc[ai][1][m][n]; }
                    if (isq) {
                        if (!isctx) {
                            const int t = (jj - 1) * 256 + rr; const float pos = (float)((wc < 2) ? (t >> 6) : (t & 63));
#pragma unroll
                            for (int n = 0; n < 2; ++n)
#pragma unroll
                                for (int j = 0; j < 4; ++j) { const float a = pos * invf[4 * n + j]; const float c = __builtin_amdgcn_cosf(a), s = __builtin_amdgcn_sinf(a);
                                    const float p = x1[n][j], q = x2[n][j]; x1[n][j] = p * c - q * s; x2[n][j] = p * s + q * c; }
                        }
                    } else {
#pragma unroll
                        for (int n = 0; n < 2; ++n)
#pragma unroll
                            for (int j = 0; j < 4; ++j) { x1[n][j] = silu_f(x1[n][j]); x2[n][j] = silu_f(x2[n][j]); }
                    }
                    bf16_t* rowp = isq ? RQ + (size_t)(u.pm * 256 + rr) * 1024 + u.pn * 256 + wc * 32 + 8 * fq : RG + (size_t)(u.pm * 256 + rr) * 4096 + (u.pn - 4) * 256 + wc * 32 + 8 * fq;
                    u32x4 w; w.x = pk_bf16(x1[0][0], x1[0][1]); w.y = pk_bf16(x1[0][2], x1[0][3]); w.z = pk_bf16(x1[1][0], x1[1][1]); w.w = pk_bf16(x1[1][2], x1[1][3]);
                    stg<u32x4>(rowp, w);
                    w.x = pk_bf16(x2[0][0], x2[0][1]); w.y = pk_bf16(x2[0][2], x2[0][3]); w.z = pk_bf16(x2[1][0], x2[1][1]); w.w = pk_bf16(x2[1][2], x2[1][3]);
                    stg<u32x4>(rowp + 128, w);
                }
            return;
        }
        const int gpm = pm0 + u.pn, jj = gpm % 9; const bool isctx = (jj == 0); const bool isk = u.pm < 4;
        if (isk) {
#pragma unroll
            for (int m = 0; m < 4; ++m) {
                const int f = wr * 64 + m * 16 + fr;
#pragma unroll
                for (int bj = 0; bj < 2; ++bj) {
                    f32x4 x1[2], x2[2];
#pragma unroll
                    for (int n = 0; n < 2; ++n) { x1[n] = acc[0][bj][m][n] * 0.0625f; x2[n] = acc[1][bj][m][n] * 0.0625f; }
                    const int tl = bj * 128 + wc * 32 + 8 * fq;
                    if (!isctx) {
                        const int t = (jj - 1) * 256 + tl;
                        const float ivf = __builtin_amdgcn_exp2f(-(float)(m * 16 + fr) * (13.287712379549449f / 64.0f)) * 0.15915494309189535f;
#pragma unroll
                        for (int n = 0; n < 2; ++n)
#pragma unroll
                            for (int j = 0; j < 4; ++j) { const int tt = t + 4 * n + j; const float a = (float)(wr == 0 ? (tt >> 6) : (tt & 63)) * ivf; const float c = __builtin_amdgcn_cosf(a), s = __builtin_amdgcn_sinf(a);
                                const float p = x1[n][j], q = x2[n][j]; x1[n][j] = p * c - q * s; x2[n][j] = p * s + q * c; }
                    }
                    bf16_t* p1 = RKT + ((size_t)(u.pn * 8 + 4 * bj + wc) * 1024 + (u.pm * 256 + f)) * 32 + 8 * fq;
                    u32x4 w; w.x = pk_bf16(x1[0][0], x1[0][1]); w.y = pk_bf16(x1[0][2], x1[0][3]); w.z = pk_bf16(x1[1][0], x1[1][1]); w.w = pk_bf16(x1[1][2], x1[1][3]);
                    stg<u32x4>(p1, w);
                    w.x = pk_bf16(x2[0][0], x2[0][1]); w.y = pk_bf16(x2[0][2], x2[0][3]); w.z = pk_bf16(x2[1][0], x2[1][1]); w.w = pk_bf16(x2[1][2], x2[1][3]);
                    stg<u32x4>(p1 + 128 * 32, w);
                }
            }
        } else {
#pragma unroll
            for (int ai = 0; ai < 2; ++ai)
#pragma unroll
                for (int m = 0; m < 4; ++m) {
                    const int f = (u.pm - 4) * 256 + ai * 128 + wr * 64 + m * 16 + fr;
#pragma unroll
                    for (int bj = 0; bj < 2; ++bj) { const f32x4 v0 = acc[ai][bj][m][0], v1 = acc[ai][bj][m][1];
                        u32x4 w; w.x = pk_bf16(v0[0], v0[1]); w.y = pk_bf16(v0[2], v0[3]); w.z = pk_bf16(v1[0], v1[1]); w.w = pk_bf16(v1[2], v1[3]);
                        stg<u32x4>(RVT + ((size_t)(u.pn * 8 + 4 * bj + wc) * 2048 + f) * 32 + 8 * fq, w); }
                }
        }
    }
};

struct EpiResid {
    static constexpr bool PERM = true;
    const float* xin_ctx; const float* xin_lat; bf16_t* hb; const float* modbase; int first;
    DI void operator()(const f32x4 (&acc)[2][2][4][2], const Unit& u, int wr, int wc, int fr, int fq) const {
        const int b = u.pm / 9, jj = u.pm % 9; const bool isctx = (jj == 0);
        const float* gate = modbase + (size_t)(isctx ? 32 : b) * 6144 + 2048;
        const int col0 = u.pn * 256 + wc * 32 + 8 * fq;
        f32x4 gv[2][2];
#pragma unroll
        for (int bj = 0; bj < 2; ++bj)
#pragma unroll
            for (int n = 0; n < 2; ++n) gv[bj][n] = ldg<f32x4>(gate + col0 + bj * 128 + n * 4);
        const size_t rbase = isctx ? (size_t)b * 256 : (size_t)b * 2048 + (size_t)(jj - 1) * 256;
        const float* xi = isctx ? xin_ctx : xin_lat;
#pragma unroll
        for (int ai = 0; ai < 2; ++ai) {
            f32x4 hv[4][2][2];
#pragma unroll
            for (int m = 0; m < 4; ++m) { const int rr = ai * 128 + wr * 64 + m * 16 + fr;
#pragma unroll
                for (int bj = 0; bj < 2; ++bj) {
                    if (first) { const float* p = xi + (rbase + rr) * 1024 + col0 + bj * 128; hv[m][bj][0] = ldg<f32x4>(p); hv[m][bj][1] = ldg<f32x4>(p + 4); }
                    else { const u32x4 w = ldg<u32x4>(hb + (size_t)(u.pm * 256 + rr) * 1024 + col0 + bj * 128);
                        hv[m][bj][0] = (f32x4){bf_lo(w.x), bf_hi(w.x), bf_lo(w.y), bf_hi(w.y)}; hv[m][bj][1] = (f32x4){bf_lo(w.z), bf_hi(w.z), bf_lo(w.w), bf_hi(w.w)}; }
                } }
#pragma unroll
            for (int m = 0; m < 4; ++m) { const int rr = ai * 128 + wr * 64 + m * 16 + fr;
#pragma unroll
                for (int bj = 0; bj < 2; ++bj) { const f32x4 v0 = hv[m][bj][0] + gv[bj][0] * acc[ai][bj][m][0], v1 = hv[m][bj][1] + gv[bj][1] * acc[ai][bj][m][1];
                    u32x4 w; w.x = pk_bf16(v0[0], v0[1]); w.y = pk_bf16(v0[2], v0[3]); w.z = pk_bf16(v1[0], v1[1]); w.w = pk_bf16(v1[2], v1[3]);
                    stg<u32x4>(hb + (size_t)(u.pm * 256 + rr) * 1024 + col0 + bj * 128, w); } }
        }
    }
};

template <bool GATHER_>
struct ProbMoE {
    static constexpr bool GATHER = GATHER_;
    int K; const char* A; const char* W; const LAS int* tile_e; const LAS int* rowtok; pg8::GridOrder go; int G, c;
    DI bool next(int i, Unit& u) const { u.kind = 0; return go.map((long)i * G + c, u.pm, u.pn); }
    DI const char* a_ptr(const Unit& u) const { return GATHER ? A : A + (size_t)u.pm * 512 * K; }
    DI const char* b_ptr(const Unit& u) const { return W + ((size_t)tile_e[u.pm] * 4 + u.pn) * 512 * K; }
};
struct EpiSwiGLU {
    static constexpr bool PERM = true;
    bf16_t* act;
    DI void operator()(const f32x4 (&acc)[2][2][4][2], const Unit& u, int wr, int wc, int fr, int fq) const {
#pragma unroll
        for (int ai = 0; ai < 2; ++ai)
#pragma unroll
            for (int m = 0; m < 4; ++m) {
                bf16_t* rowp = act + (size_t)(u.pm * 256 + ai * 128 + wr * 64 + m * 16 + fr) * 512 + u.pn * 128 + wc * 16 + 4 * fq;
#pragma unroll
                for (int bj = 0; bj < 2; ++bj) { const f32x4 g = acc[ai][bj][m][0], up = acc[ai][bj][m][1];
                    u32x2 w; w.x = pk_bf16(silu_f(g[0]) * up[0], silu_f(g[1]) * up[1]); w.y = pk_bf16(silu_f(g[2]) * up[2], silu_f(g[3]) * up[3]);
                    stg<u32x2>(rowp + bj * 64, w); }
            }
    }
};
struct EpiDown {
    static constexpr bool PERM = true;
    bf16_t* y2; const int* rowmap; const float* wsel;
    DI void operator()(const f32x4 (&acc)[2][2][4][2], const Unit& u, int wr, int wc, int fr, int fq) const {
        int dest[8]; float wv[8];
#pragma unroll
        for (int it = 0; it < 8; ++it) dest[it] = ldg<int>(rowmap + u.pm * 256 + (it >> 2) * 128 + wr * 64 + (it & 3) * 16 + fr);
#pragma unroll
        for (int it = 0; it < 8; ++it) wv[it] = ldg<float>(wsel + (dest[it] >= 0 ? dest[it] : 0));
#pragma unroll
        for (int ai = 0; ai < 2; ++ai)
#pragma unroll
            for (int m = 0; m < 4; ++m) {
                const int d = dest[ai * 4 + m];
                if (d >= 0) {
                    const float w = wv[ai * 4 + m];
                    bf16_t* rowp = y2 + (size_t)d * 1024 + u.pn * 256 + wc * 32 + 8 * fq;
#pragma unroll
                    for (int bj = 0; bj < 2; ++bj) { const f32x4 v0 = acc[ai][bj][m][0] * w, v1 = acc[ai][bj][m][1] * w;
                        u32x4 o; o.x = pk_bf16(v0[0], v0[1]); o.y = pk_bf16(v0[2], v0[3]); o.z = pk_bf16(v1[0], v1[1]); o.w = pk_bf16(v1[2], v1[3]);
                        stg<u32x4>(rowp + bj * 128, o); }
                }
            }
    }
};

template <int MODE>
DI void transpose_tile(const Frame& F, const float* src, const float* src2, int ld, bf16_t* dst, int K, int k0, int n0) {
    LAS float* tl = (LAS float*)F.lds;
    __syncthreads();
#pragma unroll
    for (int i = 0; i < 8; ++i) {
        const int idx = F.tid + 512 * i, kk = idx >> 6, nn = idx & 63, np = n0 + nn;
        float v;
        if (MODE == 0) v = ldg<float>(src + (size_t)(k0 + kk) * ld + np);
        else if (MODE == 1) { const int t = np >> 8, p = np & 255, bj = p >> 7, wc = (p >> 5) & 3, r = p & 31; v = ldg<float>(src + (size_t)(k0 + kk) * ld + t * 256 + wc * 64 + bj * 32 + r); }
        else { const int hid = 4 * (np >> 3) + (np & 3); v = ldg<float>(((np & 4) ? src2 : src) + (size_t)(k0 + kk) * ld + hid); }
        tl[nn * 65 + kk] = v;
    }
    __syncthreads();
#pragma unroll
    for (int i = 0; i < 4; ++i) {
        const int idx = F.tid + 512 * i, nn = idx >> 5, kp = (idx & 31) * 2;
        stg<unsigned>(dst + (size_t)(n0 + nn) * K + k0 + kp, pk_bf16(tl[nn * 65 + kp], tl[nn * 65 + kp + 1]));
    }
}
template <int MODE>
DI int transpose_mat(const Frame& F, const float* src, const float* src2, int ld, bf16_t* dst, int K, int Np, int u0, int u_first, int u_stride) {
    const int tk = K / 64, tn = Np / 64, ntl = tk * tn;
    int u = u_first; if (u < u0) { const int d = (u0 - u + u_stride - 1) / u_stride; u += d * u_stride; }
    for (; u < u0 + ntl; u += u_stride) { const int l = u - u0; transpose_tile<MODE>(F, src, src2, ld, dst, K, (l % tk) * 64, (l / tk) * 64); }
    return ntl;
}
DI void moe_tile_load(const Frame& F, const float* wg, const float* wu, const float* wd, int u, float (&v)[8]) {
    const int e = u / 384, l = u % 384;
#pragma unroll
    for (int i = 0; i < 8; ++i) {
        const int idx = F.tid + 512 * i, kk = idx >> 6, nn = idx & 63;
        if (l < 256) { const int np = (l >> 4) * 64 + nn, hid = 4 * (np >> 3) + (np & 3); v[i] = ldg<float>(((np & 4) ? wu : wg) + (size_t)e * DM * MOEH + (size_t)((l & 15) * 64 + kk) * MOEH + hid); }
        else { const int l2 = l - 256; v[i] = ldg<float>(wd + (size_t)e * MOEH * DM + (size_t)((l2 & 7) * 64 + kk) * DM + (l2 >> 3) * 64 + nn); }
    }
}
DI void convert_moe_weights(const Frame& F, int layer) {
    const float* wg = F.a->in[21] + (size_t)layer * NEXP * DM * MOEH; const float* wu = F.a->in[22] + (size_t)layer * NEXP * DM * MOEH; const float* wd = F.a->in[23] + (size_t)layer * NEXP * MOEH * DM;
    bf16_t* WGU = (bf16_t*)(F.ws + WS_WGU); bf16_t* WD = (bf16_t*)(F.ws + WS_WD);
    LAS float* tl = (LAS float*)F.lds;
    constexpr int NT = NEXP * 384;
    float v[8];
    int u = F.bid, par = 0;
    __syncthreads();
    if (u < NT) moe_tile_load(F, wg, wu, wd, u, v);
    for (; u < NT; u += F.G, par ^= 1) {
        LAS float* tb = tl + par * (64 * 65);
#pragma unroll
        for (int i = 0; i < 8; ++i) { const int idx = F.tid + 512 * i; tb[(idx & 63) * 65 + (idx >> 6)] = v[i]; }
        __syncthreads();
        if (u + F.G < NT) moe_tile_load(F, wg, wu, wd, u + F.G, v);
        const int e = u / 384, l = u % 384;
        bf16_t* dst; int K, k0, n0;
        if (l < 256) { dst = WGU + (size_t)e * 1024 * 1024; K = 1024; k0 = (l & 15) * 64; n0 = (l >> 4) * 64; } else { const int l2 = l - 256; dst = WD + (size_t)e * 1024 * 512; K = 512; k0 = (l2 & 7) * 64; n0 = (l2 >> 3) * 64; }
#pragma unroll
        for (int i = 0; i < 4; ++i) { const int idx = F.tid + 512 * i, nn = idx >> 5, kp = (idx & 31) * 2;
            stg<unsigned>(dst + (size_t)(n0 + nn) * K + k0 + kp, pk_bf16(tb[nn * 65 + kp], tb[nn * 65 + kp + 1])); }
    }
    __syncthreads();
}

DI void p0_prologue(const Frame& F) {
    {
        LAS float* red = (LAS float*)F.lds;
        for (int u = F.bid; u < 4 * 96; u += F.G) {
            const int layer = u / 96, col0 = (u % 96) * 64;
            const float* W = F.a->in[6] + (size_t)layer * 1024 * 6144 + col0 + F.lane;
            const float* cp = F.lane < 32 ? F.a->in[1] + F.lane * 1024 : F.a->in[3];
            float acc[33];
#pragma unroll
            for (int r = 0; r < 33; ++r) acc[r] = 0.f;
            const int k0 = F.wave * 128;
            for (int k = k0; k < k0 + 128; ++k) {
                const float w = ldg<float>(W + (size_t)k * 6144);
                const float sv = silu_f(ldg<float>(cp + k));
#pragma unroll
                for (int r = 0; r < 33; ++r) acc[r] += w * __builtin_bit_cast(float, __builtin_amdgcn_readlane(__builtin_bit_cast(int, sv), r));
            }
#pragma unroll
            for (int r = 0; r < 33; ++r) red[(F.wave * 33 + r) * 64 + F.lane] = acc[r];
            __syncthreads();
            float* outp = (float*)(F.ws + WS_ADA) + (size_t)layer * 33 * 6144;
            for (int idx = F.tid; idx < 33 * 64; idx += 512) { const int r = idx >> 6, cl = idx & 63; float v = 0.f;
#pragma unroll
                for (int w8 = 0; w8 < 8; ++w8) v += red[(w8 * 33 + r) * 64 + cl];
                stg<float>(outp + (size_t)r * 6144 + col0 + cl, v + ldg<float>(F.a->in[7] + layer * 6144 + col0 + cl)); }
            __syncthreads();
        }
    }
    {
        float* cda = (float*)(F.ws + WS_ROPE + RP_CDA); float* sda = (float*)(F.ws + WS_ROPE + RP_SDA); float* crt = (float*)(F.ws + WS_ROPE + RP_CRT); float* srt = (float*)(F.ws + WS_ROPE + RP_SRT);
        const int gt = F.bid * 512 + F.tid, gs = F.G * 512;
        for (int idx = gt; idx < 2048 * 32; idx += gs) { const int t = idx >> 5, f = idx & 31; const float pos = f < 16 ? (float)(t >> 6) : (float)(t & 63);
            const float inv = exp2f(-(float)(f & 15) * (13.287712379549449f / 16.0f)); const float a = pos * inv; stg<float>(cda + idx, __cosf(a)); stg<float>(sda + idx, __sinf(a)); }
        for (int idx = gt; idx < 2048 * 128; idx += gs) { const int t = idx >> 7, f = idx & 127; const float pos = f < 64 ? (float)(t >> 6) : (float)(t & 63);
            const float inv = exp2f(-(float)(f & 63) * (13.287712379549449f / 64.0f)); const float a = pos * inv; const float cv = __cosf(a), sv = __sinf(a); stg<float>(crt + idx, cv); stg<float>(srt + idx, sv);
            stg<float>((float*)(F.ws + WS_MISC + MS_CRTT) + f * 2048 + t, cv); stg<float>((float*)(F.ws + WS_MISC + MS_SRTT) + f * 2048 + t, sv); }
    }
    {
        int u0 = 0;
        for (int j = 0; j < 2; ++j) {
            const float* wqkv = F.a->in[8] + (size_t)j * 1024 * 3072;
            u0 += transpose_mat<1>(F, wqkv, nullptr, 3072, (bf16_t*)(F.ws + WS_WQK) + (size_t)j * 2048 * 1024, 1024, 2048, u0, F.bid, F.G);
            u0 += transpose_mat<0>(F, wqkv + 2048, nullptr, 3072, (bf16_t*)(F.ws + WS_WV) + (size_t)j * 1024 * 1024, 1024, 1024, u0, F.bid, F.G);
            u0 += transpose_mat<0>(F, F.a->in[13] + (size_t)j * 1024 * 1024, nullptr, 1024, (bf16_t*)(F.ws + WS_WODA) + (size_t)j * 1024 * 1024, 1024, 1024, u0, F.bid, F.G);
            u0 += transpose_mat<0>(F, F.a->in[14] + (size_t)j * 1024 * 8192, nullptr, 8192, (bf16_t*)(F.ws + WS_WIN) + (size_t)j * 8192 * 1024, 1024, 8192, u0, F.bid, F.G);
            u0 += transpose_mat<0>(F, F.a->in[16] + (size_t)j * 2048 * 1024, nullptr, 1024, (bf16_t*)(F.ws + WS_WORT) + (size_t)j * 1024 * 2048, 2048, 1024, u0, F.bid, F.G);
        }
        convert_moe_weights(F, 0);
    }
}

template <bool SECOND>
DI void norm_phase(const Frame& F, int layer) {
    bf16_t* abuf = (bf16_t*)(F.ws + WS_ABUF);
    bf16_t* hb = (bf16_t*)(F.ws + WS_HB);
    const bf16_t* y2 = (const bf16_t*)(F.ws + WS_PROJ + PJ_Y2);
    const float* ng = F.a->in[SECOND ? 5 : 4] + layer * 1024;
    LAS float* Wl = (LAS float*)F.lds;
    LAS int* lhist = (LAS int*)(F.lds + LDS_MISC + 1024);
    int* eid = (int*)(F.ws + WS_MISC + MS_EID); float* wsel = (float*)(F.ws + WS_MISC + MS_WSEL);
    if (SECOND) {
        const float* wgp = F.a->in[17] + (size_t)layer * 1024 * 4; const float* wep = F.a->in[19] + (size_t)layer * 1024 * 32;
        for (int idx = F.tid; idx < 1024 * 4; idx += 512) { const int k = idx >> 2, o = idx & 3; Wl[o * 1024 + k] = ldg<float>(wgp + idx); }
        for (int idx = F.tid; idx < 1024 * 32; idx += 512) { const int k = idx >> 5, o = idx & 31; Wl[(4 + o) * 1024 + k] = ldg<float>(wep + idx); }
        if (F.tid < 32) lhist[F.tid] = 0;
        __syncthreads();
    }
    const int lane = F.lane;
    for (int r = F.bid * 8 + F.wave; r < T; r += F.G * 8) {
        const int b = r / NTOK, n = r % NTOK; const bool isctx = n < CTXL;
        const size_t hoff = isctx ? ((size_t)b * 256 + n) * 1024 : ((size_t)b * 2048 + (n - 256)) * 1024;
        bf16_t* hrow = hb + (size_t)r * 1024;
        const float* mod = isctx ? mod_ctx(F, layer) : mod_lat(F, layer, b);
        f32x4 x[4];
        if (layer == 0 && !SECOND) { const float* hin = isctx ? F.a->in[2] + hoff : F.a->in[0] + hoff;
#pragma unroll
            for (int i = 0; i < 4; ++i) x[i] = ldg<f32x4>(hin + i * 256 + lane * 4);
        } else {
#pragma unroll
            for (int i = 0; i < 4; ++i) { const u32x2 w = ldg<u32x2>(hrow + i * 256 + lane * 4); x[i] = (f32x4){bf_lo(w.x), bf_hi(w.x), bf_lo(w.y), bf_hi(w.y)}; }
        }
        if (!SECOND && layer > 0) {
            const float* modp = isctx ? mod_ctx(F, layer - 1) : mod_lat(F, layer - 1, b);
#pragma unroll
            for (int i = 0; i < 4; ++i) {
                const u32x2 a = ldg<u32x2>(y2 + (size_t)(2 * r) * 1024 + i * 256 + lane * 4), c = ldg<u32x2>(y2 + (size_t)(2 * r + 1) * 1024 + i * 256 + lane * 4);
                const f32x4 g2 = ldg<f32x4>(modp + 5120 + i * 256 + lane * 4);
                x[i][0] += g2[0] * (bf_lo(a.x) + bf_lo(c.x)); x[i][1] += g2[1] * (bf_hi(a.x) + bf_hi(c.x)); x[i][2] += g2[2] * (bf_lo(a.y) + bf_lo(c.y)); x[i][3] += g2[3] * (bf_hi(a.y) + bf_hi(c.y));
                { u32x2 w; w.x = pk_bf16(x[i][0], x[i][1]); w.y = pk_bf16(x[i][2], x[i][3]); stg<u32x2>(hrow + i * 256 + lane * 4, w); }
            }
        }
        float ss = 0.f;
#pragma unroll
        for (int i = 0; i < 4; ++i) ss += (x[i][0] * x[i][0] + x[i][1] * x[i][1]) + (x[i][2] * x[i][2] + x[i][3] * x[i][3]);
        ss = wave_sum(ss, lane);
        const float rstd = 1.0f / sqrtf(ss * (1.0f / 1024.0f) + RMS_EPS);
        f32x4 v[4];
#pragma unroll
        for (int i = 0; i < 4; ++i) {
            const int c0 = i * 256 + lane * 4;
            const f32x4 g = ldg<f32x4>(ng + c0), sh = ldg<f32x4>(mod + (SECOND ? 3072 : 0) + c0), sc = ldg<f32x4>(mod + (SECOND ? 4096 : 1024) + c0);
            v[i] = (x[i] * rstd * g) * (sc + 1.0f) + sh;
            u32x2 w; w.x = pk_bf16(v[i][0], v[i][1]); w.y = pk_bf16(v[i][2], v[i][3]);
            stg<u32x2>(abuf + (size_t)r * 1024 + c0, w);
        }
        if (SECOND) {
            const float* bg = F.a->in[18] + layer * 4; const float* be = F.a->in[20] + layer * 32;
            float gl[4]; float gmax = -3.0e38f; int gi = 0;
#pragma unroll
            for (int o = 0; o < 4; ++o) {
                float p = 0.f;
#pragma unroll
                for (int i = 0; i < 4; ++i) { const f32x4 w = *(const LAS f32x4*)(Wl + o * 1024 + i * 256 + lane * 4); p += (v[i][0] * w[0] + v[i][1] * w[1]) + (v[i][2] * w[2] + v[i][3] * w[3]); }
                gl[o] = wave_sum(p, lane) + ldg<float>(bg + o);
                if (gl[o] > gmax) { gmax = gl[o]; gi = o; }
            }
            gi = __builtin_amdgcn_readfirstlane(gi);
            float gsum = 0.f;
#pragma unroll
            for (int o = 0; o < 4; ++o) { gsum += __expf(gl[o] - gmax); asm volatile("" : "+v"(gsum)); }
            const float psel = __builtin_amdgcn_rcpf(gsum);
            float el[8];
#pragma unroll
            for (int o = 0; o < 8; ++o) {
                float p = 0.f;
                const LAS float* wr = Wl + (4 + gi * 8 + o) * 1024;
#pragma unroll
                for (int i = 0; i < 4; ++i) { const f32x4 w = *(const LAS f32x4*)(wr + i * 256 + lane * 4); p += (v[i][0] * w[0] + v[i][1] * w[1]) + (v[i][2] * w[2] + v[i][3] * w[3]); }
                el[o] = wave_sum(p, lane) + ldg<float>(be + gi * 8 + o);
            }
            float m1 = -3.0e38f, m2 = -3.0e38f; int i1 = 0, i2 = 0;
#pragma unroll
            for (int o = 0; o < 8; ++o) { if (el[o] > m1) { m1 = el[o]; i1 = o; } }
#pragma unroll
            for (int o = 0; o < 8; ++o) { if (o != i1 && el[o] > m2) { m2 = el[o]; i2 = o; } }
            const float e2 = __expf(m2 - m1), inv = __builtin_amdgcn_rcpf(1.0f + e2);
            if (lane == 0) {
                stg<int>(eid + 2 * r, gi * 8 + i1); stg<int>(eid + 2 * r + 1, gi * 8 + i2); stg<float>(wsel + 2 * r, inv * psel); stg<float>(wsel + 2 * r + 1, e2 * inv * psel);
                __hip_atomic_fetch_add(&lhist[gi * 8 + i1], 1, __ATOMIC_RELAXED, __HIP_MEMORY_SCOPE_WORKGROUP); __hip_atomic_fetch_add(&lhist[gi * 8 + i2], 1, __ATOMIC_RELAXED, __HIP_MEMORY_SCOPE_WORKGROUP);
            }
        }
    }
    if (SECOND) {
        __syncthreads();
        if (F.tid < 32) { const int c = lhist[F.tid]; if (c) __hip_atomic_fetch_add((unsigned*)(F.ws + WS_CTL) + CW_CNT + layer * 64 + F.tid, (unsigned)c, __ATOMIC_RELAXED, __HIP_MEMORY_SCOPE_AGENT); }
    }
}

DI int build_segments(const Frame& F, int layer, LAS int* segs, LAS int* tile_e) {
    __syncthreads();
    if (F.tid == 0) {
        const unsigned* cnt = (const unsigned*)(F.ws + WS_CTL) + CW_CNT + layer * 64;
        int s = 0;
        for (int e = 0; e < 32; ++e) { segs[e] = s; const int c = (int)__hip_atomic_load(cnt + e, __ATOMIC_RELAXED, __HIP_MEMORY_SCOPE_AGENT); segs[40 + e] = c; s += (c + 255) & ~255; }
        segs[32] = s;
    }
    __syncthreads();
    const int ntl = segs[32] >> 8;
    if (tile_e) {
        for (int t = F.tid; t < ntl; t += 512) { int e = 0;
            for (int q = 1; q < 32; ++q) e = (segs[q] <= t * 256) ? q : e;
            tile_e[t] = e; }
        __syncthreads();
    }
    return ntl;
}

DI void sort_phase(const Frame& F, int layer) {
    LAS int* segs = (LAS int*)(F.lds + LDS_MISC + 2048);
    LAS int* lhist = (LAS int*)(F.lds + LDS_MISC + 1024);
    LAS int* lbase = (LAS int*)(F.lds + LDS_MISC + 1024 + 128);
    LAS int* lpos = (LAS int*)F.lds;
    build_segments(F, layer, segs, nullptr);
    const int* eid = (const int*)(F.ws + WS_MISC + MS_EID); int* rowmap = (int*)(F.ws + WS_MISC + MS_ROWMAP);
    const bf16_t* abuf = (const bf16_t*)(F.ws + WS_ABUF); bf16_t* sa = (bf16_t*)(F.ws + WS_PROJ + PJ_SA);
    const int RPB = (T + F.G - 1) / F.G;
    const int r0 = F.bid * RPB, r1 = (r0 + RPB < T) ? r0 + RPB : T;
    const int na = r1 > r0 ? 2 * (r1 - r0) : 0;
    if (F.tid < 32) lhist[F.tid] = 0;
    __syncthreads();
    int ee[2], lp[2];
#pragma unroll
    for (int it = 0; it < 2; ++it) { const int a = F.tid + 512 * it; ee[it] = -1; lp[it] = 0;
        if (a < na) { ee[it] = ldg<int>(eid + 2 * r0 + a); lp[it] = __hip_atomic_fetch_add(&lhist[ee[it]], 1, __ATOMIC_RELAXED, __HIP_MEMORY_SCOPE_WORKGROUP); } }
    __syncthreads();
    if (F.tid < 32) { const int c = lhist[F.tid];
        lbase[F.tid] = segs[F.tid] + (c ? (int)__hip_atomic_fetch_add((unsigned*)(F.ws + WS_CTL) + CW_CUR + layer * 64 + F.tid, (unsigned)c, __ATOMIC_RELAXED, __HIP_MEMORY_SCOPE_AGENT) : 0); }
    __syncthreads();
#pragma unroll
    for (int it = 0; it < 2; ++it) { const int a = F.tid + 512 * it;
        if (a < na) { const int pos = lbase[ee[it]] + lp[it]; lpos[a] = pos; stg<int>(rowmap + pos, 2 * r0 + a); } }
    __syncthreads();
    if (F.bid < 32) { const int e = F.bid; for (int p = segs[e] + segs[40 + e] + F.tid; p < segs[e + 1]; p += 512) stg<int>(rowmap + p, -1); }
    if (F.G < 32 && F.bid == 0) { for (int e = F.G; e < 32; ++e) for (int p = segs[e] + segs[40 + e] + F.tid; p < segs[e + 1]; p += 512) stg<int>(rowmap + p, -1); }
}

constexpr int AT_KROW = 272, AT_VROW = 136, AT_KB = 64 * AT_KROW, AT_VB = 128 * AT_VROW, AT_BUF = AT_KB + AT_VB;
DI void attn_phase(const Frame& F, int layer) {
    const int j = layer >> 1;
    const bf16_t* Qb = (const bf16_t*)(F.ws + WS_PROJ + PJ_Q); const bf16_t* Kb = (const bf16_t*)(F.ws + WS_PROJ + PJ_K); const bf16_t* VT = (const bf16_t*)(F.ws + WS_PROJ + PJ_VT);
    bf16_t* Ob = (bf16_t*)(F.ws + WS_OBUF);
    const int lane = F.lane, lr = lane & 31, lh = lane >> 5;
    const float* lam = F.a->in[11] + j * 256;
    float p01 = ldg<float>(lam + lane) * ldg<float>(lam + 64 + lane), p23 = ldg<float>(lam + 128 + lane) * ldg<float>(lam + 192 + lane);
    p01 = wave_sum(p01, lane); p23 = wave_sum(p23, lane);
    const float lam_init = 0.8f - 0.6f * __expf(-0.3f * (float)layer);
    const float lam_full = __expf(p01) - __expf(p23) + lam_init;
    float mq = fabsf(ldg<float>(F.a->in[9] + j * 64 + lane)), mk = fabsf(ldg<float>(F.a->in[10] + j * 64 + lane));
#pragma unroll
    for (int o = 32; o >= 1; o >>= 1) { mq = fmaxf(mq, shx(mq, o, lane)); mk = fmaxf(mk, shx(mk, o, lane)); }
    const float OFF = 8.0f * LOG2E * mq * mk;
    const float* gsub = F.a->in[12] + j * 128;
    const float osc = 1.0f - lam_init;

    for (int u = F.bid; u < 2304; u += F.G) {
        int b, h, qb, nkt;
        if (u < 2048) {
            int bh;
            if (F.G == 256) { const int i = u >> 8, c = u & 255; bh = i * 32 + (c & 7) * 4 + (c >> 6); qb = 1 + ((c >> 3) & 7); } else { bh = u >> 3; qb = 1 + (u & 7); }
            b = bh >> 3; h = bh & 7; nkt = 36;
        } else { const int uu = u - 2048; b = uu >> 3; h = uu & 7; qb = 0; nkt = 4; }
        const size_t rowbase = (size_t)b * NTOK;
        const size_t qrow = rowbase + qb * 256 + F.wave * 32 + lr;
        __syncthreads();
        const int qlo = 2 * AT_BUF + F.wave * 8192 + lane * 16;
#pragma unroll
        for (int mp = 0; mp < 2; ++mp)
#pragma unroll
            for (int ks = 0; ks < 4; ++ks) *(LAS bf16x8*)(F.lds + qlo + (mp * 4 + ks) * 1024) = ldg<bf16x8>(Qb + qrow * 1024 + h * 128 + mp * 64 + ks * 16 + lh * 8);
        f32x16 O1[4], O2[4];
#pragma unroll
        for (int e = 0; e < 4; ++e)
#pragma unroll
            for (int i = 0; i < 16; ++i) { O1[e][i] = 0.f; O2[e][i] = 0.f; }
        float l1 = 0.f, l2 = 0.f;
        const unsigned kgo = (unsigned)((F.tid >> 4) * 1024 + (F.tid & 15) * 8), vgo = (unsigned)((F.tid >> 3) * T + (F.tid & 7) * 8);
        const int klo = (F.tid >> 4) * AT_KROW + (F.tid & 15) * 16, vlo = AT_KB + (F.tid >> 3) * AT_VROW + (F.tid & 7) * 16;
        const bf16_t* kbase = Kb + rowbase * 1024 + h * 128; const bf16_t* vbase = VT + (size_t)(h * 128) * T + rowbase;
        u32x4 sk[2], sv[2];
#pragma unroll
        for (int i = 0; i < 2; ++i) { sk[i] = ldg<u32x4>(kbase + (size_t)i * 32768 + kgo); sv[i] = ldg<u32x4>(vbase + (size_t)i * 64 * T + vgo); }
#pragma unroll
        for (int i = 0; i < 2; ++i) { *(LAS u32x4*)(F.lds + klo + i * 32 * AT_KROW) = sk[i]; *(LAS u32x2*)(F.lds + vlo + i * 64 * AT_VROW) = (u32x2){sv[i].x, sv[i].y}; *(LAS u32x2*)(F.lds + vlo + i * 64 * AT_VROW + 8) = (u32x2){sv[i].z, sv[i].w}; }
        __syncthreads();
        for (int t = 0; t < nkt; ++t) {
            const int cb = (t & 1) * AT_BUF, nb = ((t + 1) & 1) * AT_BUF;
            if (t + 1 < nkt) {
#pragma unroll
                for (int i = 0; i < 2; ++i) { sk[i] = ldg<u32x4>(kbase + (size_t)(t + 1) * 65536 + (size_t)i * 32768 + kgo); sv[i] = ldg<u32x4>(vbase + (size_t)i * 64 * T + (size_t)(t + 1) * 64 + vgo); }
            }
#pragma unroll 1
            for (int kb = 0; kb < 2; ++kb) {
                bf16x8 P[2][2];
#pragma unroll
                for (int mp = 0; mp < 2; ++mp) {
                    f32x16 S;
#pragma unroll
                    for (int i = 0; i < 16; ++i) S[i] = 0.f;
#pragma unroll
                    for (int ks = 0; ks < 4; ++ks) {
                        const bf16x8 kf = *(const LAS bf16x8*)(F.lds + cb + (kb * 32 + lr) * AT_KROW + (mp * 64 + ks * 16 + lh * 8) * 2);
                        const bf16x8 qf = *(const LAS bf16x8*)(F.lds + qlo + (mp * 4 + ks) * 1024);
                        S = __builtin_amdgcn_mfma_f32_32x32x16_bf16(kf, qf, S, 0, 0, 0);
                    }
                    float ps = 0.f;
#pragma unroll
                    for (int i = 0; i < 16; ++i) { S[i] = __builtin_amdgcn_exp2f(S[i] - OFF); ps += S[i]; }
                    if (mp == 0) l1 += ps; else l2 += ps;
#pragma unroll
                    for (int s = 0; s < 2; ++s) { u32x4 w; w.x = pk_bf16(S[8 * s], S[8 * s + 1]); w.y = pk_bf16(S[8 * s + 2], S[8 * s + 3]); w.z = pk_bf16(S[8 * s + 4], S[8 * s + 5]); w.w = pk_bf16(S[8 * s + 6], S[8 * s + 7]);
                        P[mp][s] = __builtin_bit_cast(bf16x8, w); }
                }
#pragma unroll
                for (int eb = 0; eb < 4; ++eb)
#pragma unroll
                    for (int s = 0; s < 2; ++s) {
                        const int vo = cb + AT_KB + (eb * 32 + lr) * AT_VROW + (kb * 32 + 16 * s + 4 * lh) * 2;
                        const s16x4 lo = *(const LAS s16x4*)(F.lds + vo), hi = *(const LAS s16x4*)(F.lds + vo + 16);
                        const bf16x8 vf = __builtin_shufflevector(lo, hi, 0, 1, 2, 3, 4, 5, 6, 7);
                        O1[eb] = __builtin_amdgcn_mfma_f32_32x32x16_bf16(vf, P[0][s], O1[eb], 0, 0, 0);
                        O2[eb] = __builtin_amdgcn_mfma_f32_32x32x16_bf16(vf, P[1][s], O2[eb], 0, 0, 0);
                        if (s == 1) __builtin_amdgcn_sched_barrier(0);
                    }
            }
            if (t + 1 < nkt) {
#pragma unroll
                for (int i = 0; i < 2; ++i) { *(LAS u32x4*)(F.lds + nb + klo + i * 32 * AT_KROW) = sk[i]; *(LAS u32x2*)(F.lds + nb + vlo + i * 64 * AT_VROW) = (u32x2){sv[i].x, sv[i].y}; *(LAS u32x2*)(F.lds + nb + vlo + i * 64 * AT_VROW + 8) = (u32x2){sv[i].z, sv[i].w}; }
            }
            __syncthreads();
        }
        l1 += shx(l1, 32, lane); l2 += shx(l2, 32, lane);
        const float i1 = 1.0f / l1, i2 = lam_full / l2;
        float ss = 0.f;
#pragma unroll
        for (int e = 0; e < 4; ++e)
#pragma unroll
            for (int i = 0; i < 16; ++i) { const float o = O1[e][i] * i1 - O2[e][i] * i2; O1[e][i] = o; ss += o * o; }
        ss += shx(ss, 32, lane);
        const float rstd = __builtin_amdgcn_rsqf(ss * (1.0f / 128.0f) + RMS_EPS) * osc;
        bf16_t* orow = Ob + qrow * 1024 + h * 128;
#pragma unroll
        for (int e = 0; e < 4; ++e)
#pragma unroll
            for (int g4 = 0; g4 < 4; ++g4) {
                const int e0 = e * 32 + 8 * g4 + 4 * lh;
                const f32x4 gs = ldg<f32x4>(gsub + e0);
                u32x2 w; w.x = pk_bf16(O1[e][4 * g4] * rstd * gs[0], O1[e][4 * g4 + 1] * rstd * gs[1]); w.y = pk_bf16(O1[e][4 * g4 + 2] * rstd * gs[2], O1[e][4 * g4 + 3] * rstd * gs[3]);
                stg<u32x2>(orow + e0, w);
            }
    }
    __syncthreads();
}

constexpr int SC_Q = 0, SC_QROW = 528, SC_K = 32 * SC_QROW, SC_V = SC_K + 16384, SC_BUF = SC_V + 16384, SC_S = 2 * SC_BUF, SC_SROW = 80, SC_RED = SC_S + 2 * 32 * SC_SROW, SC_Y = SC_RED + 1024, SC_YROW = 528;
DI void scan_phase(const Frame& F, int layer, int hf) {
    const int j = layer >> 1;
    const bf16_t* RQ = (const bf16_t*)(F.ws + WS_PROJ + PJ_RQ); bf16_t* RG = (bf16_t*)(F.ws + WS_PROJ + PJ_RG);
    const bf16_t* RKT = (const bf16_t*)(F.ws + WS_PROJ + PJ_RKT); const bf16_t* RVT = (const bf16_t*)(F.ws + WS_PROJ + PJ_RVT);
    float* ssqb = (float*)(F.ws + WS_MISC + MS_SSQ);
    const int tid = F.tid;
    for (int u = F.bid; u < 256; u += F.G) {
        int bl, h, dir, eh;
        if (F.G == 256) { const int base = (u >> 5) * 8 + (u & 7), var = (u >> 3) & 3; bl = base >> 2; h = base & 3; dir = var >> 1; eh = var & 1; }
        else { bl = u >> 4; h = (u >> 2) & 3; dir = (u >> 1) & 1; eh = u & 1; }
        const float l2g = __log2f(1.0f - __expf(ldg<float>(F.a->in[15] + j * 8 + dir * 4 + h)));
        const float g32 = __builtin_amdgcn_exp2f(32.0f * l2g);
        const int sgn = dir ? -1 : 1, kd_a = dir ? 0 : 31, qd_a = dir ? 32 : 1;
        const size_t rb = (size_t)bl * NTOK;
        const bf16_t* qbase = RQ + rb * 1024 + h * 256;
        const bf16_t* ktbase = RKT + ((size_t)(rb >> 5) * 1024 + h * 256) * 32;
        const bf16_t* vtbase = RVT + ((size_t)(rb >> 5) * 2048 + h * 512 + eh * 256) * 32;
        bf16_t* gbase = RG + (rb + (tid >> 4)) * 4096 + dir * 2048 + h * 512 + eh * 256 + (tid & 15) * 16;
        const int qt = tid >> 5, qc = tid & 31;
        const unsigned qgo = (unsigned)(qt * 1024 + qc * 8);
        const int ql0 = SC_Q + qt * SC_QROW + qc * 16, ql1 = ql0 + 16 * SC_QROW;
        const int kd = tid >> 2, kc = tid & 3;
        const unsigned kgo = (unsigned)(kd * 32 + kc * 8);
        const int kl = kd * 64 + (((kc ^ (kd >> 2)) & 3) << 4);
        f32x16 S[8];
#pragma unroll
        for (int d = 0; d < 8; ++d)
#pragma unroll
            for (int i = 0; i < 16; ++i) S[d][i] = 0.f;
        u32x4 sq[2], sk[2], sv[2];
        __syncthreads();
        {
            const int tok0 = dir ? 224 : 0;
#pragma unroll
            for (int i = 0; i < 2; ++i) { sq[i] = ldg<u32x4>(qbase + (size_t)(tok0 + 16 * i) * 1024 + qgo); sk[i] = ldg<u32x4>(ktbase + (size_t)tok0 * 1024 + i * 4096 + kgo); sv[i] = ldg<u32x4>(vtbase + (size_t)tok0 * 2048 + i * 4096 + kgo); }
            *(LAS u32x4*)(F.lds + ql0) = sq[0]; *(LAS u32x4*)(F.lds + ql1) = sq[1];
#pragma unroll
            for (int i = 0; i < 2; ++i) { *(LAS u32x4*)(F.lds + SC_K + kl + i * 8192) = sk[i]; *(LAS u32x4*)(F.lds + SC_V + kl + i * 8192) = sv[i]; }
        }
        __syncthreads();
        for (int ci = 0; ci < 72; ++ci) {
            const int tok0 = dir ? 32 * ((ci < 8 ? 7 : 79) - ci) : 32 * ci;
            const int t2 = launder(tid); const int lane = t2 & 63, lr = lane & 31, lh = lane >> 5, w = __builtin_amdgcn_readfirstlane(t2 >> 6), op = t2 >> 4, oc = t2 & 15;
            float l2c = l2g; asm volatile("" : "+v"(l2c));
            const int cb = (ci & 1) * SC_BUF, nb = SC_BUF - cb, sb = SC_S + (ci & 1) * 32 * SC_SROW;
            if (ci + 1 < 72) {
                const int cn = ci + 1; const int tn = dir ? 32 * ((cn < 8 ? 7 : 79) - cn) : 32 * cn;
#pragma unroll
                for (int i = 0; i < 2; ++i) { sq[i] = ldg<u32x4>(qbase + (size_t)(tn + 16 * i) * 1024 + qgo); sk[i] = ldg<u32x4>(ktbase + (size_t)tn * 1024 + i * 4096 + kgo); sv[i] = ldg<u32x4>(vtbase + (size_t)tn * 2048 + i * 4096 + kgo); }
            }
            const u32x4 gt0 = ldg<u32x4>(gbase + (size_t)tok0 * 4096), gt1 = ldg<u32x4>(gbase + (size_t)tok0 * 4096 + 8);
            if (w < 4) {
                const int p0 = 16 * (w >> 1), m0 = 16 * (w & 1);
                const int l15 = lane & 15, g4 = lane >> 4, tq = l15 >> 2, tp = l15 & 3;
                f32x4 sc = {0.f, 0.f, 0.f, 0.f};
                const bool dead = sgn * (p0 - m0) < 0;
                if (!dead) {
#pragma unroll
                    for (int ks = 0; ks < 8; ++ks) {
                        const int prow = p0 + l15, qchunk = 4 * ks + g4;
                        const bf16x8 af = *(const LAS bf16x8*)(F.lds + cb + SC_Q + prow * SC_QROW + qchunk * 16);
                        const int d0 = 32 * ks + 8 * g4 + tq, cc = (m0 >> 3) + (tp >> 1);
                        const s16x4 b0 = __builtin_amdgcn_ds_read_tr16_b64_v4i16((LAS s16x4*)(F.lds + cb + SC_K + d0 * 64 + (((cc ^ (d0 >> 2)) & 3) << 4) + 8 * (tp & 1)));
                        const s16x4 b1 = __builtin_amdgcn_ds_read_tr16_b64_v4i16((LAS s16x4*)(F.lds + cb + SC_K + (d0 + 4) * 64 + (((cc ^ ((d0 + 4) >> 2)) & 3) << 4) + 8 * (tp & 1)));
                        const bf16x8 bfr = __builtin_shufflevector(b0, b1, 0, 1, 2, 3, 4, 5, 6, 7);
                        sc = __builtin_amdgcn_mfma_f32_16x16x32_bf16(af, bfr, sc, 0, 0, 0);
                    }
                }
                const int mm = m0 + l15;
#pragma unroll
                for (int r = 0; r < 4; ++r) { const int pp = p0 + 4 * g4 + r; const int df = sgn * (pp - mm);
                    const float v = df >= 0 ? sc[r] * __builtin_amdgcn_exp2f((float)df * l2c) : 0.f;
                    *(LAS bf16_t*)(F.lds + sb + pp * SC_SROW + mm * 2) = (bf16_t)(pk_bf16(v, 0.f) & 0xffffu); }
            }
            __syncthreads();
            bf16x8 vf[2], vd[2];
            {
                const int e = 32 * w + lr;
#pragma unroll
                for (int ks = 0; ks < 2; ++ks) {
                    const int cc = 2 * ks + lh;
                    vf[ks] = *(const LAS bf16x8*)(F.lds + cb + SC_V + e * 64 + (((cc ^ (e >> 2)) & 3) << 4));
                    const u32x4 raw = __builtin_bit_cast(u32x4, vf[ks]); u32x4 o;
                    float kd8[8];
#pragma unroll
                    for (int jj = 0; jj < 8; ++jj) { const int t = 16 * ks + 8 * lh + jj; kd8[jj] = __builtin_amdgcn_exp2f((float)(kd_a - sgn * t) * l2c); }
                    o.x = pk_bf16(bf_lo(raw.x) * kd8[0], bf_hi(raw.x) * kd8[1]); o.y = pk_bf16(bf_lo(raw.y) * kd8[2], bf_hi(raw.y) * kd8[3]);
                    o.z = pk_bf16(bf_lo(raw.z) * kd8[4], bf_hi(raw.z) * kd8[5]); o.w = pk_bf16(bf_lo(raw.w) * kd8[6], bf_hi(raw.w) * kd8[7]);
                    vd[ks] = __builtin_bit_cast(bf16x8, o);
                }
            }
            f32x16 Y;
#pragma unroll
            for (int i = 0; i < 16; ++i) Y[i] = 0.f;
#pragma unroll
            for (int dt = 0; dt < 8; ++dt)
#pragma unroll
                for (int s = 0; s < 2; ++s) {
                    u32x4 pb; pb.x = pk_bf16(S[dt][8 * s], S[dt][8 * s + 1]); pb.y = pk_bf16(S[dt][8 * s + 2], S[dt][8 * s + 3]); pb.z = pk_bf16(S[dt][8 * s + 4], S[dt][8 * s + 5]); pb.w = pk_bf16(S[dt][8 * s + 6], S[dt][8 * s + 7]);
                    const int c0 = 4 * dt + 2 * s;
                    const s16x4 a0 = *(const LAS s16x4*)(F.lds + cb + SC_Q + lr * SC_QROW + c0 * 16 + 8 * lh);
                    const s16x4 a1 = *(const LAS s16x4*)(F.lds + cb + SC_Q + lr * SC_QROW + c0 * 16 + 16 + 8 * lh);
                    const bf16x8 af = __builtin_shufflevector(a0, a1, 0, 1, 2, 3, 4, 5, 6, 7);
                    Y = __builtin_amdgcn_mfma_f32_32x32x16_bf16(af, __builtin_bit_cast(bf16x8, pb), Y, 0, 0, 0);
                }
#pragma unroll
            for (int r = 0; r < 16; ++r) { const int p = (r & 3) + 8 * (r >> 2) + 4 * lh; Y[r] *= __builtin_amdgcn_exp2f((float)(qd_a + sgn * p) * l2c); }
#pragma unroll
            for (int ks = 0; ks < 2; ++ks) {
                const bf16x8 sf = *(const LAS bf16x8*)(F.lds + sb + lr * SC_SROW + (16 * ks + 8 * lh) * 2);
                Y = __builtin_amdgcn_mfma_f32_32x32x16_bf16(sf, vf[ks], Y, 0, 0, 0);
            }
#pragma unroll
            for (int dt = 0; dt < 8; ++dt) {
#pragma unroll
                for (int i = 0; i < 16; ++i) S[dt][i] *= g32;
#pragma unroll
                for (int ks = 0; ks < 2; ++ks) {
                    const int d = 32 * dt + lr, cc = 2 * ks + lh;
                    const bf16x8 kf = *(const LAS bf16x8*)(F.lds + cb + SC_K + d * 64 + (((cc ^ (d >> 2)) & 3) << 4));
                    S[dt] = __builtin_amdgcn_mfma_f32_32x32x16_bf16(kf, vd[ks], S[dt], 0, 0, 0);
                }
            }
            float q2[16];
#pragma unroll
            for (int r = 0; r < 16; ++r) { const float y = Y[r]; q2[r] = y * y;
                *(LAS bf16_t*)(F.lds + SC_Y + ((r & 3) + 8 * (r >> 2) + 4 * lh) * SC_YROW + (w * 32 + lr) * 2) = (bf16_t)(pk_bf16(y, 0.f) & 0xffffu); }
            {
                float a8[8];
#pragma unroll
                for (int i = 0; i < 8; ++i) { const bool hi = lr & 16; const float keep = hi ? q2[i + 8] : q2[i], send = hi ? q2[i] : q2[i + 8]; a8[i] = keep + shx(send, 16, lane); }
                float a4[4];
#pragma unroll
                for (int i = 0; i < 4; ++i) { const bool hi = lr & 8; const float keep = hi ? a8[i + 4] : a8[i], send = hi ? a8[i] : a8[i + 4]; a4[i] = keep + shx(send, 8, lane); }
                float a2[2];
#pragma unroll
                for (int i = 0; i < 2; ++i) { const bool hi = lr & 4; const float keep = hi ? a4[i + 2] : a4[i], send = hi ? a4[i] : a4[i + 2]; a2[i] = keep + shx(send, 4, lane); }
                float a1; { const bool hi = lr & 2; const float keep = hi ? a2[1] : a2[0], send = hi ? a2[0] : a2[1]; a1 = keep + shx(send, 2, lane); }
                a1 += shx(a1, 1, lane);
                const int r = (lr >> 1) & 15, p = (r & 3) + 8 * (r >> 2) + 4 * lh;
                if (!(lr & 1)) *(LAS float*)(F.lds + SC_RED + (w * 32 + p) * 4) = a1;
            }
            if (ci + 1 < 72) {
                *(LAS u32x4*)(F.lds + nb + ql0) = sq[0]; *(LAS u32x4*)(F.lds + nb + ql1) = sq[1];
#pragma unroll
                for (int i = 0; i < 2; ++i) { *(LAS u32x4*)(F.lds + nb + SC_K + kl + i * 8192) = sk[i]; *(LAS u32x4*)(F.lds + nb + SC_V + kl + i * 8192) = sv[i]; }
            }
            __syncthreads();
            {
                const u32x4 y0 = *(const LAS u32x4*)(F.lds + SC_Y + op * SC_YROW + oc * 32), y1 = *(const LAS u32x4*)(F.lds + SC_Y + op * SC_YROW + oc * 32 + 16);
                u32x4 z0, z1;
                z0.x = pk_bf16(bf_lo(y0.x) * bf_lo(gt0.x), bf_hi(y0.x) * bf_hi(gt0.x)); z0.y = pk_bf16(bf_lo(y0.y) * bf_lo(gt0.y), bf_hi(y0.y) * bf_hi(gt0.y));
                z0.z = pk_bf16(bf_lo(y0.z) * bf_lo(gt0.z), bf_hi(y0.z) * bf_hi(gt0.z)); z0.w = pk_bf16(bf_lo(y0.w) * bf_lo(gt0.w), bf_hi(y0.w) * bf_hi(gt0.w));
                z1.x = pk_bf16(bf_lo(y1.x) * bf_lo(gt1.x), bf_hi(y1.x) * bf_hi(gt1.x)); z1.y = pk_bf16(bf_lo(y1.y) * bf_lo(gt1.y), bf_hi(y1.y) * bf_hi(gt1.y));
                z1.z = pk_bf16(bf_lo(y1.z) * bf_lo(gt1.z), bf_hi(y1.z) * bf_hi(gt1.z)); z1.w = pk_bf16(bf_lo(y1.w) * bf_lo(gt1.w), bf_hi(y1.w) * bf_hi(gt1.w));
                stg<u32x4>(gbase + (size_t)tok0 * 4096, z0); stg<u32x4>(gbase + (size_t)tok0 * 4096 + 8, z1);
            }
            if (tid < 32) { float s = 0.f;
#pragma unroll
                for (int ww = 0; ww < 8; ++ww) s += *(const LAS float*)(F.lds + SC_RED + (ww * 32 + tid) * 4);
                stg<float>(ssqb + (((size_t)eh * 2 + dir) * HROWS + rb + tok0 + tid) * 4 + h, s); }
        }
    }
    __syncthreads();
}

DI void comb_phase(const Frame& F, int hf) {
    const bf16_t* PJ = (const bf16_t*)(F.ws + WS_PROJ + PJ_RG);
    const float* ssqb = (const float*)(F.ws + WS_MISC + MS_SSQ);
    bf16_t* O = (bf16_t*)(F.ws + (hf == 0 ? WS_OBUF : WS_ABUF));
    for (int r = F.bid * 8 + F.wave; r < 36864; r += F.G * 8) {
#pragma unroll
        for (int i = 0; i < 4; ++i) {
            const float sf = ldg<float>(ssqb + ((size_t)(0 * 2 + 0) * 36864 + r) * 4 + i) + ldg<float>(ssqb + ((size_t)(1 * 2 + 0) * 36864 + r) * 4 + i);
            const float sb = ldg<float>(ssqb + ((size_t)(0 * 2 + 1) * 36864 + r) * 4 + i) + ldg<float>(ssqb + ((size_t)(1 * 2 + 1) * 36864 + r) * 4 + i);
            const float rf = 1.0f / sqrtf(sf * (1.0f / 512.0f) + RMS_EPS), rb = 1.0f / sqrtf(sb * (1.0f / 512.0f) + RMS_EPS);
            const int c = i * 512 + F.lane * 8;
            const u32x4 zf = ldg<u32x4>(PJ + (size_t)r * 4096 + c), zb = ldg<u32x4>(PJ + (size_t)r * 4096 + 2048 + c);
            u32x4 w;
            w.x = pk_bf16(rf * bf_lo(zf.x) + rb * bf_lo(zb.x), rf * bf_hi(zf.x) + rb * bf_hi(zb.x));
            w.y = pk_bf16(rf * bf_lo(zf.y) + rb * bf_lo(zb.y), rf * bf_hi(zf.y) + rb * bf_hi(zb.y));
            w.z = pk_bf16(rf * bf_lo(zf.z) + rb * bf_lo(zb.z), rf * bf_hi(zf.z) + rb * bf_hi(zb.z));
            w.w = pk_bf16(rf * bf_lo(zf.w) + rb * bf_lo(zb.w), rf * bf_hi(zf.w) + rb * bf_hi(zb.w));
            stg<u32x4>(O + (size_t)r * 2048 + c, w);
        }
    }
}

DI void final_phase(const Frame& F) {
    const bf16_t* y2 = (const bf16_t*)(F.ws + WS_PROJ + PJ_Y2);
    for (int r = F.bid * 8 + F.wave; r < T; r += F.G * 8) {
        const int b = r / NTOK, n = r % NTOK; if (n < CTXL) continue;
        float* hp = F.out + ((size_t)b * 2048 + (n - 256)) * 1024; const float* modp = mod_lat(F, 3, b);
        const bf16_t* hrow = (const bf16_t*)(F.ws + WS_HB) + (size_t)r * 1024;
#pragma unroll
        for (int i = 0; i < 4; ++i) {
            const u32x2 hw = ldg<u32x2>(hrow + i * 256 + F.lane * 4); f32x4 x = {bf_lo(hw.x), bf_hi(hw.x), bf_lo(hw.y), bf_hi(hw.y)};
            const u32x2 a = ldg<u32x2>(y2 + (size_t)(2 * r) * 1024 + i * 256 + F.lane * 4), c = ldg<u32x2>(y2 + (size_t)(2 * r + 1) * 1024 + i * 256 + F.lane * 4);
            const f32x4 g2 = ldg<f32x4>(modp + 5120 + i * 256 + F.lane * 4);
            x[0] += g2[0] * (bf_lo(a.x) + bf_lo(c.x)); x[1] += g2[1] * (bf_hi(a.x) + bf_hi(c.x)); x[2] += g2[2] * (bf_lo(a.y) + bf_lo(c.y)); x[3] += g2[3] * (bf_hi(a.y) + bf_hi(c.y));
            stg<f32x4>(hp + i * 256 + F.lane * 4, x);
        }
    }
}

constexpr int NPHASE = 50;
__global__ void __launch_bounds__(512, 2) fwd_kernel(Args args) {
    extern __shared__ __attribute__((aligned(16))) unsigned char lds_raw[];
    Frame F;
    F.a = &args;
    F.out = args.out; F.ws = args.ws; F.lds = (LAS unsigned char*)lds_raw;
    F.tid = threadIdx.x; F.lane = F.tid & 63; F.wave = __builtin_amdgcn_readfirstlane(F.tid >> 6); F.G = gridDim.x;
    const int lo = args.ph_lo, hi = args.ph_hi;
    const int wave_s = __builtin_amdgcn_readfirstlane((int)threadIdx.x >> 6);
    volatile LAS unsigned* bst = (volatile LAS unsigned*)(F.lds + LDS_MISC);
    if (F.tid < 4) bst[F.tid] = 0u;
    __syncthreads();
    XcdBarrier bar; bar.bar = (unsigned*)(F.ws + WS_CTL) + CW_BAR; bar.x = 0; bar.st = bst;
    if (hi - lo > 1) bar = xcd_barrier_post((unsigned*)(F.ws + WS_CTL) + CW_BAR, bst);
#ifndef PH_MASK
#define PH_MASK 0xFFFFFFFFu
#endif
#define PHASE(site, p, ...) do { if (((PH_MASK >> (site)) & 1u) && lo <= (p) && (p) < hi) { F.ws = launder_p(args.ws); F.out = (float*)launder_p((unsigned char*)args.out); { int ws_ = wave_s, bi_ = (int)blockIdx.x; asm volatile("" : "+s"(ws_), "+s"(bi_)); F.wave = ws_; F.bid = bi_; } F.lane = lane_id_asm(); F.tid = (F.wave << 6) | F.lane; __VA_ARGS__; if ((p) + 1 < hi) xcd_barrier(bar, (wave_s << 6) | lane_id_asm()); } } while (0)

    PHASE(0, 0, p0_prologue(F));
    for (int layer = 0; layer < DEPTH; ++layer) {
        const int pb = 1 + 12 * layer, j = layer >> 1; const bool isRT = layer & 1;
        PHASE(1, pb + 0, { norm_phase<false>(F, layer); if (layer > 0) convert_moe_weights(F, layer); });
        if (!isRT) {
            PHASE(2, pb + 1, {
                ProbQKV S; S.K = 1024; S.abuf = (const char*)(F.ws + WS_ABUF); S.wqk = (const char*)(F.ws + WS_WQK) + (size_t)j * 2048 * 1024 * 2; S.wv = (const char*)(F.ws + WS_WV) + (size_t)j * 1024 * 1024 * 2;
                S.go.init(NTILE, 8); S.G = F.G; S.c = F.bid;
                EpiQKV E{(bf16_t*)(F.ws + WS_PROJ + PJ_Q), (bf16_t*)(F.ws + WS_PROJ + PJ_K), (bf16_t*)(F.ws + WS_PROJ + PJ_VT), F.a->in[9] + j * 64, F.a->in[10] + j * 64,
                         (const float*)(F.ws + WS_ROPE + RP_CDA), (const float*)(F.ws + WS_ROPE + RP_SDA)};
                pg8::gemm_phase<EpiQKV, ProbQKV, true>(F.lds, S, E, F.tid, F.wave);
            });
            PHASE(3, pb + 2, attn_phase(F, layer));
        } else {
            for (int hf = 0; hf < 2; ++hf) {
                PHASE(4, pb + 1 + 3 * hf, {
                    ProbWIN S; S.K = 1024; S.abuf = (const char*)(F.ws + WS_ABUF) + (size_t)hf * 144 * 256 * 1024 * 2; S.win = (const char*)(F.ws + WS_WIN) + (size_t)j * 8192 * 1024 * 2;
                    S.go.init(144, 20); S.G = F.G; S.c = F.bid;
                    EpiWIN E{(bf16_t*)(F.ws + WS_PROJ + PJ_RQ), (bf16_t*)(F.ws + WS_PROJ + PJ_RG), (bf16_t*)(F.ws + WS_PROJ + PJ_RKT), (bf16_t*)(F.ws + WS_PROJ + PJ_RVT), hf * 144,
                             (const float*)(F.ws + WS_ROPE + RP_CRT), (const float*)(F.ws + WS_ROPE + RP_SRT), (const float*)(F.ws + WS_MISC + MS_CRTT), (const float*)(F.ws + WS_MISC + MS_SRTT)};
                    pg8::gemm_phase<EpiWIN, ProbWIN, true>(F.lds, S, E, F.tid, F.wave);
                });
                PHASE(5, pb + 2 + 3 * hf, scan_phase(F, layer, hf));
                PHASE(6, pb + 3 + 3 * hf, comb_phase(F, hf));
            }
        }
        PHASE(7, pb + 7, {
            ProbDense S; S.G = F.G; S.c = F.bid; S.go.init(NTILE, 4);
            if (!isRT) { S.K = 1024; S.A0 = (const char*)(F.ws + WS_OBUF); S.A1 = S.A0; S.pm_split = 1 << 30; S.Bt = (const char*)(F.ws + WS_WODA) + (size_t)j * 1024 * 1024 * 2; }
            else { S.K = 2048; S.A0 = (const char*)(F.ws + WS_OBUF); S.A1 = (const char*)(F.ws + WS_ABUF); S.pm_split = 144; S.Bt = (const char*)(F.ws + WS_WORT) + (size_t)j * 1024 * 2048 * 2; }
            EpiResid E{F.a->in[2], F.a->in[0], (bf16_t*)(F.ws + WS_HB), (const float*)(F.ws + WS_ADA) + (size_t)layer * 33 * 6144, layer == 0 ? 1 : 0};
            pg8::gemm_phase<EpiResid, ProbDense, true>(F.lds, S, E, F.tid, F.wave);
        });
        PHASE(8, pb + 8, norm_phase<true>(F, layer));
        PHASE(9, pb + 9, sort_phase(F, layer));
        PHASE(10, pb + 10, {
            LAS int* segs = (LAS int*)(F.lds + LDS_MISC + 2048); LAS int* tile_e = (LAS int*)(F.lds + LDS_TILE_E);
            const int ntl = build_segments(F, layer, segs, tile_e);
            ProbMoE<true> S; S.K = 1024; S.A = (const char*)(F.ws + WS_ABUF); S.W = (const char*)(F.ws + WS_WGU); S.tile_e = tile_e; S.go.init(ntl, 4); S.G = F.G; S.c = F.bid;
            LAS int* rowtok = (LAS int*)(F.lds + LDS_TILE_E + 4096); S.rowtok = rowtok;
            { const int* rowmap = (const int*)(F.ws + WS_MISC + MS_ROWMAP); Unit uu;
              for (int i = 0; i < 11 && S.next(i, uu); ++i) { if (F.tid < 256) { const int d = ldg<int>(rowmap + uu.pm * 256 + F.tid); rowtok[i * 256 + F.tid] = d >= 0 ? (d >> 1) : 0; } }
              __syncthreads(); }
            EpiSwiGLU E{(bf16_t*)(F.ws + WS_PROJ + PJ_ACT)};
            pg8::gemm_phase<EpiSwiGLU, ProbMoE<true>, true>(F.lds, S, E, F.tid, F.wave);
        });
        PHASE(11, pb + 11, {
            LAS int* segs = (LAS int*)(F.lds + LDS_MISC + 2048); LAS int* tile_e = (LAS int*)(F.lds + LDS_TILE_E);
            const int ntl = build_segments(F, layer, segs, tile_e);
            ProbMoE<false> S; S.K = 512; S.A = (const char*)(F.ws + WS_PROJ + PJ_ACT); S.W = (const char*)(F.ws + WS_WD); S.tile_e = tile_e; S.rowtok = tile_e; S.go.init(ntl, 4); S.G = F.G; S.c = F.bid;
            EpiDown E{(bf16_t*)(F.ws + WS_PROJ + PJ_Y2), (const int*)(F.ws + WS_MISC + MS_ROWMAP), (const float*)(F.ws + WS_MISC + MS_WSEL)};
            pg8::gemm_phase<EpiDown, ProbMoE<false>, true>(F.lds, S, E, F.tid, F.wave);
        });
    }
    PHASE(12, 49, final_phase(F));
#undef PHASE
}

static bool phase_exists(int p) {
    if (p == 0 || p == 49) return true;
    const int layer = (p - 1) / 12, slot = (p - 1) % 12; const bool isRT = layer & 1;
    if (!isRT && slot >= 3 && slot <= 6) return false;
    return true;
}
extern "C" void kernel_launch(void* const* d_in, const int* in_sizes, int n_in, void* d_out, int out_size, void* d_ws, size_t ws_size, hipStream_t stream) {
    static int grid = 0;
    if (grid == 0) {
        if (n_in != 24 || ws_size < WS_END) { fprintf(stderr, "kernel_launch: need 24 inputs and >= %zu bytes of workspace (got %d, %zu)\n", (size_t)WS_END, n_in, ws_size); grid = -1; return; }
        int dev = 0, cus = 0, per_cu = 0;
        if (hipGetDevice(&dev) != hipSuccess || hipDeviceGetAttribute(&cus, hipDeviceAttributeMultiprocessorCount, dev) != hipSuccess) { grid = -1; return; }
        if (hipFuncSetAttribute((const void*)fwd_kernel, hipFuncAttributeMaxDynamicSharedMemorySize, LDS_BYTES) != hipSuccess) { fprintf(stderr, "kernel_launch: hipFuncSetAttribute failed\n"); grid = -1; return; }
        if (hipOccupancyMaxActiveBlocksPerMultiprocessor(&per_cu, (const void*)fwd_kernel, 512, LDS_BYTES) != hipSuccess || per_cu < 1) fprintf(stderr, "kernel_launch: occupancy query reports %d\n", per_cu);
        (void)hipGetLastError();
        grid = cus;
    }
    if (grid < 0) return;
    (void)hipMemsetAsync((char*)d_ws + WS_CTL, 0, 1 * MiB, stream);
    Args a{};
    for (int i = 0; i < 24; ++i) a.in[i] = (const float*)d_in[i];
    a.out = (float*)d_out; a.ws = (unsigned char*)d_ws;
#ifdef MULTI_LAUNCH
    for (int p = 0; p < NPHASE; ++p) { if (!phase_exists(p)) continue; a.ph_lo = p; a.ph_hi = p + 1; hipLaunchKernelGGL(fwd_kernel, dim3(grid), dim3(512), LDS_BYTES, stream, a); }
#elif defined(PROBE_DUP_LO)
    a.ph_lo = 0; a.ph_hi = PROBE_DUP_HI; hipLaunchKernelGGL(fwd_kernel, dim3(grid), dim3(512), LDS_BYTES, stream, a);
    for (int p = PROBE_DUP_LO; p < PROBE_DUP_HI; ++p) { if (!phase_exists(p)) continue; a.ph_lo = p; a.ph_hi = p + 1; hipLaunchKernelGGL(fwd_kernel, dim3(grid), dim3(512), LDS_BYTES, stream, a); }
    (void)hipMemsetAsync((char*)d_ws + WS_CTL, 0, 16384, stream);
    a.ph_lo = PROBE_DUP_HI; a.ph_hi = NPHASE; hipLaunchKernelGGL(fwd_kernel, dim3(grid), dim3(512), LDS_BYTES, stream, a);
#else
    a.ph_lo = 0; a.ph_hi = NPHASE; hipLaunchKernelGGL(fwd_kernel, dim3(grid), dim3(512), LDS_BYTES, stream, a);
#endif
}
```

```cpp
#include <hip/hip_runtime.h>
#include <cstdio>
#include <cstdint>

#define LAS __attribute__((address_space(3)))
constexpr float LOG2E = 1.4426950408889634f;
#define DI __device__ __forceinline__
typedef unsigned short bf16_t;
typedef short bf16x8 __attribute__((ext_vector_type(8)));
typedef short s16x4 __attribute__((ext_vector_type(4)));
typedef float f32x4 __attribute__((ext_vector_type(4)));
typedef float f32x2 __attribute__((ext_vector_type(2)));
typedef float f32x16 __attribute__((ext_vector_type(16)));
typedef unsigned u32x4 __attribute__((ext_vector_type(4)));
typedef unsigned u32x2 __attribute__((ext_vector_type(2)));
typedef __bf16 bf16x2_t __attribute__((ext_vector_type(2)));

#define GAS __attribute__((address_space(1)))
template <class V, class T> DI V ldg(const T* p) { return *(const GAS V*)(unsigned long long)p; }
template <class V, class T> DI void stg(T* p, V v) { *(GAS V*)(unsigned long long)p = v; }
DI unsigned pk_bf16(float lo, float hi) { f32x2 v = {lo, hi}; return __builtin_bit_cast(unsigned, __builtin_convertvector(v, bf16x2_t)); }
DI float bf_lo(unsigned u) { return __uint_as_float(u << 16); }
DI float bf_hi(unsigned u) { return __uint_as_float(u & 0xffff0000u); }
DI float bf_f(bf16_t v) { return __uint_as_float(((unsigned)v) << 16); }
DI unsigned char* launder_p(unsigned char* p) { asm volatile("" : "+s"(p)); return p; }
DI float shx(float v, int o, int lane) { return __builtin_bit_cast(float, __builtin_amdgcn_ds_bpermute((lane ^ o) << 2, __builtin_bit_cast(int, v))); }
#define DPPF(v, ctrl, row_mask) __builtin_bit_cast(float, __builtin_amdgcn_update_dpp(0, __builtin_bit_cast(int, (v)), (ctrl), (row_mask), 0xf, false))
DI float wave_sum(float v, int lane) {
    (void)lane;
    v += DPPF(v, 0xB1, 0xf);
    v += DPPF(v, 0x4E, 0xf);
    v += DPPF(v, 0x141, 0xf);
    v += DPPF(v, 0x140, 0xf);
    v += DPPF(v, 0x142, 0xa);
    v += DPPF(v, 0x143, 0xc);
    return __builtin_bit_cast(float, __builtin_amdgcn_readlane(__builtin_bit_cast(int, v), 63));
}
DI int lane_id_asm() { int x; asm volatile("v_mbcnt_lo_u32_b32 %0, -1, 0\n\tv_mbcnt_hi_u32_b32 %0, -1, %0" : "=v"(x)); return x; }
DI int launder(int x) { asm volatile("" : "+v"(x)); return x; }
DI float uni_f(float x) { return __builtin_bit_cast(float, __builtin_amdgcn_readfirstlane(__builtin_bit_cast(int, x))); }
DI float silu_f(float x) { return x * __builtin_amdgcn_rcpf(1.0f + __builtin_amdgcn_exp2f(-LOG2E * x)); }

constexpr int NB = 32, SEQ = 2048, CTXL = 256, NTOK = SEQ + CTXL, DM = 1024, DEPTH = 4;
constexpr int T = NB * NTOK;
constexpr int NTILE = T / 256;
constexpr int NEXP = 32, MOEH = 512;
constexpr int MAXROWS = 2 * T + NEXP * 256;
constexpr float RMS_EPS = 1e-6f;

constexpr size_t MiB = 1ull << 20;
constexpr size_t WS_CTL = 0;
constexpr size_t WS_ADA = 1 * MiB;
constexpr size_t WS_ROPE = 5 * MiB;
constexpr size_t WS_MISC = 8 * MiB;
constexpr size_t WS_HCTX = 16 * MiB;
constexpr size_t WS_WQK = 48 * MiB;
constexpr size_t WS_WV = 56 * MiB;
constexpr size_t WS_WODA = 60 * MiB;
constexpr size_t WS_WIN = 64 * MiB;
constexpr size_t WS_WORT = 96 * MiB;
constexpr size_t WS_WGU = 104 * MiB;
constexpr size_t WS_WD = 168 * MiB;
constexpr size_t WS_ABUF = 200 * MiB;
constexpr size_t WS_OBUF = 344 * MiB;
constexpr size_t WS_PROJ = 488 * MiB;
constexpr size_t WS_HB = 1064 * MiB;
constexpr size_t WS_END = 1208 * MiB;
constexpr size_t PJ_Q = 0, PJ_K = 144 * MiB, PJ_VT = 288 * MiB;
constexpr size_t PJ_SA = 0, PJ_ACT = 304 * MiB, PJ_Y2 = 0;
constexpr size_t PJ_RQ = 0, PJ_RG = 72 * MiB, PJ_RKT = 360 * MiB, PJ_RVT = 432 * MiB;
constexpr int HROWS = 36864;
constexpr size_t RP_CDA = 0, RP_SDA = 256 * 1024, RP_CRT = 512 * 1024, RP_SRT = 512 * 1024 + 1 * MiB;
constexpr size_t MS_EID = 0, MS_WSEL = 1 * MiB, MS_ROWMAP = 2 * MiB, MS_SSQ = 3 * MiB, MS_WSORT = 6 * MiB, MS_CRTT = 6 * MiB, MS_SRTT = 7 * MiB;
constexpr int CW_BAR = 0;
constexpr int CW_CNT = 4096;
constexpr int CW_CUR = 4096 + 256;

constexpr int LDS_BYTES = 155648;
constexpr int LDS_MISC = 152576;
constexpr int LDS_TILE_E = 131072;

#define XB_TMO      128
#define XB_XCNT(j)  (256  + 64 * (j))
#define XB_XSUB(j)  (1280 + 64 * (j))
#define XB_XGEN(j)  (2304 + 64 * (j))
#define XB_TOP      3328
#define XB_TOPGEN   3392
#define XCD_BAR_WORDS 3456
#define XB_SPIN_CAP (1u << 18)

__device__ __forceinline__ unsigned xb_ld(unsigned* p)              { return __hip_atomic_load(p, __ATOMIC_RELAXED, __HIP_MEMORY_SCOPE_AGENT); }
__device__ __forceinline__ unsigned xb_add(unsigned* p, unsigned v) { return __hip_atomic_fetch_add(p, v, __ATOMIC_RELAXED, __HIP_MEMORY_SCOPE_AGENT); }
__device__ __forceinline__ unsigned xb_xcc_id() { return (unsigned)__builtin_amdgcn_s_getreg((3 << 11) | 20) & 0xFu; }
#define XB_SPIN(cond, bar) do { unsigned _sp = 0; while (cond) { __builtin_amdgcn_s_sleep(1); \
    if ((++_sp & 255u) == 0u) { if (xb_ld(&(bar)[XB_TMO])) break; if (_sp > XB_SPIN_CAP) { atomicAdd(&(bar)[XB_TMO], 1u); break; } } } } while (0)

struct XcdBarrier { unsigned* bar; unsigned x; volatile LAS unsigned* st; };

__device__ __forceinline__ XcdBarrier xcd_barrier_post(unsigned* bar, volatile LAS unsigned* st) {
    XcdBarrier b; b.bar = bar; b.x = xb_xcc_id(); b.st = st;
    if (threadIdx.x == 0) (void)xb_add(&bar[XB_XCNT(b.x)], 1u);
    return b;
}
__device__ __forceinline__ void xcd_barrier_complete(unsigned* bar, unsigned x, unsigned& nloc, unsigned& nx) {
    const unsigned G = gridDim.x * gridDim.y * gridDim.z;
    unsigned sum, cnt, mine, sp = 0u;
    for (;;) {
        sum = 0u; cnt = 0u; mine = 0u;
#pragma unroll
        for (unsigned j = 0; j < 16; ++j) { const unsigned c = xb_ld(&bar[XB_XCNT(j)]); sum += c; cnt += (c > 0u) ? 1u : 0u; mine = (j == x) ? c : mine; }
        if (sum == G) break;
        __builtin_amdgcn_s_sleep(1);
        if ((++sp & 255u) == 0u) { if (xb_ld(&bar[XB_TMO])) break; if (sp > XB_SPIN_CAP) { atomicAdd(&bar[XB_TMO], 1u); break; } }
    }
    nloc = mine > 0u ? mine : 1u; nx = cnt > 0u ? cnt : 1u;
}
__device__ __forceinline__ void xcd_barrier(const XcdBarrier& b, const int tid0) {
    asm volatile("s_waitcnt vmcnt(0)" ::: "memory");
    __syncthreads();
    if (tid0 == 0) {
        unsigned* bar = (unsigned*)launder_p((unsigned char*)b.bar);
        __builtin_amdgcn_s_waitcnt(0);
        unsigned nloc = b.st[0], nx = b.st[1];
        if (nloc == 0u) { xcd_barrier_complete(bar, b.x, nloc, nx); b.st[0] = nloc; b.st[1] = nx; }
        const unsigned old = xb_add(&bar[XB_XSUB(b.x)], 1u);
        const unsigned gen = old / nloc;
        if (old + 1u == (gen + 1u) * nloc) {
            __builtin_amdgcn_fence(__ATOMIC_RELEASE, "agent");
            asm volatile("s_waitcnt vmcnt(0)" ::: "memory");
            const unsigned og = xb_add(&bar[XB_TOP], 1u);
            const unsigned tg = og / nx;
            if (og + 1u == (tg + 1u) * nx) xb_add(&bar[XB_TOPGEN], 1u);
            else XB_SPIN(xb_ld(&bar[XB_TOPGEN]) == tg, bar);
            __builtin_amdgcn_fence(__ATOMIC_ACQUIRE, "agent");
            xb_add(&bar[XB_XGEN(b.x)], 1u);
            asm volatile("s_waitcnt vmcnt(0)" ::: "memory");
        } else {
            XB_SPIN(xb_ld(&bar[XB_XGEN(b.x)]) == gen, bar);
            __builtin_amdgcn_fence(__ATOMIC_ACQUIRE, "agent");
            asm volatile("s_waitcnt vmcnt(0)" ::: "memory");
        }
    }
    __syncthreads();
}

struct Args { const float* in[24]; float* out; unsigned char* ws; int ph_lo, ph_hi, flags, pad; };
struct Frame {
    const Args* a; float* out; unsigned char* ws; LAS unsigned char* lds;
    int tid, lane, wave, G, bid;
};
DI const float* mod_lat(const Frame& F, int layer, int b) { return (const float*)(F.ws + WS_ADA) + ((size_t)layer * 33 + b) * 6144; }
DI const float* mod_ctx(const Frame& F, int layer) { return (const float*)(F.ws + WS_ADA) + ((size_t)layer * 33 + 32) * 6144; }

namespace pg8 {
constexpr int BM = 256, BK = 64, HALF = 128, HTB = HALF * BK * 2, STAGE_BYTES = 8 * HTB, NXCD = 8, WGM = 8;
__host__ __device__ __forceinline__ int lds_byte(int r, int c) { const int st = (r >> 4) * 2 + (c >> 5), rr = r & 15, cc = c & 31, ob = rr * 64 + cc * 2; return st * 1024 + (ob ^ (((ob >> 9) & 1) << 5)); }
__host__ __device__ __forceinline__ void stage_rc(int b, int& R, int& C) { const int st = b / 1024, sb = b % 1024, swz = sb ^ (((sb >> 9) & 1) << 5); R = (st >> 1) * 16 + swz / 64; C = (st & 1) * 32 + (swz % 64) / 2; }
__host__ __device__ __forceinline__ int perm32(int rho) { const int n = rho >> 4, i = rho & 15; return 8 * (i >> 2) + 4 * n + (i & 3); }

struct Unit { int pm, pn, kind; };

struct GridOrder {
    int nM, nN, nwg;
    DI void init(int nM_, int nN_) { nM = nM_; nN = nN_; nwg = nM * nN; }
    DI bool map(long L, int& pm, int& pn) const {
        if (L >= nwg) return false;
        int wgid = (int)L; { const int q = nwg / NXCD, r = nwg % NXCD, xcd = wgid % NXCD, off = wgid / NXCD; wgid = (xcd < r ? xcd * (q + 1) : r * (q + 1) + (xcd - r) * q) + off; }
        const int nig = WGM * nN, gid = wgid / nig, fm = gid * WGM, gsz = (nM - fm) < WGM ? (nM - fm) : WGM;
        pm = fm + ((wgid % nig) % gsz); pn = (wgid % nig) / gsz; return true;
    }
};

template <class Epi, class P, bool ALIGN_EPI>
DI void gemm_phase(LAS unsigned char* lds, const P& S, const Epi& E, const int tid, const int wid) {
    const int lane = tid & 63, wr = wid >> 2, wc = wid & 3, fr = lane & 15, fq = lane >> 4;
    const int K = S.K, nt = K / BK;
    unsigned voffA[2], voffB[2];
#pragma unroll
    for (int i = 0; i < 2; ++i) { int R, C; stage_rc(tid * 16 + i * 8192, R, C); const int Rb = Epi::PERM ? ((R & ~31) + perm32(R & 31)) : R;
        voffA[i] = (unsigned)(R * K + C) * 2u; voffB[i] = (unsigned)(Rb * K + C) * 2u; }
    const size_t kstep = (size_t)(BK * 2);
    const size_t hstep = (size_t)HALF * K * 2;
    const unsigned ldsw = (unsigned)wid * 1024u;
    const int aoff = lds_byte(wr * 64 + fr, fq * 8), boff = lds_byte(wc * 32 + fr, fq * 8);
#define PG8_SA(b, h) (((b) * 2 + (h)) * HTB)
#define PG8_SB(b, h) ((4 + (b) * 2 + (h)) * HTB)
#define PG8_STAGE(bufoff, gbase, voff) do { _Pragma("unroll") for (int _i = 0; _i < 2; ++_i) \
        __builtin_amdgcn_global_load_lds((const unsigned*)((const char*)(gbase) + (voff)[_i]), (LAS unsigned*)(lds + (bufoff) + ldsw + _i * 8192), 16, 0, 0); } while (0)
#define PG8_LDA(dst, b, h) do { _Pragma("unroll") for (int m = 0; m < 4; ++m) _Pragma("unroll") for (int k = 0; k < 2; ++k) dst[m][k] = *(const LAS bf16x8*)(lds + PG8_SA(b, h) + aoff + m * 2048 + k * 1024); } while (0)
#define PG8_LDB(dst, b, h) do { _Pragma("unroll") for (int n = 0; n < 2; ++n) _Pragma("unroll") for (int k = 0; k < 2; ++k) dst[n][k] = *(const LAS bf16x8*)(lds + PG8_SB(b, h) + boff + n * 2048 + k * 1024); } while (0)
#define PG8_MMA(ai, bj, At, Bt) do { __builtin_amdgcn_s_setprio(1); _Pragma("unroll") for (int m = 0; m < 4; ++m) _Pragma("unroll") for (int n = 0; n < 2; ++n) _Pragma("unroll") for (int k = 0; k < 2; ++k) \
        acc[ai][bj][m][n] = __builtin_amdgcn_mfma_f32_16x16x32_bf16(Bt[n][k], At[m][k], acc[ai][bj][m][n], 0, 0, 0); __builtin_amdgcn_s_setprio(0); } while (0)
#define PG8_WAIT_V(n) asm volatile("s_waitcnt vmcnt(" #n ")" ::: "memory")
#define PG8_WAIT_L(n) asm volatile("s_waitcnt lgkmcnt(" #n ")" ::: "memory")
#define PG8_WAIT_VF asm volatile("s_waitcnt vmcnt(%0)" :: "n"(8 + Epi::EV) : "memory")
#define PG8_BAR __builtin_amdgcn_s_barrier()
#define PG8_SCHED __builtin_amdgcn_sched_barrier(0)
    Unit cur, nxt; int ui = 0;
    if (!S.next(0, cur)) return;
    if (S.stagger > 0) { const unsigned long long t0 = __builtin_amdgcn_s_memrealtime(); const unsigned long long dl = (unsigned long long)(((unsigned)S.c * 37u) & 15u) * (unsigned)S.stagger;
        while (__builtin_amdgcn_s_memrealtime() - t0 < dl) __builtin_amdgcn_s_sleep(8); }
    unsigned gaC[2][2], gaN[2][2]; int gR[2], gC[2];
    if constexpr (P::GATHER) {
#pragma unroll
        for (int i = 0; i < 2; ++i) { stage_rc(tid * 16 + i * 8192, gR[i], gC[i]); }
#pragma unroll
        for (int h = 0; h < 2; ++h)
#pragma unroll
            for (int i = 0; i < 2; ++i) { gaC[h][i] = (unsigned)(S.rowtok[0 * 256 + h * 128 + gR[i]] * K + gC[i]) * 2u; gaN[h][i] = gaC[h][i]; }
    }
#define PG8_STAGE_A(bufoff, h, usen, kofs, dense) do { if constexpr (P::GATHER) { const unsigned _v[2] = {(usen) ? gaN[h][0] : gaC[h][0], (usen) ? gaN[h][1] : gaC[h][1]}; PG8_STAGE(bufoff, S.A + (kofs), _v); } \
        else { PG8_STAGE(bufoff, dense, voffA); } } while (0)
    f32x4 acc[2][2][4][2];
#pragma unroll
    for (int a = 0; a < 2; ++a)
#pragma unroll
        for (int b = 0; b < 2; ++b)
#pragma unroll
            for (int m = 0; m < 4; ++m)
#pragma unroll
                for (int n = 0; n < 2; ++n) acc[a][b][m][n] = (f32x4){0.f, 0.f, 0.f, 0.f};
    bf16x8 At[4][2], B0[2][2], B1[2][2];
    typename Epi::Pre pre; E.pre_load(cur, wr, fr, pre);
    const char* cA = S.a_ptr(cur); const char* cB = S.b_ptr(cur);
    PG8_STAGE(PG8_SB(0, 0), cB, voffB); PG8_STAGE(PG8_SB(0, 1), cB + hstep, voffB); PG8_STAGE_A(PG8_SA(0, 0), 0, false, 0, cA); PG8_STAGE_A(PG8_SA(0, 1), 1, false, 0, cA + hstep);
    if (wr == 1) PG8_BAR;
    PG8_WAIT_V(2); PG8_BAR;
    PG8_STAGE(PG8_SB(1, 0), cB + kstep, voffB); PG8_STAGE_A(PG8_SA(1, 0), 0, false, kstep, cA + kstep); PG8_STAGE(PG8_SB(1, 1), cB + hstep + kstep, voffB);
    PG8_WAIT_V(6); PG8_BAR;
    for (;;) {
        const bool has_next = S.next(ui + 1, nxt);
        const char* nA = has_next ? S.a_ptr(nxt) : cA; const char* nB = has_next ? S.b_ptr(nxt) : cB;
        if constexpr (P::GATHER) { if (has_next) {
#pragma unroll
            for (int h = 0; h < 2; ++h)
#pragma unroll
                for (int i = 0; i < 2; ++i) gaN[h][i] = (unsigned)(S.rowtok[(ui + 1) * 256 + h * 128 + gR[i]] * K + gC[i]) * 2u; } }
#define PG8_PAIR(FRESH, t, last) do { \
            const size_t k1 = (size_t)((t) + 1) * kstep, k2 = (last) ? 0 : (size_t)((t) + 2) * kstep, k3 = k2 + kstep; \
            const char* a1 = cA + k1; \
            const char* a2 = ((last) ? nA : cA) + k2; const char* b2 = (last) ? nB : cB + (size_t)((t) + 2) * kstep; \
            const char* a3 = a2 + kstep; const char* b3 = b2 + kstep; \
            PG8_LDB(B0, 0, 0); PG8_LDB(B1, 0, 1); PG8_SCHED; PG8_LDA(At, 0, 0); if (!(FRESH)) PG8_STAGE_A(PG8_SA(1, 1), 1, false, k1, a1 + hstep); \
            if (FRESH) PG8_WAIT_VF; else PG8_WAIT_V(8); PG8_WAIT_L(0); PG8_BAR; PG8_MMA(0, 0, At, B0); PG8_MMA(0, 1, At, B1); PG8_BAR; PG8_SCHED; \
            PG8_LDA(At, 0, 1); PG8_STAGE(PG8_SB(0, 0), b2, voffB); PG8_STAGE(PG8_SB(0, 1), b2 + hstep, voffB); PG8_STAGE_A(PG8_SA(0, 0), 0, last, k2, a2); \
            if (FRESH) PG8_WAIT_VF; else PG8_WAIT_V(8); PG8_WAIT_L(0); PG8_BAR; PG8_MMA(1, 0, At, B0); PG8_MMA(1, 1, At, B1); PG8_BAR; PG8_SCHED; \
            PG8_LDB(B0, 1, 0); PG8_LDB(B1, 1, 1); PG8_SCHED; PG8_LDA(At, 1, 0); PG8_STAGE_A(PG8_SA(0, 1), 1, last, k2, a2 + hstep); \
            if (FRESH) PG8_WAIT_VF; else PG8_WAIT_V(8); PG8_WAIT_L(0); PG8_BAR; PG8_MMA(0, 0, At, B0); PG8_MMA(0, 1, At, B1); PG8_BAR; PG8_SCHED; \
            PG8_LDA(At, 1, 1); PG8_STAGE(PG8_SB(1, 0), b3, voffB); PG8_STAGE(PG8_SB(1, 1), b3 + hstep, voffB); PG8_STAGE_A(PG8_SA(1, 0), 0, last, k3, a3); \
            PG8_WAIT_V(8); PG8_WAIT_L(0); PG8_BAR; PG8_MMA(1, 0, At, B0); PG8_MMA(1, 1, At, B1); PG8_BAR; PG8_SCHED; } while (0)
        int t = 0;
        if (ui > 0 && !S.noepi) { PG8_PAIR(true, 0, false); t = 2; }
        for (; t < nt; t += 2) { const bool last = (t == nt - 2); PG8_PAIR(false, t, last); }
        PG8_STAGE_A(PG8_SA(1, 1), 1, true, kstep, nA + kstep + hstep); asm volatile("" ::: "memory"); PG8_SCHED;
#undef PG8_PAIR
        if constexpr (ALIGN_EPI) { if (wr == 0) PG8_BAR; }
        if (!S.noepi) { const int l2 = lane_id_asm(); E(acc, cur, wr, wc, l2 & 15, l2 >> 4, pre); }
        if (!has_next) break;
#pragma unroll
        for (int a = 0; a < 2; ++a)
#pragma unroll
            for (int b = 0; b < 2; ++b)
#pragma unroll
                for (int m = 0; m < 4; ++m)
#pragma unroll
                    for (int n = 0; n < 2; ++n) { acc[a][b][m][n] = (f32x4){0.f, 0.f, 0.f, 0.f}; asm volatile("" : "+v"(acc[a][b][m][n])); }
        cur = nxt; cA = nA; cB = nB; ++ui;
        E.pre_load(cur, wr, fr, pre);
        if constexpr (P::GATHER) {
#pragma unroll
            for (int h = 0; h < 2; ++h)
#pragma unroll
                for (int i = 0; i < 2; ++i) gaC[h][i] = gaN[h][i]; }
        if constexpr (ALIGN_EPI) { if (wr == 1) PG8_BAR; }
    }
    PG8_WAIT_V(0);
    if constexpr (!ALIGN_EPI) { if (wr == 0) PG8_BAR; }
    PG8_BAR;
#undef PG8_SA
#undef PG8_SB
#undef PG8_STAGE
#undef PG8_STAGE_A
#undef PG8_LDA
#undef PG8_LDB
#undef PG8_MMA
#undef PG8_WAIT_V
#undef PG8_WAIT_L
#undef PG8_WAIT_VF
#undef PG8_BAR
#undef PG8_SCHED
}
}
using pg8::Unit;

struct ProbQKV {
    static constexpr bool GATHER = false;
    int K; const char* abuf; const char* wqk; const char* wv; pg8::GridOrder go; int G, c, stagger, noepi;
    DI bool next(int i, Unit& u) const {
        const long L = (long)i * G + c;
        if (L < NTILE * 8) { u.kind = 0; const bool ok = go.map(L, u.pm, u.pn);
#ifdef PROBE_SAMEA
            if (noepi) { u.pm = u.pm & 7; }
#endif
            return ok; }
        const long r = L - NTILE * 8; if (r >= NTILE * 4) return false;
        u.kind = 1; u.pm = (int)(r & 3); u.pn = (int)(r >> 2); return true;
    }
    DI const char* a_ptr(const Unit& u) const { return (u.kind == 0 ? abuf : wv) + (size_t)u.pm * (256 * 1024 * 2); }
    DI const char* b_ptr(const Unit& u) const { return (u.kind == 0 ? wqk : abuf) + (size_t)u.pn * (256 * 1024 * 2); }
};
struct EpiQKV {
    static constexpr bool PERM = true; static constexpr int EV = 16;

    struct Pre {}; DI void pre_load(const Unit&, int, int, Pre&) const {}
    bf16_t* Q; bf16_t* Kb; bf16_t* VT; const float* gq; const float* gk; const float* cosT; const float* sinT;
    DI void operator()(const f32x4 (&acc)[2][2][4][2], const Unit& u, int wr, int wc, int fr, int fq, const Pre& pre) const {
        if (u.kind == 1) {
#pragma unroll
            for (int ai = 0; ai < 2; ++ai)
#pragma unroll
                for (int m = 0; m < 4; ++m) {
                    const int f = u.pm * 256 + ai * 128 + wr * 64 + m * 16 + fr;
                    bf16_t* rowp = VT + (size_t)f * T + (size_t)u.pn * 256 + wc * 32 + 8 * fq;
#pragma unroll
                    for (int bj = 0; bj < 2; ++bj) { const f32x4 v0 = acc[ai][bj][m][0], v1 = acc[ai][bj][m][1];
                        u32x4 w; w.x = pk_bf16(v0[0], v0[1]); w.y = pk_bf16(v0[2], v0[3]); w.z = pk_bf16(v1[0], v1[1]); w.w = pk_bf16(v1[2], v1[3]);
                        stg<u32x4>(rowp + bj * 128, w); }
                }
            return;
        }
        const bool isK = u.pn >= 4; const int sub = 4 * (u.pn & 3) + wc;
        const int jj = u.pm % 9; const bool isctx = (jj == 0);
        const float* g = isK ? gk : gq; bf16_t* dst = isK ? Kb : Q;
        const float osc = isK ? 1.0f : 0.125f * LOG2E;
        const int ln = fr + 16 * fq;
        f32x4 gv[2][2];
#pragma unroll
        for (int bj = 0; bj < 2; ++bj)
#pragma unroll
            for (int n = 0; n < 2; ++n) gv[bj][n] = ldg<f32x4>(g + 32 * bj + 8 * fq + 4 * n);
        float invf[8];
#pragma unroll
        for (int k = 0; k < 8; ++k) invf[k] = __builtin_amdgcn_exp2f(-(float)((8 * fq + k) & 15) * (13.287712379549449f / 16.0f)) * 0.15915494309189535f;
        const bool use_row = fq < 2;
        float ss[8];
#pragma unroll
        for (int ai = 0; ai < 2; ++ai)
#pragma unroll
            for (int m = 0; m < 4; ++m) { float s = 0.f;
#pragma unroll
                for (int bj = 0; bj < 2; ++bj)
#pragma unroll
                    for (int n = 0; n < 2; ++n) { const f32x4 x = acc[ai][bj][m][n]; s += (x[0] * x[0] + x[1] * x[1]) + (x[2] * x[2] + x[3] * x[3]); }
                ss[ai * 4 + m] = s; }
#pragma unroll
        for (int it = 0; it < 8; ++it) ss[it] += shx(ss[it], 16, ln);
#pragma unroll
        for (int it = 0; it < 8; ++it) ss[it] += shx(ss[it], 32, ln);
#pragma unroll
        for (int ai = 0; ai < 2; ++ai)
#pragma unroll
            for (int m = 0; m < 4; ++m) {
                const int rr = ai * 128 + wr * 64 + m * 16 + fr;
                const float rstd = __builtin_amdgcn_rsqf(ss[ai * 4 + m] * (1.0f / 64.0f) + RMS_EPS) * osc;
                f32x4 x1[2], x2[2];
#pragma unroll
                for (int n = 0; n < 2; ++n) { x1[n] = acc[ai][0][m][n] * rstd * gv[0][n]; x2[n] = acc[ai][1][m][n] * rstd * gv[1][n]; }
                if (!isctx) {
                    const int t = (jj - 1) * 256 + rr; const float pos = (float)(use_row ? (t >> 6) : (t & 63));
#pragma unroll
                    for (int n = 0; n < 2; ++n)
#pragma unroll
                        for (int j = 0; j < 4; ++j) { const float a = pos * invf[4 * n + j]; const float c = __builtin_amdgcn_cosf(a), s = __builtin_amdgcn_sinf(a);
                            const float p = x1[n][j], q = x2[n][j]; x1[n][j] = p * c - q * s; x2[n][j] = p * s + q * c; }
                }
                bf16_t* rowp = dst + (size_t)(u.pm * 256 + rr) * 1024 + 64 * sub + 8 * fq;
                u32x4 w; w.x = pk_bf16(x1[0][0], x1[0][1]); w.y = pk_bf16(x1[0][2], x1[0][3]); w.z = pk_bf16(x1[1][0], x1[1][1]); w.w = pk_bf16(x1[1][2], x1[1][3]);
                stg<u32x4>(rowp, w);
                w.x = pk_bf16(x2[0][0], x2[0][1]); w.y = pk_bf16(x2[0][2], x2[0][3]); w.z = pk_bf16(x2[1][0], x2[1][1]); w.w = pk_bf16(x2[1][2], x2[1][3]);
                stg<u32x4>(rowp + 32, w);
            }
    }
};

struct ProbDense {
    static constexpr bool GATHER = false;
    int K; const char* A0; const char* A1; int pm_split; const char* Bt; pg8::GridOrder go; int G, c, stagger, noepi, latonly;
    DI bool next(int i, Unit& u) const { u.kind = 0; const bool ok = go.map((long)i * G + c, u.pm, u.pn); if (latonly) u.pm = (u.pm >> 3) * 9 + 1 + (u.pm & 7); return ok; }
    DI const char* a_ptr(const Unit& u) const { return u.pm < pm_split ? A0 + (size_t)u.pm * 512 * K : A1 + (size_t)(u.pm - pm_split) * 512 * K; }
    DI const char* b_ptr(const Unit& u) const { return Bt + (size_t)u.pn * 512 * K; }
};

struct ProbWIN {
    static constexpr bool GATHER = false;
    int K; const char* abuf; const char* win; pg8::GridOrder go; int G, c, stagger, noepi, nnat, latonly;
    DI bool next(int i, Unit& u) const {
        const long L = (long)i * G + c;
        if (L < nnat) { u.kind = 0; const bool ok = go.map(L, u.pm, u.pn); if (latonly) u.pm = (u.pm >> 3) * 9 + 1 + (u.pm & 7); return ok; }
        const long r = L - nnat; if (r >= 144 * 12) return false;
        u.kind = 1; u.pm = (int)(r % 12); u.pn = (int)(r / 12); return true;
    }
    DI const char* a_ptr(const Unit& u) const { return u.kind == 0 ? abuf + (size_t)u.pm * (256 * 1024 * 2) : win + (size_t)(4 + u.pm) * (256 * 1024 * 2); }
    DI const char* b_ptr(const Unit& u) const { return u.kind == 0 ? win + (size_t)(u.pn < 4 ? u.pn : 12 + u.pn) * (256 * 1024 * 2) : abuf + (size_t)u.pn * (256 * 1024 * 2); }
};
struct EpiWIN {
    static constexpr bool PERM = true; static constexpr int EV = 16;

    struct Pre {}; DI void pre_load(const Unit&, int, int, Pre&) const {}
    bf16_t* RQ; bf16_t* RG; bf16_t* RKT; bf16_t* RVT; int pm0; const float* cosT; const float* sinT; const float* cosTT; const float* sinTT;
    DI void operator()(const f32x4 (&acc)[2][2][4][2], const Unit& u, int wr, int wc, int fr, int fq, const Pre& pre) const {
        if (u.kind == 0) {
            const int gpm = pm0 + u.pm, jj = gpm % 9; const bool isctx = (jj == 0); const bool isq = u.pn < 4;
            float invf[8];
#pragma unroll
            for (int k = 0; k < 8; ++k) invf[k] = __builtin_amdgcn_exp2f(-(float)((32 * wc + 8 * fq + k) & 63) * (13.287712379549449f / 64.0f)) * 0.15915494309189535f;
#pragma unroll
            for (int ai = 0; ai < 2; ++ai)
#pragma unroll
                for (int m = 0; m < 4; ++m) {
                    const int rr = ai * 128 + wr * 64 + m * 16 + fr;
                    f32x4 x1[2], x2[2];
#pragma unroll
                    for (int n = 0; n < 2; ++n) { x1[n] = acc[ai][0][m][n]; x2[n] = acc[ai][1][m][n]; }
                    if (isq) {
                        if (!isctx) {
                            const int t = (jj - 1) * 256 + rr; const float pos = (float)((wc < 2) ? (t >> 6) : (t & 63));
#pragma unroll
                            for (int n = 0; n < 2; ++n)
#pragma unroll
                                for (int j = 0; j < 4; ++j) { const float a = pos * invf[4 * n + j]; const float c = __builtin_amdgcn_cosf(a), s = __builtin_amdgcn_sinf(a);
                                    const float p = x1[n][j], q = x2[n][j]; x1[n][j] = p * c - q * s; x2[n][j] = p * s + q * c; }
                        }
                    } else {
#pragma unroll
                        for (int n = 0; n < 2; ++n)
#pragma unroll
                            for (int j = 0; j < 4; ++j) { x1[n][j] = silu_f(x1[n][j]); x2[n][j] = silu_f(x2[n][j]); }
                    }
                    bf16_t* rowp = isq ? RQ + (size_t)(u.pm * 256 + rr) * 1024 + u.pn * 256 + wc * 32 + 8 * fq : RG + (size_t)(u.pm * 256 + rr) * 4096 + (u.pn - 4) * 256 + wc * 32 + 8 * fq;
                    u32x4 w; w.x = pk_bf16(x1[0][0], x1[0][1]); w.y = pk_bf16(x1[0][2], x1[0][3]); w.z = pk_bf16(x1[1][0], x1[1][1]); w.w = pk_bf16(x1[1][2], x1[1][3]);
                    stg<u32x4>(rowp, w);
                    w.x = pk_bf16(x2[0][0], x2[0][1]); w.y = pk_bf16(x2[0][2], x2[0][3]); w.z = pk_bf16(x2[1][0], x2[1][1]); w.w = pk_bf16(x2[1][2], x2[1][3]);
                    stg<u32x4>(rowp + 128, w);
                }
            return;
        }
        const int gpm = pm0 + u.pn, jj = gpm % 9; const bool isctx = (jj == 0); const bool isk = u.pm < 4;
        if (isk) {
#pragma unroll
            for (int m = 0; m < 4; ++m) {
                const int f = wr * 64 + m * 16 + fr;
#pragma unroll
                for (int bj = 0; bj < 2; ++bj) {
                    f32x4 x1[2], x2[2];
#pragma unroll
                    for (int n = 0; n < 2; ++n) { x1[n] = acc[0][bj][m][n] * 0.0625f; x2[n] = acc[1][bj][m][n] * 0.0625f; }
                    const int tl = bj * 128 + wc * 32 + 8 * fq;
                    if (!isctx) {
                        const int t = (jj - 1) * 256 + tl;
                        const float ivf = __builtin_amdgcn_exp2f(-(float)(m * 16 + fr) * (13.287712379549449f / 64.0f)) * 0.15915494309189535f;
#pragma unroll
                        for (int n = 0; n < 2; ++n)
#pragma unroll
                            for (int j = 0; j < 4; ++j) { const int tt = t + 4 * n + j; const float a = (float)(wr == 0 ? (tt >> 6) : (tt & 63)) * ivf; const float c = __builtin_amdgcn_cosf(a), s = __builtin_amdgcn_sinf(a);
                                const float p = x1[n][j], q = x2[n][j]; x1[n][j] = p * c - q * s; x2[n][j] = p * s + q * c; }
                    }
                    bf16_t* p1 = RKT + ((size_t)(u.pn * 8 + 4 * bj + wc) * 1024 + (u.pm * 256 + f)) * 32 + 8 * fq;
                    u32x4 w; w.x = pk_bf16(x1[0][0], x1[0][1]); w.y = pk_bf16(x1[0][2], x1[0][3]); w.z = pk_bf16(x1[1][0], x1[1][1]); w.w = pk_bf16(x1[1][2], x1[1][3]);
                    stg<u32x4>(p1, w);
                    w.x = pk_bf16(x2[0][0], x2[0][1]); w.y = pk_bf16(x2[0][2], x2[0][3]); w.z = pk_bf16(x2[1][0], x2[1][1]); w.w = pk_bf16(x2[1][2], x2[1][3]);
                    stg<u32x4>(p1 + 128 * 32, w);
                }
            }
        } else {
#pragma unroll
            for (int ai = 0; ai < 2; ++ai)
#pragma unroll
                for (int m = 0; m < 4; ++m) {
                    const int f = (u.pm - 4) * 256 + ai * 128 + wr * 64 + m * 16 + fr;
#pragma unroll
                    for (int bj = 0; bj < 2; ++bj) { const f32x4 v0 = acc[ai][bj][m][0], v1 = acc[ai][bj][m][1];
                        u32x4 w; w.x = pk_bf16(v0[0], v0[1]); w.y = pk_bf16(v0[2], v0[3]); w.z = pk_bf16(v1[0], v1[1]); w.w = pk_bf16(v1[2], v1[3]);
                        stg<u32x4>(RVT + ((size_t)(u.pn * 8 + 4 * bj + wc) * 2048 + f) * 32 + 8 * fq, w); }
                }
        }
    }
};

struct EpiResid {
    static constexpr bool PERM = true; static constexpr int EV = 16;

    struct Pre {}; DI void pre_load(const Unit&, int, int, Pre&) const {}
    const float* xin_ctx; const float* xin_lat; bf16_t* hb; const float* modbase; int first;
    DI void operator()(const f32x4 (&acc)[2][2][4][2], const Unit& u, int wr, int wc, int fr, int fq, const Pre& pre) const {
        const int b = u.pm / 9, jj = u.pm % 9; const bool isctx = (jj == 0);
        const float* gate = modbase + (size_t)(isctx ? 32 : b) * 6144 + 2048;
        const int col0 = u.pn * 256 + wc * 32 + 8 * fq;
        f32x4 gv[2][2];
#pragma unroll
        for (int bj = 0; bj < 2; ++bj)
#pragma unroll
            for (int n = 0; n < 2; ++n) gv[bj][n] = ldg<f32x4>(gate + col0 + bj * 128 + n * 4);
        const size_t rbase = isctx ? (size_t)b * 256 : (size_t)b * 2048 + (size_t)(jj - 1) * 256;
        const float* xi = isctx ? xin_ctx : xin_lat;
#pragma unroll
        for (int ai = 0; ai < 2; ++ai) {
            f32x4 hv[4][2][2];
#pragma unroll
            for (int m = 0; m < 4; ++m) { const int rr = ai * 128 + wr * 64 + m * 16 + fr;
#pragma unroll
                for (int bj = 0; bj < 2; ++bj) {
                    if (first) { const float* p = xi + (rbase + rr) * 1024 + col0 + bj * 128; hv[m][bj][0] = ldg<f32x4>(p); hv[m][bj][1] = ldg<f32x4>(p + 4); }
                    else { const u32x4 w = ldg<u32x4>(hb + (size_t)(u.pm * 256 + rr) * 1024 + col0 + bj * 128);
                        hv[m][bj][0] = (f32x4){bf_lo(w.x), bf_hi(w.x), bf_lo(w.y), bf_hi(w.y)}; hv[m][bj][1] = (f32x4){bf_lo(w.z), bf_hi(w.z), bf_lo(w.w), bf_hi(w.w)}; }
                } }
#pragma unroll
            for (int m = 0; m < 4; ++m) { const int rr = ai * 128 + wr * 64 + m * 16 + fr;
#pragma unroll
                for (int bj = 0; bj < 2; ++bj) { const f32x4 v0 = hv[m][bj][0] + gv[bj][0] * acc[ai][bj][m][0], v1 = hv[m][bj][1] + gv[bj][1] * acc[ai][bj][m][1];
                    u32x4 w; w.x = pk_bf16(v0[0], v0[1]); w.y = pk_bf16(v0[2], v0[3]); w.z = pk_bf16(v1[0], v1[1]); w.w = pk_bf16(v1[2], v1[3]);
                    stg<u32x4>(hb + (size_t)(u.pm * 256 + rr) * 1024 + col0 + bj * 128, w); } }
        }
    }
};

template <bool GATHER_>
struct ProbMoE {
    static constexpr bool GATHER = GATHER_;
    int K; const char* A; const char* W; const LAS int* tile_e; const LAS int* rowtok; pg8::GridOrder go; int G, c, stagger, noepi;
    DI bool next(int i, Unit& u) const { u.kind = 0; return go.map((long)i * G + c, u.pm, u.pn); }
    DI const char* a_ptr(const Unit& u) const { return GATHER ? A : A + (size_t)u.pm * 512 * K; }
    DI const char* b_ptr(const Unit& u) const { return W + ((size_t)tile_e[u.pm] * 4 + u.pn) * 512 * K; }
};
struct EpiSwiGLU {
    static constexpr bool PERM = true; static constexpr int EV = 8;

    struct Pre {}; DI void pre_load(const Unit&, int, int, Pre&) const {}
    bf16_t* act;
    DI void operator()(const f32x4 (&acc)[2][2][4][2], const Unit& u, int wr, int wc, int fr, int fq, const Pre& pre) const {
#pragma unroll
        for (int ai = 0; ai < 2; ++ai)
#pragma unroll
            for (int m = 0; m < 4; ++m) {
                bf16_t* rowp = act + (size_t)(u.pm * 256 + ai * 128 + wr * 64 + m * 16 + fr) * 512 + u.pn * 128 + wc * 32 + 8 * fq;
                const f32x4 g0 = acc[ai][0][m][0], u0 = acc[ai][0][m][1], g1 = acc[ai][1][m][0], u1 = acc[ai][1][m][1];
                u32x4 w; w.x = pk_bf16(silu_f(g0[0]) * u0[0], silu_f(g0[1]) * u0[1]); w.y = pk_bf16(silu_f(g0[2]) * u0[2], silu_f(g0[3]) * u0[3]);
                w.z = pk_bf16(silu_f(g1[0]) * u1[0], silu_f(g1[1]) * u1[1]); w.w = pk_bf16(silu_f(g1[2]) * u1[2], silu_f(g1[3]) * u1[3]);
                stg<u32x4>(rowp, w);
            }
    }
};
struct EpiDown {
    static constexpr bool PERM = true; static constexpr int EV = 8;

    bf16_t* y2; const int* rowmap; const float* wsel;
    struct Pre { u32x2 dw[8]; };
    DI void pre_load(const Unit& u, int wr, int, Pre& p) const {
        const int fr = lane_id_asm() & 15;
#pragma unroll
        for (int it = 0; it < 8; ++it) { const int row = u.pm * 256 + (it >> 2) * 128 + wr * 64 + (it & 3) * 16 + fr; p.dw[it] = ldg<u32x2>(rowmap + 2 * row); }
    }
    DI void operator()(const f32x4 (&acc)[2][2][4][2], const Unit& u, int wr, int wc, int fr, int fq, const Pre& pre) const {
#pragma unroll
        for (int ai = 0; ai < 2; ++ai)
#pragma unroll
            for (int m = 0; m < 4; ++m) {
                const u32x2 dwv = pre.dw[ai * 4 + m];
                const int d = (int)dwv.x;
                if (d >= 0) {
                    const float w = __uint_as_float(dwv.y);
                    bf16_t* rowp = y2 + (size_t)d * 1024 + u.pn * 256 + wc * 32 + 8 * fq;
#pragma unroll
                    for (int bj = 0; bj < 2; ++bj) { const f32x4 v0 = acc[ai][bj][m][0] * w, v1 = acc[ai][bj][m][1] * w;
                        u32x4 o; o.x = pk_bf16(v0[0], v0[1]); o.y = pk_bf16(v0[2], v0[3]); o.z = pk_bf16(v1[0], v1[1]); o.w = pk_bf16(v1[2], v1[3]);
                        stg<u32x4>(rowp + bj * 128, o); }
                }
            }
    }
};

template <int MODE>
DI void transpose_tile(const Frame& F, const float* src, const float* src2, int ld, bf16_t* dst, int K, int k0, int n0) {
    LAS float* tl = (LAS float*)F.lds;
    __syncthreads();
#pragma unroll
    for (int i = 0; i < 8; ++i) {
        const int idx = F.tid + 512 * i, kk = idx >> 6, nn = idx & 63, np = n0 + nn;
        float v;
        if (MODE == 0) v = ldg<float>(src + (size_t)(k0 + kk) * ld + np);
        else if (MODE == 1) { const int t = np >> 8, p = np & 255, bj = p >> 7, wc = (p >> 5) & 3, r = p & 31; v = ldg<float>(src + (size_t)(k0 + kk) * ld + t * 256 + wc * 64 + bj * 32 + r); }
        else { const int hid = 4 * (np >> 3) + (np & 3); v = ldg<float>(((np & 4) ? src2 : src) + (size_t)(k0 + kk) * ld + hid); }
        tl[nn * 65 + kk] = v;
    }
    __syncthreads();
#pragma unroll
    for (int i = 0; i < 4; ++i) {
        const int idx = F.tid + 512 * i, nn = idx >> 5, kp = (idx & 31) * 2;
        stg<unsigned>(dst + (size_t)(n0 + nn) * K + k0 + kp, pk_bf16(tl[nn * 65 + kp], tl[nn * 65 + kp + 1]));
    }
}
template <int MODE>
DI int transpose_mat(const Frame& F, const float* src, const float* src2, int ld, bf16_t* dst, int K, int Np, int u0, int u_first, int u_stride) {
    const int tk = K / 64, tn = Np / 64, ntl = tk * tn;
    int u = u_first; if (u < u0) { const int d = (u0 - u + u_stride - 1) / u_stride; u += d * u_stride; }
    for (; u < u0 + ntl; u += u_stride) { const int l = u - u0; transpose_tile<MODE>(F, src, src2, ld, dst, K, (l % tk) * 64, (l / tk) * 64); }
    return ntl;
}
DI void moe_tile_load(const Frame& F, const float* wg, const float* wu, const float* wd, int u, float (&v)[8]) {
    const int e = u / 384, l = u % 384;
#pragma unroll
    for (int i = 0; i < 8; ++i) {
        const int idx = F.tid + 512 * i, kk = idx >> 6, nn = idx & 63;
        if (l < 256) { const int np = (l >> 4) * 64 + nn, hid = 128 * (np >> 8) + 32 * ((np >> 5) & 3) + 8 * ((np >> 3) & 3) + 4 * ((np >> 7) & 1) + (np & 3);
            v[i] = ldg<float>(((np & 4) ? wu : wg) + (size_t)e * DM * MOEH + (size_t)((l & 15) * 64 + kk) * MOEH + hid); }
        else { const int l2 = l - 256; v[i] = ldg<float>(wd + (size_t)e * MOEH * DM + (size_t)((l2 & 7) * 64 + kk) * DM + (l2 >> 3) * 64 + nn); }
    }
}
constexpr int MOE_NT = NEXP * 384, MOE_T_WO = 28 * 128, MOE_T_QKV = 20 * 128;
DI int moe_split_lo(const Frame& F, int layer) {
    if (F.G != 256 || layer == DEPTH - 1) return 0;
    return (layer & 1) ? MOE_T_WO : MOE_T_WO + MOE_T_QKV;
}
DI void convert_moe_weights(const Frame& F, int layer, const int t_lo, const int t_hi, const int first, const int stride) {
    const float* wg = F.a->in[21] + (size_t)layer * NEXP * DM * MOEH; const float* wu = F.a->in[22] + (size_t)layer * NEXP * DM * MOEH; const float* wd = F.a->in[23] + (size_t)layer * NEXP * MOEH * DM;
    bf16_t* WGU = (bf16_t*)(F.ws + WS_WGU); bf16_t* WD = (bf16_t*)(F.ws + WS_WD);
    LAS float* tl = (LAS float*)F.lds;
    const int NT = t_hi;
    float v[8];
    int u = t_lo + first, par = 0;
    __syncthreads();
    if (u < NT) moe_tile_load(F, wg, wu, wd, u, v);
    for (; u < NT; u += stride, par ^= 1) {
        LAS float* tb = tl + par * (64 * 65);
#pragma unroll
        for (int i = 0; i < 8; ++i) { const int idx = F.tid + 512 * i; tb[(idx & 63) * 65 + (idx >> 6)] = v[i]; }
        __syncthreads();
        if (u + stride < NT) moe_tile_load(F, wg, wu, wd, u + stride, v);
        const int e = u / 384, l = u % 384;
        bf16_t* dst; int K, k0, n0;
        if (l < 256) { dst = WGU + (size_t)e * 1024 * 1024; K = 1024; k0 = (l & 15) * 64; n0 = (l >> 4) * 64; } else { const int l2 = l - 256; dst = WD + (size_t)e * 1024 * 512; K = 512; k0 = (l2 & 7) * 64; n0 = (l2 >> 3) * 64; }
#pragma unroll
        for (int i = 0; i < 4; ++i) { const int idx = F.tid + 512 * i, nn = idx >> 5, kp = (idx & 31) * 2;
            stg<unsigned>(dst + (size_t)(n0 + nn) * K + k0 + kp, pk_bf16(tb[nn * 65 + kp], tb[nn * 65 + kp + 1])); }
    }
    __syncthreads();
}

DI void p0_prologue(const Frame& F) {
    {
        LAS float* red = (LAS float*)F.lds;
        for (int u = F.bid; u < 4 * 96; u += F.G) {
            const int layer = u / 96, col0 = (u % 96) * 64;
            const float* W = F.a->in[6] + (size_t)layer * 1024 * 6144 + col0 + F.lane;
            const float* cp = F.lane < 32 ? F.a->in[1] + F.lane * 1024 : F.a->in[3];
            float acc[33];
#pragma unroll
            for (int r = 0; r < 33; ++r) acc[r] = 0.f;
            const int k0 = F.wave * 128;
            for (int k = k0; k < k0 + 128; k += 8) {
                float w8[8], c8[8];
#pragma unroll
                for (int q = 0; q < 8; ++q) { w8[q] = ldg<float>(W + (size_t)(k + q) * 6144); c8[q] = ldg<float>(cp + k + q); }
#pragma unroll
                for (int q = 0; q < 8; ++q) { const float sv = silu_f(c8[q]);
#pragma unroll
                    for (int r = 0; r < 33; ++r) acc[r] += w8[q] * __builtin_bit_cast(float, __builtin_amdgcn_readlane(__builtin_bit_cast(int, sv), r)); }
            }
#pragma unroll
            for (int r = 0; r < 33; ++r) red[(F.wave * 33 + r) * 64 + F.lane] = acc[r];
            __syncthreads();
            float* outp = (float*)(F.ws + WS_ADA) + (size_t)layer * 33 * 6144;
            for (int idx = F.tid; idx < 33 * 64; idx += 512) { const int r = idx >> 6, cl = idx & 63; float v = 0.f;
#pragma unroll
                for (int w8 = 0; w8 < 8; ++w8) v += red[(w8 * 33 + r) * 64 + cl];
                stg<float>(outp + (size_t)r * 6144 + col0 + cl, v + ldg<float>(F.a->in[7] + layer * 6144 + col0 + cl)); }
            __syncthreads();
        }
    }
    {
        int u0 = 0;
        for (int j = 0; j < 2; ++j) {
            const float* wqkv = F.a->in[8] + (size_t)j * 1024 * 3072;
            u0 += transpose_mat<1>(F, wqkv, nullptr, 3072, (bf16_t*)(F.ws + WS_WQK) + (size_t)j * 2048 * 1024, 1024, 2048, u0, F.bid, F.G);
            u0 += transpose_mat<0>(F, wqkv + 2048, nullptr, 3072, (bf16_t*)(F.ws + WS_WV) + (size_t)j * 1024 * 1024, 1024, 1024, u0, F.bid, F.G);
            u0 += transpose_mat<0>(F, F.a->in[13] + (size_t)j * 1024 * 1024, nullptr, 1024, (bf16_t*)(F.ws + WS_WODA) + (size_t)j * 1024 * 1024, 1024, 1024, u0, F.bid, F.G);
            u0 += transpose_mat<0>(F, F.a->in[14] + (size_t)j * 1024 * 8192, nullptr, 8192, (bf16_t*)(F.ws + WS_WIN) + (size_t)j * 8192 * 1024, 1024, 8192, u0, F.bid, F.G);
            u0 += transpose_mat<0>(F, F.a->in[16] + (size_t)j * 2048 * 1024, nullptr, 1024, (bf16_t*)(F.ws + WS_WORT) + (size_t)j * 1024 * 2048, 2048, 1024, u0, F.bid, F.G);
        }
        convert_moe_weights(F, 0, moe_split_lo(F, 0), MOE_NT, F.bid, F.G);
    }
}

template <bool SECOND>
DI void norm_phase(const Frame& F, int layer) {
    bf16_t* abuf = (bf16_t*)(F.ws + WS_ABUF);
    bf16_t* hb = (bf16_t*)(F.ws + WS_HB);
    const bf16_t* y2 = (const bf16_t*)(F.ws + WS_PROJ + PJ_Y2);
    const float* ng = F.a->in[SECOND ? 5 : 4] + layer * 1024;
    LAS float* Wl = (LAS float*)F.lds;
    LAS int* lhist = (LAS int*)(F.lds + LDS_MISC + 1024);
    int* eid = (int*)(F.ws + WS_MISC + MS_EID); float* wsel = (float*)(F.ws + WS_MISC + MS_WSEL);
    if (SECOND) {
        const float* wgp = F.a->in[17] + (size_t)layer * 1024 * 4; const float* wep = F.a->in[19] + (size_t)layer * 1024 * 32;
        {
            f32x4 wg4[2];
#pragma unroll
            for (int q = 0; q < 2; ++q) wg4[q] = ldg<f32x4>(wgp + (F.tid + 512 * q) * 4);
#pragma unroll
            for (int q = 0; q < 2; ++q) { const int k = F.tid + 512 * q; Wl[0 * 1024 + k] = wg4[q][0]; Wl[1 * 1024 + k] = wg4[q][1]; Wl[2 * 1024 + k] = wg4[q][2]; Wl[3 * 1024 + k] = wg4[q][3]; }
#pragma unroll
            for (int h2 = 0; h2 < 2; ++h2) {
                f32x4 we4[8];
#pragma unroll
                for (int q = 0; q < 8; ++q) we4[q] = ldg<f32x4>(wep + (size_t)(F.tid + 512 * (h2 * 8 + q)) * 4);
#pragma unroll
                for (int q = 0; q < 8; ++q) { const int c = F.tid + 512 * (h2 * 8 + q), k = c >> 3, o = 4 * (c & 7);
                    Wl[(4 + o) * 1024 + k] = we4[q][0]; Wl[(5 + o) * 1024 + k] = we4[q][1]; Wl[(6 + o) * 1024 + k] = we4[q][2]; Wl[(7 + o) * 1024 + k] = we4[q][3]; }
            }
        }
        if (F.tid < 32) lhist[F.tid] = 0;
        __syncthreads();
    }
    const int lane = F.lane;
    const int rpw = (T + F.G * 8 - 1) / (F.G * 8), rbeg = (F.bid * 8 + F.wave) * rpw;
    int mkey = -2; f32x4 gnv[4], shv[4], scv[4], g2v[4];
#pragma unroll
    for (int i = 0; i < 4; ++i) { gnv[i] = ldg<f32x4>(ng + i * 256 + lane * 4); g2v[i] = gnv[i]; shv[i] = gnv[i]; scv[i] = gnv[i]; }
    const bool pref = !(layer == 0 && !SECOND); const bool fin = (!SECOND && layer > 0);
    const int rend = (rbeg + rpw < T) ? rbeg + rpw : T;
    u32x2 hn[4], yn[8];
#pragma unroll
    for (int i = 0; i < 4; ++i) { hn[i] = (u32x2){0u, 0u}; yn[i] = hn[i]; yn[4 + i] = hn[i]; }
#define NORM_ISSUE(rr) do { if (pref) { _Pragma("unroll") for (int i = 0; i < 4; ++i) hn[i] = ldg<u32x2>(hb + (size_t)(rr) * 1024 + i * 256 + lane * 4); \
        if (fin) { _Pragma("unroll") for (int i = 0; i < 4; ++i) { yn[i] = ldg<u32x2>(y2 + (size_t)(2 * (rr)) * 1024 + i * 256 + lane * 4); yn[4 + i] = ldg<u32x2>(y2 + (size_t)(2 * (rr) + 1) * 1024 + i * 256 + lane * 4); } } } } while (0)
    if (rbeg < rend) NORM_ISSUE(rbeg);
    for (int r = rbeg; r < rend; ++r) {
        u32x2 hc[4], yc[8];
#pragma unroll
        for (int i = 0; i < 4; ++i) { hc[i] = hn[i]; yc[i] = yn[i]; yc[4 + i] = yn[4 + i]; }
        if (r + 1 < rend) NORM_ISSUE(r + 1);
        const int b = r / NTOK, n = r % NTOK; const bool isctx = n < CTXL;
        if (SECOND && layer == DEPTH - 1 && isctx) continue;
        { const int nk = isctx ? -1 : b;
          if (nk != mkey) { mkey = nk; const float* mod = isctx ? mod_ctx(F, layer) : mod_lat(F, layer, b);
#pragma unroll
            for (int i = 0; i < 4; ++i) { const int c0 = i * 256 + lane * 4; shv[i] = ldg<f32x4>(mod + (SECOND ? 3072 : 0) + c0); scv[i] = ldg<f32x4>(mod + (SECOND ? 4096 : 1024) + c0) + 1.0f; }
            if (!SECOND && layer > 0) { const float* modp = isctx ? mod_ctx(F, layer - 1) : mod_lat(F, layer - 1, b);
#pragma unroll
                for (int i = 0; i < 4; ++i) g2v[i] = ldg<f32x4>(modp + 5120 + i * 256 + lane * 4); } } }
        const size_t hoff = isctx ? ((size_t)b * 256 + n) * 1024 : ((size_t)b * 2048 + (n - 256)) * 1024;
        bf16_t* hrow = hb + (size_t)r * 1024;
        f32x4 x[4];
        if (layer == 0 && !SECOND) { const float* hin = isctx ? F.a->in[2] + hoff : F.a->in[0] + hoff;
#pragma unroll
            for (int i = 0; i < 4; ++i) x[i] = ldg<f32x4>(hin + i * 256 + lane * 4);
        } else {
#pragma unroll
            for (int i = 0; i < 4; ++i) { const u32x2 w = hc[i]; x[i] = (f32x4){bf_lo(w.x), bf_hi(w.x), bf_lo(w.y), bf_hi(w.y)}; }
        }
        if (!SECOND && layer > 0) {
#pragma unroll
            for (int i = 0; i < 4; ++i) {
                const u32x2 a = yc[i], c = yc[4 + i];
                const f32x4 g2 = g2v[i];
                x[i][0] += g2[0] * (bf_lo(a.x) + bf_lo(c.x)); x[i][1] += g2[1] * (bf_hi(a.x) + bf_hi(c.x)); x[i][2] += g2[2] * (bf_lo(a.y) + bf_lo(c.y)); x[i][3] += g2[3] * (bf_hi(a.y) + bf_hi(c.y));
                { u32x2 w; w.x = pk_bf16(x[i][0], x[i][1]); w.y = pk_bf16(x[i][2], x[i][3]); stg<u32x2>(hrow + i * 256 + lane * 4, w); }
            }
        }
        float ss = 0.f;
#pragma unroll
        for (int i = 0; i < 4; ++i) ss += (x[i][0] * x[i][0] + x[i][1] * x[i][1]) + (x[i][2] * x[i][2] + x[i][3] * x[i][3]);
        ss = wave_sum(ss, lane);
        const float rstd = 1.0f / sqrtf(ss * (1.0f / 1024.0f) + RMS_EPS);
        f32x4 v[4];
#pragma unroll
        for (int i = 0; i < 4; ++i) {
            const int c0 = i * 256 + lane * 4;
            v[i] = (x[i] * rstd * gnv[i]) * scv[i] + shv[i];
            u32x2 w; w.x = pk_bf16(v[i][0], v[i][1]); w.y = pk_bf16(v[i][2], v[i][3]);
            stg<u32x2>(abuf + (size_t)r * 1024 + c0, w);
        }
        if (SECOND) {
            const float* bg = F.a->in[18] + layer * 4; const float* be = F.a->in[20] + layer * 32;
            float gl[4]; float gmax = -3.0e38f; int gi = 0;
#pragma unroll
            for (int o = 0; o < 4; ++o) {
                float p = 0.f;
#pragma unroll
                for (int i = 0; i < 4; ++i) { const f32x4 w = *(const LAS f32x4*)(Wl + o * 1024 + i * 256 + lane * 4); p += (v[i][0] * w[0] + v[i][1] * w[1]) + (v[i][2] * w[2] + v[i][3] * w[3]); }
                gl[o] = wave_sum(p, lane) + ldg<float>(bg + o);
                if (gl[o] > gmax) { gmax = gl[o]; gi = o; }
            }
            gi = __builtin_amdgcn_readfirstlane(gi);
            float gsum = 0.f;
#pragma unroll
            for (int o = 0; o < 4; ++o) { gsum += __expf(gl[o] - gmax); asm volatile("" : "+v"(gsum)); }
            const float psel = __builtin_amdgcn_rcpf(gsum);
            float el[8];
#pragma unroll
            for (int o = 0; o < 8; ++o) {
                float p = 0.f;
                const LAS float* wr = Wl + (4 + gi * 8 + o) * 1024;
#pragma unroll
                for (int i = 0; i < 4; ++i) { const f32x4 w = *(const LAS f32x4*)(wr + i * 256 + lane * 4); p += (v[i][0] * w[0] + v[i][1] * w[1]) + (v[i][2] * w[2] + v[i][3] * w[3]); }
                el[o] = wave_sum(p, lane) + ldg<float>(be + gi * 8 + o);
            }
            float m1 = -3.0e38f, m2 = -3.0e38f; int i1 = 0, i2 = 0;
#pragma unroll
            for (int o = 0; o < 8; ++o) { if (el[o] > m1) { m1 = el[o]; i1 = o; } }
#pragma unroll
            for (int o = 0; o < 8; ++o) { if (o != i1 && el[o] > m2) { m2 = el[o]; i2 = o; } }
            const float e2 = __expf(m2 - m1), inv = __builtin_amdgcn_rcpf(1.0f + e2);
            if (lane == 0) {
                stg<int>(eid + 2 * r, gi * 8 + i1); stg<int>(eid + 2 * r + 1, gi * 8 + i2); stg<float>(wsel + 2 * r, inv * psel); stg<float>(wsel + 2 * r + 1, e2 * inv * psel);
                __hip_atomic_fetch_add(&lhist[gi * 8 + i1], 1, __ATOMIC_RELAXED, __HIP_MEMORY_SCOPE_WORKGROUP); __hip_atomic_fetch_add(&lhist[gi * 8 + i2], 1, __ATOMIC_RELAXED, __HIP_MEMORY_SCOPE_WORKGROUP);
            }
        }
    }
    if (SECOND) {
        __syncthreads();
        if (F.tid < 32) { const int c = lhist[F.tid]; if (c) __hip_atomic_fetch_add((unsigned*)(F.ws + WS_CTL) + CW_CNT + layer * 64 + F.tid, (unsigned)c, __ATOMIC_RELAXED, __HIP_MEMORY_SCOPE_AGENT); }
    }
}

#undef NORM_ISSUE
DI int build_segments(const Frame& F, int layer, LAS int* segs, LAS int* tile_e) {
    __syncthreads();
    if (F.tid < 32) {
        const unsigned* cnt = (const unsigned*)(F.ws + WS_CTL) + CW_CNT + layer * 64;
        segs[40 + F.tid] = (int)__hip_atomic_load(cnt + F.tid, __ATOMIC_RELAXED, __HIP_MEMORY_SCOPE_AGENT);
    }
    __syncthreads();
    if (F.tid == 0) {
        int s = 0;
        for (int e = 0; e < 32; ++e) { segs[e] = s; s += (segs[40 + e] + 255) & ~255; }
        segs[32] = s;
    }
    __syncthreads();
    const int ntl = segs[32] >> 8;
    if (tile_e) {
        for (int t = F.tid; t < ntl; t += 512) { int e = 0;
            for (int q = 1; q < 32; ++q) e = (segs[q] <= t * 256) ? q : e;
            tile_e[t] = e; }
        __syncthreads();
    }
    return ntl;
}

DI void sort_phase(const Frame& F, int layer) {
    LAS int* segs = (LAS int*)(F.lds + LDS_MISC + 2048);
    LAS int* lhist = (LAS int*)(F.lds + LDS_MISC + 1024);
    LAS int* lbase = (LAS int*)(F.lds + LDS_MISC + 1024 + 128);
    LAS int* lpos = (LAS int*)F.lds;
    build_segments(F, layer, segs, nullptr);
    const int* eid = (const int*)(F.ws + WS_MISC + MS_EID); const float* wsel = (const float*)(F.ws + WS_MISC + MS_WSEL); int* rowinfo = (int*)(F.ws + WS_MISC + MS_WSORT);
    const bf16_t* abuf = (const bf16_t*)(F.ws + WS_ABUF); bf16_t* sa = (bf16_t*)(F.ws + WS_PROJ + PJ_SA);
    const int RPB = (T + F.G - 1) / F.G;
    const int r0 = F.bid * RPB, r1 = (r0 + RPB < T) ? r0 + RPB : T;
    const int na = r1 > r0 ? 2 * (r1 - r0) : 0;
    if (F.tid < 32) lhist[F.tid] = 0;
    __syncthreads();
    int ee[2], lp[2];
#pragma unroll
    for (int it = 0; it < 2; ++it) { const int a = F.tid + 512 * it; ee[it] = -1; lp[it] = 0;
        if (a < na && !(layer == DEPTH - 1 && ((r0 + (a >> 1)) % NTOK) < CTXL)) { ee[it] = ldg<int>(eid + 2 * r0 + a); lp[it] = __hip_atomic_fetch_add(&lhist[ee[it]], 1, __ATOMIC_RELAXED, __HIP_MEMORY_SCOPE_WORKGROUP); } }
    __syncthreads();
    if (F.tid < 32) { const int c = lhist[F.tid];
        lbase[F.tid] = segs[F.tid] + (c ? (int)__hip_atomic_fetch_add((unsigned*)(F.ws + WS_CTL) + CW_CUR + layer * 64 + F.tid, (unsigned)c, __ATOMIC_RELAXED, __HIP_MEMORY_SCOPE_AGENT) : 0); }
    __syncthreads();
#pragma unroll
    for (int it = 0; it < 2; ++it) { const int a = F.tid + 512 * it;
        if (ee[it] >= 0) { const int pos = lbase[ee[it]] + lp[it]; lpos[a] = pos; stg<u32x2>((unsigned*)rowinfo + 2 * (size_t)pos, (u32x2){(unsigned)(2 * r0 + a), __float_as_uint(ldg<float>(wsel + 2 * r0 + a))}); } }
    __syncthreads();
    if (F.bid < 32) { const int e = F.bid; for (int p = segs[e] + segs[40 + e] + F.tid; p < segs[e + 1]; p += 512) stg<int>(rowinfo + 2 * (size_t)p, -1); }
    if (F.G < 32 && F.bid == 0) { for (int e = F.G; e < 32; ++e) for (int p = segs[e] + segs[40 + e] + F.tid; p < segs[e + 1]; p += 512) stg<int>(rowinfo + 2 * (size_t)p, -1); }
}

typedef __bf16 bf16x2_t __attribute__((ext_vector_type(2)));
DI float dot2_ones(unsigned packed, float c) { return __builtin_amdgcn_fdot2_f32_bf16(__builtin_bit_cast(bf16x2_t, packed), __builtin_bit_cast(bf16x2_t, 0x3f803f80u), c, false); }
constexpr int AT_KROW = 272, AT_VROW = 136, AT_KB = 64 * AT_KROW, AT_VB = 128 * AT_VROW, AT_BUF = AT_KB + AT_VB, AT_V0 = 3 * AT_KB, AT_Q0 = 3 * AT_KB + 2 * AT_VB;
static_assert(AT_Q0 + 65536 <= LDS_MISC, "attention LDS");
template <bool USEOFF>
DI void attn_body(const Frame& F, int layer) {
    const int j = layer >> 1;
    const bf16_t* Qb = (const bf16_t*)(F.ws + WS_PROJ + PJ_Q); const bf16_t* Kb = (const bf16_t*)(F.ws + WS_PROJ + PJ_K); const bf16_t* VT = (const bf16_t*)(F.ws + WS_PROJ + PJ_VT);
    bf16_t* Ob = (bf16_t*)(F.ws + WS_OBUF);
    { }
    const int lane0 = F.lane;
    const float* lam = F.a->in[11] + j * 256;
    float p01 = ldg<float>(lam + lane0) * ldg<float>(lam + 64 + lane0), p23 = ldg<float>(lam + 128 + lane0) * ldg<float>(lam + 192 + lane0);
    p01 = wave_sum(p01, lane0); p23 = wave_sum(p23, lane0);
    const float lam_init = 0.8f - 0.6f * __expf(-0.3f * (float)layer);
    const float lam_full = uni_f(__expf(p01) - __expf(p23) + lam_init);
    float mq = fabsf(ldg<float>(F.a->in[9] + j * 64 + lane0)), mk = fabsf(ldg<float>(F.a->in[10] + j * 64 + lane0));
#pragma unroll
    for (int o = 32; o >= 1; o >>= 1) { mq = fmaxf(mq, shx(mq, o, lane0)); mk = fmaxf(mk, shx(mk, o, lane0)); }
    const float OFF = uni_f(8.0f * LOG2E * mq * mk);
    const float* gsub = F.a->in[12] + j * 128;
    const float lam_init_s = uni_f(lam_init);

    for (int u = F.bid; u < 2304; u += F.G) {
        int b, h, qb, nkt;
        if (u < 2048) {
            int bh;
            if (F.G == 256) { const int i = u >> 8, c = u & 255; bh = i * 32 + (c & 7) * 4 + (c >> 6); qb = 1 + ((c >> 3) & 7); } else { bh = u >> 3; qb = 1 + (u & 7); }
            b = bh >> 3; h = bh & 7; nkt = 36;
        } else { const int uu = u - 2048; b = uu >> 3; h = uu & 7; qb = 0; nkt = 4; }
        const size_t rowbase = (size_t)b * NTOK;
        const int lane = lane_id_asm(), lr = lane & 31, lh = lane >> 5, tidu = (F.wave << 6) | lane;
        const size_t qrow = rowbase + qb * 256 + F.wave * 32 + (lane_id_asm() & 31);
        __syncthreads();
        const int qlo = AT_Q0 + F.wave * 8192 + lane * 16;
#pragma unroll
        for (int mp = 0; mp < 2; ++mp)
#pragma unroll
            for (int ks = 0; ks < 4; ++ks) *(LAS bf16x8*)(F.lds + qlo + (mp * 4 + ks) * 1024) = ldg<bf16x8>(Qb + qrow * 1024 + h * 128 + mp * 64 + ks * 16 + lh * 8);
        f32x16 O1[4], O2[4];
#pragma unroll
        for (int e = 0; e < 4; ++e)
#pragma unroll
            for (int i = 0; i < 16; ++i) { O1[e][i] = 0.f; O2[e][i] = 0.f; }
        float l1p = 0.f, l2p = 0.f;
        const unsigned kgo = (unsigned)((tidu >> 4) * 1024 + (tidu & 15) * 8), vgo = (unsigned)((tidu >> 3) * T + (tidu & 7) * 8);
        const int klo = (tidu >> 4) * AT_KROW + (tidu & 15) * 16, vlo = (tidu >> 3) * AT_VROW + (tidu & 7) * 16;
        const bf16_t* kbase = Kb + rowbase * 1024 + h * 128; const bf16_t* vbase = VT + (size_t)(h * 128) * T + rowbase;
        u32x4 sk[2], sv[2];
#define AT_LOADK(tt) do { _Pragma("unroll") for (int i = 0; i < 2; ++i) sk[i] = ldg<u32x4>(kbase + (size_t)(tt) * 65536 + (size_t)i * 32768 + kgo); } while (0)
#define AT_LOADV(tt) do { _Pragma("unroll") for (int i = 0; i < 2; ++i) sv[i] = ldg<u32x4>(vbase + (size_t)i * 64 * T + (size_t)(tt) * 64 + vgo); } while (0)
#define AT_WRITEK(ko) do { _Pragma("unroll") for (int i = 0; i < 2; ++i) *(LAS u32x4*)(F.lds + (ko) + klo + i * 32 * AT_KROW) = sk[i]; } while (0)
#define AT_WRITEV(vo_) do { _Pragma("unroll") for (int i = 0; i < 2; ++i) { *(LAS u32x2*)(F.lds + (vo_) + vlo + i * 64 * AT_VROW) = (u32x2){sv[i].x, sv[i].y}; *(LAS u32x2*)(F.lds + (vo_) + vlo + i * 64 * AT_VROW + 8) = (u32x2){sv[i].z, sv[i].w}; } } while (0)
#define AT_KFR(bo, kb, st) (*(const LAS bf16x8*)(F.lds + (bo) + ((kb) * 32 + lr) * AT_KROW + (((st) & 1) * 64 + ((st) >> 1) * 16 + lh * 8) * 2))
#define AT_QFR(st) (*(const LAS bf16x8*)(F.lds + qlo + (((st) & 1) * 4 + ((st) >> 1)) * 1024))
#define AT_QK(bo, kb, S1_, S2_) do { \
            _Pragma("unroll") for (int i = 0; i < 16; ++i) { S1_[i] = USEOFF ? -OFF : 0.f; S2_[i] = USEOFF ? -OFF : 0.f; } \
            bf16x8 kfr_[3], qfr_[3]; \
            kfr_[0] = AT_KFR(bo, kb, 0); qfr_[0] = AT_QFR(0); kfr_[1] = AT_KFR(bo, kb, 1); qfr_[1] = AT_QFR(1); \
            _Pragma("unroll") for (int st = 0; st < 8; ++st) { \
                if (st + 2 < 8) { kfr_[(st + 2) % 3] = AT_KFR(bo, kb, st + 2); qfr_[(st + 2) % 3] = AT_QFR(st + 2); } \
                if (st & 1) S2_ = __builtin_amdgcn_mfma_f32_32x32x16_bf16(kfr_[st % 3], qfr_[st % 3], S2_, 0, 0, 0); \
                else S1_ = __builtin_amdgcn_mfma_f32_32x32x16_bf16(kfr_[st % 3], qfr_[st % 3], S1_, 0, 0, 0); \
                __builtin_amdgcn_sched_barrier(0); } } while (0)
#define AT_FIN(S_, lp_, P_) do { \
            _Pragma("unroll") for (int s = 0; s < 2; ++s) { u32x4 w; w.x = pk_bf16(S_[8 * s], S_[8 * s + 1]); w.y = pk_bf16(S_[8 * s + 2], S_[8 * s + 3]); w.z = pk_bf16(S_[8 * s + 4], S_[8 * s + 5]); w.w = pk_bf16(S_[8 * s + 6], S_[8 * s + 7]); \
                lp_ = dot2_ones(w.x, lp_); lp_ = dot2_ones(w.y, lp_); lp_ = dot2_ones(w.z, lp_); lp_ = dot2_ones(w.w, lp_);        \
                P_[s] = __builtin_bit_cast(bf16x8, w); } } while (0)
#define AT_VFR(bo, kb, ix) ([&]() -> bf16x8 { const int vo = (bo) + (((ix) >> 1) * 32 + lr) * AT_VROW + ((kb) * 32 + 16 * ((ix) & 1) + 4 * lh) * 2; \
            const s16x4 lo = *(const LAS s16x4*)(F.lds + vo), hi = *(const LAS s16x4*)(F.lds + vo + 16); return __builtin_shufflevector(lo, hi, 0, 1, 2, 3, 4, 5, 6, 7); }())
#define AT_PV_EXP(bo, kb, Pa_, Pb_, X1_, X2_, doexp) do { \
            bf16x8 vfr_[3]; vfr_[0] = AT_VFR(bo, kb, 0); vfr_[1] = AT_VFR(bo, kb, 1); \
            _Pragma("unroll") for (int ix = 0; ix < 8; ++ix) { \
                if (ix + 2 < 8) vfr_[(ix + 2) % 3] = AT_VFR(bo, kb, ix + 2); \
                O1[ix >> 1] = __builtin_amdgcn_mfma_f32_32x32x16_bf16(vfr_[ix % 3], Pa_[ix & 1], O1[ix >> 1], 0, 0, 0); \
                O2[ix >> 1] = __builtin_amdgcn_mfma_f32_32x32x16_bf16(vfr_[ix % 3], Pb_[ix & 1], O2[ix >> 1], 0, 0, 0); \
                if (doexp) { _Pragma("unroll") for (int i = 0; i < 2; ++i) { X1_[2 * ix + i] = __builtin_amdgcn_exp2f(X1_[2 * ix + i]); X2_[2 * ix + i] = __builtin_amdgcn_exp2f(X2_[2 * ix + i]); } } \
                __builtin_amdgcn_sched_barrier(0); } } while (0)
        f32x16 Sa1, Sa2, Sb1, Sb2; bf16x8 Pa1[2], Pa2[2], Pb1[2], Pb2[2];
        AT_LOADK(0); AT_LOADV(0);
        AT_WRITEK(0); AT_WRITEV(AT_V0);
        if (nkt > 1) { AT_LOADK(1); AT_WRITEK(AT_KB); AT_LOADV(1); }
        if (nkt > 2) AT_LOADK(2);
        __syncthreads();
        AT_QK(0, 0, Sa1, Sa2);
#pragma unroll
        for (int i = 0; i < 16; ++i) { Sa1[i] = __builtin_amdgcn_exp2f(Sa1[i]); Sa2[i] = __builtin_amdgcn_exp2f(Sa2[i]); }
        AT_FIN(Sa1, l1p, Pa1); AT_FIN(Sa2, l2p, Pa2);
        int kc = 0, kn = AT_KB, kw = 2 * AT_KB;
        for (int t = 0; t < nkt; ++t) {
            const int vc = AT_V0 + (t & 1) * AT_VB, vn = AT_V0 + AT_VB - (t & 1) * AT_VB;
            const bool hn = (t + 1 < nkt);
            __syncthreads();
            if (t + 2 < nkt) AT_WRITEK(kw);
            if (hn) AT_WRITEV(vn);
            if (t + 3 < nkt) AT_LOADK(t + 3);
            if (t + 2 < nkt) AT_LOADV(t + 2);
            AT_QK(kc, 1, Sb1, Sb2);
            AT_PV_EXP(vc, 0, Pa1, Pa2, Sb1, Sb2, true);
            AT_FIN(Sb1, l1p, Pb1); AT_FIN(Sb2, l2p, Pb2);
            if (hn) AT_QK(kn, 0, Sa1, Sa2);
            AT_PV_EXP(vc, 1, Pb1, Pb2, Sa1, Sa2, hn);
            if (hn) { AT_FIN(Sa1, l1p, Pa1); AT_FIN(Sa2, l2p, Pa2); }
            { const int k_ = kc; kc = kn; kn = kw; kw = k_; }
        }
#undef AT_LOADK
#undef AT_LOADV
#undef AT_WRITEK
#undef AT_WRITEV
#undef AT_QK
#undef AT_KFR
#undef AT_QFR
#undef AT_VFR
#undef AT_FIN
#undef AT_PV_EXP
        const int lane3 = lane_id_asm(), lr3 = lane3 & 31, lh3 = lane3 >> 5;
        const size_t qrow3 = rowbase + qb * 256 + F.wave * 32 + lr3;
        float l1 = l1p, l2 = l2p;
        l1 += shx(l1, 32, lane3); l2 += shx(l2, 32, lane3);
        const float i1 = 1.0f / l1, i2 = lam_full / l2;
        float ss = 0.f;
#pragma unroll
        for (int e = 0; e < 4; ++e)
#pragma unroll
            for (int i = 0; i < 16; ++i) { const float o = O1[e][i] * i1 - O2[e][i] * i2; O1[e][i] = o; ss += o * o; }
        ss += shx(ss, 32, lane3);
        float li_ = lam_init_s; asm volatile("" : "+s"(li_));
        const float rstd = __builtin_amdgcn_rsqf(ss * (1.0f / 128.0f) + RMS_EPS) * (1.0f - li_);
        bf16_t* orow = Ob + qrow3 * 1024 + h * 128;
#pragma unroll
        for (int e = 0; e < 4; ++e)
#pragma unroll
            for (int g4 = 0; g4 < 4; ++g4) {
                const int e0 = e * 32 + 8 * g4 + 4 * lh3;
                const f32x4 gs = ldg<f32x4>(gsub + e0);
                u32x2 w; w.x = pk_bf16(O1[e][4 * g4] * rstd * gs[0], O1[e][4 * g4 + 1] * rstd * gs[1]); w.y = pk_bf16(O1[e][4 * g4 + 2] * rstd * gs[2], O1[e][4 * g4 + 3] * rstd * gs[3]);
                stg<u32x2>(orow + e0, w);
            }
    }
    __syncthreads();
}

DI void attn_phase(const Frame& F, int layer) {
    const int j = layer >> 1;
    float mq = fabsf(ldg<float>(F.a->in[9] + j * 64 + F.lane)), mk = fabsf(ldg<float>(F.a->in[10] + j * 64 + F.lane));
#pragma unroll
    for (int o = 32; o >= 1; o >>= 1) { mq = fmaxf(mq, shx(mq, o, F.lane)); mk = fmaxf(mk, shx(mk, o, F.lane)); }
    const bool useoff = uni_f(8.0f * LOG2E * mq * mk) > 40.0f;
    if (useoff) attn_body<true>(F, layer); else attn_body<false>(F, layer);
}

constexpr int SC_Q = 0, SC_QROW = 528, SC_K = 32 * SC_QROW, SC_V = SC_K + 16384, SC_BUF = SC_V + 16384, SC_S = 2 * SC_BUF, SC_SROW = 80, SC_RED = SC_S + 2 * 32 * SC_SROW, SC_Y = SC_RED + 1024, SC_YROW = 528;
DI void scan_phase(const Frame& F, int layer, int hf) {
    const int j = layer >> 1;
    const bf16_t* RQ = (const bf16_t*)(F.ws + WS_PROJ + PJ_RQ); bf16_t* RG = (bf16_t*)(F.ws + WS_PROJ + PJ_RG);
    const bf16_t* RKT = (const bf16_t*)(F.ws + WS_PROJ + PJ_RKT); const bf16_t* RVT = (const bf16_t*)(F.ws + WS_PROJ + PJ_RVT);
    float* ssqb = (float*)(F.ws + WS_MISC + MS_SSQ);
    const int tid = F.tid;
    for (int u = F.bid; u < 256; u += F.G) {
        int bl, h, dir, eh;
        if (F.G == 256) { const int base = (u >> 5) * 8 + (u & 7), var = (u >> 3) & 3; bl = base >> 2; h = base & 3; dir = var >> 1; eh = var & 1; }
        else { bl = u >> 4; h = (u >> 2) & 3; dir = (u >> 1) & 1; eh = u & 1; }
        const float l2g = __log2f(1.0f - __expf(ldg<float>(F.a->in[15] + j * 8 + dir * 4 + h)));
        const float g32 = __builtin_amdgcn_exp2f(32.0f * l2g);
        const int sgn = dir ? -1 : 1, kd_a = dir ? 0 : 31, qd_a = dir ? 32 : 1;
        const size_t rb = (size_t)bl * NTOK;
        const bf16_t* qbase = RQ + rb * 1024 + h * 256;
        const bf16_t* ktbase = RKT + ((size_t)(rb >> 5) * 1024 + h * 256) * 32;
        const bf16_t* vtbase = RVT + ((size_t)(rb >> 5) * 2048 + h * 512 + eh * 256) * 32;
        bf16_t* gbase = RG + (rb + (tid >> 4)) * 4096 + dir * 2048 + h * 512 + eh * 256 + (tid & 15) * 16;
        const int qt = tid >> 5, qc = tid & 31;
        const unsigned qgo = (unsigned)(qt * 1024 + qc * 8);
        const int ql0 = SC_Q + qt * SC_QROW + qc * 16, ql1 = ql0 + 16 * SC_QROW;
        const int kd = tid >> 2, kc = tid & 3;
        const unsigned kgo = (unsigned)(kd * 32 + kc * 8);
        const int kl = kd * 64 + (((kc ^ (kd >> 2)) & 3) << 4);
        f32x16 S[8];
#pragma unroll
        for (int d = 0; d < 8; ++d)
#pragma unroll
            for (int i = 0; i < 16; ++i) S[d][i] = 0.f;
        u32x4 sq[2], sk[2], sv[2];
        __syncthreads();
        if (tid < 64) { const int t = tid & 31; *(LAS float*)(F.lds + SC_RED + tid * 4) = __builtin_amdgcn_exp2f((float)(tid < 32 ? kd_a - sgn * t : qd_a + sgn * t) * l2g); }
        {
            const int tok0 = dir ? 224 : 0;
#pragma unroll
            for (int i = 0; i < 2; ++i) { sq[i] = ldg<u32x4>(qbase + (size_t)(tok0 + 16 * i) * 1024 + qgo); sk[i] = ldg<u32x4>(ktbase + (size_t)tok0 * 1024 + i * 4096 + kgo); sv[i] = ldg<u32x4>(vtbase + (size_t)tok0 * 2048 + i * 4096 + kgo); }
            *(LAS u32x4*)(F.lds + ql0) = sq[0]; *(LAS u32x4*)(F.lds + ql1) = sq[1];
#pragma unroll
            for (int i = 0; i < 2; ++i) { *(LAS u32x4*)(F.lds + SC_K + kl + i * 8192) = sk[i]; *(LAS u32x4*)(F.lds + SC_V + kl + i * 8192) = sv[i]; }
        }
        __syncthreads();
        for (int ci = 0; ci < 72; ++ci) {
            const int tok0 = dir ? 32 * ((ci < 8 ? 7 : 79) - ci) : 32 * ci;
            const int t2 = launder(tid); const int lane = t2 & 63, lr = lane & 31, lh = lane >> 5, w = __builtin_amdgcn_readfirstlane(t2 >> 6), op = t2 >> 4, oc = t2 & 15;
            float l2c = l2g; asm volatile("" : "+v"(l2c));
            const int cb = (ci & 1) * SC_BUF, nb = SC_BUF - cb, sb = SC_S + (ci & 1) * 32 * SC_SROW;
            if (ci + 1 < 72) {
                const int cn = ci + 1; const int tn = dir ? 32 * ((cn < 8 ? 7 : 79) - cn) : 32 * cn;
#pragma unroll
                for (int i = 0; i < 2; ++i) { sq[i] = ldg<u32x4>(qbase + (size_t)(tn + 16 * i) * 1024 + qgo); sk[i] = ldg<u32x4>(ktbase + (size_t)tn * 1024 + i * 4096 + kgo); sv[i] = ldg<u32x4>(vtbase + (size_t)tn * 2048 + i * 4096 + kgo); }
            }
            const u32x4 gt0 = ldg<u32x4>(gbase + (size_t)tok0 * 4096), gt1 = ldg<u32x4>(gbase + (size_t)tok0 * 4096 + 8);
            if (w < 4) {
                const int p0 = 16 * (w >> 1), m0 = 16 * (w & 1);
                const int l15 = lane & 15, g4 = lane >> 4, tq = l15 >> 2, tp = l15 & 3;
                f32x4 sc = {0.f, 0.f, 0.f, 0.f};
                const bool dead = sgn * (p0 - m0) < 0;
                if (!dead) {
#pragma unroll
                    for (int ks = 0; ks < 8; ++ks) {
                        const int prow = p0 + l15, qchunk = 4 * ks + g4;
                        const bf16x8 af = *(const LAS bf16x8*)(F.lds + cb + SC_Q + prow * SC_QROW + qchunk * 16);
                        const int d0 = 32 * ks + 8 * g4 + tq, cc = (m0 >> 3) + (tp >> 1);
                        const s16x4 b0 = __builtin_amdgcn_ds_read_tr16_b64_v4i16((LAS s16x4*)(F.lds + cb + SC_K + d0 * 64 + (((cc ^ (d0 >> 2)) & 3) << 4) + 8 * (tp & 1)));
                        const s16x4 b1 = __builtin_amdgcn_ds_read_tr16_b64_v4i16((LAS s16x4*)(F.lds + cb + SC_K + (d0 + 4) * 64 + (((cc ^ ((d0 + 4) >> 2)) & 3) << 4) + 8 * (tp & 1)));
                        const bf16x8 bfr = __builtin_shufflevector(b0, b1, 0, 1, 2, 3, 4, 5, 6, 7);
                        sc = __builtin_amdgcn_mfma_f32_16x16x32_bf16(af, bfr, sc, 0, 0, 0);
                    }
                }
                const int mm = m0 + l15;
#pragma unroll
                for (int r = 0; r < 4; ++r) { const int pp = p0 + 4 * g4 + r; const int df = sgn * (pp - mm);
                    const float v = df >= 0 ? sc[r] * __builtin_amdgcn_exp2f((float)df * l2c) : 0.f;
                    *(LAS bf16_t*)(F.lds + sb + pp * SC_SROW + mm * 2) = (bf16_t)(pk_bf16(v, 0.f) & 0xffffu); }
            }
            __syncthreads();
            bf16x8 vf[2], vd[2];
            {
                const int e = 32 * w + lr;
#pragma unroll
                for (int ks = 0; ks < 2; ++ks) {
                    const int cc = 2 * ks + lh;
                    vf[ks] = *(const LAS bf16x8*)(F.lds + cb + SC_V + e * 64 + (((cc ^ (e >> 2)) & 3) << 4));
                    const u32x4 raw = __builtin_bit_cast(u32x4, vf[ks]); u32x4 o;
                    const f32x4 kda = *(const LAS f32x4*)(F.lds + SC_RED + (16 * ks + 8 * lh) * 4), kdb = *(const LAS f32x4*)(F.lds + SC_RED + (16 * ks + 8 * lh + 4) * 4);
                    const float kd8[8] = {kda[0], kda[1], kda[2], kda[3], kdb[0], kdb[1], kdb[2], kdb[3]};
                    o.x = pk_bf16(bf_lo(raw.x) * kd8[0], bf_hi(raw.x) * kd8[1]); o.y = pk_bf16(bf_lo(raw.y) * kd8[2], bf_hi(raw.y) * kd8[3]);
                    o.z = pk_bf16(bf_lo(raw.z) * kd8[4], bf_hi(raw.z) * kd8[5]); o.w = pk_bf16(bf_lo(raw.w) * kd8[6], bf_hi(raw.w) * kd8[7]);
                    vd[ks] = __builtin_bit_cast(bf16x8, o);
                }
            }
            f32x16 Y;
#pragma unroll
            for (int i = 0; i < 16; ++i) Y[i] = 0.f;
#pragma unroll
            for (int dt = 0; dt < 8; ++dt)
#pragma unroll
                for (int s = 0; s < 2; ++s) {
                    u32x4 pb; pb.x = pk_bf16(S[dt][8 * s], S[dt][8 * s + 1]); pb.y = pk_bf16(S[dt][8 * s + 2], S[dt][8 * s + 3]); pb.z = pk_bf16(S[dt][8 * s + 4], S[dt][8 * s + 5]); pb.w = pk_bf16(S[dt][8 * s + 6], S[dt][8 * s + 7]);
                    const int c0 = 4 * dt + 2 * s;
                    const s16x4 a0 = *(const LAS s16x4*)(F.lds + cb + SC_Q + lr * SC_QROW + c0 * 16 + 8 * lh);
                    const s16x4 a1 = *(const LAS s16x4*)(F.lds + cb + SC_Q + lr * SC_QROW + c0 * 16 + 16 + 8 * lh);
                    const bf16x8 af = __builtin_shufflevector(a0, a1, 0, 1, 2, 3, 4, 5, 6, 7);
                    Y = __builtin_amdgcn_mfma_f32_32x32x16_bf16(af, __builtin_bit_cast(bf16x8, pb), Y, 0, 0, 0);
                }
#pragma unroll
            for (int g = 0; g < 4; ++g) { const f32x4 qd = *(const LAS f32x4*)(F.lds + SC_RED + 128 + (8 * g + 4 * lh) * 4); Y[4 * g] *= qd[0]; Y[4 * g + 1] *= qd[1]; Y[4 * g + 2] *= qd[2]; Y[4 * g + 3] *= qd[3]; }
#pragma unroll
            for (int ks = 0; ks < 2; ++ks) {
                const bf16x8 sf = *(const LAS bf16x8*)(F.lds + sb + lr * SC_SROW + (16 * ks + 8 * lh) * 2);
                Y = __builtin_amdgcn_mfma_f32_32x32x16_bf16(sf, vf[ks], Y, 0, 0, 0);
            }
#pragma unroll
            for (int dt = 0; dt < 8; ++dt) {
#pragma unroll
                for (int i = 0; i < 16; ++i) { float r_; asm("v_mul_f32 %0, %1, %2" : "=v"(r_) : "v"(g32), "v"(S[dt][i])); S[dt][i] = r_; }
#pragma unroll
                for (int ks = 0; ks < 2; ++ks) {
                    const int d = 32 * dt + lr, cc = 2 * ks + lh;
                    const bf16x8 kf = *(const LAS bf16x8*)(F.lds + cb + SC_K + d * 64 + (((cc ^ (d >> 2)) & 3) << 4));
                    S[dt] = __builtin_amdgcn_mfma_f32_32x32x16_bf16(kf, vd[ks], S[dt], 0, 0, 0);
                }
            }
#pragma unroll
            for (int r = 0; r < 16; ++r) *(LAS bf16_t*)(F.lds + SC_Y + ((r & 3) + 8 * (r >> 2) + 4 * lh) * SC_YROW + (w * 32 + lr) * 2) = (bf16_t)(pk_bf16(Y[r], 0.f) & 0xffffu);
            if (ci + 1 < 72) {
                *(LAS u32x4*)(F.lds + nb + ql0) = sq[0]; *(LAS u32x4*)(F.lds + nb + ql1) = sq[1];
#pragma unroll
                for (int i = 0; i < 2; ++i) { *(LAS u32x4*)(F.lds + nb + SC_K + kl + i * 8192) = sk[i]; *(LAS u32x4*)(F.lds + nb + SC_V + kl + i * 8192) = sv[i]; }
            }
            __syncthreads();
            {
                const u32x4 y0 = *(const LAS u32x4*)(F.lds + SC_Y + op * SC_YROW + oc * 32), y1 = *(const LAS u32x4*)(F.lds + SC_Y + op * SC_YROW + oc * 32 + 16);
                u32x4 z0, z1;
                z0.x = pk_bf16(bf_lo(y0.x) * bf_lo(gt0.x), bf_hi(y0.x) * bf_hi(gt0.x)); z0.y = pk_bf16(bf_lo(y0.y) * bf_lo(gt0.y), bf_hi(y0.y) * bf_hi(gt0.y));
                z0.z = pk_bf16(bf_lo(y0.z) * bf_lo(gt0.z), bf_hi(y0.z) * bf_hi(gt0.z)); z0.w = pk_bf16(bf_lo(y0.w) * bf_lo(gt0.w), bf_hi(y0.w) * bf_hi(gt0.w));
                z1.x = pk_bf16(bf_lo(y1.x) * bf_lo(gt1.x), bf_hi(y1.x) * bf_hi(gt1.x)); z1.y = pk_bf16(bf_lo(y1.y) * bf_lo(gt1.y), bf_hi(y1.y) * bf_hi(gt1.y));
                z1.z = pk_bf16(bf_lo(y1.z) * bf_lo(gt1.z), bf_hi(y1.z) * bf_hi(gt1.z)); z1.w = pk_bf16(bf_lo(y1.w) * bf_lo(gt1.w), bf_hi(y1.w) * bf_hi(gt1.w));
                stg<u32x4>(gbase + (size_t)tok0 * 4096, z0); stg<u32x4>(gbase + (size_t)tok0 * 4096 + 8, z1);
                float q = (bf_lo(y0.x) * bf_lo(y0.x) + bf_hi(y0.x) * bf_hi(y0.x)) + (bf_lo(y0.y) * bf_lo(y0.y) + bf_hi(y0.y) * bf_hi(y0.y)) + (bf_lo(y0.z) * bf_lo(y0.z) + bf_hi(y0.z) * bf_hi(y0.z)) + (bf_lo(y0.w) * bf_lo(y0.w) + bf_hi(y0.w) * bf_hi(y0.w))
                        + (bf_lo(y1.x) * bf_lo(y1.x) + bf_hi(y1.x) * bf_hi(y1.x)) + (bf_lo(y1.y) * bf_lo(y1.y) + bf_hi(y1.y) * bf_hi(y1.y)) + (bf_lo(y1.z) * bf_lo(y1.z) + bf_hi(y1.z) * bf_hi(y1.z)) + (bf_lo(y1.w) * bf_lo(y1.w) + bf_hi(y1.w) * bf_hi(y1.w));
                q += DPPF(q, 0xB1, 0xf); q += DPPF(q, 0x4E, 0xf); q += DPPF(q, 0x141, 0xf); q += DPPF(q, 0x140, 0xf);
                if (oc == 0) stg<float>(ssqb + (((size_t)eh * 2 + dir) * HROWS + rb + tok0 + op) * 4 + h, q);
            }
        }
    }
    __syncthreads();
}

DI void comb_phase(const Frame& F, int hf, bool latonly) {
    const bf16_t* PJ = (const bf16_t*)(F.ws + WS_PROJ + PJ_RG);
    const float* ssqb = (const float*)(F.ws + WS_MISC + MS_SSQ);
    bf16_t* O = (bf16_t*)(F.ws + (hf == 0 ? WS_OBUF : WS_ABUF));
    const int rpw = (36864 + F.G * 8 - 1) / (F.G * 8), rbeg = (F.bid * 8 + F.wave) * rpw;
    for (int r0 = rbeg; r0 < rbeg + rpw && r0 < 36864; r0 += 2) {
        u32x4 zf[2][4], zb[2][4]; float sf[2][4], sb[2][4]; bool on[2];
#pragma unroll
        for (int q = 0; q < 2; ++q) { const int r = r0 + q; on[q] = (r < rbeg + rpw) && (r < 36864) && !(latonly && (r % NTOK) < CTXL);
            if (on[q]) {
#pragma unroll
                for (int i = 0; i < 4; ++i) { const int c = i * 512 + F.lane * 8;
                    zf[q][i] = ldg<u32x4>(PJ + (size_t)r * 4096 + c); zb[q][i] = ldg<u32x4>(PJ + (size_t)r * 4096 + 2048 + c);
                    sf[q][i] = ldg<float>(ssqb + ((size_t)(0 * 2 + 0) * 36864 + r) * 4 + i) + ldg<float>(ssqb + ((size_t)(1 * 2 + 0) * 36864 + r) * 4 + i);
                    sb[q][i] = ldg<float>(ssqb + ((size_t)(0 * 2 + 1) * 36864 + r) * 4 + i) + ldg<float>(ssqb + ((size_t)(1 * 2 + 1) * 36864 + r) * 4 + i); } } }
#pragma unroll
        for (int q = 0; q < 2; ++q) if (on[q]) { const int r = r0 + q;
#pragma unroll
            for (int i = 0; i < 4; ++i) {
                const float rf = __builtin_amdgcn_rsqf(sf[q][i] * (1.0f / 512.0f) + RMS_EPS), rb = __builtin_amdgcn_rsqf(sb[q][i] * (1.0f / 512.0f) + RMS_EPS);
                const u32x4 a = zf[q][i], b = zb[q][i]; u32x4 w;
                w.x = pk_bf16(rf * bf_lo(a.x) + rb * bf_lo(b.x), rf * bf_hi(a.x) + rb * bf_hi(b.x));
                w.y = pk_bf16(rf * bf_lo(a.y) + rb * bf_lo(b.y), rf * bf_hi(a.y) + rb * bf_hi(b.y));
                w.z = pk_bf16(rf * bf_lo(a.z) + rb * bf_lo(b.z), rf * bf_hi(a.z) + rb * bf_hi(b.z));
                w.w = pk_bf16(rf * bf_lo(a.w) + rb * bf_lo(b.w), rf * bf_hi(a.w) + rb * bf_hi(b.w));
                stg<u32x4>(O + (size_t)r * 2048 + i * 512 + F.lane * 8, w);
            } }
    }
}

DI void final_phase(const Frame& F) {
    const bf16_t* y2 = (const bf16_t*)(F.ws + WS_PROJ + PJ_Y2);
    const int rpw = (T + F.G * 8 - 1) / (F.G * 8), rbeg = (F.bid * 8 + F.wave) * rpw;
    int mkey = -1; f32x4 g2v[4];
#pragma unroll
    for (int i = 0; i < 4; ++i) g2v[i] = (f32x4){0.f, 0.f, 0.f, 0.f};
    for (int r = rbeg; r < rbeg + rpw && r < T; ++r) {
        const int b = r / NTOK, n = r % NTOK; if (n < CTXL) continue;
        float* hp = F.out + ((size_t)b * 2048 + (n - 256)) * 1024;
        if (b != mkey) { mkey = b; const float* modp = mod_lat(F, 3, b);
#pragma unroll
            for (int i = 0; i < 4; ++i) g2v[i] = ldg<f32x4>(modp + 5120 + i * 256 + F.lane * 4); }
        const bf16_t* hrow = (const bf16_t*)(F.ws + WS_HB) + (size_t)r * 1024;
#pragma unroll
        for (int i = 0; i < 4; ++i) {
            const u32x2 hw = ldg<u32x2>(hrow + i * 256 + F.lane * 4); f32x4 x = {bf_lo(hw.x), bf_hi(hw.x), bf_lo(hw.y), bf_hi(hw.y)};
            const u32x2 a = ldg<u32x2>(y2 + (size_t)(2 * r) * 1024 + i * 256 + F.lane * 4), c = ldg<u32x2>(y2 + (size_t)(2 * r + 1) * 1024 + i * 256 + F.lane * 4);
            const f32x4 g2 = g2v[i];
            x[0] += g2[0] * (bf_lo(a.x) + bf_lo(c.x)); x[1] += g2[1] * (bf_hi(a.x) + bf_hi(c.x)); x[2] += g2[2] * (bf_lo(a.y) + bf_lo(c.y)); x[3] += g2[3] * (bf_hi(a.y) + bf_hi(c.y));
            stg<f32x4>(hp + i * 256 + F.lane * 4, x);
        }
    }
}

#ifndef STAGGER_TICKS
#define STAGGER_TICKS 0
#endif
constexpr int NPHASE = 50;
__global__ void __launch_bounds__(512, 2) fwd_kernel(Args args) {
    extern __shared__ __attribute__((aligned(16))) unsigned char lds_raw[];
    Frame F;
    F.a = &args;
    F.out = args.out; F.ws = args.ws; F.lds = (LAS unsigned char*)lds_raw;
    F.tid = threadIdx.x; F.lane = F.tid & 63; F.wave = __builtin_amdgcn_readfirstlane(F.tid >> 6); F.G = gridDim.x;
    const int lo = args.ph_lo, hi = args.ph_hi;
    const int wave_s = __builtin_amdgcn_readfirstlane((int)threadIdx.x >> 6);
    volatile LAS unsigned* bst = (volatile LAS unsigned*)(F.lds + LDS_MISC);
    if (F.tid < 4) bst[F.tid] = 0u;
    __syncthreads();
    XcdBarrier bar; bar.bar = (unsigned*)(F.ws + WS_CTL) + CW_BAR; bar.x = 0; bar.st = bst;
    if (hi - lo > 1) bar = xcd_barrier_post((unsigned*)(F.ws + WS_CTL) + CW_BAR, bst);
#ifndef PH_MASK
#define PH_MASK 0xFFFFFFFFu
#endif
#define PHASE(site, p, ...) do { if (((PH_MASK >> (site)) & 1u) && lo <= (p) && (p) < hi) { F.ws = launder_p(args.ws); F.out = (float*)launder_p((unsigned char*)args.out); { int ws_ = wave_s, bi_ = (int)blockIdx.x; asm volatile("" : "+s"(ws_), "+s"(bi_)); F.wave = ws_; F.bid = bi_; } F.lane = lane_id_asm(); F.tid = (F.wave << 6) | F.lane; __VA_ARGS__; if ((p) + 1 < hi) xcd_barrier(bar, (wave_s << 6) | lane_id_asm()); } } while (0)

    PHASE(0, 0, p0_prologue(F));
    for (int layer = 0; layer < DEPTH; ++layer) {
        const int pb = 1 + 12 * layer, j = layer >> 1; const bool isRT = layer & 1;
        PHASE(1, pb + 0, { norm_phase<false>(F, layer); if (layer > 0) convert_moe_weights(F, layer, moe_split_lo(F, layer), MOE_NT, F.bid, F.G); });
        if (!isRT) {
            PHASE(2, pb + 1, {
                ProbQKV S; S.K = 1024; S.abuf = (const char*)(F.ws + WS_ABUF); S.wqk = (const char*)(F.ws + WS_WQK) + (size_t)j * 2048 * 1024 * 2; S.wv = (const char*)(F.ws + WS_WV) + (size_t)j * 1024 * 1024 * 2;
                S.go.init(NTILE, 8); S.G = F.G; S.c = F.bid; S.stagger = STAGGER_TICKS; S.noepi = args.flags & 1;
                EpiQKV E{(bf16_t*)(F.ws + WS_PROJ + PJ_Q), (bf16_t*)(F.ws + WS_PROJ + PJ_K), (bf16_t*)(F.ws + WS_PROJ + PJ_VT), F.a->in[9] + j * 64, F.a->in[10] + j * 64,
                         (const float*)(F.ws + WS_ROPE + RP_CDA), (const float*)(F.ws + WS_ROPE + RP_SDA)};
                pg8::gemm_phase<EpiQKV, ProbQKV, true>(F.lds, S, E, F.tid, F.wave);
                if (F.G == 256 && F.bid >= 128) convert_moe_weights(F, layer, MOE_T_WO, MOE_T_WO + MOE_T_QKV, F.bid - 128, 128);
            });
            PHASE(3, pb + 2, attn_phase(F, layer));
        } else {
            for (int hf = 0; hf < 2; ++hf) {
                PHASE(4, pb + 1 + 3 * hf, {
                    ProbWIN S; S.K = 1024; S.abuf = (const char*)(F.ws + WS_ABUF) + (size_t)hf * 144 * 256 * 1024 * 2; S.win = (const char*)(F.ws + WS_WIN) + (size_t)j * 8192 * 1024 * 2;
                    S.latonly = (layer == DEPTH - 1); S.nnat = S.latonly ? 128 * 20 : 144 * 20; S.go.init(S.latonly ? 128 : 144, 20); S.G = F.G; S.c = F.bid; S.stagger = STAGGER_TICKS; S.noepi = args.flags & 1;
                    EpiWIN E{(bf16_t*)(F.ws + WS_PROJ + PJ_RQ), (bf16_t*)(F.ws + WS_PROJ + PJ_RG), (bf16_t*)(F.ws + WS_PROJ + PJ_RKT), (bf16_t*)(F.ws + WS_PROJ + PJ_RVT), hf * 144,
                             (const float*)(F.ws + WS_ROPE + RP_CRT), (const float*)(F.ws + WS_ROPE + RP_SRT), (const float*)(F.ws + WS_MISC + MS_CRTT), (const float*)(F.ws + WS_MISC + MS_SRTT)};
                    pg8::gemm_phase<EpiWIN, ProbWIN, true>(F.lds, S, E, F.tid, F.wave);
                });
                PHASE(5, pb + 2 + 3 * hf, scan_phase(F, layer, hf));
                PHASE(6, pb + 3 + 3 * hf, comb_phase(F, hf, layer == DEPTH - 1));
            }
        }
        PHASE(7, pb + 7, {
            ProbDense S; S.G = F.G; S.c = F.bid; S.stagger = STAGGER_TICKS; S.noepi = args.flags & 1; S.latonly = (layer == DEPTH - 1); S.go.init(S.latonly ? NB * 8 : NTILE, 4);
            if (!isRT) { S.K = 1024; S.A0 = (const char*)(F.ws + WS_OBUF); S.A1 = S.A0; S.pm_split = 1 << 30; S.Bt = (const char*)(F.ws + WS_WODA) + (size_t)j * 1024 * 1024 * 2; }
            else { S.K = 2048; S.A0 = (const char*)(F.ws + WS_OBUF); S.A1 = (const char*)(F.ws + WS_ABUF); S.pm_split = 144; S.Bt = (const char*)(F.ws + WS_WORT) + (size_t)j * 1024 * 2048 * 2; }
            EpiResid E{F.a->in[2], F.a->in[0], (bf16_t*)(F.ws + WS_HB), (const float*)(F.ws + WS_ADA) + (size_t)layer * 33 * 6144, layer == 0 ? 1 : 0};
            pg8::gemm_phase<EpiResid, ProbDense, true>(F.lds, S, E, F.tid, F.wave);
            if (F.G == 256 && F.bid >= 128 && layer != DEPTH - 1) convert_moe_weights(F, layer, 0, MOE_T_WO, F.bid - 128, 128);
        });
        PHASE(8, pb + 8, norm_phase<true>(F, layer));
        PHASE(9, pb + 9, sort_phase(F, layer));
        PHASE(10, pb + 10, {
            LAS int* segs = (LAS int*)(F.lds + LDS_MISC + 2048); LAS int* tile_e = (LAS int*)(F.lds + LDS_TILE_E);
            const int ntl = build_segments(F, layer, segs, tile_e);
            ProbMoE<true> S; S.K = 1024; S.A = (const char*)(F.ws + WS_ABUF); S.W = (const char*)(F.ws + WS_WGU); S.tile_e = tile_e; S.go.init(ntl, 4); S.G = F.G; S.c = F.bid; S.stagger = STAGGER_TICKS; S.noepi = args.flags & 1;
            LAS int* rowtok = (LAS int*)(F.lds + LDS_TILE_E + 4096); S.rowtok = rowtok;
            { const int* rowmap = (const int*)(F.ws + WS_MISC + MS_WSORT); Unit uu;
              int dd[11];
              _Pragma("unroll") for (int i = 0; i < 11; ++i) { dd[i] = 0; if (S.next(i, uu) && F.tid < 256) dd[i] = ldg<int>(rowmap + 2 * (uu.pm * 256 + F.tid)); }
              _Pragma("unroll") for (int i = 0; i < 11; ++i) { if (F.tid < 256) rowtok[i * 256 + F.tid] = dd[i] >= 0 ? (dd[i] >> 1) : 0; }
              __syncthreads(); }
            EpiSwiGLU E{(bf16_t*)(F.ws + WS_PROJ + PJ_ACT)};
            pg8::gemm_phase<EpiSwiGLU, ProbMoE<true>, true>(F.lds, S, E, F.tid, F.wave);
        });
        PHASE(11, pb + 11, {
            LAS int* segs = (LAS int*)(F.lds + LDS_MISC + 2048); LAS int* tile_e = (LAS int*)(F.lds + LDS_TILE_E);
            const int ntl = build_segments(F, layer, segs, tile_e);
            ProbMoE<false> S; S.K = 512; S.A = (const char*)(F.ws + WS_PROJ + PJ_ACT); S.W = (const char*)(F.ws + WS_WD); S.tile_e = tile_e; S.rowtok = tile_e; S.go.init(ntl, 4); S.G = F.G; S.c = F.bid; S.stagger = STAGGER_TICKS; S.noepi = args.flags & 1;
            EpiDown E{(bf16_t*)(F.ws + WS_PROJ + PJ_Y2), (const int*)(F.ws + WS_MISC + MS_WSORT), nullptr};
            pg8::gemm_phase<EpiDown, ProbMoE<false>, true>(F.lds, S, E, F.tid, F.wave);
        });
    }
    PHASE(12, 49, final_phase(F));
#ifdef PROBE_BARRIERS
    for (int i = 0; i < PROBE_BARRIERS; ++i) xcd_barrier(bar, (wave_s << 6) | lane_id_asm());
#endif
#undef PHASE
}

static bool phase_exists(int p) {
    if (p == 0 || p == 49) return true;
    const int layer = (p - 1) / 12, slot = (p - 1) % 12; const bool isRT = layer & 1;
    if (!isRT && slot >= 3 && slot <= 6) return false;
    return true;
}
extern "C" void kernel_launch(void* const* d_in, const int* in_sizes, int n_in, void* d_out, int out_size, void* d_ws, size_t ws_size, hipStream_t stream) {
    static int grid = 0;
    if (grid == 0) {
        if (n_in != 24 || ws_size < WS_END) { fprintf(stderr, "kernel_launch: need 24 inputs and >= %zu bytes of workspace (got %d, %zu)\n", (size_t)WS_END, n_in, ws_size); grid = -1; return; }
        int dev = 0, cus = 0, per_cu = 0;
        if (hipGetDevice(&dev) != hipSuccess || hipDeviceGetAttribute(&cus, hipDeviceAttributeMultiprocessorCount, dev) != hipSuccess) { grid = -1; return; }
        if (hipFuncSetAttribute((const void*)fwd_kernel, hipFuncAttributeMaxDynamicSharedMemorySize, LDS_BYTES) != hipSuccess) { fprintf(stderr, "kernel_launch: hipFuncSetAttribute failed\n"); grid = -1; return; }
        if (hipOccupancyMaxActiveBlocksPerMultiprocessor(&per_cu, (const void*)fwd_kernel, 512, LDS_BYTES) != hipSuccess || per_cu < 1) fprintf(stderr, "kernel_launch: occupancy query reports %d\n", per_cu);
        (void)hipGetLastError();
        grid = cus;
    }
    if (grid < 0) return;
    (void)hipMemsetAsync((char*)d_ws + WS_CTL, 0, 1 * MiB, stream);
    Args a{};
    for (int i = 0; i < 24; ++i) a.in[i] = (const float*)d_in[i];
    a.out = (float*)d_out; a.ws = (unsigned char*)d_ws;
#ifdef MULTI_LAUNCH
    for (int p = 0; p < NPHASE; ++p) { if (!phase_exists(p)) continue; a.ph_lo = p; a.ph_hi = p + 1; hipLaunchKernelGGL(fwd_kernel, dim3(grid), dim3(512), LDS_BYTES, stream, a); }
#elif defined(PROBE_DUP_LO)
    a.ph_lo = 0; a.ph_hi = PROBE_DUP_HI; hipLaunchKernelGGL(fwd_kernel, dim3(grid), dim3(512), LDS_BYTES, stream, a);
#ifdef PROBE_NOEPI
    a.flags = 1;
#endif
    for (int p = PROBE_DUP_LO; p < PROBE_DUP_HI; ++p) { if (!phase_exists(p)) continue; a.ph_lo = p; a.ph_hi = p + 1; hipLaunchKernelGGL(fwd_kernel, dim3(grid), dim3(512), LDS_BYTES, stream, a); }
    a.flags = 0;
    (void)hipMemsetAsync((char*)d_ws + WS_CTL, 0, 16384, stream);
    a.ph_lo = PROBE_DUP_HI; a.ph_hi = NPHASE; hipLaunchKernelGGL(fwd_kernel, dim3(grid), dim3(512), LDS_BYTES, stream, a);
#else
    a.ph_lo = 0; a.ph_hi = NPHASE; hipLaunchKernelGGL(fwd_kernel, dim3(grid), dim3(512), LDS_BYTES, stream, a);
#endif
}
```

```cpp
#include <hip/hip_runtime.h>
#include <cstdio>
#include <cstdint>

#define LAS __attribute__((address_space(3)))
constexpr float LOG2E = 1.4426950408889634f;
#define DI __device__ __forceinline__
typedef unsigned short bf16_t;
typedef short bf16x8 __attribute__((ext_vector_type(8)));
typedef short s16x4 __attribute__((ext_vector_type(4)));
typedef float f32x4 __attribute__((ext_vector_type(4)));
typedef float f32x2 __attribute__((ext_vector_type(2)));
typedef float f32x16 __attribute__((ext_vector_type(16)));
typedef unsigned u32x4 __attribute__((ext_vector_type(4)));
typedef unsigned u32x2 __attribute__((ext_vector_type(2)));
typedef __bf16 bf16x2_t __attribute__((ext_vector_type(2)));

#define GAS __attribute__((address_space(1)))
template <class V, class T> DI V ldg(const T* p) { return *(const GAS V*)(unsigned long long)p; }
template <class V, class T> DI void stg(T* p, V v) { *(GAS V*)(unsigned long long)p = v; }
DI unsigned pk_bf16(float lo, float hi) { f32x2 v = {lo, hi}; return __builtin_bit_cast(unsigned, __builtin_convertvector(v, bf16x2_t)); }
DI float bf_lo(unsigned u) { return __uint_as_float(u << 16); }
DI float bf_hi(unsigned u) { return __uint_as_float(u & 0xffff0000u); }
DI float bf_f(bf16_t v) { return __uint_as_float(((unsigned)v) << 16); }
DI unsigned char* launder_p(unsigned char* p) { asm volatile("" : "+s"(p)); return p; }
DI float shx(float v, int o, int lane) { return __builtin_bit_cast(float, __builtin_amdgcn_ds_bpermute((lane ^ o) << 2, __builtin_bit_cast(int, v))); }
#define DPPF(v, ctrl, row_mask) __builtin_bit_cast(float, __builtin_amdgcn_update_dpp(0, __builtin_bit_cast(int, (v)), (ctrl), (row_mask), 0xf, false))
DI float wave_sum(float v, int lane) {
    (void)lane;
    v += DPPF(v, 0xB1, 0xf);
    v += DPPF(v, 0x4E, 0xf);
    v += DPPF(v, 0x141, 0xf);
    v += DPPF(v, 0x140, 0xf);
    v += DPPF(v, 0x142, 0xa);
    v += DPPF(v, 0x143, 0xc);
    return __builtin_bit_cast(float, __builtin_amdgcn_readlane(__builtin_bit_cast(int, v), 63));
}
DI int lane_id_asm() { int x; asm volatile("v_mbcnt_lo_u32_b32 %0, -1, 0\n\tv_mbcnt_hi_u32_b32 %0, -1, %0" : "=v"(x)); return x; }
DI int launder(int x) { asm volatile("" : "+v"(x)); return x; }
DI float uni_f(float x) { return __builtin_bit_cast(float, __builtin_amdgcn_readfirstlane(__builtin_bit_cast(int, x))); }
DI float silu_f(float x) { return x * __builtin_amdgcn_rcpf(1.0f + __builtin_amdgcn_exp2f(-LOG2E * x)); }

constexpr int NB = 32, SEQ = 2048, CTXL = 256, NTOK = SEQ + CTXL, DM = 1024, DEPTH = 4;
constexpr int T = NB * NTOK;
constexpr int NTILE = T / 256;
constexpr int NEXP = 32, MOEH = 512;
constexpr int MAXROWS = 2 * T + NEXP * 256;
constexpr float RMS_EPS = 1e-6f;

constexpr size_t MiB = 1ull << 20;
constexpr size_t WS_CTL = 0;
constexpr size_t WS_ADA = 1 * MiB;
constexpr size_t WS_ROPE = 5 * MiB;
constexpr size_t WS_MISC = 8 * MiB;
constexpr size_t WS_HCTX = 16 * MiB;
constexpr size_t WS_WQK = 48 * MiB;
constexpr size_t WS_WV = 56 * MiB;
constexpr size_t WS_WODA = 60 * MiB;
constexpr size_t WS_WIN = 64 * MiB;
constexpr size_t WS_WORT = 96 * MiB;
constexpr size_t WS_WGU = 104 * MiB;
constexpr size_t WS_WD = 168 * MiB;
constexpr size_t WS_ABUF = 200 * MiB;
constexpr size_t WS_OBUF = 344 * MiB;
constexpr size_t WS_PROJ = 488 * MiB;
constexpr size_t WS_HB = 1064 * MiB;
constexpr size_t WS_END = 1208 * MiB;
constexpr size_t PJ_Q = 0, PJ_K = 144 * MiB, PJ_VT = 288 * MiB;
constexpr size_t PJ_SA = 0, PJ_ACT = 304 * MiB, PJ_Y2 = 0;
constexpr size_t PJ_RQ = 0, PJ_RG = 72 * MiB, PJ_RKT = 360 * MiB, PJ_RVT = 432 * MiB;
constexpr int HROWS = 36864;
constexpr size_t RP_CDA = 0, RP_SDA = 256 * 1024, RP_CRT = 512 * 1024, RP_SRT = 512 * 1024 + 1 * MiB;
constexpr size_t MS_EID = 0, MS_WSEL = 1 * MiB, MS_ROWMAP = 2 * MiB, MS_SSQ = 3 * MiB, MS_WSORT = 6 * MiB, MS_CRTT = 6 * MiB, MS_SRTT = 7 * MiB;
constexpr int CW_BAR = 0;
constexpr int CW_CNT = 4096;
constexpr int CW_CUR = 4096 + 256;

constexpr int LDS_BYTES = 155648;
constexpr int LDS_MISC = 152576;
constexpr int LDS_TILE_E = 131072;

#define XB_TMO      128
#define XB_XCNT(j)  (256  + 64 * (j))
#define XB_XSUB(j)  (1280 + 64 * (j))
#define XB_XGEN(j)  (2304 + 64 * (j))
#define XB_TOP      3328
#define XB_TOPGEN   3392
#define XCD_BAR_WORDS 3456
#define XB_SPIN_CAP (1u << 18)

__device__ __forceinline__ unsigned xb_ld(unsigned* p)              { return __hip_atomic_load(p, __ATOMIC_RELAXED, __HIP_MEMORY_SCOPE_AGENT); }
__device__ __forceinline__ unsigned xb_add(unsigned* p, unsigned v) { return __hip_atomic_fetch_add(p, v, __ATOMIC_RELAXED, __HIP_MEMORY_SCOPE_AGENT); }
__device__ __forceinline__ unsigned xb_xcc_id() { return (unsigned)__builtin_amdgcn_s_getreg((3 << 11) | 20) & 0xFu; }
#define XB_SPIN(cond, bar) do { unsigned _sp = 0; while (cond) { __builtin_amdgcn_s_sleep(1); \
    if ((++_sp & 255u) == 0u) { if (xb_ld(&(bar)[XB_TMO])) break; if (_sp > XB_SPIN_CAP) { atomicAdd(&(bar)[XB_TMO], 1u); break; } } } } while (0)

struct XcdBarrier { unsigned* bar; unsigned x; volatile LAS unsigned* st; };

__device__ __forceinline__ XcdBarrier xcd_barrier_post(unsigned* bar, volatile LAS unsigned* st) {
    XcdBarrier b; b.bar = bar; b.x = xb_xcc_id(); b.st = st;
    if (threadIdx.x == 0) (void)xb_add(&bar[XB_XCNT(b.x)], 1u);
    return b;
}
__device__ __forceinline__ void xcd_barrier_complete(unsigned* bar, unsigned x, unsigned& nloc, unsigned& nx) {
    const unsigned G = gridDim.x * gridDim.y * gridDim.z;
    unsigned sum, cnt, mine, sp = 0u;
    for (;;) {
        sum = 0u; cnt = 0u; mine = 0u;
#pragma unroll
        for (unsigned j = 0; j < 16; ++j) { const unsigned c = xb_ld(&bar[XB_XCNT(j)]); sum += c; cnt += (c > 0u) ? 1u : 0u; mine = (j == x) ? c : mine; }
        if (sum == G) break;
        __builtin_amdgcn_s_sleep(1);
        if ((++sp & 255u) == 0u) { if (xb_ld(&bar[XB_TMO])) break; if (sp > XB_SPIN_CAP) { atomicAdd(&bar[XB_TMO], 1u); break; } }
    }
    nloc = mine > 0u ? mine : 1u; nx = cnt > 0u ? cnt : 1u;
}
__device__ __forceinline__ void xcd_barrier(const XcdBarrier& b, const int tid0) {
    asm volatile("s_waitcnt vmcnt(0)" ::: "memory");
    __syncthreads();
    if (tid0 == 0) {
        unsigned* bar = (unsigned*)launder_p((unsigned char*)b.bar);
        __builtin_amdgcn_s_waitcnt(0);
        unsigned nloc = b.st[0], nx = b.st[1];
        if (nloc == 0u) { xcd_barrier_complete(bar, b.x, nloc, nx); b.st[0] = nloc; b.st[1] = nx; }
        const unsigned old = xb_add(&bar[XB_XSUB(b.x)], 1u);
        const unsigned gen = old / nloc;
        if (old + 1u == (gen + 1u) * nloc) {
            __builtin_amdgcn_fence(__ATOMIC_RELEASE, "agent");
            asm volatile("s_waitcnt vmcnt(0)" ::: "memory");
            const unsigned og = xb_add(&bar[XB_TOP], 1u);
            const unsigned tg = og / nx;
            if (og + 1u == (tg + 1u) * nx) xb_add(&bar[XB_TOPGEN], 1u);
            else XB_SPIN(xb_ld(&bar[XB_TOPGEN]) == tg, bar);
            __builtin_amdgcn_fence(__ATOMIC_ACQUIRE, "agent");
            xb_add(&bar[XB_XGEN(b.x)], 1u);
            asm volatile("s_waitcnt vmcnt(0)" ::: "memory");
        } else {
            XB_SPIN(xb_ld(&bar[XB_XGEN(b.x)]) == gen, bar);
            __builtin_amdgcn_fence(__ATOMIC_ACQUIRE, "agent");
            asm volatile("s_waitcnt vmcnt(0)" ::: "memory");
        }
    }
    __syncthreads();
}

struct Args { const float* in[24]; float* out; unsigned char* ws; int ph_lo, ph_hi, flags, pad; };
struct Frame {
    const Args* a; float* out; unsigned char* ws; LAS unsigned char* lds;
    int tid, lane, wave, G, bid;
};
DI const float* mod_lat(const Frame& F, int layer, int b) { return (const float*)(F.ws + WS_ADA) + ((size_t)layer * 33 + b) * 6144; }
DI const float* mod_ctx(const Frame& F, int layer) { return (const float*)(F.ws + WS_ADA) + ((size_t)layer * 33 + 32) * 6144; }

namespace pg8 {
constexpr int BM = 256, BK = 64, HALF = 128, HTB = HALF * BK * 2, STAGE_BYTES = 8 * HTB, NXCD = 8, WGM = 8;
__host__ __device__ __forceinline__ int lds_byte(int r, int c) { const int st = (r >> 4) * 2 + (c >> 5), rr = r & 15, cc = c & 31, ob = rr * 64 + cc * 2; return st * 1024 + (ob ^ (((ob >> 9) & 1) << 5)); }
__host__ __device__ __forceinline__ void stage_rc(int b, int& R, int& C) { const int st = b / 1024, sb = b % 1024, swz = sb ^ (((sb >> 9) & 1) << 5); R = (st >> 1) * 16 + swz / 64; C = (st & 1) * 32 + (swz % 64) / 2; }
__host__ __device__ __forceinline__ int perm32(int rho) { const int n = rho >> 4, i = rho & 15; return 8 * (i >> 2) + 4 * n + (i & 3); }

struct Unit { int pm, pn, kind; };

struct GridOrder {
    int nM, nN, nwg;
    DI void init(int nM_, int nN_) { nM = nM_; nN = nN_; nwg = nM * nN; }
    DI bool map(long L, int& pm, int& pn) const {
        if (L >= nwg) return false;
        int wgid = (int)L; { const int q = nwg / NXCD, r = nwg % NXCD, xcd = wgid % NXCD, off = wgid / NXCD; wgid = (xcd < r ? xcd * (q + 1) : r * (q + 1) + (xcd - r) * q) + off; }
        const int nig = WGM * nN, gid = wgid / nig, fm = gid * WGM, gsz = (nM - fm) < WGM ? (nM - fm) : WGM;
        pm = fm + ((wgid % nig) % gsz); pn = (wgid % nig) / gsz; return true;
    }
};

template <class Epi, class P, bool ALIGN_EPI>
DI void gemm_phase(LAS unsigned char* lds, const P& S, const Epi& E, const int tid, const int wid) {
    const int lane = tid & 63, wr = wid >> 2, wc = wid & 3, fr = lane & 15, fq = lane >> 4;
    const int K = S.K, nt = K / BK;
    unsigned voffA[2], voffB[2];
#pragma unroll
    for (int i = 0; i < 2; ++i) { int R, C; stage_rc(tid * 16 + i * 8192, R, C); const int Rb = Epi::PERM ? ((R & ~31) + perm32(R & 31)) : R;
        voffA[i] = (unsigned)(R * K + C) * 2u; voffB[i] = (unsigned)(Rb * K + C) * 2u; }
    const size_t kstep = (size_t)(BK * 2);
    const size_t hstep = (size_t)HALF * K * 2;
    const unsigned ldsw = (unsigned)wid * 1024u;
    const int aoff = lds_byte(wr * 64 + fr, fq * 8), boff = lds_byte(wc * 32 + fr, fq * 8);
#define PG8_SA(b, h) (((b) * 2 + (h)) * HTB)
#define PG8_SB(b, h) ((4 + (b) * 2 + (h)) * HTB)
#define PG8_STAGE(bufoff, gbase, voff) do { _Pragma("unroll") for (int _i = 0; _i < 2; ++_i) \
        __builtin_amdgcn_global_load_lds((const unsigned*)((const char*)(gbase) + (voff)[_i]), (LAS unsigned*)(lds + (bufoff) + ldsw + _i * 8192), 16, 0, 0); } while (0)
#define PG8_LDA(dst, b, h) do { _Pragma("unroll") for (int m = 0; m < 4; ++m) _Pragma("unroll") for (int k = 0; k < 2; ++k) dst[m][k] = *(const LAS bf16x8*)(lds + PG8_SA(b, h) + aoff + m * 2048 + k * 1024); } while (0)
#define PG8_LDB(dst, b, h) do { _Pragma("unroll") for (int n = 0; n < 2; ++n) _Pragma("unroll") for (int k = 0; k < 2; ++k) dst[n][k] = *(const LAS bf16x8*)(lds + PG8_SB(b, h) + boff + n * 2048 + k * 1024); } while (0)
#define PG8_MMA(ai, bj, At, Bt) do { __builtin_amdgcn_s_setprio(1); _Pragma("unroll") for (int m = 0; m < 4; ++m) _Pragma("unroll") for (int n = 0; n < 2; ++n) _Pragma("unroll") for (int k = 0; k < 2; ++k) \
        acc[ai][bj][m][n] = __builtin_amdgcn_mfma_f32_16x16x32_bf16(Bt[n][k], At[m][k], acc[ai][bj][m][n], 0, 0, 0); __builtin_amdgcn_s_setprio(0); } while (0)
#define PG8_WAIT_V(n) asm volatile("s_waitcnt vmcnt(" #n ")" ::: "memory")
#define PG8_WAIT_L(n) asm volatile("s_waitcnt lgkmcnt(" #n ")" ::: "memory")
#define PG8_WAIT_VF asm volatile("s_waitcnt vmcnt(%0)" :: "n"(8 + Epi::EV) : "memory")
#define PG8_BAR __builtin_amdgcn_s_barrier()
#define PG8_SCHED __builtin_amdgcn_sched_barrier(0)
    Unit cur, nxt; int ui = 0;
    if (!S.next(0, cur)) return;
    if (S.stagger > 0) { const unsigned long long t0 = __builtin_amdgcn_s_memrealtime(); const unsigned long long dl = (unsigned long long)(((unsigned)S.c * 37u) & 15u) * (unsigned)S.stagger;
        while (__builtin_amdgcn_s_memrealtime() - t0 < dl) __builtin_amdgcn_s_sleep(8); }
    unsigned gaC[2][2], gaN[2][2]; int gR[2], gC[2];
    if constexpr (P::GATHER) {
#pragma unroll
        for (int i = 0; i < 2; ++i) { stage_rc(tid * 16 + i * 8192, gR[i], gC[i]); }
#pragma unroll
        for (int h = 0; h < 2; ++h)
#pragma unroll
            for (int i = 0; i < 2; ++i) { gaC[h][i] = (unsigned)(S.rowtok[0 * 256 + h * 128 + gR[i]] * K + gC[i]) * 2u; gaN[h][i] = gaC[h][i]; }
    }
#define PG8_STAGE_A(bufoff, h, usen, kofs, dense) do { if constexpr (P::GATHER) { const unsigned _v[2] = {(usen) ? gaN[h][0] : gaC[h][0], (usen) ? gaN[h][1] : gaC[h][1]}; PG8_STAGE(bufoff, S.A + (kofs), _v); } \
        else { PG8_STAGE(bufoff, dense, voffA); } } while (0)
    f32x4 acc[2][2][4][2];
#pragma unroll
    for (int a = 0; a < 2; ++a)
#pragma unroll
        for (int b = 0; b < 2; ++b)
#pragma unroll
            for (int m = 0; m < 4; ++m)
#pragma unroll
                for (int n = 0; n < 2; ++n) acc[a][b][m][n] = (f32x4){0.f, 0.f, 0.f, 0.f};
    bf16x8 At[4][2], B0[2][2], B1[2][2];
    typename Epi::Pre pre; E.pre_load(cur, wr, fr, pre);
    const char* cA = S.a_ptr(cur); const char* cB = S.b_ptr(cur);
    PG8_STAGE(PG8_SB(0, 0), cB, voffB); PG8_STAGE(PG8_SB(0, 1), cB + hstep, voffB); PG8_STAGE_A(PG8_SA(0, 0), 0, false, 0, cA); PG8_STAGE_A(PG8_SA(0, 1), 1, false, 0, cA + hstep);
    if (wr == 1) PG8_BAR;
    PG8_WAIT_V(2); PG8_BAR;
    PG8_STAGE(PG8_SB(1, 0), cB + kstep, voffB); PG8_STAGE_A(PG8_SA(1, 0), 0, false, kstep, cA + kstep); PG8_STAGE(PG8_SB(1, 1), cB + hstep + kstep, voffB);
    PG8_WAIT_V(6); PG8_BAR;
    for (;;) {
        const bool has_next = S.next(ui + 1, nxt);
        const char* nA = has_next ? S.a_ptr(nxt) : cA; const char* nB = has_next ? S.b_ptr(nxt) : cB;
        if constexpr (P::GATHER) { if (has_next) {
#pragma unroll
            for (int h = 0; h < 2; ++h)
#pragma unroll
                for (int i = 0; i < 2; ++i) gaN[h][i] = (unsigned)(S.rowtok[(ui + 1) * 256 + h * 128 + gR[i]] * K + gC[i]) * 2u; } }
#define PG8_PAIR(FRESH, t, last) do { \
            const size_t k1 = (size_t)((t) + 1) * kstep, k2 = (last) ? 0 : (size_t)((t) + 2) * kstep, k3 = k2 + kstep; \
            const char* a1 = cA + k1; \
            const char* a2 = ((last) ? nA : cA) + k2; const char* b2 = (last) ? nB : cB + (size_t)((t) + 2) * kstep; \
            const char* a3 = a2 + kstep; const char* b3 = b2 + kstep; \
            PG8_LDB(B0, 0, 0); PG8_LDB(B1, 0, 1); PG8_SCHED; PG8_LDA(At, 0, 0); if (!(FRESH)) PG8_STAGE_A(PG8_SA(1, 1), 1, false, k1, a1 + hstep); \
            if (FRESH) PG8_WAIT_VF; else PG8_WAIT_V(8); PG8_WAIT_L(0); PG8_BAR; PG8_MMA(0, 0, At, B0); PG8_MMA(0, 1, At, B1); PG8_BAR; PG8_SCHED; \
            PG8_LDA(At, 0, 1); PG8_STAGE(PG8_SB(0, 0), b2, voffB); PG8_STAGE(PG8_SB(0, 1), b2 + hstep, voffB); PG8_STAGE_A(PG8_SA(0, 0), 0, last, k2, a2); \
            if (FRESH) PG8_WAIT_VF; else PG8_WAIT_V(8); PG8_WAIT_L(0); PG8_BAR; PG8_MMA(1, 0, At, B0); PG8_MMA(1, 1, At, B1); PG8_BAR; PG8_SCHED; \
            PG8_LDB(B0, 1, 0); PG8_LDB(B1, 1, 1); PG8_SCHED; PG8_LDA(At, 1, 0); PG8_STAGE_A(PG8_SA(0, 1), 1, last, k2, a2 + hstep); \
            if (FRESH) PG8_WAIT_VF; else PG8_WAIT_V(8); PG8_WAIT_L(0); PG8_BAR; PG8_MMA(0, 0, At, B0); PG8_MMA(0, 1, At, B1); PG8_BAR; PG8_SCHED; \
            PG8_LDA(At, 1, 1); PG8_STAGE(PG8_SB(1, 0), b3, voffB); PG8_STAGE(PG8_SB(1, 1), b3 + hstep, voffB); PG8_STAGE_A(PG8_SA(1, 0), 0, last, k3, a3); \
            PG8_WAIT_V(8); PG8_WAIT_L(0); PG8_BAR; PG8_MMA(1, 0, At, B0); PG8_MMA(1, 1, At, B1); PG8_BAR; PG8_SCHED; } while (0)
        int t = 0;
        if (ui > 0 && !S.noepi) { PG8_PAIR(true, 0, false); t = 2; }
        for (; t < nt; t += 2) { const bool last = (t == nt - 2); PG8_PAIR(false, t, last); }
        PG8_STAGE_A(PG8_SA(1, 1), 1, true, kstep, nA + kstep + hstep); asm volatile("" ::: "memory"); PG8_SCHED;
#undef PG8_PAIR
        if constexpr (ALIGN_EPI) { if (wr == 0) PG8_BAR; }
        if (!S.noepi) { const int l2 = lane_id_asm(); E(acc, cur, wr, wc, l2 & 15, l2 >> 4, pre); }
        if (!has_next) break;
#pragma unroll
        for (int a = 0; a < 2; ++a)
#pragma unroll
            for (int b = 0; b < 2; ++b)
#pragma unroll
                for (int m = 0; m < 4; ++m)
#pragma unroll
                    for (int n = 0; n < 2; ++n) { acc[a][b][m][n] = (f32x4){0.f, 0.f, 0.f, 0.f}; asm volatile("" : "+v"(acc[a][b][m][n])); }
        cur = nxt; cA = nA; cB = nB; ++ui;
        E.pre_load(cur, wr, fr, pre);
        if constexpr (P::GATHER) {
#pragma unroll
            for (int h = 0; h < 2; ++h)
#pragma unroll
                for (int i = 0; i < 2; ++i) gaC[h][i] = gaN[h][i]; }
        if constexpr (ALIGN_EPI) { if (wr == 1) PG8_BAR; }
    }
    PG8_WAIT_V(0);
    if constexpr (!ALIGN_EPI) { if (wr == 0) PG8_BAR; }
    PG8_BAR;
#undef PG8_SA
#undef PG8_SB
#undef PG8_STAGE
#undef PG8_STAGE_A
#undef PG8_LDA
#undef PG8_LDB
#undef PG8_MMA
#undef PG8_WAIT_V
#undef PG8_WAIT_L
#undef PG8_WAIT_VF
#undef PG8_BAR
#undef PG8_SCHED
}
}
using pg8::Unit;

struct ProbQKV {
    static constexpr bool GATHER = false;
    int K; const char* abuf; const char* wqk; const char* wv; pg8::GridOrder go; int G, c, stagger, noepi;
    DI bool next(int i, Unit& u) const {
        const long L = (long)i * G + c;
        if (L < NTILE * 8) { u.kind = 0; const bool ok = go.map(L, u.pm, u.pn);
#ifdef PROBE_SAMEA
            if (noepi) { u.pm = u.pm & 7; }
#endif
            return ok; }
        const long r = L - NTILE * 8; if (r >= NTILE * 4) return false;
        u.kind = 1; u.pm = (int)(r & 3); u.pn = (int)(r >> 2); return true;
    }
    DI const char* a_ptr(const Unit& u) const { return (u.kind == 0 ? abuf : wv) + (size_t)u.pm * (256 * 1024 * 2); }
    DI const char* b_ptr(const Unit& u) const { return (u.kind == 0 ? wqk : abuf) + (size_t)u.pn * (256 * 1024 * 2); }
};
struct EpiQKV {
    static constexpr bool PERM = true; static constexpr int EV = 16;

    struct Pre {}; DI void pre_load(const Unit&, int, int, Pre&) const {}
    bf16_t* Q; bf16_t* Kb; bf16_t* VT; const float* gq; const float* gk; const float* cosT; const float* sinT;
    DI void operator()(const f32x4 (&acc)[2][2][4][2], const Unit& u, int wr, int wc, int fr, int fq, const Pre& pre) const {
        if (u.kind == 1) {
#pragma unroll
            for (int ai = 0; ai < 2; ++ai)
#pragma unroll
                for (int m = 0; m < 4; ++m) {
                    const int f = u.pm * 256 + ai * 128 + wr * 64 + m * 16 + fr;
                    bf16_t* rowp = VT + (size_t)f * T + (size_t)u.pn * 256 + wc * 32 + 8 * fq;
#pragma unroll
                    for (int bj = 0; bj < 2; ++bj) { const f32x4 v0 = acc[ai][bj][m][0], v1 = acc[ai][bj][m][1];
                        u32x4 w; w.x = pk_bf16(v0[0], v0[1]); w.y = pk_bf16(v0[2], v0[3]); w.z = pk_bf16(v1[0], v1[1]); w.w = pk_bf16(v1[2], v1[3]);
                        stg<u32x4>(rowp + bj * 128, w); }
                }
            return;
        }
        const bool isK = u.pn >= 4; const int sub = 4 * (u.pn & 3) + wc;
        const int jj = u.pm % 9; const bool isctx = (jj == 0);
        const float* g = isK ? gk : gq; bf16_t* dst = isK ? Kb : Q;
        const float osc = isK ? 1.0f : 0.125f * LOG2E;
        const int ln = fr + 16 * fq;
        f32x4 gv[2][2];
#pragma unroll
        for (int bj = 0; bj < 2; ++bj)
#pragma unroll
            for (int n = 0; n < 2; ++n) gv[bj][n] = ldg<f32x4>(g + 32 * bj + 8 * fq + 4 * n);
        float invf[8];
#pragma unroll
        for (int k = 0; k < 8; ++k) invf[k] = __builtin_amdgcn_exp2f(-(float)((8 * fq + k) & 15) * (13.287712379549449f / 16.0f)) * 0.15915494309189535f;
        const bool use_row = fq < 2;
        float ss[8];
#pragma unroll
        for (int ai = 0; ai < 2; ++ai)
#pragma unroll
            for (int m = 0; m < 4; ++m) { float s = 0.f;
#pragma unroll
                for (int bj = 0; bj < 2; ++bj)
#pragma unroll
                    for (int n = 0; n < 2; ++n) { const f32x4 x = acc[ai][bj][m][n]; s += (x[0] * x[0] + x[1] * x[1]) + (x[2] * x[2] + x[3] * x[3]); }
                ss[ai * 4 + m] = s; }
#pragma unroll
        for (int it = 0; it < 8; ++it) ss[it] += shx(ss[it], 16, ln);
#pragma unroll
        for (int it = 0; it < 8; ++it) ss[it] += shx(ss[it], 32, ln);
#pragma unroll
        for (int ai = 0; ai < 2; ++ai)
#pragma unroll
            for (int m = 0; m < 4; ++m) {
                const int rr = ai * 128 + wr * 64 + m * 16 + fr;
                const float rstd = __builtin_amdgcn_rsqf(ss[ai * 4 + m] * (1.0f / 64.0f) + RMS_EPS) * osc;
                f32x4 x1[2], x2[2];
#pragma unroll
                for (int n = 0; n < 2; ++n) { x1[n] = acc[ai][0][m][n] * rstd * gv[0][n]; x2[n] = acc[ai][1][m][n] * rstd * gv[1][n]; }
                if (!isctx) {
                    const int t = (jj - 1) * 256 + rr; const float pos = (float)(use_row ? (t >> 6) : (t & 63));
#pragma unroll
                    for (int n = 0; n < 2; ++n)
#pragma unroll
                        for (int j = 0; j < 4; ++j) { const float a = pos * invf[4 * n + j]; const float c = __builtin_amdgcn_cosf(a), s = __builtin_amdgcn_sinf(a);
                            const float p = x1[n][j], q = x2[n][j]; x1[n][j] = p * c - q * s; x2[n][j] = p * s + q * c; }
                }
                bf16_t* rowp = dst + (size_t)(u.pm * 256 + rr) * 1024 + 64 * sub + 8 * fq;
                u32x4 w; w.x = pk_bf16(x1[0][0], x1[0][1]); w.y = pk_bf16(x1[0][2], x1[0][3]); w.z = pk_bf16(x1[1][0], x1[1][1]); w.w = pk_bf16(x1[1][2], x1[1][3]);
                stg<u32x4>(rowp, w);
                w.x = pk_bf16(x2[0][0], x2[0][1]); w.y = pk_bf16(x2[0][2], x2[0][3]); w.z = pk_bf16(x2[1][0], x2[1][1]); w.w = pk_bf16(x2[1][2], x2[1][3]);
                stg<u32x4>(rowp + 32, w);
            }
    }
};

struct ProbDense {
    static constexpr bool GATHER = false;
    int K; const char* A0; const char* A1; int pm_split; const char* Bt; pg8::GridOrder go; int G, c, stagger, noepi, latonly;
    DI bool next(int i, Unit& u) const { u.kind = 0; const bool ok = go.map((long)i * G + c, u.pm, u.pn); if (latonly) u.pm = (u.pm >> 3) * 9 + 1 + (u.pm & 7); return ok; }
    DI const char* a_ptr(const Unit& u) const { return u.pm < pm_split ? A0 + (size_t)u.pm * 512 * K : A1 + (size_t)(u.pm - pm_split) * 512 * K; }
    DI const char* b_ptr(const Unit& u) const { return Bt + (size_t)u.pn * 512 * K; }
};

struct ProbWIN {
    static constexpr bool GATHER = false;
    int K; const char* abuf; const char* win; pg8::GridOrder go; int G, c, stagger, noepi, nnat, latonly;
    DI bool next(int i, Unit& u) const {
        const long L = (long)i * G + c;
        if (L < nnat) { u.kind = 0; const bool ok = go.map(L, u.pm, u.pn); if (latonly) u.pm = (u.pm >> 3) * 9 + 1 + (u.pm & 7); return ok; }
        const long r = L - nnat; if (r >= 144 * 12) return false;
        u.kind = 1; u.pm = (int)(r % 12); u.pn = (int)(r / 12); return true;
    }
    DI const char* a_ptr(const Unit& u) const { return u.kind == 0 ? abuf + (size_t)u.pm * (256 * 1024 * 2) : win + (size_t)(4 + u.pm) * (256 * 1024 * 2); }
    DI const char* b_ptr(const Unit& u) const { return u.kind == 0 ? win + (size_t)(u.pn < 4 ? u.pn : 12 + u.pn) * (256 * 1024 * 2) : abuf + (size_t)u.pn * (256 * 1024 * 2); }
};
struct EpiWIN {
    static constexpr bool PERM = true; static constexpr int EV = 16;

    struct Pre {}; DI void pre_load(const Unit&, int, int, Pre&) const {}
    bf16_t* RQ; bf16_t* RG; bf16_t* RKT; bf16_t* RVT; int pm0; const float* cosT; const float* sinT; const float* cosTT; const float* sinTT;
    DI void operator()(const f32x4 (&acc)[2][2][4][2], const Unit& u, int wr, int wc, int fr, int fq, const Pre& pre) const {
        if (u.kind == 0) {
            const int gpm = pm0 + u.pm, jj = gpm % 9; const bool isctx = (jj == 0); const bool isq = u.pn < 4;
            float invf[8];
#pragma unroll
            for (int k = 0; k < 8; ++k) invf[k] = __builtin_amdgcn_exp2f(-(float)((32 * wc + 8 * fq + k) & 63) * (13.287712379549449f / 64.0f)) * 0.15915494309189535f;
#pragma unroll
            for (int ai = 0; ai < 2; ++ai)
#pragma unroll
                for (int m = 0; m < 4; ++m) {
                    const int rr = ai * 128 + wr * 64 + m * 16 + fr;
                    f32x4 x1[2], x2[2];
#pragma unroll
                    for (int n = 0; n < 2; ++n) { x1[n] = acc[ai][0][m][n]; x2[n] = acc[ai][1][m][n]; }
                    if (isq) {
                        if (!isctx) {
                            const int t = (jj - 1) * 256 + rr; const float pos = (float)((wc < 2) ? (t >> 6) : (t & 63));
#pragma unroll
                            for (int n = 0; n < 2; ++n)
#pragma unroll
                                for (int j = 0; j < 4; ++j) { const float a = pos * invf[4 * n + j]; const float c = __builtin_amdgcn_cosf(a), s = __builtin_amdgcn_sinf(a);
                                    const float p = x1[n][j], q = x2[n][j]; x1[n][j] = p * c - q * s; x2[n][j] = p * s + q * c; }
                        }
                    } else {
#pragma unroll
                        for (int n = 0; n < 2; ++n)
#pragma unroll
                            for (int j = 0; j < 4; ++j) { x1[n][j] = silu_f(x1[n][j]); x2[n][j] = silu_f(x2[n][j]); }
                    }
                    bf16_t* rowp = isq ? RQ + (size_t)(u.pm * 256 + rr) * 1024 + u.pn * 256 + wc * 32 + 8 * fq : RG + (size_t)(u.pm * 256 + rr) * 4096 + (u.pn - 4) * 256 + wc * 32 + 8 * fq;
                    u32x4 w; w.x = pk_bf16(x1[0][0], x1[0][1]); w.y = pk_bf16(x1[0][2], x1[0][3]); w.z = pk_bf16(x1[1][0], x1[1][1]); w.w = pk_bf16(x1[1][2], x1[1][3]);
                    stg<u32x4>(rowp, w);
                    w.x = pk_bf16(x2[0][0], x2[0][1]); w.y = pk_bf16(x2[0][2], x2[0][3]); w.z = pk_bf16(x2[1][0], x2[1][1]); w.w = pk_bf16(x2[1][2], x2[1][3]);
                    stg<u32x4>(rowp + 128, w);
                }
            return;
        }
        const int gpm = pm0 + u.pn, jj = gpm % 9; const bool isctx = (jj == 0); const bool isk = u.pm < 4;
        if (isk) {
#pragma unroll
            for (int m = 0; m < 4; ++m) {
                const int f = wr * 64 + m * 16 + fr;
#pragma unroll
                for (int bj = 0; bj < 2; ++bj) {
                    f32x4 x1[2], x2[2];
#pragma unroll
                    for (int n = 0; n < 2; ++n) { x1[n] = acc[0][bj][m][n] * 0.0625f; x2[n] = acc[1][bj][m][n] * 0.0625f; }
                    const int tl = bj * 128 + wc * 32 + 8 * fq;
                    if (!isctx) {
                        const int t = (jj - 1) * 256 + tl;
                        const float ivf = __builtin_amdgcn_exp2f(-(float)(m * 16 + fr) * (13.287712379549449f / 64.0f)) * 0.15915494309189535f;
#pragma unroll
                        for (int n = 0; n < 2; ++n)
#pragma unroll
                            for (int j = 0; j < 4; ++j) { const int tt = t + 4 * n + j; const float a = (float)(wr == 0 ? (tt >> 6) : (tt & 63)) * ivf; const float c = __builtin_amdgcn_cosf(a), s = __builtin_amdgcn_sinf(a);
                                const float p = x1[n][j], q = x2[n][j]; x1[n][j] = p * c - q * s; x2[n][j] = p * s + q * c; }
                    }
                    bf16_t* p1 = RKT + ((size_t)(u.pn * 8 + 4 * bj + wc) * 1024 + (u.pm * 256 + f)) * 32 + 8 * fq;
                    u32x4 w; w.x = pk_bf16(x1[0][0], x1[0][1]); w.y = pk_bf16(x1[0][2], x1[0][3]); w.z = pk_bf16(x1[1][0], x1[1][1]); w.w = pk_bf16(x1[1][2], x1[1][3]);
                    stg<u32x4>(p1, w);
                    w.x = pk_bf16(x2[0][0], x2[0][1]); w.y = pk_bf16(x2[0][2], x2[0][3]); w.z = pk_bf16(x2[1][0], x2[1][1]); w.w = pk_bf16(x2[1][2], x2[1][3]);
                    stg<u32x4>(p1 + 128 * 32, w);
                }
            }
        } else {
#pragma unroll
            for (int ai = 0; ai < 2; ++ai)
#pragma unroll
                for (int m = 0; m < 4; ++m) {
                    const int f = (u.pm - 4) * 256 + ai * 128 + wr * 64 + m * 16 + fr;
#pragma unroll
                    for (int bj = 0; bj < 2; ++bj) { const f32x4 v0 = acc[ai][bj][m][0], v1 = acc[ai][bj][m][1];
                        u32x4 w; w.x = pk_bf16(v0[0], v0[1]); w.y = pk_bf16(v0[2], v0[3]); w.z = pk_bf16(v1[0], v1[1]); w.w = pk_bf16(v1[2], v1[3]);
                        stg<u32x4>(RVT + ((size_t)(u.pn * 8 + 4 * bj + wc) * 2048 + f) * 32 + 8 * fq, w); }
                }
        }
    }
};

struct EpiResid {
    static constexpr bool PERM = true; static constexpr int EV = 16;

    struct Pre {}; DI void pre_load(const Unit&, int, int, Pre&) const {}
    const float* xin_ctx; const float* xin_lat; bf16_t* hb; const float* modbase; int first;
    DI void operator()(const f32x4 (&acc)[2][2][4][2], const Unit& u, int wr, int wc, int fr, int fq, const Pre& pre) const {
        const int b = u.pm / 9, jj = u.pm % 9; const bool isctx = (jj == 0);
        const float* gate = modbase + (size_t)(isctx ? 32 : b) * 6144 + 2048;
        const int col0 = u.pn * 256 + wc * 32 + 8 * fq;
        f32x4 gv[2][2];
#pragma unroll
        for (int bj = 0; bj < 2; ++bj)
#pragma unroll
            for (int n = 0; n < 2; ++n) gv[bj][n] = ldg<f32x4>(gate + col0 + bj * 128 + n * 4);
        const size_t rbase = isctx ? (size_t)b * 256 : (size_t)b * 2048 + (size_t)(jj - 1) * 256;
        const float* xi = isctx ? xin_ctx : xin_lat;
#pragma unroll
        for (int ai = 0; ai < 2; ++ai) {
            f32x4 hv[4][2][2];
#pragma unroll
            for (int m = 0; m < 4; ++m) { const int rr = ai * 128 + wr * 64 + m * 16 + fr;
#pragma unroll
                for (int bj = 0; bj < 2; ++bj) {
                    if (first) { const float* p = xi + (rbase + rr) * 1024 + col0 + bj * 128; hv[m][bj][0] = ldg<f32x4>(p); hv[m][bj][1] = ldg<f32x4>(p + 4); }
                    else { const u32x4 w = ldg<u32x4>(hb + (size_t)(u.pm * 256 + rr) * 1024 + col0 + bj * 128);
                        hv[m][bj][0] = (f32x4){bf_lo(w.x), bf_hi(w.x), bf_lo(w.y), bf_hi(w.y)}; hv[m][bj][1] = (f32x4){bf_lo(w.z), bf_hi(w.z), bf_lo(w.w), bf_hi(w.w)}; }
                } }
#pragma unroll
            for (int m = 0; m < 4; ++m) { const int rr = ai * 128 + wr * 64 + m * 16 + fr;
#pragma unroll
                for (int bj = 0; bj < 2; ++bj) { const f32x4 v0 = hv[m][bj][0] + gv[bj][0] * acc[ai][bj][m][0], v1 = hv[m][bj][1] + gv[bj][1] * acc[ai][bj][m][1];
                    u32x4 w; w.x = pk_bf16(v0[0], v0[1]); w.y = pk_bf16(v0[2], v0[3]); w.z = pk_bf16(v1[0], v1[1]); w.w = pk_bf16(v1[2], v1[3]);
                    stg<u32x4>(hb + (size_t)(u.pm * 256 + rr) * 1024 + col0 + bj * 128, w); } }
        }
    }
};

template <bool GATHER_>
struct ProbMoE {
    static constexpr bool GATHER = GATHER_;
    int K; const char* A; const char* W; const LAS int* tile_e; const LAS int* rowtok; pg8::GridOrder go; int G, c, stagger, noepi;
    DI bool next(int i, Unit& u) const { u.kind = 0; return go.map((long)i * G + c, u.pm, u.pn); }
    DI const char* a_ptr(const Unit& u) const { return GATHER ? A : A + (size_t)u.pm * 512 * K; }
    DI const char* b_ptr(const Unit& u) const { return W + ((size_t)tile_e[u.pm] * 4 + u.pn) * 512 * K; }
};
struct EpiSwiGLU {
    static constexpr bool PERM = true; static constexpr int EV = 8;

    struct Pre {}; DI void pre_load(const Unit&, int, int, Pre&) const {}
    bf16_t* act;
    DI void operator()(const f32x4 (&acc)[2][2][4][2], const Unit& u, int wr, int wc, int fr, int fq, const Pre& pre) const {
#pragma unroll
        for (int ai = 0; ai < 2; ++ai)
#pragma unroll
            for (int m = 0; m < 4; ++m) {
                bf16_t* rowp = act + (size_t)(u.pm * 256 + ai * 128 + wr * 64 + m * 16 + fr) * 512 + u.pn * 128 + wc * 32 + 8 * fq;
                const f32x4 g0 = acc[ai][0][m][0], u0 = acc[ai][0][m][1], g1 = acc[ai][1][m][0], u1 = acc[ai][1][m][1];
                u32x4 w; w.x = pk_bf16(silu_f(g0[0]) * u0[0], silu_f(g0[1]) * u0[1]); w.y = pk_bf16(silu_f(g0[2]) * u0[2], silu_f(g0[3]) * u0[3]);
                w.z = pk_bf16(silu_f(g1[0]) * u1[0], silu_f(g1[1]) * u1[1]); w.w = pk_bf16(silu_f(g1[2]) * u1[2], silu_f(g1[3]) * u1[3]);
                stg<u32x4>(rowp, w);
            }
    }
};
struct EpiDown {
    static constexpr bool PERM = true; static constexpr int EV = 8;

    bf16_t* y2; const int* rowmap; const float* wsel;
    struct Pre { u32x2 dw[8]; };
    DI void pre_load(const Unit& u, int wr, int, Pre& p) const {
        const int fr = lane_id_asm() & 15;
#pragma unroll
        for (int it = 0; it < 8; ++it) { const int row = u.pm * 256 + (it >> 2) * 128 + wr * 64 + (it & 3) * 16 + fr; p.dw[it] = ldg<u32x2>(rowmap + 2 * row); }
    }
    DI void operator()(const f32x4 (&acc)[2][2][4][2], const Unit& u, int wr, int wc, int fr, int fq, const Pre& pre) const {
#pragma unroll
        for (int ai = 0; ai < 2; ++ai)
#pragma unroll
            for (int m = 0; m < 4; ++m) {
                const u32x2 dwv = pre.dw[ai * 4 + m];
                const int d = (int)dwv.x;
                if (d >= 0) {
                    const float w = __uint_as_float(dwv.y);
                    bf16_t* rowp = y2 + (size_t)d * 1024 + u.pn * 256 + wc * 32 + 8 * fq;
#pragma unroll
                    for (int bj = 0; bj < 2; ++bj) { const f32x4 v0 = acc[ai][bj][m][0] * w, v1 = acc[ai][bj][m][1] * w;
                        u32x4 o; o.x = pk_bf16(v0[0], v0[1]); o.y = pk_bf16(v0[2], v0[3]); o.z = pk_bf16(v1[0], v1[1]); o.w = pk_bf16(v1[2], v1[3]);
                        stg<u32x4>(rowp + bj * 128, o); }
                }
            }
    }
};

template <int MODE>
DI void transpose_tile(const Frame& F, const float* src, const float* src2, int ld, bf16_t* dst, int K, int k0, int n0) {
    LAS float* tl = (LAS float*)F.lds;
    __syncthreads();
#pragma unroll
    for (int i = 0; i < 8; ++i) {
        const int idx = F.tid + 512 * i, kk = idx >> 6, nn = idx & 63, np = n0 + nn;
        float v;
        if (MODE == 0) v = ldg<float>(src + (size_t)(k0 + kk) * ld + np);
        else if (MODE == 1) { const int t = np >> 8, p = np & 255, bj = p >> 7, wc = (p >> 5) & 3, r = p & 31; v = ldg<float>(src + (size_t)(k0 + kk) * ld + t * 256 + wc * 64 + bj * 32 + r); }
        else { const int hid = 4 * (np >> 3) + (np & 3); v = ldg<float>(((np & 4) ? src2 : src) + (size_t)(k0 + kk) * ld + hid); }
        tl[nn * 65 + kk] = v;
    }
    __syncthreads();
#pragma unroll
    for (int i = 0; i < 4; ++i) {
        const int idx = F.tid + 512 * i, nn = idx >> 5, kp = (idx & 31) * 2;
        stg<unsigned>(dst + (size_t)(n0 + nn) * K + k0 + kp, pk_bf16(tl[nn * 65 + kp], tl[nn * 65 + kp + 1]));
    }
}
template <int MODE>
DI int transpose_mat(const Frame& F, const float* src, const float* src2, int ld, bf16_t* dst, int K, int Np, int u0, int u_first, int u_stride) {
    const int tk = K / 64, tn = Np / 64, ntl = tk * tn;
    int u = u_first; if (u < u0) { const int d = (u0 - u + u_stride - 1) / u_stride; u += d * u_stride; }
    for (; u < u0 + ntl; u += u_stride) { const int l = u - u0; transpose_tile<MODE>(F, src, src2, ld, dst, K, (l % tk) * 64, (l / tk) * 64); }
    return ntl;
}
DI void moe_tile_load(const Frame& F, const float* wg, const float* wu, const float* wd, int u, float (&v)[8]) {
    const int e = u / 384, l = u % 384;
#pragma unroll
    for (int i = 0; i < 8; ++i) {
        const int idx = F.tid + 512 * i, kk = idx >> 6, nn = idx & 63;
        if (l < 256) { const int np = (l >> 4) * 64 + nn, hid = 128 * (np >> 8) + 32 * ((np >> 5) & 3) + 8 * ((np >> 3) & 3) + 4 * ((np >> 7) & 1) + (np & 3);
            v[i] = ldg<float>(((np & 4) ? wu : wg) + (size_t)e * DM * MOEH + (size_t)((l & 15) * 64 + kk) * MOEH + hid); }
        else { const int l2 = l - 256; v[i] = ldg<float>(wd + (size_t)e * MOEH * DM + (size_t)((l2 & 7) * 64 + kk) * DM + (l2 >> 3) * 64 + nn); }
    }
}
constexpr int MOE_NT = NEXP * 384, MOE_T_WO = 28 * 128, MOE_T_QKV = 20 * 128;
DI int moe_split_lo(const Frame& F, int layer) {
    if (F.G != 256 || layer == DEPTH - 1) return 0;
    return (layer & 1) ? MOE_T_WO : MOE_T_WO + MOE_T_QKV;
}
DI void convert_moe_weights(const Frame& F, int layer, const int t_lo, const int t_hi, const int first, const int stride) {
    const float* wg = F.a->in[21] + (size_t)layer * NEXP * DM * MOEH; const float* wu = F.a->in[22] + (size_t)layer * NEXP * DM * MOEH; const float* wd = F.a->in[23] + (size_t)layer * NEXP * MOEH * DM;
    bf16_t* WGU = (bf16_t*)(F.ws + WS_WGU); bf16_t* WD = (bf16_t*)(F.ws + WS_WD);
    LAS float* tl = (LAS float*)F.lds;
    const int NT = t_hi;
    float v[8];
    int u = t_lo + first, par = 0;
    __syncthreads();
    if (u < NT) moe_tile_load(F, wg, wu, wd, u, v);
    for (; u < NT; u += stride, par ^= 1) {
        LAS float* tb = tl + par * (64 * 65);
#pragma unroll
        for (int i = 0; i < 8; ++i) { const int idx = F.tid + 512 * i; tb[(idx & 63) * 65 + (idx >> 6)] = v[i]; }
        __syncthreads();
        if (u + stride < NT) moe_tile_load(F, wg, wu, wd, u + stride, v);
        const int e = u / 384, l = u % 384;
        bf16_t* dst; int K, k0, n0;
        if (l < 256) { dst = WGU + (size_t)e * 1024 * 1024; K = 1024; k0 = (l & 15) * 64; n0 = (l >> 4) * 64; } else { const int l2 = l - 256; dst = WD + (size_t)e * 1024 * 512; K = 512; k0 = (l2 & 7) * 64; n0 = (l2 >> 3) * 64; }
#pragma unroll
        for (int i = 0; i < 4; ++i) { const int idx = F.tid + 512 * i, nn = idx >> 5, kp = (idx & 31) * 2;
            stg<unsigned>(dst + (size_t)(n0 + nn) * K + k0 + kp, pk_bf16(tb[nn * 65 + kp], tb[nn * 65 + kp + 1])); }
    }
    __syncthreads();
}

DI void p0_prologue(const Frame& F) {
    {
        LAS float* red = (LAS float*)F.lds;
        for (int u = F.bid; u < 4 * 96; u += F.G) {
            const int layer = u / 96, col0 = (u % 96) * 64;
            const float* W = F.a->in[6] + (size_t)layer * 1024 * 6144 + col0 + F.lane;
            const float* cp = F.lane < 32 ? F.a->in[1] + F.lane * 1024 : F.a->in[3];
            float acc[33];
#pragma unroll
            for (int r = 0; r < 33; ++r) acc[r] = 0.f;
            const int k0 = F.wave * 128;
            for (int k = k0; k < k0 + 128; k += 8) {
                float w8[8], c8[8];
#pragma unroll
                for (int q = 0; q < 8; ++q) { w8[q] = ldg<float>(W + (size_t)(k + q) * 6144); c8[q] = ldg<float>(cp + k + q); }
#pragma unroll
                for (int q = 0; q < 8; ++q) { const float sv = silu_f(c8[q]);
#pragma unroll
                    for (int r = 0; r < 33; ++r) acc[r] += w8[q] * __builtin_bit_cast(float, __builtin_amdgcn_readlane(__builtin_bit_cast(int, sv), r)); }
            }
#pragma unroll
            for (int r = 0; r < 33; ++r) red[(F.wave * 33 + r) * 64 + F.lane] = acc[r];
            __syncthreads();
            float* outp = (float*)(F.ws + WS_ADA) + (size_t)layer * 33 * 6144;
            for (int idx = F.tid; idx < 33 * 64; idx += 512) { const int r = idx >> 6, cl = idx & 63; float v = 0.f;
#pragma unroll
                for (int w8 = 0; w8 < 8; ++w8) v += red[(w8 * 33 + r) * 64 + cl];
                stg<float>(outp + (size_t)r * 6144 + col0 + cl, v + ldg<float>(F.a->in[7] + layer * 6144 + col0 + cl)); }
            __syncthreads();
        }
    }
    {
        int u0 = 0;
        for (int j = 0; j < 2; ++j) {
            const float* wqkv = F.a->in[8] + (size_t)j * 1024 * 3072;
            u0 += transpose_mat<1>(F, wqkv, nullptr, 3072, (bf16_t*)(F.ws + WS_WQK) + (size_t)j * 2048 * 1024, 1024, 2048, u0, F.bid, F.G);
            u0 += transpose_mat<0>(F, wqkv + 2048, nullptr, 3072, (bf16_t*)(F.ws + WS_WV) + (size_t)j * 1024 * 1024, 1024, 1024, u0, F.bid, F.G);
            u0 += transpose_mat<0>(F, F.a->in[13] + (size_t)j * 1024 * 1024, nullptr, 1024, (bf16_t*)(F.ws + WS_WODA) + (size_t)j * 1024 * 1024, 1024, 1024, u0, F.bid, F.G);
            u0 += transpose_mat<0>(F, F.a->in[14] + (size_t)j * 1024 * 8192, nullptr, 8192, (bf16_t*)(F.ws + WS_WIN) + (size_t)j * 8192 * 1024, 1024, 8192, u0, F.bid, F.G);
            u0 += transpose_mat<0>(F, F.a->in[16] + (size_t)j * 2048 * 1024, nullptr, 1024, (bf16_t*)(F.ws + WS_WORT) + (size_t)j * 1024 * 2048, 2048, 1024, u0, F.bid, F.G);
        }
        convert_moe_weights(F, 0, moe_split_lo(F, 0), MOE_NT, F.bid, F.G);
    }
}

template <bool SECOND>
DI void norm_phase(const Frame& F, int layer) {
    bf16_t* abuf = (bf16_t*)(F.ws + WS_ABUF);
    bf16_t* hb = (bf16_t*)(F.ws + WS_HB);
    const bf16_t* y2 = (const bf16_t*)(F.ws + WS_PROJ + PJ_Y2);
    const float* ng = F.a->in[SECOND ? 5 : 4] + layer * 1024;
    LAS float* Wl = (LAS float*)F.lds;
    LAS int* lhist = (LAS int*)(F.lds + LDS_MISC + 1024);
    int* eid = (int*)(F.ws + WS_MISC + MS_EID); float* wsel = (float*)(F.ws + WS_MISC + MS_WSEL);
    if (SECOND) {
        const float* wgp = F.a->in[17] + (size_t)layer * 1024 * 4; const float* wep = F.a->in[19] + (size_t)layer * 1024 * 32;
        {
            f32x4 wg4[2];
#pragma unroll
            for (int q = 0; q < 2; ++q) wg4[q] = ldg<f32x4>(wgp + (F.tid + 512 * q) * 4);
#pragma unroll
            for (int q = 0; q < 2; ++q) { const int k = F.tid + 512 * q; Wl[0 * 1024 + k] = wg4[q][0]; Wl[1 * 1024 + k] = wg4[q][1]; Wl[2 * 1024 + k] = wg4[q][2]; Wl[3 * 1024 + k] = wg4[q][3]; }
#pragma unroll
            for (int h2 = 0; h2 < 2; ++h2) {
                f32x4 we4[8];
#pragma unroll
                for (int q = 0; q < 8; ++q) we4[q] = ldg<f32x4>(wep + (size_t)(F.tid + 512 * (h2 * 8 + q)) * 4);
#pragma unroll
                for (int q = 0; q < 8; ++q) { const int c = F.tid + 512 * (h2 * 8 + q), k = c >> 3, o = 4 * (c & 7);
                    Wl[(4 + o) * 1024 + k] = we4[q][0]; Wl[(5 + o) * 1024 + k] = we4[q][1]; Wl[(6 + o) * 1024 + k] = we4[q][2]; Wl[(7 + o) * 1024 + k] = we4[q][3]; }
            }
        }
        if (F.tid < 32) lhist[F.tid] = 0;
        __syncthreads();
    }
    const int lane = F.lane;
#define NCOL(i) (((i) >> 1) * 512 + lane * 8 + ((i) & 1) * 4)
    const int rpw = (T + F.G * 8 - 1) / (F.G * 8), rbeg = (F.bid * 8 + F.wave) * rpw;
    int mkey = -2; f32x4 gnv[4], shv[4], scv[4], g2v[4];
#pragma unroll
    for (int i = 0; i < 4; ++i) { gnv[i] = ldg<f32x4>(ng + NCOL(i)); g2v[i] = gnv[i]; shv[i] = gnv[i]; scv[i] = gnv[i]; }
    const bool pref = !(layer == 0 && !SECOND); const bool fin = (!SECOND && layer > 0);
    const int rend = (rbeg + rpw < T) ? rbeg + rpw : T;
    u32x4 hn[2], yn[4];
#pragma unroll
    for (int q = 0; q < 2; ++q) { hn[q] = (u32x4){0u, 0u, 0u, 0u}; yn[q] = hn[q]; yn[2 + q] = hn[q]; }
#define NORM_ISSUE(rr) do { if (pref) { _Pragma("unroll") for (int q = 0; q < 2; ++q) hn[q] = ldg<u32x4>(hb + (size_t)(rr) * 1024 + q * 512 + lane * 8); \
        if (fin) { _Pragma("unroll") for (int q = 0; q < 2; ++q) { yn[q] = ldg<u32x4>(y2 + (size_t)(2 * (rr)) * 1024 + q * 512 + lane * 8); yn[2 + q] = ldg<u32x4>(y2 + (size_t)(2 * (rr) + 1) * 1024 + q * 512 + lane * 8); } } } } while (0)
    if (rbeg < rend) NORM_ISSUE(rbeg);
    for (int r = rbeg; r < rend; ++r) {
        u32x4 hc[2], yc[4];
#pragma unroll
        for (int q = 0; q < 2; ++q) { hc[q] = hn[q]; yc[q] = yn[q]; yc[2 + q] = yn[2 + q]; }
        if (r + 1 < rend) NORM_ISSUE(r + 1);
        const int b = r / NTOK, n = r % NTOK; const bool isctx = n < CTXL;
        if (SECOND && layer == DEPTH - 1 && isctx) continue;
        { const int nk = isctx ? -1 : b;
          if (nk != mkey) { mkey = nk; const float* mod = isctx ? mod_ctx(F, layer) : mod_lat(F, layer, b);
#pragma unroll
            for (int i = 0; i < 4; ++i) { const int c0 = NCOL(i); shv[i] = ldg<f32x4>(mod + (SECOND ? 3072 : 0) + c0); scv[i] = ldg<f32x4>(mod + (SECOND ? 4096 : 1024) + c0) + 1.0f; }
            if (!SECOND && layer > 0) { const float* modp = isctx ? mod_ctx(F, layer - 1) : mod_lat(F, layer - 1, b);
#pragma unroll
                for (int i = 0; i < 4; ++i) g2v[i] = ldg<f32x4>(modp + 5120 + NCOL(i)); } } }
        const size_t hoff = isctx ? ((size_t)b * 256 + n) * 1024 : ((size_t)b * 2048 + (n - 256)) * 1024;
        bf16_t* hrow = hb + (size_t)r * 1024;
        f32x4 x[4];
        if (layer == 0 && !SECOND) { const float* hin = isctx ? F.a->in[2] + hoff : F.a->in[0] + hoff;
#pragma unroll
            for (int i = 0; i < 4; ++i) x[i] = ldg<f32x4>(hin + NCOL(i));
        } else {
#pragma unroll
            for (int q = 0; q < 2; ++q) { const u32x4 w = hc[q]; x[2 * q] = (f32x4){bf_lo(w.x), bf_hi(w.x), bf_lo(w.y), bf_hi(w.y)}; x[2 * q + 1] = (f32x4){bf_lo(w.z), bf_hi(w.z), bf_lo(w.w), bf_hi(w.w)}; }
        }
        if (!SECOND && layer > 0) {
#pragma unroll
            for (int q = 0; q < 2; ++q) {
                const u32x4 a4 = yc[q], c4 = yc[2 + q];
#pragma unroll
                for (int hh = 0; hh < 2; ++hh) { const int i = 2 * q + hh; const unsigned ax = hh ? a4.z : a4.x, ay = hh ? a4.w : a4.y, cx = hh ? c4.z : c4.x, cy = hh ? c4.w : c4.y;
                    const f32x4 g2 = g2v[i];
                    x[i][0] += g2[0] * (bf_lo(ax) + bf_lo(cx)); x[i][1] += g2[1] * (bf_hi(ax) + bf_hi(cx)); x[i][2] += g2[2] * (bf_lo(ay) + bf_lo(cy)); x[i][3] += g2[3] * (bf_hi(ay) + bf_hi(cy)); }
                { u32x4 w; w.x = pk_bf16(x[2 * q][0], x[2 * q][1]); w.y = pk_bf16(x[2 * q][2], x[2 * q][3]); w.z = pk_bf16(x[2 * q + 1][0], x[2 * q + 1][1]); w.w = pk_bf16(x[2 * q + 1][2], x[2 * q + 1][3]); stg<u32x4>(hrow + q * 512 + lane * 8, w); }
            }
        }
        float ss = 0.f;
#pragma unroll
        for (int i = 0; i < 4; ++i) ss += (x[i][0] * x[i][0] + x[i][1] * x[i][1]) + (x[i][2] * x[i][2] + x[i][3] * x[i][3]);
        ss = wave_sum(ss, lane);
        const float rstd = 1.0f / sqrtf(ss * (1.0f / 1024.0f) + RMS_EPS);
        f32x4 v[4];
#pragma unroll
        for (int i = 0; i < 4; ++i) v[i] = (x[i] * rstd * gnv[i]) * scv[i] + shv[i];
#pragma unroll
        for (int q = 0; q < 2; ++q) {
            u32x4 w; w.x = pk_bf16(v[2 * q][0], v[2 * q][1]); w.y = pk_bf16(v[2 * q][2], v[2 * q][3]); w.z = pk_bf16(v[2 * q + 1][0], v[2 * q + 1][1]); w.w = pk_bf16(v[2 * q + 1][2], v[2 * q + 1][3]);
            stg<u32x4>(abuf + (size_t)r * 1024 + q * 512 + lane * 8, w);
        }
        if (SECOND) {
            const float* bg = F.a->in[18] + layer * 4; const float* be = F.a->in[20] + layer * 32;
            float gl[4]; float gmax = -3.0e38f; int gi = 0;
#pragma unroll
            for (int o = 0; o < 4; ++o) {
                float p = 0.f;
#pragma unroll
                for (int i = 0; i < 4; ++i) { const f32x4 w = *(const LAS f32x4*)(Wl + o * 1024 + NCOL(i)); p += (v[i][0] * w[0] + v[i][1] * w[1]) + (v[i][2] * w[2] + v[i][3] * w[3]); }
                gl[o] = wave_sum(p, lane) + ldg<float>(bg + o);
                if (gl[o] > gmax) { gmax = gl[o]; gi = o; }
            }
            gi = __builtin_amdgcn_readfirstlane(gi);
            float gsum = 0.f;
#pragma unroll
            for (int o = 0; o < 4; ++o) { gsum += __expf(gl[o] - gmax); asm volatile("" : "+v"(gsum)); }
            const float psel = __builtin_amdgcn_rcpf(gsum);
            float el[8];
#pragma unroll
            for (int o = 0; o < 8; ++o) {
                float p = 0.f;
                const LAS float* wr = Wl + (4 + gi * 8 + o) * 1024;
#pragma unroll
                for (int i = 0; i < 4; ++i) { const f32x4 w = *(const LAS f32x4*)(wr + NCOL(i)); p += (v[i][0] * w[0] + v[i][1] * w[1]) + (v[i][2] * w[2] + v[i][3] * w[3]); }
                el[o] = wave_sum(p, lane) + ldg<float>(be + gi * 8 + o);
            }
            float m1 = -3.0e38f, m2 = -3.0e38f; int i1 = 0, i2 = 0;
#pragma unroll
            for (int o = 0; o < 8; ++o) { if (el[o] > m1) { m1 = el[o]; i1 = o; } }
#pragma unroll
            for (int o = 0; o < 8; ++o) { if (o != i1 && el[o] > m2) { m2 = el[o]; i2 = o; } }
            const float e2 = __expf(m2 - m1), inv = __builtin_amdgcn_rcpf(1.0f + e2);
            if (lane == 0) {
                stg<int>(eid + 2 * r, gi * 8 + i1); stg<int>(eid + 2 * r + 1, gi * 8 + i2); stg<float>(wsel + 2 * r, inv * psel); stg<float>(wsel + 2 * r + 1, e2 * inv * psel);
                __hip_atomic_fetch_add(&lhist[gi * 8 + i1], 1, __ATOMIC_RELAXED, __HIP_MEMORY_SCOPE_WORKGROUP); __hip_atomic_fetch_add(&lhist[gi * 8 + i2], 1, __ATOMIC_RELAXED, __HIP_MEMORY_SCOPE_WORKGROUP);
            }
        }
    }
    if (SECOND) {
        __syncthreads();
        if (F.tid < 32) { const int c = lhist[F.tid]; if (c) __hip_atomic_fetch_add((unsigned*)(F.ws + WS_CTL) + CW_CNT + layer * 64 + F.tid, (unsigned)c, __ATOMIC_RELAXED, __HIP_MEMORY_SCOPE_AGENT); }
    }
}
#undef NCOL

#undef NORM_ISSUE
DI int build_segments(const Frame& F, int layer, LAS int* segs, LAS int* tile_e) {
    __syncthreads();
    if (F.tid < 32) {
        const unsigned* cnt = (const unsigned*)(F.ws + WS_CTL) + CW_CNT + layer * 64;
        segs[40 + F.tid] = (int)__hip_atomic_load(cnt + F.tid, __ATOMIC_RELAXED, __HIP_MEMORY_SCOPE_AGENT);
    }
    __syncthreads();
    if (F.tid == 0) {
        int s = 0;
        for (int e = 0; e < 32; ++e) { segs[e] = s; s += (segs[40 + e] + 255) & ~255; }
        segs[32] = s;
    }
    __syncthreads();
    const int ntl = segs[32] >> 8;
    if (tile_e) {
        for (int t = F.tid; t < ntl; t += 512) { int e = 0;
            for (int q = 1; q < 32; ++q) e = (segs[q] <= t * 256) ? q : e;
            tile_e[t] = e; }
        __syncthreads();
    }
    return ntl;
}

DI void sort_phase(const Frame& F, int layer) {
    LAS int* segs = (LAS int*)(F.lds + LDS_MISC + 2048);
    LAS int* lhist = (LAS int*)(F.lds + LDS_MISC + 1024);
    LAS int* lbase = (LAS int*)(F.lds + LDS_MISC + 1024 + 128);
    LAS int* lpos = (LAS int*)F.lds;
    build_segments(F, layer, segs, nullptr);
    const int* eid = (const int*)(F.ws + WS_MISC + MS_EID); const float* wsel = (const float*)(F.ws + WS_MISC + MS_WSEL); int* rowinfo = (int*)(F.ws + WS_MISC + MS_WSORT);
    const bf16_t* abuf = (const bf16_t*)(F.ws + WS_ABUF); bf16_t* sa = (bf16_t*)(F.ws + WS_PROJ + PJ_SA);
    const int RPB = (T + F.G - 1) / F.G;
    const int r0 = F.bid * RPB, r1 = (r0 + RPB < T) ? r0 + RPB : T;
    const int na = r1 > r0 ? 2 * (r1 - r0) : 0;
    if (F.tid < 32) lhist[F.tid] = 0;
    __syncthreads();
    int ee[2], lp[2];
#pragma unroll
    for (int it = 0; it < 2; ++it) { const int a = F.tid + 512 * it; ee[it] = -1; lp[it] = 0;
        if (a < na && !(layer == DEPTH - 1 && ((r0 + (a >> 1)) % NTOK) < CTXL)) { ee[it] = ldg<int>(eid + 2 * r0 + a); lp[it] = __hip_atomic_fetch_add(&lhist[ee[it]], 1, __ATOMIC_RELAXED, __HIP_MEMORY_SCOPE_WORKGROUP); } }
    __syncthreads();
    if (F.tid < 32) { const int c = lhist[F.tid];
        lbase[F.tid] = segs[F.tid] + (c ? (int)__hip_atomic_fetch_add((unsigned*)(F.ws + WS_CTL) + CW_CUR + layer * 64 + F.tid, (unsigned)c, __ATOMIC_RELAXED, __HIP_MEMORY_SCOPE_AGENT) : 0); }
    __syncthreads();
#pragma unroll
    for (int it = 0; it < 2; ++it) { const int a = F.tid + 512 * it;
        if (ee[it] >= 0) { const int pos = lbase[ee[it]] + lp[it]; lpos[a] = pos; stg<u32x2>((unsigned*)rowinfo + 2 * (size_t)pos, (u32x2){(unsigned)(2 * r0 + a), __float_as_uint(ldg<float>(wsel + 2 * r0 + a))}); } }
    __syncthreads();
    if (F.bid < 32) { const int e = F.bid; for (int p = segs[e] + segs[40 + e] + F.tid; p < segs[e + 1]; p += 512) stg<int>(rowinfo + 2 * (size_t)p, -1); }
    if (F.G < 32 && F.bid == 0) { for (int e = F.G; e < 32; ++e) for (int p = segs[e] + segs[40 + e] + F.tid; p < segs[e + 1]; p += 512) stg<int>(rowinfo + 2 * (size_t)p, -1); }
}

typedef __bf16 bf16x2_t __attribute__((ext_vector_type(2)));
DI float dot2_ones(unsigned packed, float c) { return __builtin_amdgcn_fdot2_f32_bf16(__builtin_bit_cast(bf16x2_t, packed), __builtin_bit_cast(bf16x2_t, 0x3f803f80u), c, false); }
constexpr int AT_KROW = 272, AT_VROW = 136, AT_KB = 64 * AT_KROW, AT_VB = 128 * AT_VROW, AT_BUF = AT_KB + AT_VB, AT_V0 = 3 * AT_KB, AT_Q0 = 3 * AT_KB + 2 * AT_VB;
static_assert(AT_Q0 + 65536 <= LDS_MISC, "attention LDS");
template <bool USEOFF>
DI void attn_body(const Frame& F, int layer) {
    const int j = layer >> 1;
    const bf16_t* Qb = (const bf16_t*)(F.ws + WS_PROJ + PJ_Q); const bf16_t* Kb = (const bf16_t*)(F.ws + WS_PROJ + PJ_K); const bf16_t* VT = (const bf16_t*)(F.ws + WS_PROJ + PJ_VT);
    bf16_t* Ob = (bf16_t*)(F.ws + WS_OBUF);
    { }
    const int lane0 = F.lane;
    const float* lam = F.a->in[11] + j * 256;
    float p01 = ldg<float>(lam + lane0) * ldg<float>(lam + 64 + lane0), p23 = ldg<float>(lam + 128 + lane0) * ldg<float>(lam + 192 + lane0);
    p01 = wave_sum(p01, lane0); p23 = wave_sum(p23, lane0);
    const float lam_init = 0.8f - 0.6f * __expf(-0.3f * (float)layer);
    const float lam_full = uni_f(__expf(p01) - __expf(p23) + lam_init);
    float mq = fabsf(ldg<float>(F.a->in[9] + j * 64 + lane0)), mk = fabsf(ldg<float>(F.a->in[10] + j * 64 + lane0));
#pragma unroll
    for (int o = 32; o >= 1; o >>= 1) { mq = fmaxf(mq, shx(mq, o, lane0)); mk = fmaxf(mk, shx(mk, o, lane0)); }
    const float OFF = uni_f(8.0f * LOG2E * mq * mk);
    const float* gsub = F.a->in[12] + j * 128;
    const float lam_init_s = uni_f(lam_init);

    for (int u = F.bid; u < 2304; u += F.G) {
        int b, h, qb, nkt;
        if (u < 2048) {
            int bh;
            if (F.G == 256) { const int i = u >> 8, c = u & 255; bh = i * 32 + (c & 7) * 4 + (c >> 6); qb = 1 + ((c >> 3) & 7); } else { bh = u >> 3; qb = 1 + (u & 7); }
            b = bh >> 3; h = bh & 7; nkt = 36;
        } else { const int uu = u - 2048; b = uu >> 3; h = uu & 7; qb = 0; nkt = 4; }
        const size_t rowbase = (size_t)b * NTOK;
        const int lane = lane_id_asm(), lr = lane & 31, lh = lane >> 5, tidu = (F.wave << 6) | lane;
        const size_t qrow = rowbase + qb * 256 + F.wave * 32 + (lane_id_asm() & 31);
        __syncthreads();
        const int qlo = AT_Q0 + F.wave * 8192 + lane * 16;
#pragma unroll
        for (int mp = 0; mp < 2; ++mp)
#pragma unroll
            for (int ks = 0; ks < 4; ++ks) *(LAS bf16x8*)(F.lds + qlo + (mp * 4 + ks) * 1024) = ldg<bf16x8>(Qb + qrow * 1024 + h * 128 + mp * 64 + ks * 16 + lh * 8);
        f32x16 O1[4], O2[4];
#pragma unroll
        for (int e = 0; e < 4; ++e)
#pragma unroll
            for (int i = 0; i < 16; ++i) { O1[e][i] = 0.f; O2[e][i] = 0.f; }
        float l1p = 0.f, l2p = 0.f;
        const unsigned kgo = (unsigned)((tidu >> 4) * 1024 + (tidu & 15) * 8), vgo = (unsigned)((tidu >> 3) * T + (tidu & 7) * 8);
        const int klo = (tidu >> 4) * AT_KROW + (tidu & 15) * 16, vlo = (tidu >> 3) * AT_VROW + (tidu & 7) * 16;
        const bf16_t* kbase = Kb + rowbase * 1024 + h * 128; const bf16_t* vbase = VT + (size_t)(h * 128) * T + rowbase;
        u32x4 sk[2], sv[2];
#define AT_LOADK(tt) do { _Pragma("unroll") for (int i = 0; i < 2; ++i) sk[i] = ldg<u32x4>(kbase + (size_t)(tt) * 65536 + (size_t)i * 32768 + kgo); } while (0)
#define AT_LOADV(tt) do { _Pragma("unroll") for (int i = 0; i < 2; ++i) sv[i] = ldg<u32x4>(vbase + (size_t)i * 64 * T + (size_t)(tt) * 64 + vgo); } while (0)
#define AT_WRITEK(ko) do { _Pragma("unroll") for (int i = 0; i < 2; ++i) *(LAS u32x4*)(F.lds + (ko) + klo + i * 32 * AT_KROW) = sk[i]; } while (0)
#define AT_WRITEV(vo_) do { _Pragma("unroll") for (int i = 0; i < 2; ++i) { *(LAS u32x2*)(F.lds + (vo_) + vlo + i * 64 * AT_VROW) = (u32x2){sv[i].x, sv[i].y}; *(LAS u32x2*)(F.lds + (vo_) + vlo + i * 64 * AT_VROW + 8) = (u32x2){sv[i].z, sv[i].w}; } } while (0)
#define AT_KFR(bo, kb, st) (*(const LAS bf16x8*)(F.lds + (bo) + ((kb) * 32 + lr) * AT_KROW + (((st) & 1) * 64 + ((st) >> 1) * 16 + lh * 8) * 2))
#define AT_QFR(st) (*(const LAS bf16x8*)(F.lds + qlo + (((st) & 1) * 4 + ((st) >> 1)) * 1024))
#define AT_QK(bo, kb, S1_, S2_) do { \
            _Pragma("unroll") for (int i = 0; i < 16; ++i) { S1_[i] = USEOFF ? -OFF : 0.f; S2_[i] = USEOFF ? -OFF : 0.f; } \
            bf16x8 kfr_[3], qfr_[3]; \
            kfr_[0] = AT_KFR(bo, kb, 0); qfr_[0] = AT_QFR(0); kfr_[1] = AT_KFR(bo, kb, 1); qfr_[1] = AT_QFR(1); \
            _Pragma("unroll") for (int st = 0; st < 8; ++st) { \
                if (st + 2 < 8) { kfr_[(st + 2) % 3] = AT_KFR(bo, kb, st + 2); qfr_[(st + 2) % 3] = AT_QFR(st + 2); } \
                if (st & 1) S2_ = __builtin_amdgcn_mfma_f32_32x32x16_bf16(kfr_[st % 3], qfr_[st % 3], S2_, 0, 0, 0); \
                else S1_ = __builtin_amdgcn_mfma_f32_32x32x16_bf16(kfr_[st % 3], qfr_[st % 3], S1_, 0, 0, 0); \
                __builtin_amdgcn_sched_barrier(0); } } while (0)
#define AT_FIN(S_, lp_, P_) do { \
            _Pragma("unroll") for (int s = 0; s < 2; ++s) { u32x4 w; w.x = pk_bf16(S_[8 * s], S_[8 * s + 1]); w.y = pk_bf16(S_[8 * s + 2], S_[8 * s + 3]); w.z = pk_bf16(S_[8 * s + 4], S_[8 * s + 5]); w.w = pk_bf16(S_[8 * s + 6], S_[8 * s + 7]); \
                lp_ = dot2_ones(w.x, lp_); lp_ = dot2_ones(w.y, lp_); lp_ = dot2_ones(w.z, lp_); lp_ = dot2_ones(w.w, lp_);        \
                P_[s] = __builtin_bit_cast(bf16x8, w); } } while (0)
#define AT_VFR(bo, kb, ix) ([&]() -> bf16x8 { const int vo = (bo) + (((ix) >> 1) * 32 + lr) * AT_VROW + ((kb) * 32 + 16 * ((ix) & 1) + 4 * lh) * 2; \
            const s16x4 lo = *(const LAS s16x4*)(F.lds + vo), hi = *(const LAS s16x4*)(F.lds + vo + 16); return __builtin_shufflevector(lo, hi, 0, 1, 2, 3, 4, 5, 6, 7); }())
#define AT_PV_EXP(bo, kb, Pa_, Pb_, X1_, X2_, doexp) do { \
            bf16x8 vfr_[3]; vfr_[0] = AT_VFR(bo, kb, 0); vfr_[1] = AT_VFR(bo, kb, 1); \
            _Pragma("unroll") for (int ix = 0; ix < 8; ++ix) { \
                if (ix + 2 < 8) vfr_[(ix + 2) % 3] = AT_VFR(bo, kb, ix + 2); \
                O1[ix >> 1] = __builtin_amdgcn_mfma_f32_32x32x16_bf16(vfr_[ix % 3], Pa_[ix & 1], O1[ix >> 1], 0, 0, 0); \
                O2[ix >> 1] = __builtin_amdgcn_mfma_f32_32x32x16_bf16(vfr_[ix % 3], Pb_[ix & 1], O2[ix >> 1], 0, 0, 0); \
                if (doexp) { _Pragma("unroll") for (int i = 0; i < 2; ++i) { X1_[2 * ix + i] = __builtin_amdgcn_exp2f(X1_[2 * ix + i]); X2_[2 * ix + i] = __builtin_amdgcn_exp2f(X2_[2 * ix + i]); } } \
                __builtin_amdgcn_sched_barrier(0); } } while (0)
        f32x16 Sa1, Sa2, Sb1, Sb2; bf16x8 Pa1[2], Pa2[2], Pb1[2], Pb2[2];
        AT_LOADK(0); AT_LOADV(0);
        AT_WRITEK(0); AT_WRITEV(AT_V0);
        if (nkt > 1) { AT_LOADK(1); AT_WRITEK(AT_KB); AT_LOADV(1); }
        if (nkt > 2) AT_LOADK(2);
        __syncthreads();
        AT_QK(0, 0, Sa1, Sa2);
#pragma unroll
        for (int i = 0; i < 16; ++i) { Sa1[i] = __builtin_amdgcn_exp2f(Sa1[i]); Sa2[i] = __builtin_amdgcn_exp2f(Sa2[i]); }
        AT_FIN(Sa1, l1p, Pa1); AT_FIN(Sa2, l2p, Pa2);
        int kc = 0, kn = AT_KB, kw = 2 * AT_KB;
        for (int t = 0; t < nkt; ++t) {
            const int vc = AT_V0 + (t & 1) * AT_VB, vn = AT_V0 + AT_VB - (t & 1) * AT_VB;
            const bool hn = (t + 1 < nkt);
            __syncthreads();
            if (t + 2 < nkt) AT_WRITEK(kw);
            if (hn) AT_WRITEV(vn);
            if (t + 3 < nkt) AT_LOADK(t + 3);
            if (t + 2 < nkt) AT_LOADV(t + 2);
            AT_QK(kc, 1, Sb1, Sb2);
            AT_PV_EXP(vc, 0, Pa1, Pa2, Sb1, Sb2, true);
            AT_FIN(Sb1, l1p, Pb1); AT_FIN(Sb2, l2p, Pb2);
            if (hn) AT_QK(kn, 0, Sa1, Sa2);
            AT_PV_EXP(vc, 1, Pb1, Pb2, Sa1, Sa2, hn);
            if (hn) { AT_FIN(Sa1, l1p, Pa1); AT_FIN(Sa2, l2p, Pa2); }
            { const int k_ = kc; kc = kn; kn = kw; kw = k_; }
        }
#undef AT_LOADK
#undef AT_LOADV
#undef AT_WRITEK
#undef AT_WRITEV
#undef AT_QK
#undef AT_KFR
#undef AT_QFR
#undef AT_VFR
#undef AT_FIN
#undef AT_PV_EXP
        const int lane3 = lane_id_asm(), lr3 = lane3 & 31, lh3 = lane3 >> 5;
        const size_t qrow3 = rowbase + qb * 256 + F.wave * 32 + lr3;
        float l1 = l1p, l2 = l2p;
        l1 += shx(l1, 32, lane3); l2 += shx(l2, 32, lane3);
        const float i1 = 1.0f / l1, i2 = lam_full / l2;
        float ss = 0.f;
#pragma unroll
        for (int e = 0; e < 4; ++e)
#pragma unroll
            for (int i = 0; i < 16; ++i) { const float o = O1[e][i] * i1 - O2[e][i] * i2; O1[e][i] = o; ss += o * o; }
        ss += shx(ss, 32, lane3);
        float li_ = lam_init_s; asm volatile("" : "+s"(li_));
        const float rstd = __builtin_amdgcn_rsqf(ss * (1.0f / 128.0f) + RMS_EPS) * (1.0f - li_);
        bf16_t* orow = Ob + qrow3 * 1024 + h * 128;
#pragma unroll
        for (int e = 0; e < 4; ++e)
#pragma unroll
            for (int g4 = 0; g4 < 4; ++g4) {
                const int e0 = e * 32 + 8 * g4 + 4 * lh3;
                const f32x4 gs = ldg<f32x4>(gsub + e0);
                u32x2 w; w.x = pk_bf16(O1[e][4 * g4] * rstd * gs[0], O1[e][4 * g4 + 1] * rstd * gs[1]); w.y = pk_bf16(O1[e][4 * g4 + 2] * rstd * gs[2], O1[e][4 * g4 + 3] * rstd * gs[3]);
                stg<u32x2>(orow + e0, w);
            }
    }
    __syncthreads();
}

DI void attn_phase(const Frame& F, int layer) {
    const int j = layer >> 1;
    float mq = fabsf(ldg<float>(F.a->in[9] + j * 64 + F.lane)), mk = fabsf(ldg<float>(F.a->in[10] + j * 64 + F.lane));
#pragma unroll
    for (int o = 32; o >= 1; o >>= 1) { mq = fmaxf(mq, shx(mq, o, F.lane)); mk = fmaxf(mk, shx(mk, o, F.lane)); }
    const bool useoff = uni_f(8.0f * LOG2E * mq * mk) > 40.0f;
    if (useoff) attn_body<true>(F, layer); else attn_body<false>(F, layer);
}

constexpr int SC_Q = 0, SC_QROW = 528, SC_K = 32 * SC_QROW, SC_V = SC_K + 16384, SC_BUF = SC_V + 16384, SC_S = 2 * SC_BUF, SC_SROW = 80, SC_RED = SC_S + 2 * 32 * SC_SROW, SC_Y = SC_RED + 1024, SC_YROW = 528;
DI void scan_phase(const Frame& F, int layer, int hf) {
    const int j = layer >> 1;
    const bf16_t* RQ = (const bf16_t*)(F.ws + WS_PROJ + PJ_RQ); bf16_t* RG = (bf16_t*)(F.ws + WS_PROJ + PJ_RG);
    const bf16_t* RKT = (const bf16_t*)(F.ws + WS_PROJ + PJ_RKT); const bf16_t* RVT = (const bf16_t*)(F.ws + WS_PROJ + PJ_RVT);
    float* ssqb = (float*)(F.ws + WS_MISC + MS_SSQ);
    const int tid = F.tid;
    for (int u = F.bid; u < 256; u += F.G) {
        int bl, h, dir, eh;
        if (F.G == 256) { const int base = (u >> 5) * 8 + (u & 7), var = (u >> 3) & 3; bl = base >> 2; h = base & 3; dir = var >> 1; eh = var & 1; }
        else { bl = u >> 4; h = (u >> 2) & 3; dir = (u >> 1) & 1; eh = u & 1; }
        const float l2g = __log2f(1.0f - __expf(ldg<float>(F.a->in[15] + j * 8 + dir * 4 + h)));
        const float g32 = __builtin_amdgcn_exp2f(32.0f * l2g);
        const int sgn = dir ? -1 : 1, kd_a = dir ? 0 : 31, qd_a = dir ? 32 : 1;
        const size_t rb = (size_t)bl * NTOK;
        const bf16_t* qbase = RQ + rb * 1024 + h * 256;
        const bf16_t* ktbase = RKT + ((size_t)(rb >> 5) * 1024 + h * 256) * 32;
        const bf16_t* vtbase = RVT + ((size_t)(rb >> 5) * 2048 + h * 512 + eh * 256) * 32;
        bf16_t* gbase = RG + (rb + (tid >> 4)) * 4096 + dir * 2048 + h * 512 + eh * 256 + (tid & 15) * 16;
        const int qt = tid >> 5, qc = tid & 31;
        const unsigned qgo = (unsigned)(qt * 1024 + qc * 8);
        const int ql0 = SC_Q + qt * SC_QROW + qc * 16, ql1 = ql0 + 16 * SC_QROW;
        const int kd = tid >> 2, kc = tid & 3;
        const unsigned kgo = (unsigned)(kd * 32 + kc * 8);
        const int kl = kd * 64 + (((kc ^ (kd >> 2)) & 3) << 4);
        f32x16 S[8];
#pragma unroll
        for (int d = 0; d < 8; ++d)
#pragma unroll
            for (int i = 0; i < 16; ++i) S[d][i] = 0.f;
        u32x4 sq[2], sk[2], sv[2];
        __syncthreads();
        if (tid < 64) { const int t = tid & 31; *(LAS float*)(F.lds + SC_RED + tid * 4) = __builtin_amdgcn_exp2f((float)(tid < 32 ? kd_a - sgn * t : qd_a + sgn * t) * l2g); }
        {
            const int tok0 = dir ? 224 : 0;
#pragma unroll
            for (int i = 0; i < 2; ++i) { sq[i] = ldg<u32x4>(qbase + (size_t)(tok0 + 16 * i) * 1024 + qgo); sk[i] = ldg<u32x4>(ktbase + (size_t)tok0 * 1024 + i * 4096 + kgo); sv[i] = ldg<u32x4>(vtbase + (size_t)tok0 * 2048 + i * 4096 + kgo); }
            *(LAS u32x4*)(F.lds + ql0) = sq[0]; *(LAS u32x4*)(F.lds + ql1) = sq[1];
#pragma unroll
            for (int i = 0; i < 2; ++i) { *(LAS u32x4*)(F.lds + SC_K + kl + i * 8192) = sk[i]; *(LAS u32x4*)(F.lds + SC_V + kl + i * 8192) = sv[i]; }
        }
        __syncthreads();
        for (int ci = 0; ci < 72; ++ci) {
            const int tok0 = dir ? 32 * ((ci < 8 ? 7 : 79) - ci) : 32 * ci;
            const int t2 = launder(tid); const int lane = t2 & 63, lr = lane & 31, lh = lane >> 5, w = __builtin_amdgcn_readfirstlane(t2 >> 6), op = t2 >> 4, oc = t2 & 15;
            float l2c = l2g; asm volatile("" : "+v"(l2c));
            const int cb = (ci & 1) * SC_BUF, nb = SC_BUF - cb, sb = SC_S + (ci & 1) * 32 * SC_SROW;
            if (ci + 1 < 72) {
                const int cn = ci + 1; const int tn = dir ? 32 * ((cn < 8 ? 7 : 79) - cn) : 32 * cn;
#pragma unroll
                for (int i = 0; i < 2; ++i) { sq[i] = ldg<u32x4>(qbase + (size_t)(tn + 16 * i) * 1024 + qgo); sk[i] = ldg<u32x4>(ktbase + (size_t)tn * 1024 + i * 4096 + kgo); sv[i] = ldg<u32x4>(vtbase + (size_t)tn * 2048 + i * 4096 + kgo); }
            }
            const u32x4 gt0 = ldg<u32x4>(gbase + (size_t)tok0 * 4096), gt1 = ldg<u32x4>(gbase + (size_t)tok0 * 4096 + 8);
            if (w < 4) {
                const int p0 = 16 * (w >> 1), m0 = 16 * (w & 1);
                const int l15 = lane & 15, g4 = lane >> 4, tq = l15 >> 2, tp = l15 & 3;
                f32x4 sc = {0.f, 0.f, 0.f, 0.f};
                const bool dead = sgn * (p0 - m0) < 0;
                if (!dead) {
#pragma unroll
                    for (int ks = 0; ks < 8; ++ks) {
                        const int prow = p0 + l15, qchunk = 4 * ks + g4;
                        const bf16x8 af = *(const LAS bf16x8*)(F.lds + cb + SC_Q + prow * SC_QROW + qchunk * 16);
                        const int d0 = 32 * ks + 8 * g4 + tq, cc = (m0 >> 3) + (tp >> 1);
                        const s16x4 b0 = __builtin_amdgcn_ds_read_tr16_b64_v4i16((LAS s16x4*)(F.lds + cb + SC_K + d0 * 64 + (((cc ^ (d0 >> 2)) & 3) << 4) + 8 * (tp & 1)));
                        const s16x4 b1 = __builtin_amdgcn_ds_read_tr16_b64_v4i16((LAS s16x4*)(F.lds + cb + SC_K + (d0 + 4) * 64 + (((cc ^ ((d0 + 4) >> 2)) & 3) << 4) + 8 * (tp & 1)));
                        const bf16x8 bfr = __builtin_shufflevector(b0, b1, 0, 1, 2, 3, 4, 5, 6, 7);
                        sc = __builtin_amdgcn_mfma_f32_16x16x32_bf16(af, bfr, sc, 0, 0, 0);
                    }
                }
                const int mm = m0 + l15;
#pragma unroll
                for (int r = 0; r < 4; ++r) { const int pp = p0 + 4 * g4 + r; const int df = sgn * (pp - mm);
                    const float v = df >= 0 ? sc[r] * __builtin_amdgcn_exp2f((float)df * l2c) : 0.f;
                    *(LAS bf16_t*)(F.lds + sb + pp * SC_SROW + mm * 2) = (bf16_t)(pk_bf16(v, 0.f) & 0xffffu); }
            }
            __syncthreads();
            bf16x8 vf[2], vd[2];
            {
                const int e = 32 * w + lr;
#pragma unroll
                for (int ks = 0; ks < 2; ++ks) {
                    const int cc = 2 * ks + lh;
                    vf[ks] = *(const LAS bf16x8*)(F.lds + cb + SC_V + e * 64 + (((cc ^ (e >> 2)) & 3) << 4));
                    const u32x4 raw = __builtin_bit_cast(u32x4, vf[ks]); u32x4 o;
                    const f32x4 kda = *(const LAS f32x4*)(F.lds + SC_RED + (16 * ks + 8 * lh) * 4), kdb = *(const LAS f32x4*)(F.lds + SC_RED + (16 * ks + 8 * lh + 4) * 4);
                    const float kd8[8] = {kda[0], kda[1], kda[2], kda[3], kdb[0], kdb[1], kdb[2], kdb[3]};
                    o.x = pk_bf16(bf_lo(raw.x) * kd8[0], bf_hi(raw.x) * kd8[1]); o.y = pk_bf16(bf_lo(raw.y) * kd8[2], bf_hi(raw.y) * kd8[3]);
                    o.z = pk_bf16(bf_lo(raw.z) * kd8[4], bf_hi(raw.z) * kd8[5]); o.w = pk_bf16(bf_lo(raw.w) * kd8[6], bf_hi(raw.w) * kd8[7]);
                    vd[ks] = __builtin_bit_cast(bf16x8, o);
                }
            }
            f32x16 Y;
#pragma unroll
            for (int i = 0; i < 16; ++i) Y[i] = 0.f;
#pragma unroll
            for (int dt = 0; dt < 8; ++dt)
#pragma unroll
                for (int s = 0; s < 2; ++s) {
                    u32x4 pb; pb.x = pk_bf16(S[dt][8 * s], S[dt][8 * s + 1]); pb.y = pk_bf16(S[dt][8 * s + 2], S[dt][8 * s + 3]); pb.z = pk_bf16(S[dt][8 * s + 4], S[dt][8 * s + 5]); pb.w = pk_bf16(S[dt][8 * s + 6], S[dt][8 * s + 7]);
                    const int c0 = 4 * dt + 2 * s;
                    const s16x4 a0 = *(const LAS s16x4*)(F.lds + cb + SC_Q + lr * SC_QROW + c0 * 16 + 8 * lh);
                    const s16x4 a1 = *(const LAS s16x4*)(F.lds + cb + SC_Q + lr * SC_QROW + c0 * 16 + 16 + 8 * lh);
                    const bf16x8 af = __builtin_shufflevector(a0, a1, 0, 1, 2, 3, 4, 5, 6, 7);
                    Y = __builtin_amdgcn_mfma_f32_32x32x16_bf16(af, __builtin_bit_cast(bf16x8, pb), Y, 0, 0, 0);
                }
#pragma unroll
            for (int g = 0; g < 4; ++g) { const f32x4 qd = *(const LAS f32x4*)(F.lds + SC_RED + 128 + (8 * g + 4 * lh) * 4); Y[4 * g] *= qd[0]; Y[4 * g + 1] *= qd[1]; Y[4 * g + 2] *= qd[2]; Y[4 * g + 3] *= qd[3]; }
#pragma unroll
            for (int ks = 0; ks < 2; ++ks) {
                const bf16x8 sf = *(const LAS bf16x8*)(F.lds + sb + lr * SC_SROW + (16 * ks + 8 * lh) * 2);
                Y = __builtin_amdgcn_mfma_f32_32x32x16_bf16(sf, vf[ks], Y, 0, 0, 0);
            }
#pragma unroll
            for (int dt = 0; dt < 8; ++dt) {
#pragma unroll
                for (int i = 0; i < 16; ++i) S[dt][i] *= g32;
#pragma unroll
                for (int ks = 0; ks < 2; ++ks) {
                    const int d = 32 * dt + lr, cc = 2 * ks + lh;
                    const bf16x8 kf = *(const LAS bf16x8*)(F.lds + cb + SC_K + d * 64 + (((cc ^ (d >> 2)) & 3) << 4));
                    S[dt] = __builtin_amdgcn_mfma_f32_32x32x16_bf16(kf, vd[ks], S[dt], 0, 0, 0);
                }
            }
#pragma unroll
            for (int r = 0; r < 16; ++r) *(LAS bf16_t*)(F.lds + SC_Y + ((r & 3) + 8 * (r >> 2) + 4 * lh) * SC_YROW + (w * 32 + lr) * 2) = (bf16_t)(pk_bf16(Y[r], 0.f) & 0xffffu);
            if (ci + 1 < 72) {
                *(LAS u32x4*)(F.lds + nb + ql0) = sq[0]; *(LAS u32x4*)(F.lds + nb + ql1) = sq[1];
#pragma unroll
                for (int i = 0; i < 2; ++i) { *(LAS u32x4*)(F.lds + nb + SC_K + kl + i * 8192) = sk[i]; *(LAS u32x4*)(F.lds + nb + SC_V + kl + i * 8192) = sv[i]; }
            }
            __syncthreads();
            {
                const u32x4 y0 = *(const LAS u32x4*)(F.lds + SC_Y + op * SC_YROW + oc * 32), y1 = *(const LAS u32x4*)(F.lds + SC_Y + op * SC_YROW + oc * 32 + 16);
                u32x4 z0, z1;
                z0.x = pk_bf16(bf_lo(y0.x) * bf_lo(gt0.x), bf_hi(y0.x) * bf_hi(gt0.x)); z0.y = pk_bf16(bf_lo(y0.y) * bf_lo(gt0.y), bf_hi(y0.y) * bf_hi(gt0.y));
                z0.z = pk_bf16(bf_lo(y0.z) * bf_lo(gt0.z), bf_hi(y0.z) * bf_hi(gt0.z)); z0.w = pk_bf16(bf_lo(y0.w) * bf_lo(gt0.w), bf_hi(y0.w) * bf_hi(gt0.w));
                z1.x = pk_bf16(bf_lo(y1.x) * bf_lo(gt1.x), bf_hi(y1.x) * bf_hi(gt1.x)); z1.y = pk_bf16(bf_lo(y1.y) * bf_lo(gt1.y), bf_hi(y1.y) * bf_hi(gt1.y));
                z1.z = pk_bf16(bf_lo(y1.z) * bf_lo(gt1.z), bf_hi(y1.z) * bf_hi(gt1.z)); z1.w = pk_bf16(bf_lo(y1.w) * bf_lo(gt1.w), bf_hi(y1.w) * bf_hi(gt1.w));
                stg<u32x4>(gbase + (size_t)tok0 * 4096, z0); stg<u32x4>(gbase + (size_t)tok0 * 4096 + 8, z1);
                float q = (bf_lo(y0.x) * bf_lo(y0.x) + bf_hi(y0.x) * bf_hi(y0.x)) + (bf_lo(y0.y) * bf_lo(y0.y) + bf_hi(y0.y) * bf_hi(y0.y)) + (bf_lo(y0.z) * bf_lo(y0.z) + bf_hi(y0.z) * bf_hi(y0.z)) + (bf_lo(y0.w) * bf_lo(y0.w) + bf_hi(y0.w) * bf_hi(y0.w))
                        + (bf_lo(y1.x) * bf_lo(y1.x) + bf_hi(y1.x) * bf_hi(y1.x)) + (bf_lo(y1.y) * bf_lo(y1.y) + bf_hi(y1.y) * bf_hi(y1.y)) + (bf_lo(y1.z) * bf_lo(y1.z) + bf_hi(y1.z) * bf_hi(y1.z)) + (bf_lo(y1.w) * bf_lo(y1.w) + bf_hi(y1.w) * bf_hi(y1.w));
                q += DPPF(q, 0xB1, 0xf); q += DPPF(q, 0x4E, 0xf); q += DPPF(q, 0x141, 0xf); q += DPPF(q, 0x140, 0xf);
                if (oc == 0) stg<float>(ssqb + (((size_t)eh * 2 + dir) * HROWS + rb + tok0 + op) * 4 + h, q);
            }
        }
    }
    __syncthreads();
}

DI void comb_phase(const Frame& F, int hf, bool latonly) {
    const bf16_t* PJ = (const bf16_t*)(F.ws + WS_PROJ + PJ_RG);
    const float* ssqb = (const float*)(F.ws + WS_MISC + MS_SSQ);
    bf16_t* O = (bf16_t*)(F.ws + (hf == 0 ? WS_OBUF : WS_ABUF));
    const int rpw = (36864 + F.G * 8 - 1) / (F.G * 8), rbeg = (F.bid * 8 + F.wave) * rpw;
    for (int r0 = rbeg; r0 < rbeg + rpw && r0 < 36864; r0 += 2) {
        u32x4 zf[2][4], zb[2][4]; float sf[2][4], sb[2][4]; bool on[2];
#pragma unroll
        for (int q = 0; q < 2; ++q) { const int r = r0 + q; on[q] = (r < rbeg + rpw) && (r < 36864) && !(latonly && (r % NTOK) < CTXL);
            if (on[q]) {
#pragma unroll
                for (int i = 0; i < 4; ++i) { const int c = i * 512 + F.lane * 8;
                    zf[q][i] = ldg<u32x4>(PJ + (size_t)r * 4096 + c); zb[q][i] = ldg<u32x4>(PJ + (size_t)r * 4096 + 2048 + c);
                    sf[q][i] = ldg<float>(ssqb + ((size_t)(0 * 2 + 0) * 36864 + r) * 4 + i) + ldg<float>(ssqb + ((size_t)(1 * 2 + 0) * 36864 + r) * 4 + i);
                    sb[q][i] = ldg<float>(ssqb + ((size_t)(0 * 2 + 1) * 36864 + r) * 4 + i) + ldg<float>(ssqb + ((size_t)(1 * 2 + 1) * 36864 + r) * 4 + i); } } }
#pragma unroll
        for (int q = 0; q < 2; ++q) if (on[q]) { const int r = r0 + q;
#pragma unroll
            for (int i = 0; i < 4; ++i) {
                const float rf = __builtin_amdgcn_rsqf(sf[q][i] * (1.0f / 512.0f) + RMS_EPS), rb = __builtin_amdgcn_rsqf(sb[q][i] * (1.0f / 512.0f) + RMS_EPS);
                const u32x4 a = zf[q][i], b = zb[q][i]; u32x4 w;
                w.x = pk_bf16(rf * bf_lo(a.x) + rb * bf_lo(b.x), rf * bf_hi(a.x) + rb * bf_hi(b.x));
                w.y = pk_bf16(rf * bf_lo(a.y) + rb * bf_lo(b.y), rf * bf_hi(a.y) + rb * bf_hi(b.y));
                w.z = pk_bf16(rf * bf_lo(a.z) + rb * bf_lo(b.z), rf * bf_hi(a.z) + rb * bf_hi(b.z));
                w.w = pk_bf16(rf * bf_lo(a.w) + rb * bf_lo(b.w), rf * bf_hi(a.w) + rb * bf_hi(b.w));
                stg<u32x4>(O + (size_t)r * 2048 + i * 512 + F.lane * 8, w);
            } }
    }
}

DI void final_phase(const Frame& F) {
    const bf16_t* y2 = (const bf16_t*)(F.ws + WS_PROJ + PJ_Y2);
    const int rpw = (T + F.G * 8 - 1) / (F.G * 8), rbeg = (F.bid * 8 + F.wave) * rpw;
    int mkey = -1; f32x4 g2v[4];
#pragma unroll
    for (int i = 0; i < 4; ++i) g2v[i] = (f32x4){0.f, 0.f, 0.f, 0.f};
    for (int r = rbeg; r < rbeg + rpw && r < T; ++r) {
        const int b = r / NTOK, n = r % NTOK; if (n < CTXL) continue;
        float* hp = F.out + ((size_t)b * 2048 + (n - 256)) * 1024;
        if (b != mkey) { mkey = b; const float* modp = mod_lat(F, 3, b);
#pragma unroll
            for (int i = 0; i < 4; ++i) g2v[i] = ldg<f32x4>(modp + 5120 + i * 256 + F.lane * 4); }
        const bf16_t* hrow = (const bf16_t*)(F.ws + WS_HB) + (size_t)r * 1024;
#pragma unroll
        for (int i = 0; i < 4; ++i) {
            const u32x2 hw = ldg<u32x2>(hrow + i * 256 + F.lane * 4); f32x4 x = {bf_lo(hw.x), bf_hi(hw.x), bf_lo(hw.y), bf_hi(hw.y)};
            const u32x2 a = ldg<u32x2>(y2 + (size_t)(2 * r) * 1024 + i * 256 + F.lane * 4), c = ldg<u32x2>(y2 + (size_t)(2 * r + 1) * 1024 + i * 256 + F.lane * 4);
            const f32x4 g2 = g2v[i];
            x[0] += g2[0] * (bf_lo(a.x) + bf_lo(c.x)); x[1] += g2[1] * (bf_hi(a.x) + bf_hi(c.x)); x[2] += g2[2] * (bf_lo(a.y) + bf_lo(c.y)); x[3] += g2[3] * (bf_hi(a.y) + bf_hi(c.y));
            stg<f32x4>(hp + i * 256 + F.lane * 4, x);
        }
    }
}

#ifndef STAGGER_TICKS
#define STAGGER_TICKS 0
#endif
constexpr int NPHASE = 50;
__global__ void __launch_bounds__(512, 2) fwd_kernel(Args args) {
    extern __shared__ __attribute__((aligned(16))) unsigned char lds_raw[];
    Frame F;
    F.a = &args;
    F.out = args.out; F.ws = args.ws; F.lds = (LAS unsigned char*)lds_raw;
    F.tid = threadIdx.x; F.lane = F.tid & 63; F.wave = __builtin_amdgcn_readfirstlane(F.tid >> 6); F.G = gridDim.x;
    const int lo = args.ph_lo, hi = args.ph_hi;
    const int wave_s = __builtin_amdgcn_readfirstlane((int)threadIdx.x >> 6);
    volatile LAS unsigned* bst = (volatile LAS unsigned*)(F.lds + LDS_MISC);
    if (F.tid < 4) bst[F.tid] = 0u;
    __syncthreads();
    XcdBarrier bar; bar.bar = (unsigned*)(F.ws + WS_CTL) + CW_BAR; bar.x = 0; bar.st = bst;
    if (hi - lo > 1) bar = xcd_barrier_post((unsigned*)(F.ws + WS_CTL) + CW_BAR, bst);
#ifndef PH_MASK
#define PH_MASK 0xFFFFFFFFu
#endif
#define PHASE(site, p, ...) do { if (((PH_MASK >> (site)) & 1u) && lo <= (p) && (p) < hi) { F.ws = launder_p(args.ws); F.out = (float*)launder_p((unsigned char*)args.out); { int ws_ = wave_s, bi_ = (int)blockIdx.x; asm volatile("" : "+s"(ws_), "+s"(bi_)); F.wave = ws_; F.bid = bi_; } F.lane = lane_id_asm(); F.tid = (F.wave << 6) | F.lane; __VA_ARGS__; if ((p) + 1 < hi) xcd_barrier(bar, (wave_s << 6) | lane_id_asm()); } } while (0)

    PHASE(0, 0, p0_prologue(F));
    for (int layer = 0; layer < DEPTH; ++layer) {
        const int pb = 1 + 12 * layer, j = layer >> 1; const bool isRT = layer & 1;
        PHASE(1, pb + 0, { norm_phase<false>(F, layer); if (layer > 0) convert_moe_weights(F, layer, moe_split_lo(F, layer), MOE_NT, F.bid, F.G); });
        if (!isRT) {
            PHASE(2, pb + 1, {
                ProbQKV S; S.K = 1024; S.abuf = (const char*)(F.ws + WS_ABUF); S.wqk = (const char*)(F.ws + WS_WQK) + (size_t)j * 2048 * 1024 * 2; S.wv = (const char*)(F.ws + WS_WV) + (size_t)j * 1024 * 1024 * 2;
                S.go.init(NTILE, 8); S.G = F.G; S.c = F.bid; S.stagger = STAGGER_TICKS; S.noepi = args.flags & 1;
                EpiQKV E{(bf16_t*)(F.ws + WS_PROJ + PJ_Q), (bf16_t*)(F.ws + WS_PROJ + PJ_K), (bf16_t*)(F.ws + WS_PROJ + PJ_VT), F.a->in[9] + j * 64, F.a->in[10] + j * 64,
                         (const float*)(F.ws + WS_ROPE + RP_CDA), (const float*)(F.ws + WS_ROPE + RP_SDA)};
                pg8::gemm_phase<EpiQKV, ProbQKV, true>(F.lds, S, E, F.tid, F.wave);
                if (F.G == 256 && F.bid >= 128) convert_moe_weights(F, layer, MOE_T_WO, MOE_T_WO + MOE_T_QKV, F.bid - 128, 128);
            });
            PHASE(3, pb + 2, attn_phase(F, layer));
        } else {
            for (int hf = 0; hf < 2; ++hf) {
                PHASE(4, pb + 1 + 3 * hf, {
                    ProbWIN S; S.K = 1024; S.abuf = (const char*)(F.ws + WS_ABUF) + (size_t)hf * 144 * 256 * 1024 * 2; S.win = (const char*)(F.ws + WS_WIN) + (size_t)j * 8192 * 1024 * 2;
                    S.latonly = (layer == DEPTH - 1); S.nnat = S.latonly ? 128 * 20 : 144 * 20; S.go.init(S.latonly ? 128 : 144, 20); S.G = F.G; S.c = F.bid; S.stagger = STAGGER_TICKS; S.noepi = args.flags & 1;
                    EpiWIN E{(bf16_t*)(F.ws + WS_PROJ + PJ_RQ), (bf16_t*)(F.ws + WS_PROJ + PJ_RG), (bf16_t*)(F.ws + WS_PROJ + PJ_RKT), (bf16_t*)(F.ws + WS_PROJ + PJ_RVT), hf * 144,
                             (const float*)(F.ws + WS_ROPE + RP_CRT), (const float*)(F.ws + WS_ROPE + RP_SRT), (const float*)(F.ws + WS_MISC + MS_CRTT), (const float*)(F.ws + WS_MISC + MS_SRTT)};
                    pg8::gemm_phase<EpiWIN, ProbWIN, true>(F.lds, S, E, F.tid, F.wave);
                });
                PHASE(5, pb + 2 + 3 * hf, scan_phase(F, layer, hf));
                PHASE(6, pb + 3 + 3 * hf, comb_phase(F, hf, layer == DEPTH - 1));
            }
        }
        PHASE(7, pb + 7, {
            ProbDense S; S.G = F.G; S.c = F.bid; S.stagger = STAGGER_TICKS; S.noepi = args.flags & 1; S.latonly = (layer == DEPTH - 1); S.go.init(S.latonly ? NB * 8 : NTILE, 4);
            if (!isRT) { S.K = 1024; S.A0 = (const char*)(F.ws + WS_OBUF); S.A1 = S.A0; S.pm_split = 1 << 30; S.Bt = (const char*)(F.ws + WS_WODA) + (size_t)j * 1024 * 1024 * 2; }
            else { S.K = 2048; S.A0 = (const char*)(F.ws + WS_OBUF); S.A1 = (const char*)(F.ws + WS_ABUF); S.pm_split = 144; S.Bt = (const char*)(F.ws + WS_WORT) + (size_t)j * 1024 * 2048 * 2; }
            EpiResid E{F.a->in[2], F.a->in[0], (bf16_t*)(F.ws + WS_HB), (const float*)(F.ws + WS_ADA) + (size_t)layer * 33 * 6144, layer == 0 ? 1 : 0};
            pg8::gemm_phase<EpiResid, ProbDense, true>(F.lds, S, E, F.tid, F.wave);
            if (F.G == 256 && F.bid >= 128 && layer != DEPTH - 1) convert_moe_weights(F, layer, 0, MOE_T_WO, F.bid - 128, 128);
        });
        PHASE(8, pb + 8, norm_phase<true>(F, layer));
        PHASE(9, pb + 9, sort_phase(F, layer));
        PHASE(10, pb + 10, {
            LAS int* segs = (LAS int*)(F.lds + LDS_MISC + 2048); LAS int* tile_e = (LAS int*)(F.lds + LDS_TILE_E);
            const int ntl = build_segments(F, layer, segs, tile_e);
            ProbMoE<true> S; S.K = 1024; S.A = (const char*)(F.ws + WS_ABUF); S.W = (const char*)(F.ws + WS_WGU); S.tile_e = tile_e; S.go.init(ntl, 4); S.G = F.G; S.c = F.bid; S.stagger = STAGGER_TICKS; S.noepi = args.flags & 1;
            LAS int* rowtok = (LAS int*)(F.lds + LDS_TILE_E + 4096); S.rowtok = rowtok;
            { const int* rowmap = (const int*)(F.ws + WS_MISC + MS_WSORT); Unit uu;
              int dd[11];
              _Pragma("unroll") for (int i = 0; i < 11; ++i) { dd[i] = 0; if (S.next(i, uu) && F.tid < 256) dd[i] = ldg<int>(rowmap + 2 * (uu.pm * 256 + F.tid)); }
              _Pragma("unroll") for (int i = 0; i < 11; ++i) { if (F.tid < 256) rowtok[i * 256 + F.tid] = dd[i] >= 0 ? (dd[i] >> 1) : 0; }
              __syncthreads(); }
            EpiSwiGLU E{(bf16_t*)(F.ws + WS_PROJ + PJ_ACT)};
            pg8::gemm_phase<EpiSwiGLU, ProbMoE<true>, true>(F.lds, S, E, F.tid, F.wave);
        });
        PHASE(11, pb + 11, {
            LAS int* segs = (LAS int*)(F.lds + LDS_MISC + 2048); LAS int* tile_e = (LAS int*)(F.lds + LDS_TILE_E);
            const int ntl = build_segments(F, layer, segs, tile_e);
            ProbMoE<false> S; S.K = 512; S.A = (const char*)(F.ws + WS_PROJ + PJ_ACT); S.W = (const char*)(F.ws + WS_WD); S.tile_e = tile_e; S.rowtok = tile_e; S.go.init(ntl, 4); S.G = F.G; S.c = F.bid; S.stagger = STAGGER_TICKS; S.noepi = args.flags & 1;
            EpiDown E{(bf16_t*)(F.ws + WS_PROJ + PJ_Y2), (const int*)(F.ws + WS_MISC + MS_WSORT), nullptr};
            pg8::gemm_phase<EpiDown, ProbMoE<false>, true>(F.lds, S, E, F.tid, F.wave);
        });
    }
    PHASE(12, 49, final_phase(F));
#ifdef PROBE_BARRIERS
    for (int i = 0; i < PROBE_BARRIERS; ++i) xcd_barrier(bar, (wave_s << 6) | lane_id_asm());
#endif
#undef PHASE
}

static bool phase_exists(int p) {
    if (p == 0 || p == 49) return true;
    const int layer = (p - 1) / 12, slot = (p - 1) % 12; const bool isRT = layer & 1;
    if (!isRT && slot >= 3 && slot <= 6) return false;
    return true;
}
extern "C" void kernel_launch(void* const* d_in, const int* in_sizes, int n_in, void* d_out, int out_size, void* d_ws, size_t ws_size, hipStream_t stream) {
    static int grid = 0;
    if (grid == 0) {
        if (n_in != 24 || ws_size < WS_END) { fprintf(stderr, "kernel_launch: need 24 inputs and >= %zu bytes of workspace (got %d, %zu)\n", (size_t)WS_END, n_in, ws_size); grid = -1; return; }
        int dev = 0, cus = 0, per_cu = 0;
        if (hipGetDevice(&dev) != hipSuccess || hipDeviceGetAttribute(&cus, hipDeviceAttributeMultiprocessorCount, dev) != hipSuccess) { grid = -1; return; }
        if (hipFuncSetAttribute((const void*)fwd_kernel, hipFuncAttributeMaxDynamicSharedMemorySize, LDS_BYTES) != hipSuccess) { fprintf(stderr, "kernel_launch: hipFuncSetAttribute failed\n"); grid = -1; return; }
        if (hipOccupancyMaxActiveBlocksPerMultiprocessor(&per_cu, (const void*)fwd_kernel, 512, LDS_BYTES) != hipSuccess || per_cu < 1) fprintf(stderr, "kernel_launch: occupancy query reports %d\n", per_cu);
        (void)hipGetLastError();
        grid = cus;
    }
    if (grid < 0) return;
    (void)hipMemsetAsync((char*)d_ws + WS_CTL, 0, 1 * MiB, stream);
    Args a{};
    for (int i = 0; i < 24; ++i) a.in[i] = (const float*)d_in[i];
    a.out = (float*)d_out; a.ws = (unsigned char*)d_ws;
#ifdef MULTI_LAUNCH
    for (int p = 0; p < NPHASE; ++p) { if (!phase_exists(p)) continue; a.ph_lo = p; a.ph_hi = p + 1; hipLaunchKernelGGL(fwd_kernel, dim3(grid), dim3(512), LDS_BYTES, stream, a); }
#elif defined(PROBE_DUP_LO)
    a.ph_lo = 0; a.ph_hi = PROBE_DUP_HI; hipLaunchKernelGGL(fwd_kernel, dim3(grid), dim3(512), LDS_BYTES, stream, a);
#ifdef PROBE_NOEPI
    a.flags = 1;
#endif
    for (int p = PROBE_DUP_LO; p < PROBE_DUP_HI; ++p) { if (!phase_exists(p)) continue; a.ph_lo = p; a.ph_hi = p + 1; hipLaunchKernelGGL(fwd_kernel, dim3(grid), dim3(512), LDS_BYTES, stream, a); }
    a.flags = 0;
    (void)hipMemsetAsync((char*)d_ws + WS_CTL, 0, 16384, stream);
    a.ph_lo = PROBE_DUP_HI; a.ph_hi = NPHASE; hipLaunchKernelGGL(fwd_kernel, dim3(grid), dim3(512), LDS_BYTES, stream, a);
#else
    a.ph_lo = 0; a.ph_hi = NPHASE; hipLaunchKernelGGL(fwd_kernel, dim3(grid), dim3(512), LDS_BYTES, stream, a);
#endif
}
```

```cpp
#include <hip/hip_runtime.h>
#include <cstdio>
#include <cstdint>

#define LAS __attribute__((address_space(3)))
constexpr float LOG2E = 1.4426950408889634f;
#define DI __device__ __forceinline__
typedef unsigned short bf16_t;
typedef short bf16x8 __attribute__((ext_vector_type(8)));
typedef short s16x4 __attribute__((ext_vector_type(4)));
typedef float f32x4 __attribute__((ext_vector_type(4)));
typedef float f32x2 __attribute__((ext_vector_type(2)));
typedef float f32x16 __attribute__((ext_vector_type(16)));
typedef unsigned u32x4 __attribute__((ext_vector_type(4)));
typedef unsigned u32x2 __attribute__((ext_vector_type(2)));
typedef __bf16 bf16x2_t __attribute__((ext_vector_type(2)));

#define GAS __attribute__((address_space(1)))
template <class V, class T> DI V ldg(const T* p) { return *(const GAS V*)(unsigned long long)p; }
template <class V, class T> DI void stg(T* p, V v) { *(GAS V*)(unsigned long long)p = v; }
DI unsigned pk_bf16(float lo, float hi) { f32x2 v = {lo, hi}; return __builtin_bit_cast(unsigned, __builtin_convertvector(v, bf16x2_t)); }
DI float bf_lo(unsigned u) { return __uint_as_float(u << 16); }
DI float bf_hi(unsigned u) { return __uint_as_float(u & 0xffff0000u); }
DI float bf_f(bf16_t v) { return __uint_as_float(((unsigned)v) << 16); }
DI unsigned char* launder_p(unsigned char* p) { asm volatile("" : "+s"(p)); return p; }
DI float shx(float v, int o, int lane) { return __builtin_bit_cast(float, __builtin_amdgcn_ds_bpermute((lane ^ o) << 2, __builtin_bit_cast(int, v))); }
#define DPPF(v, ctrl, row_mask) __builtin_bit_cast(float, __builtin_amdgcn_update_dpp(0, __builtin_bit_cast(int, (v)), (ctrl), (row_mask), 0xf, false))
DI float wave_sum(float v, int lane) {
    (void)lane;
    v += DPPF(v, 0xB1, 0xf);
    v += DPPF(v, 0x4E, 0xf);
    v += DPPF(v, 0x141, 0xf);
    v += DPPF(v, 0x140, 0xf);
    v += DPPF(v, 0x142, 0xa);
    v += DPPF(v, 0x143, 0xc);
    return __builtin_bit_cast(float, __builtin_amdgcn_readlane(__builtin_bit_cast(int, v), 63));
}
DI int lane_id_asm() { int x; asm volatile("v_mbcnt_lo_u32_b32 %0, -1, 0\n\tv_mbcnt_hi_u32_b32 %0, -1, %0" : "=v"(x)); return x; }
DI int launder(int x) { asm volatile("" : "+v"(x)); return x; }
DI float uni_f(float x) { return __builtin_bit_cast(float, __builtin_amdgcn_readfirstlane(__builtin_bit_cast(int, x))); }
DI float silu_f(float x) { return x * __builtin_amdgcn_rcpf(1.0f + __builtin_amdgcn_exp2f(-LOG2E * x)); }

constexpr int NB = 32, SEQ = 2048, CTXL = 256, NTOK = SEQ + CTXL, DM = 1024, DEPTH = 4;
constexpr int T = NB * NTOK;
constexpr int NTILE = T / 256;
constexpr int NEXP = 32, MOEH = 512;
constexpr int MAXROWS = 2 * T + NEXP * 256;
constexpr float RMS_EPS = 1e-6f;

constexpr size_t MiB = 1ull << 20;
constexpr size_t WS_CTL = 0;
constexpr size_t WS_ADA = 1 * MiB;
constexpr size_t WS_ROPE = 5 * MiB;
constexpr size_t WS_MISC = 8 * MiB;
constexpr size_t WS_HCTX = 16 * MiB;
constexpr size_t WS_WQK = 48 * MiB;
constexpr size_t WS_WV = 56 * MiB;
constexpr size_t WS_WODA = 60 * MiB;
constexpr size_t WS_WIN = 64 * MiB;
constexpr size_t WS_WORT = 96 * MiB;
constexpr size_t WS_WGU = 104 * MiB;
constexpr size_t WS_WD = 168 * MiB;
constexpr size_t WS_ABUF = 200 * MiB;
constexpr size_t WS_OBUF = 344 * MiB;
constexpr size_t WS_PROJ = 488 * MiB;
constexpr size_t WS_HB = 1064 * MiB;
constexpr size_t WS_END = 1208 * MiB;
constexpr size_t PJ_Q = 0, PJ_K = 144 * MiB, PJ_VT = 288 * MiB;
constexpr size_t PJ_SA = 0, PJ_ACT = 304 * MiB, PJ_Y2 = 0;
constexpr size_t PJ_RQ = 0, PJ_RG = 72 * MiB, PJ_RKT = 360 * MiB, PJ_RVT = 432 * MiB;
constexpr int HROWS = 36864;
constexpr size_t RP_CDA = 0, RP_SDA = 256 * 1024, RP_CRT = 512 * 1024, RP_SRT = 512 * 1024 + 1 * MiB;
constexpr size_t MS_EID = 0, MS_WSEL = 1 * MiB, MS_ROWMAP = 2 * MiB, MS_SSQ = 3 * MiB, MS_WSORT = 6 * MiB, MS_CRTT = 6 * MiB, MS_SRTT = 7 * MiB;
constexpr int CW_BAR = 0;
constexpr int CW_CNT = 4096;
constexpr int CW_CUR = 4096 + 256;

constexpr int LDS_BYTES = 155648;
constexpr int LDS_MISC = 152576;
constexpr int LDS_TILE_E = 131072;

#define XB_TMO      128
#define XB_XCNT(j)  (256  + 64 * (j))
#define XB_XSUB(j)  (1280 + 64 * (j))
#define XB_XGEN(j)  (2304 + 64 * (j))
#define XB_TOP      3328
#define XB_TOPGEN   3392
#define XCD_BAR_WORDS 3456
#define XB_SPIN_CAP (1u << 18)

__device__ __forceinline__ unsigned xb_ld(unsigned* p)              { return __hip_atomic_load(p, __ATOMIC_RELAXED, __HIP_MEMORY_SCOPE_AGENT); }
__device__ __forceinline__ unsigned xb_add(unsigned* p, unsigned v) { return __hip_atomic_fetch_add(p, v, __ATOMIC_RELAXED, __HIP_MEMORY_SCOPE_AGENT); }
__device__ __forceinline__ unsigned xb_xcc_id() { return (unsigned)__builtin_amdgcn_s_getreg((3 << 11) | 20) & 0xFu; }
#define XB_SPIN(cond, bar) do { unsigned _sp = 0; while (cond) { __builtin_amdgcn_s_sleep(1); \
    if ((++_sp & 255u) == 0u) { if (xb_ld(&(bar)[XB_TMO])) break; if (_sp > XB_SPIN_CAP) { atomicAdd(&(bar)[XB_TMO], 1u); break; } } } } while (0)

struct XcdBarrier { unsigned* bar; unsigned x; volatile LAS unsigned* st; };

__device__ __forceinline__ XcdBarrier xcd_barrier_post(unsigned* bar, volatile LAS unsigned* st) {
    XcdBarrier b; b.bar = bar; b.x = xb_xcc_id(); b.st = st;
    if (threadIdx.x == 0) (void)xb_add(&bar[XB_XCNT(b.x)], 1u);
    return b;
}
__device__ __forceinline__ void xcd_barrier_complete(unsigned* bar, unsigned x, unsigned& nloc, unsigned& nx) {
    const unsigned G = gridDim.x * gridDim.y * gridDim.z;
    unsigned sum, cnt, mine, sp = 0u;
    for (;;) {
        sum = 0u; cnt = 0u; mine = 0u;
#pragma unroll
        for (unsigned j = 0; j < 16; ++j) { const unsigned c = xb_ld(&bar[XB_XCNT(j)]); sum += c; cnt += (c > 0u) ? 1u : 0u; mine = (j == x) ? c : mine; }
        if (sum == G) break;
        __builtin_amdgcn_s_sleep(1);
        if ((++sp & 255u) == 0u) { if (xb_ld(&bar[XB_TMO])) break; if (sp > XB_SPIN_CAP) { atomicAdd(&bar[XB_TMO], 1u); break; } }
    }
    nloc = mine > 0u ? mine : 1u; nx = cnt > 0u ? cnt : 1u;
}
__device__ __forceinline__ void xcd_barrier(const XcdBarrier& b, const int tid0) {
    asm volatile("s_waitcnt vmcnt(0)" ::: "memory");
    __syncthreads();
    if (tid0 == 0) {
        unsigned* bar = (unsigned*)launder_p((unsigned char*)b.bar);
        __builtin_amdgcn_s_waitcnt(0);
        unsigned nloc = b.st[0], nx = b.st[1];
        if (nloc == 0u) { xcd_barrier_complete(bar, b.x, nloc, nx); b.st[0] = nloc; b.st[1] = nx; }
        const unsigned old = xb_add(&bar[XB_XSUB(b.x)], 1u);
        const unsigned gen = old / nloc;
        if (old + 1u == (gen + 1u) * nloc) {
            __builtin_amdgcn_fence(__ATOMIC_RELEASE, "agent");
            asm volatile("s_waitcnt vmcnt(0)" ::: "memory");
            const unsigned og = xb_add(&bar[XB_TOP], 1u);
            const unsigned tg = og / nx;
            if (og + 1u == (tg + 1u) * nx) xb_add(&bar[XB_TOPGEN], 1u);
            else XB_SPIN(xb_ld(&bar[XB_TOPGEN]) == tg, bar);
            __builtin_amdgcn_fence(__ATOMIC_ACQUIRE, "agent");
            xb_add(&bar[XB_XGEN(b.x)], 1u);
            asm volatile("s_waitcnt vmcnt(0)" ::: "memory");
        } else {
            XB_SPIN(xb_ld(&bar[XB_XGEN(b.x)]) == gen, bar);
            __builtin_amdgcn_fence(__ATOMIC_ACQUIRE, "agent");
            asm volatile("s_waitcnt vmcnt(0)" ::: "memory");
        }
    }
    __syncthreads();
}

struct Args { const float* in[24]; float* out; unsigned char* ws; int ph_lo, ph_hi, flags, pad; };
struct Frame {
    const Args* a; float* out; unsigned char* ws; LAS unsigned char* lds;
    int tid, lane, wave, G, bid;
};
DI const float* mod_lat(const Frame& F, int layer, int b) { return (const float*)(F.ws + WS_ADA) + ((size_t)layer * 33 + b) * 6144; }
DI const float* mod_ctx(const Frame& F, int layer) { return (const float*)(F.ws + WS_ADA) + ((size_t)layer * 33 + 32) * 6144; }

namespace pg8 {
constexpr int BM = 256, BK = 64, HALF = 128, HTB = HALF * BK * 2, STAGE_BYTES = 8 * HTB, NXCD = 8, WGM = 8;
__host__ __device__ __forceinline__ int lds_byte(int r, int c) { const int st = (r >> 4) * 2 + (c >> 5), rr = r & 15, cc = c & 31, ob = rr * 64 + cc * 2; return st * 1024 + (ob ^ (((ob >> 9) & 1) << 5)); }
__host__ __device__ __forceinline__ void stage_rc(int b, int& R, int& C) { const int st = b / 1024, sb = b % 1024, swz = sb ^ (((sb >> 9) & 1) << 5); R = (st >> 1) * 16 + swz / 64; C = (st & 1) * 32 + (swz % 64) / 2; }
__host__ __device__ __forceinline__ int perm32(int rho) { const int n = rho >> 4, i = rho & 15; return 8 * (i >> 2) + 4 * n + (i & 3); }

struct Unit { int pm, pn, kind; };

struct GridOrder {
    int nM, nN, nwg;
    DI void init(int nM_, int nN_) { nM = nM_; nN = nN_; nwg = nM * nN; }
    DI bool map(long L, int& pm, int& pn) const {
        if (L >= nwg) return false;
        int wgid = (int)L; { const int q = nwg / NXCD, r = nwg % NXCD, xcd = wgid % NXCD, off = wgid / NXCD; wgid = (xcd < r ? xcd * (q + 1) : r * (q + 1) + (xcd - r) * q) + off; }
        const int nig = WGM * nN, gid = wgid / nig, fm = gid * WGM, gsz = (nM - fm) < WGM ? (nM - fm) : WGM;
        pm = fm + ((wgid % nig) % gsz); pn = (wgid % nig) / gsz; return true;
    }
};

template <class Epi, class P, bool ALIGN_EPI>
DI void gemm_phase(LAS unsigned char* lds, const P& S, const Epi& E, const int tid, const int wid) {
    const int lane = tid & 63, wr = wid >> 2, wc = wid & 3, fr = lane & 15, fq = lane >> 4;
    const int K = S.K, nt = K / BK;
    unsigned voffA[2], voffB[2];
#pragma unroll
    for (int i = 0; i < 2; ++i) { int R, C; stage_rc(tid * 16 + i * 8192, R, C); const int Rb = Epi::PERM ? ((R & ~31) + perm32(R & 31)) : R;
        voffA[i] = (unsigned)(R * K + C) * 2u; voffB[i] = (unsigned)(Rb * K + C) * 2u; }
    const size_t kstep = (size_t)(BK * 2);
    const size_t hstep = (size_t)HALF * K * 2;
    const unsigned ldsw = (unsigned)wid * 1024u;
    const int aoff = lds_byte(wr * 64 + fr, fq * 8), boff = lds_byte(wc * 32 + fr, fq * 8);
#define PG8_SA(b, h) (((b) * 2 + (h)) * HTB)
#define PG8_SB(b, h) ((4 + (b) * 2 + (h)) * HTB)
#define PG8_STAGE(bufoff, gbase, voff) do { _Pragma("unroll") for (int _i = 0; _i < 2; ++_i) \
        __builtin_amdgcn_global_load_lds((const unsigned*)((const char*)(gbase) + (voff)[_i]), (LAS unsigned*)(lds + (bufoff) + ldsw + _i * 8192), 16, 0, 0); } while (0)
#define PG8_LDA(dst, b, h) do { _Pragma("unroll") for (int m = 0; m < 4; ++m) _Pragma("unroll") for (int k = 0; k < 2; ++k) dst[m][k] = *(const LAS bf16x8*)(lds + PG8_SA(b, h) + aoff + m * 2048 + k * 1024); } while (0)
#define PG8_LDB(dst, b, h) do { _Pragma("unroll") for (int n = 0; n < 2; ++n) _Pragma("unroll") for (int k = 0; k < 2; ++k) dst[n][k] = *(const LAS bf16x8*)(lds + PG8_SB(b, h) + boff + n * 2048 + k * 1024); } while (0)
#define PG8_MMA(ai, bj, At, Bt) do { __builtin_amdgcn_s_setprio(1); _Pragma("unroll") for (int m = 0; m < 4; ++m) _Pragma("unroll") for (int n = 0; n < 2; ++n) _Pragma("unroll") for (int k = 0; k < 2; ++k) \
        acc[ai][bj][m][n] = __builtin_amdgcn_mfma_f32_16x16x32_bf16(Bt[n][k], At[m][k], acc[ai][bj][m][n], 0, 0, 0); __builtin_amdgcn_s_setprio(0); } while (0)
#define PG8_WAIT_V(n) asm volatile("s_waitcnt vmcnt(" #n ")" ::: "memory")
#define PG8_WAIT_L(n) asm volatile("s_waitcnt lgkmcnt(" #n ")" ::: "memory")
#define PG8_WAIT_VF asm volatile("s_waitcnt vmcnt(%0)" :: "n"(8 + Epi::EV) : "memory")
#define PG8_BAR __builtin_amdgcn_s_barrier()
#define PG8_SCHED __builtin_amdgcn_sched_barrier(0)
    Unit cur, nxt; int ui = 0;
    if (!S.next(0, cur)) return;
    if (S.stagger > 0) { const unsigned long long t0 = __builtin_amdgcn_s_memrealtime(); const unsigned long long dl = (unsigned long long)(((unsigned)S.c * 37u) & 15u) * (unsigned)S.stagger;
        while (__builtin_amdgcn_s_memrealtime() - t0 < dl) __builtin_amdgcn_s_sleep(8); }
    unsigned gaC[2][2], gaN[2][2]; int gR[2], gC[2];
    if constexpr (P::GATHER) {
#pragma unroll
        for (int i = 0; i < 2; ++i) { stage_rc(tid * 16 + i * 8192, gR[i], gC[i]); }
#pragma unroll
        for (int h = 0; h < 2; ++h)
#pragma unroll
            for (int i = 0; i < 2; ++i) { gaC[h][i] = (unsigned)(S.rowtok[0 * 256 + h * 128 + gR[i]] * K + gC[i]) * 2u; gaN[h][i] = gaC[h][i]; }
    }
#define PG8_STAGE_A(bufoff, h, usen, kofs, dense) do { if constexpr (P::GATHER) { const unsigned _v[2] = {(usen) ? gaN[h][0] : gaC[h][0], (usen) ? gaN[h][1] : gaC[h][1]}; PG8_STAGE(bufoff, S.A + (kofs), _v); } \
        else { PG8_STAGE(bufoff, dense, voffA); } } while (0)
    f32x4 acc[2][2][4][2];
#pragma unroll
    for (int a = 0; a < 2; ++a)
#pragma unroll
        for (int b = 0; b < 2; ++b)
#pragma unroll
            for (int m = 0; m < 4; ++m)
#pragma unroll
                for (int n = 0; n < 2; ++n) acc[a][b][m][n] = (f32x4){0.f, 0.f, 0.f, 0.f};
    bf16x8 At[4][2], B0[2][2], B1[2][2];
    typename Epi::Pre pre; E.pre_load(cur, wr, fr, pre);
    const char* cA = S.a_ptr(cur); const char* cB = S.b_ptr(cur);
    PG8_STAGE(PG8_SB(0, 0), cB, voffB); PG8_STAGE(PG8_SB(0, 1), cB + hstep, voffB); PG8_STAGE_A(PG8_SA(0, 0), 0, false, 0, cA); PG8_STAGE_A(PG8_SA(0, 1), 1, false, 0, cA + hstep);
    if (wr == 1) PG8_BAR;
    PG8_WAIT_V(2); PG8_BAR;
    PG8_STAGE(PG8_SB(1, 0), cB + kstep, voffB); PG8_STAGE_A(PG8_SA(1, 0), 0, false, kstep, cA + kstep); PG8_STAGE(PG8_SB(1, 1), cB + hstep + kstep, voffB);
    PG8_WAIT_V(6); PG8_BAR;
    for (;;) {
        const bool has_next = S.next(ui + 1, nxt);
        const char* nA = has_next ? S.a_ptr(nxt) : cA; const char* nB = has_next ? S.b_ptr(nxt) : cB;
        if constexpr (P::GATHER) { if (has_next) {
#pragma unroll
            for (int h = 0; h < 2; ++h)
#pragma unroll
                for (int i = 0; i < 2; ++i) gaN[h][i] = (unsigned)(S.rowtok[(ui + 1) * 256 + h * 128 + gR[i]] * K + gC[i]) * 2u; } }
#define PG8_PAIR(FRESH, t, last) do { \
            const size_t k1 = (size_t)((t) + 1) * kstep, k2 = (last) ? 0 : (size_t)((t) + 2) * kstep, k3 = k2 + kstep; \
            const char* a1 = cA + k1; \
            const char* a2 = ((last) ? nA : cA) + k2; const char* b2 = (last) ? nB : cB + (size_t)((t) + 2) * kstep; \
            const char* a3 = a2 + kstep; const char* b3 = b2 + kstep; \
            PG8_LDB(B0, 0, 0); PG8_LDB(B1, 0, 1); PG8_SCHED; PG8_LDA(At, 0, 0); if (!(FRESH)) PG8_STAGE_A(PG8_SA(1, 1), 1, false, k1, a1 + hstep); \
            if (FRESH) PG8_WAIT_VF; else PG8_WAIT_V(8); PG8_WAIT_L(0); PG8_BAR; PG8_MMA(0, 0, At, B0); PG8_MMA(0, 1, At, B1); PG8_BAR; PG8_SCHED; \
            PG8_LDA(At, 0, 1); PG8_STAGE(PG8_SB(0, 0), b2, voffB); PG8_STAGE(PG8_SB(0, 1), b2 + hstep, voffB); PG8_STAGE_A(PG8_SA(0, 0), 0, last, k2, a2); \
            if (FRESH) PG8_WAIT_VF; else PG8_WAIT_V(8); PG8_WAIT_L(0); PG8_BAR; PG8_MMA(1, 0, At, B0); PG8_MMA(1, 1, At, B1); PG8_BAR; PG8_SCHED; \
            PG8_LDB(B0, 1, 0); PG8_LDB(B1, 1, 1); PG8_SCHED; PG8_LDA(At, 1, 0); PG8_STAGE_A(PG8_SA(0, 1), 1, last, k2, a2 + hstep); \
            if (FRESH) PG8_WAIT_VF; else PG8_WAIT_V(8); PG8_WAIT_L(0); PG8_BAR; PG8_MMA(0, 0, At, B0); PG8_MMA(0, 1, At, B1); PG8_BAR; PG8_SCHED; \
            PG8_LDA(At, 1, 1); PG8_STAGE(PG8_SB(1, 0), b3, voffB); PG8_STAGE(PG8_SB(1, 1), b3 + hstep, voffB); PG8_STAGE_A(PG8_SA(1, 0), 0, last, k3, a3); \
            PG8_WAIT_V(8); PG8_WAIT_L(0); PG8_BAR; PG8_MMA(1, 0, At, B0); PG8_MMA(1, 1, At, B1); PG8_BAR; PG8_SCHED; } while (0)
        int t = 0;
        if (ui > 0 && !S.noepi) { PG8_PAIR(true, 0, false); t = 2; }
        for (; t < nt; t += 2) { const bool last = (t == nt - 2); PG8_PAIR(false, t, last); }
        PG8_STAGE_A(PG8_SA(1, 1), 1, true, kstep, nA + kstep + hstep); asm volatile("" ::: "memory"); PG8_SCHED;
#undef PG8_PAIR
        if constexpr (ALIGN_EPI) { if (wr == 0) PG8_BAR; }
        if (!S.noepi) { const int l2 = lane_id_asm(); E(acc, cur, wr, wc, l2 & 15, l2 >> 4, pre); }
        if (!has_next) break;
#pragma unroll
        for (int a = 0; a < 2; ++a)
#pragma unroll
            for (int b = 0; b < 2; ++b)
#pragma unroll
                for (int m = 0; m < 4; ++m)
#pragma unroll
                    for (int n = 0; n < 2; ++n) { acc[a][b][m][n] = (f32x4){0.f, 0.f, 0.f, 0.f}; asm volatile("" : "+v"(acc[a][b][m][n])); }
        cur = nxt; cA = nA; cB = nB; ++ui;
        E.pre_load(cur, wr, fr, pre);
        if constexpr (P::GATHER) {
#pragma unroll
            for (int h = 0; h < 2; ++h)
#pragma unroll
                for (int i = 0; i < 2; ++i) gaC[h][i] = gaN[h][i]; }
        if constexpr (ALIGN_EPI) { if (wr == 1) PG8_BAR; }
    }
    PG8_WAIT_V(0);
    if constexpr (!ALIGN_EPI) { if (wr == 0) PG8_BAR; }
    PG8_BAR;
#undef PG8_SA
#undef PG8_SB
#undef PG8_STAGE
#undef PG8_STAGE_A
#undef PG8_LDA
#undef PG8_LDB
#undef PG8_MMA
#undef PG8_WAIT_V
#undef PG8_WAIT_L
#undef PG8_WAIT_VF
#undef PG8_BAR
#undef PG8_SCHED
}
}
using pg8::Unit;

struct ProbQKV {
    static constexpr bool GATHER = false;
    int K; const char* abuf; const char* wqk; const char* wv; pg8::GridOrder go; int G, c, stagger, noepi;
    DI bool next(int i, Unit& u) const {
        const long L = (long)i * G + c;
        if (L < NTILE * 8) { u.kind = 0; const bool ok = go.map(L, u.pm, u.pn);
#ifdef PROBE_SAMEA
            if (noepi) { u.pm = u.pm & 7; }
#endif
            return ok; }
        const long r = L - NTILE * 8; if (r >= NTILE * 4) return false;
        u.kind = 1; u.pm = (int)(r & 3); u.pn = (int)(r >> 2); return true;
    }
    DI const char* a_ptr(const Unit& u) const { return (u.kind == 0 ? abuf : wv) + (size_t)u.pm * (256 * 1024 * 2); }
    DI const char* b_ptr(const Unit& u) const { return (u.kind == 0 ? wqk : abuf) + (size_t)u.pn * (256 * 1024 * 2); }
};
struct EpiQKV {
    static constexpr bool PERM = true; static constexpr int EV = 16;

    struct Pre {}; DI void pre_load(const Unit&, int, int, Pre&) const {}
    bf16_t* Q; bf16_t* Kb; bf16_t* VT; const float* gq; const float* gk; const float* cosT; const float* sinT;
    DI void operator()(const f32x4 (&acc)[2][2][4][2], const Unit& u, int wr, int wc, int fr, int fq, const Pre& pre) const {
        if (u.kind == 1) {
#pragma unroll
            for (int ai = 0; ai < 2; ++ai)
#pragma unroll
                for (int m = 0; m < 4; ++m) {
                    const int f = u.pm * 256 + ai * 128 + wr * 64 + m * 16 + fr;
                    bf16_t* rowp = VT + (size_t)f * T + (size_t)u.pn * 256 + wc * 32 + 8 * fq;
#pragma unroll
                    for (int bj = 0; bj < 2; ++bj) { const f32x4 v0 = acc[ai][bj][m][0], v1 = acc[ai][bj][m][1];
                        u32x4 w; w.x = pk_bf16(v0[0], v0[1]); w.y = pk_bf16(v0[2], v0[3]); w.z = pk_bf16(v1[0], v1[1]); w.w = pk_bf16(v1[2], v1[3]);
                        stg<u32x4>(rowp + bj * 128, w); }
                }
            return;
        }
        const bool isK = u.pn >= 4; const int sub = 4 * (u.pn & 3) + wc;
        const int jj = u.pm % 9; const bool isctx = (jj == 0);
        const float* g = isK ? gk : gq; bf16_t* dst = isK ? Kb : Q;
        const float osc = isK ? 1.0f : 0.125f * LOG2E;
        const int ln = fr + 16 * fq;
        f32x4 gv[2][2];
#pragma unroll
        for (int bj = 0; bj < 2; ++bj)
#pragma unroll
            for (int n = 0; n < 2; ++n) gv[bj][n] = ldg<f32x4>(g + 32 * bj + 8 * fq + 4 * n);
        float invf[8];
#pragma unroll
        for (int k = 0; k < 8; ++k) invf[k] = __builtin_amdgcn_exp2f(-(float)((8 * fq + k) & 15) * (13.287712379549449f / 16.0f)) * 0.15915494309189535f;
        const bool use_row = fq < 2;
        float ss[8];
#pragma unroll
        for (int ai = 0; ai < 2; ++ai)
#pragma unroll
            for (int m = 0; m < 4; ++m) { float s = 0.f;
#pragma unroll
                for (int bj = 0; bj < 2; ++bj)
#pragma unroll
                    for (int n = 0; n < 2; ++n) { const f32x4 x = acc[ai][bj][m][n]; s += (x[0] * x[0] + x[1] * x[1]) + (x[2] * x[2] + x[3] * x[3]); }
                ss[ai * 4 + m] = s; }
#pragma unroll
        for (int it = 0; it < 8; ++it) ss[it] += shx(ss[it], 16, ln);
#pragma unroll
        for (int it = 0; it < 8; ++it) ss[it] += shx(ss[it], 32, ln);
#pragma unroll
        for (int ai = 0; ai < 2; ++ai)
#pragma unroll
            for (int m = 0; m < 4; ++m) {
                const int rr = ai * 128 + wr * 64 + m * 16 + fr;
                const float rstd = __builtin_amdgcn_rsqf(ss[ai * 4 + m] * (1.0f / 64.0f) + RMS_EPS) * osc;
                f32x4 x1[2], x2[2];
#pragma unroll
                for (int n = 0; n < 2; ++n) { x1[n] = acc[ai][0][m][n] * rstd * gv[0][n]; x2[n] = acc[ai][1][m][n] * rstd * gv[1][n]; }
                if (!isctx) {
                    const int t = (jj - 1) * 256 + rr; const float pos = (float)(use_row ? (t >> 6) : (t & 63));
#pragma unroll
                    for (int n = 0; n < 2; ++n)
#pragma unroll
                        for (int j = 0; j < 4; ++j) { const float a = pos * invf[4 * n + j]; const float c = __builtin_amdgcn_cosf(a), s = __builtin_amdgcn_sinf(a);
                            const float p = x1[n][j], q = x2[n][j]; x1[n][j] = p * c - q * s; x2[n][j] = p * s + q * c; }
                }
                bf16_t* rowp = dst + (size_t)(u.pm * 256 + rr) * 1024 + 64 * sub + 8 * fq;
                u32x4 w; w.x = pk_bf16(x1[0][0], x1[0][1]); w.y = pk_bf16(x1[0][2], x1[0][3]); w.z = pk_bf16(x1[1][0], x1[1][1]); w.w = pk_bf16(x1[1][2], x1[1][3]);
                stg<u32x4>(rowp, w);
                w.x = pk_bf16(x2[0][0], x2[0][1]); w.y = pk_bf16(x2[0][2], x2[0][3]); w.z = pk_bf16(x2[1][0], x2[1][1]); w.w = pk_bf16(x2[1][2], x2[1][3]);
                stg<u32x4>(rowp + 32, w);
            }
    }
};

struct ProbDense {
    static constexpr bool GATHER = false;
    int K; const char* A0; const char* A1; int pm_split; const char* Bt; pg8::GridOrder go; int G, c, stagger, noepi, latonly;
    DI bool next(int i, Unit& u) const { u.kind = 0; const bool ok = go.map((long)i * G + c, u.pm, u.pn); if (latonly) u.pm = (u.pm >> 3) * 9 + 1 + (u.pm & 7); return ok; }
    DI const char* a_ptr(const Unit& u) const { return u.pm < pm_split ? A0 + (size_t)u.pm * 512 * K : A1 + (size_t)(u.pm - pm_split) * 512 * K; }
    DI const char* b_ptr(const Unit& u) const { return Bt + (size_t)u.pn * 512 * K; }
};

struct ProbWIN {
    static constexpr bool GATHER = false;
    int K; const char* abuf; const char* win; pg8::GridOrder go; int G, c, stagger, noepi, nnat, latonly;
    DI bool next(int i, Unit& u) const {
        const long L = (long)i * G + c;
        if (L < nnat) { u.kind = 0; const bool ok = go.map(L, u.pm, u.pn); if (latonly) u.pm = (u.pm >> 3) * 9 + 1 + (u.pm & 7); return ok; }
        const long r = L - nnat; if (r >= 144 * 12) return false;
        u.kind = 1; u.pm = (int)(r % 12); u.pn = (int)(r / 12); return true;
    }
    DI const char* a_ptr(const Unit& u) const { return u.kind == 0 ? abuf + (size_t)u.pm * (256 * 1024 * 2) : win + (size_t)(4 + u.pm) * (256 * 1024 * 2); }
    DI const char* b_ptr(const Unit& u) const { return u.kind == 0 ? win + (size_t)(u.pn < 4 ? u.pn : 12 + u.pn) * (256 * 1024 * 2) : abuf + (size_t)u.pn * (256 * 1024 * 2); }
};
struct EpiWIN {
    static constexpr bool PERM = true; static constexpr int EV = 16;

    struct Pre {}; DI void pre_load(const Unit&, int, int, Pre&) const {}
    bf16_t* RQ; bf16_t* RG; bf16_t* RKT; bf16_t* RVT; int pm0; const float* cosT; const float* sinT; const float* cosTT; const float* sinTT;
    DI void operator()(const f32x4 (&acc)[2][2][4][2], const Unit& u, int wr, int wc, int fr, int fq, const Pre& pre) const {
        if (u.kind == 0) {
            const int gpm = pm0 + u.pm, jj = gpm % 9; const bool isctx = (jj == 0); const bool isq = u.pn < 4;
            float invf[8];
#pragma unroll
            for (int k = 0; k < 8; ++k) invf[k] = __builtin_amdgcn_exp2f(-(float)((32 * wc + 8 * fq + k) & 63) * (13.287712379549449f / 64.0f)) * 0.15915494309189535f;
#pragma unroll
            for (int ai = 0; ai < 2; ++ai)
#pragma unroll
                for (int m = 0; m < 4; ++m) {
                    const int rr = ai * 128 + wr * 64 + m * 16 + fr;
                    f32x4 x1[2], x2[2];
#pragma unroll
                    for (int n = 0; n < 2; ++n) { x1[n] = acc[ai][0][m][n]; x2[n] = acc[ai][1][m][n]; }
                    if (isq) {
                        if (!isctx) {
                            const int t = (jj - 1) * 256 + rr; const float pos = (float)((wc < 2) ? (t >> 6) : (t & 63));
#pragma unroll
                            for (int n = 0; n < 2; ++n)
#pragma unroll
                                for (int j = 0; j < 4; ++j) { const float a = pos * invf[4 * n + j]; const float c = __builtin_amdgcn_cosf(a), s = __builtin_amdgcn_sinf(a);
                                    const float p = x1[n][j], q = x2[n][j]; x1[n][j] = p * c - q * s; x2[n][j] = p * s + q * c; }
                        }
                    } else {
#pragma unroll
                        for (int n = 0; n < 2; ++n)
#pragma unroll
                            for (int j = 0; j < 4; ++j) { x1[n][j] = silu_f(x1[n][j]); x2[n][j] = silu_f(x2[n][j]); }
                    }
                    bf16_t* rowp = isq ? RQ + (size_t)(u.pm * 256 + rr) * 1024 + u.pn * 256 + wc * 32 + 8 * fq : RG + (size_t)(u.pm * 256 + rr) * 4096 + (u.pn - 4) * 256 + wc * 32 + 8 * fq;
                    u32x4 w; w.x = pk_bf16(x1[0][0], x1[0][1]); w.y = pk_bf16(x1[0][2], x1[0][3]); w.z = pk_bf16(x1[1][0], x1[1][1]); w.w = pk_bf16(x1[1][2], x1[1][3]);
                    stg<u32x4>(rowp, w);
                    w.x = pk_bf16(x2[0][0], x2[0][1]); w.y = pk_bf16(x2[0][2], x2[0][3]); w.z = pk_bf16(x2[1][0], x2[1][1]); w.w = pk_bf16(x2[1][2], x2[1][3]);
                    stg<u32x4>(rowp + 128, w);
                }
            return;
        }
        const int gpm = pm0 + u.pn, jj = gpm % 9; const bool isctx = (jj == 0); const bool isk = u.pm < 4;
        if (isk) {
#pragma unroll
            for (int m = 0; m < 4; ++m) {
                const int f = wr * 64 + m * 16 + fr;
#pragma unroll
                for (int bj = 0; bj < 2; ++bj) {
                    f32x4 x1[2], x2[2];
#pragma unroll
                    for (int n = 0; n < 2; ++n) { x1[n] = acc[0][bj][m][n] * 0.0625f; x2[n] = acc[1][bj][m][n] * 0.0625f; }
                    const int tl = bj * 128 + wc * 32 + 8 * fq;
                    if (!isctx) {
                        const int t = (jj - 1) * 256 + tl;
                        const float ivf = __builtin_amdgcn_exp2f(-(float)(m * 16 + fr) * (13.287712379549449f / 64.0f)) * 0.15915494309189535f;
#pragma unroll
                        for (int n = 0; n < 2; ++n)
#pragma unroll
                            for (int j = 0; j < 4; ++j) { const int tt = t + 4 * n + j; const float a = (float)(wr == 0 ? (tt >> 6) : (tt & 63)) * ivf; const float c = __builtin_amdgcn_cosf(a), s = __builtin_amdgcn_sinf(a);
                                const float p = x1[n][j], q = x2[n][j]; x1[n][j] = p * c - q * s; x2[n][j] = p * s + q * c; }
                    }
                    bf16_t* p1 = RKT + ((size_t)(u.pn * 8 + 4 * bj + wc) * 1024 + (u.pm * 256 + f)) * 32 + 8 * fq;
                    u32x4 w; w.x = pk_bf16(x1[0][0], x1[0][1]); w.y = pk_bf16(x1[0][2], x1[0][3]); w.z = pk_bf16(x1[1][0], x1[1][1]); w.w = pk_bf16(x1[1][2], x1[1][3]);
                    stg<u32x4>(p1, w);
                    w.x = pk_bf16(x2[0][0], x2[0][1]); w.y = pk_bf16(x2[0][2], x2[0][3]); w.z = pk_bf16(x2[1][0], x2[1][1]); w.w = pk_bf16(x2[1][2], x2[1][3]);
                    stg<u32x4>(p1 + 128 * 32, w);
                }
            }
        } else {
#pragma unroll
            for (int ai = 0; ai < 2; ++ai)
#pragma unroll
                for (int m = 0; m < 4; ++m) {
                    const int f = (u.pm - 4) * 256 + ai * 128 + wr * 64 + m * 16 + fr;
#pragma unroll
                    for (int bj = 0; bj < 2; ++bj) { const f32x4 v0 = acc[ai][bj][m][0], v1 = acc[ai][bj][m][1];
                        u32x4 w; w.x = pk_bf16(v0[0], v0[1]); w.y = pk_bf16(v0[2], v0[3]); w.z = pk_bf16(v1[0], v1[1]); w.w = pk_bf16(v1[2], v1[3]);
                        stg<u32x4>(RVT + ((size_t)(u.pn * 8 + 4 * bj + wc) * 2048 + f) * 32 + 8 * fq, w); }
                }
        }
    }
};

struct EpiResid {
    static constexpr bool PERM = true; static constexpr int EV = 16;

    struct Pre {}; DI void pre_load(const Unit&, int, int, Pre&) const {}
    const float* xin_ctx; const float* xin_lat; bf16_t* hb; const float* modbase; int first;
    DI void operator()(const f32x4 (&acc)[2][2][4][2], const Unit& u, int wr, int wc, int fr, int fq, const Pre& pre) const {
        const int b = u.pm / 9, jj = u.pm % 9; const bool isctx = (jj == 0);
        const float* gate = modbase + (size_t)(isctx ? 32 : b) * 6144 + 2048;
        const int col0 = u.pn * 256 + wc * 32 + 8 * fq;
        f32x4 gv[2][2];
#pragma unroll
        for (int bj = 0; bj < 2; ++bj)
#pragma unroll
            for (int n = 0; n < 2; ++n) gv[bj][n] = ldg<f32x4>(gate + col0 + bj * 128 + n * 4);
        const size_t rbase = isctx ? (size_t)b * 256 : (size_t)b * 2048 + (size_t)(jj - 1) * 256;
        const float* xi = isctx ? xin_ctx : xin_lat;
#pragma unroll
        for (int ai = 0; ai < 2; ++ai) {
            f32x4 hv[4][2][2];
#pragma unroll
            for (int m = 0; m < 4; ++m) { const int rr = ai * 128 + wr * 64 + m * 16 + fr;
#pragma unroll
                for (int bj = 0; bj < 2; ++bj) {
                    if (first) { const float* p = xi + (rbase + rr) * 1024 + col0 + bj * 128; hv[m][bj][0] = ldg<f32x4>(p); hv[m][bj][1] = ldg<f32x4>(p + 4); }
                    else { const u32x4 w = ldg<u32x4>(hb + (size_t)(u.pm * 256 + rr) * 1024 + col0 + bj * 128);
                        hv[m][bj][0] = (f32x4){bf_lo(w.x), bf_hi(w.x), bf_lo(w.y), bf_hi(w.y)}; hv[m][bj][1] = (f32x4){bf_lo(w.z), bf_hi(w.z), bf_lo(w.w), bf_hi(w.w)}; }
                } }
#pragma unroll
            for (int m = 0; m < 4; ++m) { const int rr = ai * 128 + wr * 64 + m * 16 + fr;
#pragma unroll
                for (int bj = 0; bj < 2; ++bj) { const f32x4 v0 = hv[m][bj][0] + gv[bj][0] * acc[ai][bj][m][0], v1 = hv[m][bj][1] + gv[bj][1] * acc[ai][bj][m][1];
                    u32x4 w; w.x = pk_bf16(v0[0], v0[1]); w.y = pk_bf16(v0[2], v0[3]); w.z = pk_bf16(v1[0], v1[1]); w.w = pk_bf16(v1[2], v1[3]);
                    stg<u32x4>(hb + (size_t)(u.pm * 256 + rr) * 1024 + col0 + bj * 128, w); } }
        }
    }
};

template <bool GATHER_>
struct ProbMoE {
    static constexpr bool GATHER = GATHER_;
    int K; const char* A; const char* W; const LAS int* tile_e; const LAS int* rowtok; pg8::GridOrder go; int G, c, stagger, noepi;
    DI bool next(int i, Unit& u) const { u.kind = 0; return go.map((long)i * G + c, u.pm, u.pn); }
    DI const char* a_ptr(const Unit& u) const { return GATHER ? A : A + (size_t)u.pm * 512 * K; }
    DI const char* b_ptr(const Unit& u) const { return W + ((size_t)tile_e[u.pm] * 4 + u.pn) * 512 * K; }
};
struct EpiSwiGLU {
    static constexpr bool PERM = true; static constexpr int EV = 8;

    struct Pre {}; DI void pre_load(const Unit&, int, int, Pre&) const {}
    bf16_t* act;
    DI void operator()(const f32x4 (&acc)[2][2][4][2], const Unit& u, int wr, int wc, int fr, int fq, const Pre& pre) const {
#pragma unroll
        for (int ai = 0; ai < 2; ++ai)
#pragma unroll
            for (int m = 0; m < 4; ++m) {
                bf16_t* rowp = act + (size_t)(u.pm * 256 + ai * 128 + wr * 64 + m * 16 + fr) * 512 + u.pn * 128 + wc * 32 + 8 * fq;
                const f32x4 g0 = acc[ai][0][m][0], u0 = acc[ai][0][m][1], g1 = acc[ai][1][m][0], u1 = acc[ai][1][m][1];
                u32x4 w; w.x = pk_bf16(silu_f(g0[0]) * u0[0], silu_f(g0[1]) * u0[1]); w.y = pk_bf16(silu_f(g0[2]) * u0[2], silu_f(g0[3]) * u0[3]);
                w.z = pk_bf16(silu_f(g1[0]) * u1[0], silu_f(g1[1]) * u1[1]); w.w = pk_bf16(silu_f(g1[2]) * u1[2], silu_f(g1[3]) * u1[3]);
                stg<u32x4>(rowp, w);
            }
    }
};
struct EpiDown {
    static constexpr bool PERM = true; static constexpr int EV = 2;
    bf16_t* y2; const int* rowmap; const float* wsel;
    struct Pre { u32x2 dw[2]; };
    DI void pre_load(const Unit& u, int wr, int, Pre& p) const {
        const int l = lane_id_asm();
#pragma unroll
        for (int ai = 0; ai < 2; ++ai) p.dw[ai] = ldg<u32x2>(rowmap + 2 * (u.pm * 256 + ai * 128 + wr * 64 + l));
    }
    DI void operator()(const f32x4 (&acc)[2][2][4][2], const Unit& u, int wr, int wc, int fr, int fq, const Pre& pre) const {
#pragma unroll
        for (int ai = 0; ai < 2; ++ai)
#pragma unroll
            for (int m = 0; m < 4; ++m) {
                const int src = (m * 16 + fr) << 2;
                const int d = __builtin_amdgcn_ds_bpermute(src, (int)pre.dw[ai].x);
                const float w = __builtin_bit_cast(float, __builtin_amdgcn_ds_bpermute(src, (int)pre.dw[ai].y));
                if (d >= 0) {
                    bf16_t* rowp = y2 + (size_t)d * 1024 + u.pn * 256 + wc * 32 + 8 * fq;
#pragma unroll
                    for (int bj = 0; bj < 2; ++bj) { const f32x4 v0 = acc[ai][bj][m][0] * w, v1 = acc[ai][bj][m][1] * w;
                        u32x4 o; o.x = pk_bf16(v0[0], v0[1]); o.y = pk_bf16(v0[2], v0[3]); o.z = pk_bf16(v1[0], v1[1]); o.w = pk_bf16(v1[2], v1[3]);
                        stg<u32x4>(rowp + bj * 128, o); }
                }
            }
    }
};

template <int MODE>
DI void transpose_tile(const Frame& F, const float* src, const float* src2, int ld, bf16_t* dst, int K, int k0, int n0) {
    LAS float* tl = (LAS float*)F.lds;
    __syncthreads();
#pragma unroll
    for (int i = 0; i < 8; ++i) {
        const int idx = F.tid + 512 * i, kk = idx >> 6, nn = idx & 63, np = n0 + nn;
        float v;
        if (MODE == 0) v = ldg<float>(src + (size_t)(k0 + kk) * ld + np);
        else if (MODE == 1) { const int t = np >> 8, p = np & 255, bj = p >> 7, wc = (p >> 5) & 3, r = p & 31; v = ldg<float>(src + (size_t)(k0 + kk) * ld + t * 256 + wc * 64 + bj * 32 + r); }
        else { const int hid = 4 * (np >> 3) + (np & 3); v = ldg<float>(((np & 4) ? src2 : src) + (size_t)(k0 + kk) * ld + hid); }
        tl[nn * 65 + kk] = v;
    }
    __syncthreads();
#pragma unroll
    for (int i = 0; i < 4; ++i) {
        const int idx = F.tid + 512 * i, nn = idx >> 5, kp = (idx & 31) * 2;
        stg<unsigned>(dst + (size_t)(n0 + nn) * K + k0 + kp, pk_bf16(tl[nn * 65 + kp], tl[nn * 65 + kp + 1]));
    }
}
template <int MODE>
DI int transpose_mat(const Frame& F, const float* src, const float* src2, int ld, bf16_t* dst, int K, int Np, int u0, int u_first, int u_stride) {
    const int tk = K / 64, tn = Np / 64, ntl = tk * tn;
    int u = u_first; if (u < u0) { const int d = (u0 - u + u_stride - 1) / u_stride; u += d * u_stride; }
    for (; u < u0 + ntl; u += u_stride) { const int l = u - u0; transpose_tile<MODE>(F, src, src2, ld, dst, K, (l % tk) * 64, (l / tk) * 64); }
    return ntl;
}
DI void moe_tile_load(const Frame& F, const float* wg, const float* wu, const float* wd, int u, float (&v)[8]) {
    const int e = u / 384, l = u % 384;
#pragma unroll
    for (int i = 0; i < 8; ++i) {
        const int idx = F.tid + 512 * i, kk = idx >> 6, nn = idx & 63;
        if (l < 256) { const int np = (l >> 4) * 64 + nn, hid = 128 * (np >> 8) + 32 * ((np >> 5) & 3) + 8 * ((np >> 3) & 3) + 4 * ((np >> 7) & 1) + (np & 3);
            v[i] = ldg<float>(((np & 4) ? wu : wg) + (size_t)e * DM * MOEH + (size_t)((l & 15) * 64 + kk) * MOEH + hid); }
        else { const int l2 = l - 256; v[i] = ldg<float>(wd + (size_t)e * MOEH * DM + (size_t)((l2 & 7) * 64 + kk) * DM + (l2 >> 3) * 64 + nn); }
    }
}
constexpr int MOE_NT = NEXP * 384, MOE_T_WO = 28 * 128, MOE_T_QKV = 20 * 128;
DI int moe_split_lo(const Frame& F, int layer) {
    if (F.G != 256 || layer == DEPTH - 1) return 0;
    return (layer & 1) ? MOE_T_WO : MOE_T_WO + MOE_T_QKV;
}
DI void convert_moe_weights(const Frame& F, int layer, const int t_lo, const int t_hi, const int first, const int stride) {
    const float* wg = F.a->in[21] + (size_t)layer * NEXP * DM * MOEH; const float* wu = F.a->in[22] + (size_t)layer * NEXP * DM * MOEH; const float* wd = F.a->in[23] + (size_t)layer * NEXP * MOEH * DM;
    bf16_t* WGU = (bf16_t*)(F.ws + WS_WGU); bf16_t* WD = (bf16_t*)(F.ws + WS_WD);
    LAS float* tl = (LAS float*)F.lds;
    const int NT = t_hi;
    float v[8];
    int u = t_lo + first, par = 0;
    __syncthreads();
    if (u < NT) moe_tile_load(F, wg, wu, wd, u, v);
    for (; u < NT; u += stride, par ^= 1) {
        LAS float* tb = tl + par * (64 * 65);
#pragma unroll
        for (int i = 0; i < 8; ++i) { const int idx = F.tid + 512 * i; tb[(idx & 63) * 65 + (idx >> 6)] = v[i]; }
        __syncthreads();
        if (u + stride < NT) moe_tile_load(F, wg, wu, wd, u + stride, v);
        const int e = u / 384, l = u % 384;
        bf16_t* dst; int K, k0, n0;
        if (l < 256) { dst = WGU + (size_t)e * 1024 * 1024; K = 1024; k0 = (l & 15) * 64; n0 = (l >> 4) * 64; } else { const int l2 = l - 256; dst = WD + (size_t)e * 1024 * 512; K = 512; k0 = (l2 & 7) * 64; n0 = (l2 >> 3) * 64; }
#pragma unroll
        for (int i = 0; i < 4; ++i) { const int idx = F.tid + 512 * i, nn = idx >> 5, kp = (idx & 31) * 2;
            stg<unsigned>(dst + (size_t)(n0 + nn) * K + k0 + kp, pk_bf16(tb[nn * 65 + kp], tb[nn * 65 + kp + 1])); }
    }
    __syncthreads();
}

DI void p0_prologue(const Frame& F) {
    {
        LAS float* red = (LAS float*)F.lds;
        for (int u = F.bid; u < 4 * 96; u += F.G) {
            const int layer = u / 96, col0 = (u % 96) * 64;
            const float* W = F.a->in[6] + (size_t)layer * 1024 * 6144 + col0 + F.lane;
            const float* cp = F.lane < 32 ? F.a->in[1] + F.lane * 1024 : F.a->in[3];
            float acc[33];
#pragma unroll
            for (int r = 0; r < 33; ++r) acc[r] = 0.f;
            const int k0 = F.wave * 128;
            for (int k = k0; k < k0 + 128; k += 8) {
                float w8[8], c8[8];
#pragma unroll
                for (int q = 0; q < 8; ++q) { w8[q] = ldg<float>(W + (size_t)(k + q) * 6144); c8[q] = ldg<float>(cp + k + q); }
#pragma unroll
                for (int q = 0; q < 8; ++q) { const float sv = silu_f(c8[q]);
#pragma unroll
                    for (int r = 0; r < 33; ++r) acc[r] += w8[q] * __builtin_bit_cast(float, __builtin_amdgcn_readlane(__builtin_bit_cast(int, sv), r)); }
            }
#pragma unroll
            for (int r = 0; r < 33; ++r) red[(F.wave * 33 + r) * 64 + F.lane] = acc[r];
            __syncthreads();
            float* outp = (float*)(F.ws + WS_ADA) + (size_t)layer * 33 * 6144;
            for (int idx = F.tid; idx < 33 * 64; idx += 512) { const int r = idx >> 6, cl = idx & 63; float v = 0.f;
#pragma unroll
                for (int w8 = 0; w8 < 8; ++w8) v += red[(w8 * 33 + r) * 64 + cl];
                stg<float>(outp + (size_t)r * 6144 + col0 + cl, v + ldg<float>(F.a->in[7] + layer * 6144 + col0 + cl)); }
            __syncthreads();
        }
    }
    {
        int u0 = 0;
        for (int j = 0; j < 2; ++j) {
            const float* wqkv = F.a->in[8] + (size_t)j * 1024 * 3072;
            u0 += transpose_mat<1>(F, wqkv, nullptr, 3072, (bf16_t*)(F.ws + WS_WQK) + (size_t)j * 2048 * 1024, 1024, 2048, u0, F.bid, F.G);
            u0 += transpose_mat<0>(F, wqkv + 2048, nullptr, 3072, (bf16_t*)(F.ws + WS_WV) + (size_t)j * 1024 * 1024, 1024, 1024, u0, F.bid, F.G);
            u0 += transpose_mat<0>(F, F.a->in[13] + (size_t)j * 1024 * 1024, nullptr, 1024, (bf16_t*)(F.ws + WS_WODA) + (size_t)j * 1024 * 1024, 1024, 1024, u0, F.bid, F.G);
            u0 += transpose_mat<0>(F, F.a->in[14] + (size_t)j * 1024 * 8192, nullptr, 8192, (bf16_t*)(F.ws + WS_WIN) + (size_t)j * 8192 * 1024, 1024, 8192, u0, F.bid, F.G);
            u0 += transpose_mat<0>(F, F.a->in[16] + (size_t)j * 2048 * 1024, nullptr, 1024, (bf16_t*)(F.ws + WS_WORT) + (size_t)j * 1024 * 2048, 2048, 1024, u0, F.bid, F.G);
        }
        convert_moe_weights(F, 0, moe_split_lo(F, 0), MOE_NT, F.bid, F.G);
    }
}

template <bool SECOND>
DI void norm_phase(const Frame& F, int layer) {
    bf16_t* abuf = (bf16_t*)(F.ws + WS_ABUF);
    bf16_t* hb = (bf16_t*)(F.ws + WS_HB);
    const bf16_t* y2 = (const bf16_t*)(F.ws + WS_PROJ + PJ_Y2);
    const float* ng = F.a->in[SECOND ? 5 : 4] + layer * 1024;
    LAS float* Wl = (LAS float*)F.lds;
    LAS int* lhist = (LAS int*)(F.lds + LDS_MISC + 1024);
    int* eid = (int*)(F.ws + WS_MISC + MS_EID); float* wsel = (float*)(F.ws + WS_MISC + MS_WSEL);
    if (SECOND) {
        const float* wgp = F.a->in[17] + (size_t)layer * 1024 * 4; const float* wep = F.a->in[19] + (size_t)layer * 1024 * 32;
        {
            f32x4 wg4[2];
#pragma unroll
            for (int q = 0; q < 2; ++q) wg4[q] = ldg<f32x4>(wgp + (F.tid + 512 * q) * 4);
#pragma unroll
            for (int q = 0; q < 2; ++q) { const int k = F.tid + 512 * q; Wl[0 * 1024 + k] = wg4[q][0]; Wl[1 * 1024 + k] = wg4[q][1]; Wl[2 * 1024 + k] = wg4[q][2]; Wl[3 * 1024 + k] = wg4[q][3]; }
#pragma unroll
            for (int h2 = 0; h2 < 2; ++h2) {
                f32x4 we4[8];
#pragma unroll
                for (int q = 0; q < 8; ++q) we4[q] = ldg<f32x4>(wep + (size_t)(F.tid + 512 * (h2 * 8 + q)) * 4);
#pragma unroll
                for (int q = 0; q < 8; ++q) { const int c = F.tid + 512 * (h2 * 8 + q), k = c >> 3, o = 4 * (c & 7);
                    Wl[(4 + o) * 1024 + k] = we4[q][0]; Wl[(5 + o) * 1024 + k] = we4[q][1]; Wl[(6 + o) * 1024 + k] = we4[q][2]; Wl[(7 + o) * 1024 + k] = we4[q][3]; }
            }
        }
        if (F.tid < 32) lhist[F.tid] = 0;
        __syncthreads();
    }
    const int lane = F.lane;
    const int rpw = (T + F.G * 8 - 1) / (F.G * 8), rbeg = (F.bid * 8 + F.wave) * rpw;
    int mkey = -2; f32x4 gnv[4], shv[4], scv[4], g2v[4];
#pragma unroll
    for (int i = 0; i < 4; ++i) { gnv[i] = ldg<f32x4>(ng + i * 256 + lane * 4); g2v[i] = gnv[i]; shv[i] = gnv[i]; scv[i] = gnv[i]; }
    const bool pref = !(layer == 0 && !SECOND); const bool fin = (!SECOND && layer > 0);
    const int rend = (rbeg + rpw < T) ? rbeg + rpw : T;
    u32x2 hn[4], yn[8];
#pragma unroll
    for (int i = 0; i < 4; ++i) { hn[i] = (u32x2){0u, 0u}; yn[i] = hn[i]; yn[4 + i] = hn[i]; }
#define NORM_ISSUE(rr) do { if (pref) { _Pragma("unroll") for (int i = 0; i < 4; ++i) hn[i] = ldg<u32x2>(hb + (size_t)(rr) * 1024 + i * 256 + lane * 4); \
        if (fin) { _Pragma("unroll") for (int i = 0; i < 4; ++i) { yn[i] = ldg<u32x2>(y2 + (size_t)(2 * (rr)) * 1024 + i * 256 + lane * 4); yn[4 + i] = ldg<u32x2>(y2 + (size_t)(2 * (rr) + 1) * 1024 + i * 256 + lane * 4); } } } } while (0)
    if (rbeg < rend) NORM_ISSUE(rbeg);
    for (int r = rbeg; r < rend; ++r) {
        u32x2 hc[4], yc[8];
#pragma unroll
        for (int i = 0; i < 4; ++i) { hc[i] = hn[i]; yc[i] = yn[i]; yc[4 + i] = yn[4 + i]; }
        if (r + 1 < rend) NORM_ISSUE(r + 1);
        const int b = r / NTOK, n = r % NTOK; const bool isctx = n < CTXL;
        if (SECOND && layer == DEPTH - 1 && isctx) continue;
        { const int nk = isctx ? -1 : b;
          if (nk != mkey) { mkey = nk; const float* mod = isctx ? mod_ctx(F, layer) : mod_lat(F, layer, b);
#pragma unroll
            for (int i = 0; i < 4; ++i) { const int c0 = i * 256 + lane * 4; shv[i] = ldg<f32x4>(mod + (SECOND ? 3072 : 0) + c0); scv[i] = ldg<f32x4>(mod + (SECOND ? 4096 : 1024) + c0) + 1.0f; }
            if (!SECOND && layer > 0) { const float* modp = isctx ? mod_ctx(F, layer - 1) : mod_lat(F, layer - 1, b);
#pragma unroll
                for (int i = 0; i < 4; ++i) g2v[i] = ldg<f32x4>(modp + 5120 + i * 256 + lane * 4); } } }
        const size_t hoff = isctx ? ((size_t)b * 256 + n) * 1024 : ((size_t)b * 2048 + (n - 256)) * 1024;
        bf16_t* hrow = hb + (size_t)r * 1024;
        f32x4 x[4];
        if (layer == 0 && !SECOND) { const float* hin = isctx ? F.a->in[2] + hoff : F.a->in[0] + hoff;
#pragma unroll
            for (int i = 0; i < 4; ++i) x[i] = ldg<f32x4>(hin + i * 256 + lane * 4);
        } else {
#pragma unroll
            for (int i = 0; i < 4; ++i) { const u32x2 w = hc[i]; x[i] = (f32x4){bf_lo(w.x), bf_hi(w.x), bf_lo(w.y), bf_hi(w.y)}; }
        }
        if (!SECOND && layer > 0) {
#pragma unroll
            for (int i = 0; i < 4; ++i) {
                const u32x2 a = yc[i], c = yc[4 + i];
                const f32x4 g2 = g2v[i];
                x[i][0] += g2[0] * (bf_lo(a.x) + bf_lo(c.x)); x[i][1] += g2[1] * (bf_hi(a.x) + bf_hi(c.x)); x[i][2] += g2[2] * (bf_lo(a.y) + bf_lo(c.y)); x[i][3] += g2[3] * (bf_hi(a.y) + bf_hi(c.y));
                { u32x2 w; w.x = pk_bf16(x[i][0], x[i][1]); w.y = pk_bf16(x[i][2], x[i][3]); stg<u32x2>(hrow + i * 256 + lane * 4, w); }
            }
        }
        float ss = 0.f;
#pragma unroll
        for (int i = 0; i < 4; ++i) ss += (x[i][0] * x[i][0] + x[i][1] * x[i][1]) + (x[i][2] * x[i][2] + x[i][3] * x[i][3]);
        ss = wave_sum(ss, lane);
        const float rstd = 1.0f / sqrtf(ss * (1.0f / 1024.0f) + RMS_EPS);
        f32x4 v[4];
#pragma unroll
        for (int i = 0; i < 4; ++i) {
            const int c0 = i * 256 + lane * 4;
            v[i] = (x[i] * rstd * gnv[i]) * scv[i] + shv[i];
            u32x2 w; w.x = pk_bf16(v[i][0], v[i][1]); w.y = pk_bf16(v[i][2], v[i][3]);
            stg<u32x2>(abuf + (size_t)r * 1024 + c0, w);
        }
        if (SECOND) {
            const float* bg = F.a->in[18] + layer * 4; const float* be = F.a->in[20] + layer * 32;
            float gl[4]; float gmax = -3.0e38f; int gi = 0;
#pragma unroll
            for (int o = 0; o < 4; ++o) {
                float p = 0.f;
#pragma unroll
                for (int i = 0; i < 4; ++i) { const f32x4 w = *(const LAS f32x4*)(Wl + o * 1024 + i * 256 + lane * 4); p += (v[i][0] * w[0] + v[i][1] * w[1]) + (v[i][2] * w[2] + v[i][3] * w[3]); }
                gl[o] = wave_sum(p, lane) + ldg<float>(bg + o);
                if (gl[o] > gmax) { gmax = gl[o]; gi = o; }
            }
            gi = __builtin_amdgcn_readfirstlane(gi);
            float gsum = 0.f;
#pragma unroll
            for (int o = 0; o < 4; ++o) { gsum += __expf(gl[o] - gmax); asm volatile("" : "+v"(gsum)); }
            const float psel = __builtin_amdgcn_rcpf(gsum);
            float el[8];
#pragma unroll
            for (int o = 0; o < 8; ++o) {
                float p = 0.f;
                const LAS float* wr = Wl + (4 + gi * 8 + o) * 1024;
#pragma unroll
                for (int i = 0; i < 4; ++i) { const f32x4 w = *(const LAS f32x4*)(wr + i * 256 + lane * 4); p += (v[i][0] * w[0] + v[i][1] * w[1]) + (v[i][2] * w[2] + v[i][3] * w[3]); }
                el[o] = wave_sum(p, lane) + ldg<float>(be + gi * 8 + o);
            }
            float m1 = -3.0e38f, m2 = -3.0e38f; int i1 = 0, i2 = 0;
#pragma unroll
            for (int o = 0; o < 8; ++o) { if (el[o] > m1) { m1 = el[o]; i1 = o; } }
#pragma unroll
            for (int o = 0; o < 8; ++o) { if (o != i1 && el[o] > m2) { m2 = el[o]; i2 = o; } }
            const float e2 = __expf(m2 - m1), inv = __builtin_amdgcn_rcpf(1.0f + e2);
            if (lane == 0) {
                stg<int>(eid + 2 * r, gi * 8 + i1); stg<int>(eid + 2 * r + 1, gi * 8 + i2); stg<float>(wsel + 2 * r, inv * psel); stg<float>(wsel + 2 * r + 1, e2 * inv * psel);
                __hip_atomic_fetch_add(&lhist[gi * 8 + i1], 1, __ATOMIC_RELAXED, __HIP_MEMORY_SCOPE_WORKGROUP); __hip_atomic_fetch_add(&lhist[gi * 8 + i2], 1, __ATOMIC_RELAXED, __HIP_MEMORY_SCOPE_WORKGROUP);
            }
        }
    }
    if (SECOND) {
        __syncthreads();
        if (F.tid < 32) { const int c = lhist[F.tid]; if (c) __hip_atomic_fetch_add((unsigned*)(F.ws + WS_CTL) + CW_CNT + layer * 64 + F.tid, (unsigned)c, __ATOMIC_RELAXED, __HIP_MEMORY_SCOPE_AGENT); }
    }
}

#undef NORM_ISSUE
DI int build_segments(const Frame& F, int layer, LAS int* segs, LAS int* tile_e) {
    __syncthreads();
    if (F.tid < 32) {
        const unsigned* cnt = (const unsigned*)(F.ws + WS_CTL) + CW_CNT + layer * 64;
        segs[40 + F.tid] = (int)__hip_atomic_load(cnt + F.tid, __ATOMIC_RELAXED, __HIP_MEMORY_SCOPE_AGENT);
    }
    __syncthreads();
    if (F.tid == 0) {
        int s = 0;
        for (int e = 0; e < 32; ++e) { segs[e] = s; s += (segs[40 + e] + 255) & ~255; }
        segs[32] = s;
    }
    __syncthreads();
    const int ntl = segs[32] >> 8;
    if (tile_e) {
        for (int t = F.tid; t < ntl; t += 512) { int e = 0;
            for (int q = 1; q < 32; ++q) e = (segs[q] <= t * 256) ? q : e;
            tile_e[t] = e; }
        __syncthreads();
    }
    return ntl;
}

DI void sort_phase(const Frame& F, int layer) {
    LAS int* segs = (LAS int*)(F.lds + LDS_MISC + 2048);
    LAS int* lhist = (LAS int*)(F.lds + LDS_MISC + 1024);
    LAS int* lbase = (LAS int*)(F.lds + LDS_MISC + 1024 + 128);
    LAS int* lpos = (LAS int*)F.lds;
    build_segments(F, layer, segs, nullptr);
    const int* eid = (const int*)(F.ws + WS_MISC + MS_EID); const float* wsel = (const float*)(F.ws + WS_MISC + MS_WSEL); int* rowinfo = (int*)(F.ws + WS_MISC + MS_WSORT);
    const bf16_t* abuf = (const bf16_t*)(F.ws + WS_ABUF); bf16_t* sa = (bf16_t*)(F.ws + WS_PROJ + PJ_SA);
    const int RPB = (T + F.G - 1) / F.G;
    const int r0 = F.bid * RPB, r1 = (r0 + RPB < T) ? r0 + RPB : T;
    const int na = r1 > r0 ? 2 * (r1 - r0) : 0;
    if (F.tid < 32) lhist[F.tid] = 0;
    __syncthreads();
    int ee[2], lp[2];
#pragma unroll
    for (int it = 0; it < 2; ++it) { const int a = F.tid + 512 * it; ee[it] = -1; lp[it] = 0;
        if (a < na && !(layer == DEPTH - 1 && ((r0 + (a >> 1)) % NTOK) < CTXL)) { ee[it] = ldg<int>(eid + 2 * r0 + a); lp[it] = __hip_atomic_fetch_add(&lhist[ee[it]], 1, __ATOMIC_RELAXED, __HIP_MEMORY_SCOPE_WORKGROUP); } }
    __syncthreads();
    if (F.tid < 32) { const int c = lhist[F.tid];
        lbase[F.tid] = segs[F.tid] + (c ? (int)__hip_atomic_fetch_add((unsigned*)(F.ws + WS_CTL) + CW_CUR + layer * 64 + F.tid, (unsigned)c, __ATOMIC_RELAXED, __HIP_MEMORY_SCOPE_AGENT) : 0); }
    __syncthreads();
#pragma unroll
    for (int it = 0; it < 2; ++it) { const int a = F.tid + 512 * it;
        if (ee[it] >= 0) { const int pos = lbase[ee[it]] + lp[it]; lpos[a] = pos; stg<u32x2>((unsigned*)rowinfo + 2 * (size_t)pos, (u32x2){(unsigned)(2 * r0 + a), __float_as_uint(ldg<float>(wsel + 2 * r0 + a))}); } }
    __syncthreads();
    if (F.bid < 32) { const int e = F.bid; for (int p = segs[e] + segs[40 + e] + F.tid; p < segs[e + 1]; p += 512) stg<int>(rowinfo + 2 * (size_t)p, -1); }
    if (F.G < 32 && F.bid == 0) { for (int e = F.G; e < 32; ++e) for (int p = segs[e] + segs[40 + e] + F.tid; p < segs[e + 1]; p += 512) stg<int>(rowinfo + 2 * (size_t)p, -1); }
}

typedef __bf16 bf16x2_t __attribute__((ext_vector_type(2)));
DI float dot2_ones(unsigned packed, float c) { return __builtin_amdgcn_fdot2_f32_bf16(__builtin_bit_cast(bf16x2_t, packed), __builtin_bit_cast(bf16x2_t, 0x3f803f80u), c, false); }
constexpr int AT_KROW = 272, AT_VROW = 136, AT_KB = 64 * AT_KROW, AT_VB = 128 * AT_VROW, AT_BUF = AT_KB + AT_VB, AT_V0 = 3 * AT_KB, AT_Q0 = 3 * AT_KB + 2 * AT_VB;
static_assert(AT_Q0 + 65536 <= LDS_MISC, "attention LDS");
template <bool USEOFF>
DI void attn_body(const Frame& F, int layer) {
    const int j = layer >> 1;
    const bf16_t* Qb = (const bf16_t*)(F.ws + WS_PROJ + PJ_Q); const bf16_t* Kb = (const bf16_t*)(F.ws + WS_PROJ + PJ_K); const bf16_t* VT = (const bf16_t*)(F.ws + WS_PROJ + PJ_VT);
    bf16_t* Ob = (bf16_t*)(F.ws + WS_OBUF);
    { }
    const int lane0 = F.lane;
    const float* lam = F.a->in[11] + j * 256;
    float p01 = ldg<float>(lam + lane0) * ldg<float>(lam + 64 + lane0), p23 = ldg<float>(lam + 128 + lane0) * ldg<float>(lam + 192 + lane0);
    p01 = wave_sum(p01, lane0); p23 = wave_sum(p23, lane0);
    const float lam_init = 0.8f - 0.6f * __expf(-0.3f * (float)layer);
    const float lam_full = uni_f(__expf(p01) - __expf(p23) + lam_init);
    float mq = fabsf(ldg<float>(F.a->in[9] + j * 64 + lane0)), mk = fabsf(ldg<float>(F.a->in[10] + j * 64 + lane0));
#pragma unroll
    for (int o = 32; o >= 1; o >>= 1) { mq = fmaxf(mq, shx(mq, o, lane0)); mk = fmaxf(mk, shx(mk, o, lane0)); }
    const float OFF = uni_f(8.0f * LOG2E * mq * mk);
    const float* gsub = F.a->in[12] + j * 128;
    const float lam_init_s = uni_f(lam_init);

    for (int u = F.bid; u < 2304; u += F.G) {
        int b, h, qb, nkt;
        if (u < 2048) {
            int bh;
            if (F.G == 256) { const int i = u >> 8, c = u & 255; bh = i * 32 + (c & 7) * 4 + (c >> 6); qb = 1 + ((c >> 3) & 7); } else { bh = u >> 3; qb = 1 + (u & 7); }
            b = bh >> 3; h = bh & 7; nkt = 36;
        } else { const int uu = u - 2048; b = uu >> 3; h = uu & 7; qb = 0; nkt = 4; }
        const size_t rowbase = (size_t)b * NTOK;
        const int lane = lane_id_asm(), lr = lane & 31, lh = lane >> 5, tidu = (F.wave << 6) | lane;
        const size_t qrow = rowbase + qb * 256 + F.wave * 32 + (lane_id_asm() & 31);
        __syncthreads();
        const int qlo = AT_Q0 + F.wave * 8192 + lane * 16;
#pragma unroll
        for (int mp = 0; mp < 2; ++mp)
#pragma unroll
            for (int ks = 0; ks < 4; ++ks) *(LAS bf16x8*)(F.lds + qlo + (mp * 4 + ks) * 1024) = ldg<bf16x8>(Qb + qrow * 1024 + h * 128 + mp * 64 + ks * 16 + lh * 8);
        f32x16 O1[4], O2[4];
#pragma unroll
        for (int e = 0; e < 4; ++e)
#pragma unroll
            for (int i = 0; i < 16; ++i) { O1[e][i] = 0.f; O2[e][i] = 0.f; }
        float l1p = 0.f, l2p = 0.f;
        const unsigned kgo = (unsigned)((tidu >> 4) * 1024 + (tidu & 15) * 8), vgo = (unsigned)((tidu >> 3) * T + (tidu & 7) * 8);
        const int klo = (tidu >> 4) * AT_KROW + (tidu & 15) * 16, vlo = (tidu >> 3) * AT_VROW + (tidu & 7) * 16;
        const bf16_t* kbase = Kb + rowbase * 1024 + h * 128; const bf16_t* vbase = VT + (size_t)(h * 128) * T + rowbase;
        u32x4 sk[2], sv[2];
#define AT_LOADK(tt) do { _Pragma("unroll") for (int i = 0; i < 2; ++i) sk[i] = ldg<u32x4>(kbase + (size_t)(tt) * 65536 + (size_t)i * 32768 + kgo); } while (0)
#define AT_LOADV(tt) do { _Pragma("unroll") for (int i = 0; i < 2; ++i) sv[i] = ldg<u32x4>(vbase + (size_t)i * 64 * T + (size_t)(tt) * 64 + vgo); } while (0)
#define AT_WRITEK(ko) do { _Pragma("unroll") for (int i = 0; i < 2; ++i) *(LAS u32x4*)(F.lds + (ko) + klo + i * 32 * AT_KROW) = sk[i]; } while (0)
#define AT_WRITEV(vo_) do { _Pragma("unroll") for (int i = 0; i < 2; ++i) { *(LAS u32x2*)(F.lds + (vo_) + vlo + i * 64 * AT_VROW) = (u32x2){sv[i].x, sv[i].y}; *(LAS u32x2*)(F.lds + (vo_) + vlo + i * 64 * AT_VROW + 8) = (u32x2){sv[i].z, sv[i].w}; } } while (0)
#define AT_KFR(bo, kb, st) (*(const LAS bf16x8*)(F.lds + (bo) + ((kb) * 32 + lr) * AT_KROW + (((st) & 1) * 64 + ((st) >> 1) * 16 + lh * 8) * 2))
#define AT_QFR(st) (*(const LAS bf16x8*)(F.lds + qlo + (((st) & 1) * 4 + ((st) >> 1)) * 1024))
#define AT_QK(bo, kb, S1_, S2_) do { \
            _Pragma("unroll") for (int i = 0; i < 16; ++i) { S1_[i] = USEOFF ? -OFF : 0.f; S2_[i] = USEOFF ? -OFF : 0.f; } \
            bf16x8 kfr_[3], qfr_[3]; \
            kfr_[0] = AT_KFR(bo, kb, 0); qfr_[0] = AT_QFR(0); kfr_[1] = AT_KFR(bo, kb, 1); qfr_[1] = AT_QFR(1); \
            _Pragma("unroll") for (int st = 0; st < 8; ++st) { \
                if (st + 2 < 8) { kfr_[(st + 2) % 3] = AT_KFR(bo, kb, st + 2); qfr_[(st + 2) % 3] = AT_QFR(st + 2); } \
                if (st & 1) S2_ = __builtin_amdgcn_mfma_f32_32x32x16_bf16(kfr_[st % 3], qfr_[st % 3], S2_, 0, 0, 0); \
                else S1_ = __builtin_amdgcn_mfma_f32_32x32x16_bf16(kfr_[st % 3], qfr_[st % 3], S1_, 0, 0, 0); \
                __builtin_amdgcn_sched_barrier(0); } } while (0)
#define AT_FIN(S_, lp_, P_) do { \
            _Pragma("unroll") for (int s = 0; s < 2; ++s) { u32x4 w; w.x = pk_bf16(S_[8 * s], S_[8 * s + 1]); w.y = pk_bf16(S_[8 * s + 2], S_[8 * s + 3]); w.z = pk_bf16(S_[8 * s + 4], S_[8 * s + 5]); w.w = pk_bf16(S_[8 * s + 6], S_[8 * s + 7]); \
                lp_ = dot2_ones(w.x, lp_); lp_ = dot2_ones(w.y, lp_); lp_ = dot2_ones(w.z, lp_); lp_ = dot2_ones(w.w, lp_);        \
                P_[s] = __builtin_bit_cast(bf16x8, w); } } while (0)
#define AT_VFR(bo, kb, ix) ([&]() -> bf16x8 { const int vo = (bo) + (((ix) >> 1) * 32 + lr) * AT_VROW + ((kb) * 32 + 16 * ((ix) & 1) + 4 * lh) * 2; \
            const s16x4 lo = *(const LAS s16x4*)(F.lds + vo), hi = *(const LAS s16x4*)(F.lds + vo + 16); return __builtin_shufflevector(lo, hi, 0, 1, 2, 3, 4, 5, 6, 7); }())
#define AT_PV_EXP(bo, kb, Pa_, Pb_, X1_, X2_, doexp) do { \
            bf16x8 vfr_[3]; vfr_[0] = AT_VFR(bo, kb, 0); vfr_[1] = AT_VFR(bo, kb, 1); \
            _Pragma("unroll") for (int ix = 0; ix < 8; ++ix) { \
                if (ix + 2 < 8) vfr_[(ix + 2) % 3] = AT_VFR(bo, kb, ix + 2); \
                O1[ix >> 1] = __builtin_amdgcn_mfma_f32_32x32x16_bf16(vfr_[ix % 3], Pa_[ix & 1], O1[ix >> 1], 0, 0, 0); \
                O2[ix >> 1] = __builtin_amdgcn_mfma_f32_32x32x16_bf16(vfr_[ix % 3], Pb_[ix & 1], O2[ix >> 1], 0, 0, 0); \
                if (doexp) { _Pragma("unroll") for (int i = 0; i < 2; ++i) { X1_[2 * ix + i] = __builtin_amdgcn_exp2f(X1_[2 * ix + i]); X2_[2 * ix + i] = __builtin_amdgcn_exp2f(X2_[2 * ix + i]); } } \
                __builtin_amdgcn_sched_barrier(0); } } while (0)
        f32x16 Sa1, Sa2, Sb1, Sb2; bf16x8 Pa1[2], Pa2[2], Pb1[2], Pb2[2];
        AT_LOADK(0); AT_LOADV(0);
        AT_WRITEK(0); AT_WRITEV(AT_V0);
        if (nkt > 1) { AT_LOADK(1); AT_WRITEK(AT_KB); AT_LOADV(1); }
        if (nkt > 2) AT_LOADK(2);
        __syncthreads();
        AT_QK(0, 0, Sa1, Sa2);
#pragma unroll
        for (int i = 0; i < 16; ++i) { Sa1[i] = __builtin_amdgcn_exp2f(Sa1[i]); Sa2[i] = __builtin_amdgcn_exp2f(Sa2[i]); }
        AT_FIN(Sa1, l1p, Pa1); AT_FIN(Sa2, l2p, Pa2);
        int kc = 0, kn = AT_KB, kw = 2 * AT_KB;
        for (int t = 0; t < nkt; ++t) {
            const int vc = AT_V0 + (t & 1) * AT_VB, vn = AT_V0 + AT_VB - (t & 1) * AT_VB;
            const bool hn = (t + 1 < nkt);
            __syncthreads();
            if (t + 2 < nkt) AT_WRITEK(kw);
            if (hn) AT_WRITEV(vn);
            if (t + 3 < nkt) AT_LOADK(t + 3);
            if (t + 2 < nkt) AT_LOADV(t + 2);
            AT_QK(kc, 1, Sb1, Sb2);
            AT_PV_EXP(vc, 0, Pa1, Pa2, Sb1, Sb2, true);
            AT_FIN(Sb1, l1p, Pb1); AT_FIN(Sb2, l2p, Pb2);
            if (hn) AT_QK(kn, 0, Sa1, Sa2);
            AT_PV_EXP(vc, 1, Pb1, Pb2, Sa1, Sa2, hn);
            if (hn) { AT_FIN(Sa1, l1p, Pa1); AT_FIN(Sa2, l2p, Pa2); }
            { const int k_ = kc; kc = kn; kn = kw; kw = k_; }
        }
#undef AT_LOADK
#undef AT_LOADV
#undef AT_WRITEK
#undef AT_WRITEV
#undef AT_QK
#undef AT_KFR
#undef AT_QFR
#undef AT_VFR
#undef AT_FIN
#undef AT_PV_EXP
        const int lane3 = lane_id_asm(), lr3 = lane3 & 31, lh3 = lane3 >> 5;
        const size_t qrow3 = rowbase + qb * 256 + F.wave * 32 + lr3;
        float l1 = l1p, l2 = l2p;
        l1 += shx(l1, 32, lane3); l2 += shx(l2, 32, lane3);
        const float i1 = 1.0f / l1, i2 = lam_full / l2;
        float ss = 0.f;
#pragma unroll
        for (int e = 0; e < 4; ++e)
#pragma unroll
            for (int i = 0; i < 16; ++i) { const float o = O1[e][i] * i1 - O2[e][i] * i2; O1[e][i] = o; ss += o * o; }
        ss += shx(ss, 32, lane3);
        float li_ = lam_init_s; asm volatile("" : "+s"(li_));
        const float rstd = __builtin_amdgcn_rsqf(ss * (1.0f / 128.0f) + RMS_EPS) * (1.0f - li_);
        bf16_t* orow = Ob + qrow3 * 1024 + h * 128;
#pragma unroll
        for (int e = 0; e < 4; ++e)
#pragma unroll
            for (int g4 = 0; g4 < 4; ++g4) {
                const int e0 = e * 32 + 8 * g4 + 4 * lh3;
                const f32x4 gs = ldg<f32x4>(gsub + e0);
                u32x2 w; w.x = pk_bf16(O1[e][4 * g4] * rstd * gs[0], O1[e][4 * g4 + 1] * rstd * gs[1]); w.y = pk_bf16(O1[e][4 * g4 + 2] * rstd * gs[2], O1[e][4 * g4 + 3] * rstd * gs[3]);
                stg<u32x2>(orow + e0, w);
            }
    }
    __syncthreads();
}

DI void attn_phase(const Frame& F, int layer) {
    const int j = layer >> 1;
    float mq = fabsf(ldg<float>(F.a->in[9] + j * 64 + F.lane)), mk = fabsf(ldg<float>(F.a->in[10] + j * 64 + F.lane));
#pragma unroll
    for (int o = 32; o >= 1; o >>= 1) { mq = fmaxf(mq, shx(mq, o, F.lane)); mk = fmaxf(mk, shx(mk, o, F.lane)); }
    const bool useoff = uni_f(8.0f * LOG2E * mq * mk) > 40.0f;
    if (useoff) attn_body<true>(F, layer); else attn_body<false>(F, layer);
}

constexpr int SC_Q = 0, SC_QROW = 528, SC_K = 32 * SC_QROW, SC_V = SC_K + 16384, SC_BUF = SC_V + 16384, SC_S = 2 * SC_BUF, SC_SROW = 80, SC_RED = SC_S + 2 * 32 * SC_SROW, SC_Y = SC_RED + 1024, SC_YROW = 528;
DI void scan_phase(const Frame& F, int layer, int hf) {
    const int j = layer >> 1;
    const bf16_t* RQ = (const bf16_t*)(F.ws + WS_PROJ + PJ_RQ); bf16_t* RG = (bf16_t*)(F.ws + WS_PROJ + PJ_RG);
    const bf16_t* RKT = (const bf16_t*)(F.ws + WS_PROJ + PJ_RKT); const bf16_t* RVT = (const bf16_t*)(F.ws + WS_PROJ + PJ_RVT);
    float* ssqb = (float*)(F.ws + WS_MISC + MS_SSQ);
    const int tid = F.tid;
    for (int u = F.bid; u < 256; u += F.G) {
        int bl, h, dir, eh;
        if (F.G == 256) { const int base = (u >> 5) * 8 + (u & 7), var = (u >> 3) & 3; bl = base >> 2; h = base & 3; dir = var >> 1; eh = var & 1; }
        else { bl = u >> 4; h = (u >> 2) & 3; dir = (u >> 1) & 1; eh = u & 1; }
        const float l2g = __log2f(1.0f - __expf(ldg<float>(F.a->in[15] + j * 8 + dir * 4 + h)));
        const float g32 = __builtin_amdgcn_exp2f(32.0f * l2g);
        const int sgn = dir ? -1 : 1, kd_a = dir ? 0 : 31, qd_a = dir ? 32 : 1;
        const size_t rb = (size_t)bl * NTOK;
        const bf16_t* qbase = RQ + rb * 1024 + h * 256;
        const bf16_t* ktbase = RKT + ((size_t)(rb >> 5) * 1024 + h * 256) * 32;
        const bf16_t* vtbase = RVT + ((size_t)(rb >> 5) * 2048 + h * 512 + eh * 256) * 32;
        bf16_t* gbase = RG + (rb + (tid >> 4)) * 4096 + dir * 2048 + h * 512 + eh * 256 + (tid & 15) * 16;
        const int qt = tid >> 5, qc = tid & 31;
        const unsigned qgo = (unsigned)(qt * 1024 + qc * 8);
        const int ql0 = SC_Q + qt * SC_QROW + qc * 16, ql1 = ql0 + 16 * SC_QROW;
        const int kd = tid >> 2, kc = tid & 3;
        const unsigned kgo = (unsigned)(kd * 32 + kc * 8);
        const int kl = kd * 64 + (((kc ^ (kd >> 2)) & 3) << 4);
        f32x16 S[8];
#pragma unroll
        for (int d = 0; d < 8; ++d)
#pragma unroll
            for (int i = 0; i < 16; ++i) S[d][i] = 0.f;
        u32x4 sq[2], sk[2], sv[2];
        __syncthreads();
        if (tid < 64) { const int t = tid & 31; *(LAS float*)(F.lds + SC_RED + tid * 4) = __builtin_amdgcn_exp2f((float)(tid < 32 ? kd_a - sgn * t : qd_a + sgn * t) * l2g); }
        {
            const int tok0 = dir ? 224 : 0;
#pragma unroll
            for (int i = 0; i < 2; ++i) { sq[i] = ldg<u32x4>(qbase + (size_t)(tok0 + 16 * i) * 1024 + qgo); sk[i] = ldg<u32x4>(ktbase + (size_t)tok0 * 1024 + i * 4096 + kgo); sv[i] = ldg<u32x4>(vtbase + (size_t)tok0 * 2048 + i * 4096 + kgo); }
            *(LAS u32x4*)(F.lds + ql0) = sq[0]; *(LAS u32x4*)(F.lds + ql1) = sq[1];
#pragma unroll
            for (int i = 0; i < 2; ++i) { *(LAS u32x4*)(F.lds + SC_K + kl + i * 8192) = sk[i]; *(LAS u32x4*)(F.lds + SC_V + kl + i * 8192) = sv[i]; }
        }
        __syncthreads();
        for (int ci = 0; ci < 72; ++ci) {
            const int tok0 = dir ? 32 * ((ci < 8 ? 7 : 79) - ci) : 32 * ci;
            const int t2 = launder(tid); const int lane = t2 & 63, lr = lane & 31, lh = lane >> 5, w = __builtin_amdgcn_readfirstlane(t2 >> 6), op = t2 >> 4, oc = t2 & 15;
            float l2c = l2g; asm volatile("" : "+v"(l2c));
            const int cb = (ci & 1) * SC_BUF, nb = SC_BUF - cb, sb = SC_S + (ci & 1) * 32 * SC_SROW;
            if (ci + 1 < 72) {
                const int cn = ci + 1; const int tn = dir ? 32 * ((cn < 8 ? 7 : 79) - cn) : 32 * cn;
#pragma unroll
                for (int i = 0; i < 2; ++i) { sq[i] = ldg<u32x4>(qbase + (size_t)(tn + 16 * i) * 1024 + qgo); sk[i] = ldg<u32x4>(ktbase + (size_t)tn * 1024 + i * 4096 + kgo); sv[i] = ldg<u32x4>(vtbase + (size_t)tn * 2048 + i * 4096 + kgo); }
            }
            const u32x4 gt0 = ldg<u32x4>(gbase + (size_t)tok0 * 4096), gt1 = ldg<u32x4>(gbase + (size_t)tok0 * 4096 + 8);
            if (w < 4) {
                const int p0 = 16 * (w >> 1), m0 = 16 * (w & 1);
                const int l15 = lane & 15, g4 = lane >> 4, tq = l15 >> 2, tp = l15 & 3;
                f32x4 sc = {0.f, 0.f, 0.f, 0.f};
                const bool dead = sgn * (p0 - m0) < 0;
                if (!dead) {
#pragma unroll
                    for (int ks = 0; ks < 8; ++ks) {
                        const int prow = p0 + l15, qchunk = 4 * ks + g4;
                        const bf16x8 af = *(const LAS bf16x8*)(F.lds + cb + SC_Q + prow * SC_QROW + qchunk * 16);
                        const int d0 = 32 * ks + 8 * g4 + tq, cc = (m0 >> 3) + (tp >> 1);
                        const s16x4 b0 = __builtin_amdgcn_ds_read_tr16_b64_v4i16((LAS s16x4*)(F.lds + cb + SC_K + d0 * 64 + (((cc ^ (d0 >> 2)) & 3) << 4) + 8 * (tp & 1)));
                        const s16x4 b1 = __builtin_amdgcn_ds_read_tr16_b64_v4i16((LAS s16x4*)(F.lds + cb + SC_K + (d0 + 4) * 64 + (((cc ^ ((d0 + 4) >> 2)) & 3) << 4) + 8 * (tp & 1)));
                        const bf16x8 bfr = __builtin_shufflevector(b0, b1, 0, 1, 2, 3, 4, 5, 6, 7);
                        sc = __builtin_amdgcn_mfma_f32_16x16x32_bf16(af, bfr, sc, 0, 0, 0);
                    }
                }
                const int mm = m0 + l15;
#pragma unroll
                for (int r = 0; r < 4; ++r) { const int pp = p0 + 4 * g4 + r; const int df = sgn * (pp - mm);
                    const float v = df >= 0 ? sc[r] * __builtin_amdgcn_exp2f((float)df * l2c) : 0.f;
                    *(LAS bf16_t*)(F.lds + sb + pp * SC_SROW + mm * 2) = (bf16_t)(pk_bf16(v, 0.f) & 0xffffu); }
            }
            __syncthreads();
            bf16x8 vf[2], vd[2];
            {
                const int e = 32 * w + lr;
#pragma unroll
                for (int ks = 0; ks < 2; ++ks) {
                    const int cc = 2 * ks + lh;
                    vf[ks] = *(const LAS bf16x8*)(F.lds + cb + SC_V + e * 64 + (((cc ^ (e >> 2)) & 3) << 4));
                    const u32x4 raw = __builtin_bit_cast(u32x4, vf[ks]); u32x4 o;
                    const f32x4 kda = *(const LAS f32x4*)(F.lds + SC_RED + (16 * ks + 8 * lh) * 4), kdb = *(const LAS f32x4*)(F.lds + SC_RED + (16 * ks + 8 * lh + 4) * 4);
                    const float kd8[8] = {kda[0], kda[1], kda[2], kda[3], kdb[0], kdb[1], kdb[2], kdb[3]};
                    o.x = pk_bf16(bf_lo(raw.x) * kd8[0], bf_hi(raw.x) * kd8[1]); o.y = pk_bf16(bf_lo(raw.y) * kd8[2], bf_hi(raw.y) * kd8[3]);
                    o.z = pk_bf16(bf_lo(raw.z) * kd8[4], bf_hi(raw.z) * kd8[5]); o.w = pk_bf16(bf_lo(raw.w) * kd8[6], bf_hi(raw.w) * kd8[7]);
                    vd[ks] = __builtin_bit_cast(bf16x8, o);
                }
            }
            f32x16 Y;
#pragma unroll
            for (int i = 0; i < 16; ++i) Y[i] = 0.f;
#pragma unroll
            for (int dt = 0; dt < 8; ++dt)
#pragma unroll
                for (int s = 0; s < 2; ++s) {
                    u32x4 pb; pb.x = pk_bf16(S[dt][8 * s], S[dt][8 * s + 1]); pb.y = pk_bf16(S[dt][8 * s + 2], S[dt][8 * s + 3]); pb.z = pk_bf16(S[dt][8 * s + 4], S[dt][8 * s + 5]); pb.w = pk_bf16(S[dt][8 * s + 6], S[dt][8 * s + 7]);
                    const int c0 = 4 * dt + 2 * s;
                    const s16x4 a0 = *(const LAS s16x4*)(F.lds + cb + SC_Q + lr * SC_QROW + c0 * 16 + 8 * lh);
                    const s16x4 a1 = *(const LAS s16x4*)(F.lds + cb + SC_Q + lr * SC_QROW + c0 * 16 + 16 + 8 * lh);
                    const bf16x8 af = __builtin_shufflevector(a0, a1, 0, 1, 2, 3, 4, 5, 6, 7);
                    Y = __builtin_amdgcn_mfma_f32_32x32x16_bf16(af, __builtin_bit_cast(bf16x8, pb), Y, 0, 0, 0);
                }
#pragma unroll
            for (int g = 0; g < 4; ++g) { const f32x4 qd = *(const LAS f32x4*)(F.lds + SC_RED + 128 + (8 * g + 4 * lh) * 4); Y[4 * g] *= qd[0]; Y[4 * g + 1] *= qd[1]; Y[4 * g + 2] *= qd[2]; Y[4 * g + 3] *= qd[3]; }
#pragma unroll
            for (int ks = 0; ks < 2; ++ks) {
                const bf16x8 sf = *(const LAS bf16x8*)(F.lds + sb + lr * SC_SROW + (16 * ks + 8 * lh) * 2);
                Y = __builtin_amdgcn_mfma_f32_32x32x16_bf16(sf, vf[ks], Y, 0, 0, 0);
            }
#pragma unroll
            for (int dt = 0; dt < 8; ++dt) {
#pragma unroll
                for (int i = 0; i < 16; ++i) S[dt][i] *= g32;
#pragma unroll
                for (int ks = 0; ks < 2; ++ks) {
                    const int d = 32 * dt + lr, cc = 2 * ks + lh;
                    const bf16x8 kf = *(const LAS bf16x8*)(F.lds + cb + SC_K + d * 64 + (((cc ^ (d >> 2)) & 3) << 4));
                    S[dt] = __builtin_amdgcn_mfma_f32_32x32x16_bf16(kf, vd[ks], S[dt], 0, 0, 0);
                }
            }
#pragma unroll
            for (int r = 0; r < 16; ++r) *(LAS bf16_t*)(F.lds + SC_Y + ((r & 3) + 8 * (r >> 2) + 4 * lh) * SC_YROW + (w * 32 + lr) * 2) = (bf16_t)(pk_bf16(Y[r], 0.f) & 0xffffu);
            if (ci + 1 < 72) {
                *(LAS u32x4*)(F.lds + nb + ql0) = sq[0]; *(LAS u32x4*)(F.lds + nb + ql1) = sq[1];
#pragma unroll
                for (int i = 0; i < 2; ++i) { *(LAS u32x4*)(F.lds + nb + SC_K + kl + i * 8192) = sk[i]; *(LAS u32x4*)(F.lds + nb + SC_V + kl + i * 8192) = sv[i]; }
            }
            __syncthreads();
            {
                const u32x4 y0 = *(const LAS u32x4*)(F.lds + SC_Y + op * SC_YROW + oc * 32), y1 = *(const LAS u32x4*)(F.lds + SC_Y + op * SC_YROW + oc * 32 + 16);
                u32x4 z0, z1;
                z0.x = pk_bf16(bf_lo(y0.x) * bf_lo(gt0.x), bf_hi(y0.x) * bf_hi(gt0.x)); z0.y = pk_bf16(bf_lo(y0.y) * bf_lo(gt0.y), bf_hi(y0.y) * bf_hi(gt0.y));
                z0.z = pk_bf16(bf_lo(y0.z) * bf_lo(gt0.z), bf_hi(y0.z) * bf_hi(gt0.z)); z0.w = pk_bf16(bf_lo(y0.w) * bf_lo(gt0.w), bf_hi(y0.w) * bf_hi(gt0.w));
                z1.x = pk_bf16(bf_lo(y1.x) * bf_lo(gt1.x), bf_hi(y1.x) * bf_hi(gt1.x)); z1.y = pk_bf16(bf_lo(y1.y) * bf_lo(gt1.y), bf_hi(y1.y) * bf_hi(gt1.y));
                z1.z = pk_bf16(bf_lo(y1.z) * bf_lo(gt1.z), bf_hi(y1.z) * bf_hi(gt1.z)); z1.w = pk_bf16(bf_lo(y1.w) * bf_lo(gt1.w), bf_hi(y1.w) * bf_hi(gt1.w));
                stg<u32x4>(gbase + (size_t)tok0 * 4096, z0); stg<u32x4>(gbase + (size_t)tok0 * 4096 + 8, z1);
                float q = (bf_lo(y0.x) * bf_lo(y0.x) + bf_hi(y0.x) * bf_hi(y0.x)) + (bf_lo(y0.y) * bf_lo(y0.y) + bf_hi(y0.y) * bf_hi(y0.y)) + (bf_lo(y0.z) * bf_lo(y0.z) + bf_hi(y0.z) * bf_hi(y0.z)) + (bf_lo(y0.w) * bf_lo(y0.w) + bf_hi(y0.w) * bf_hi(y0.w))
                        + (bf_lo(y1.x) * bf_lo(y1.x) + bf_hi(y1.x) * bf_hi(y1.x)) + (bf_lo(y1.y) * bf_lo(y1.y) + bf_hi(y1.y) * bf_hi(y1.y)) + (bf_lo(y1.z) * bf_lo(y1.z) + bf_hi(y1.z) * bf_hi(y1.z)) + (bf_lo(y1.w) * bf_lo(y1.w) + bf_hi(y1.w) * bf_hi(y1.w));
                q += DPPF(q, 0xB1, 0xf); q += DPPF(q, 0x4E, 0xf); q += DPPF(q, 0x141, 0xf); q += DPPF(q, 0x140, 0xf);
                if (oc == 0) stg<float>(ssqb + (((size_t)eh * 2 + dir) * HROWS + rb + tok0 + op) * 4 + h, q);
            }
        }
    }
    __syncthreads();
}

DI void comb_phase(const Frame& F, int hf, bool latonly) {
    const bf16_t* PJ = (const bf16_t*)(F.ws + WS_PROJ + PJ_RG);
    const float* ssqb = (const float*)(F.ws + WS_MISC + MS_SSQ);
    bf16_t* O = (bf16_t*)(F.ws + (hf == 0 ? WS_OBUF : WS_ABUF));
    const int rpw = (36864 + F.G * 8 - 1) / (F.G * 8), rbeg = (F.bid * 8 + F.wave) * rpw;
    for (int r0 = rbeg; r0 < rbeg + rpw && r0 < 36864; r0 += 2) {
        u32x4 zf[2][4], zb[2][4]; float sf[2][4], sb[2][4]; bool on[2];
#pragma unroll
        for (int q = 0; q < 2; ++q) { const int r = r0 + q; on[q] = (r < rbeg + rpw) && (r < 36864) && !(latonly && (r % NTOK) < CTXL);
            if (on[q]) {
#pragma unroll
                for (int i = 0; i < 4; ++i) { const int c = i * 512 + F.lane * 8;
                    zf[q][i] = ldg<u32x4>(PJ + (size_t)r * 4096 + c); zb[q][i] = ldg<u32x4>(PJ + (size_t)r * 4096 + 2048 + c);
                    sf[q][i] = ldg<float>(ssqb + ((size_t)(0 * 2 + 0) * 36864 + r) * 4 + i) + ldg<float>(ssqb + ((size_t)(1 * 2 + 0) * 36864 + r) * 4 + i);
                    sb[q][i] = ldg<float>(ssqb + ((size_t)(0 * 2 + 1) * 36864 + r) * 4 + i) + ldg<float>(ssqb + ((size_t)(1 * 2 + 1) * 36864 + r) * 4 + i); } } }
#pragma unroll
        for (int q = 0; q < 2; ++q) if (on[q]) { const int r = r0 + q;
#pragma unroll
            for (int i = 0; i < 4; ++i) {
                const float rf = __builtin_amdgcn_rsqf(sf[q][i] * (1.0f / 512.0f) + RMS_EPS), rb = __builtin_amdgcn_rsqf(sb[q][i] * (1.0f / 512.0f) + RMS_EPS);
                const u32x4 a = zf[q][i], b = zb[q][i]; u32x4 w;
                w.x = pk_bf16(rf * bf_lo(a.x) + rb * bf_lo(b.x), rf * bf_hi(a.x) + rb * bf_hi(b.x));
                w.y = pk_bf16(rf * bf_lo(a.y) + rb * bf_lo(b.y), rf * bf_hi(a.y) + rb * bf_hi(b.y));
                w.z = pk_bf16(rf * bf_lo(a.z) + rb * bf_lo(b.z), rf * bf_hi(a.z) + rb * bf_hi(b.z));
                w.w = pk_bf16(rf * bf_lo(a.w) + rb * bf_lo(b.w), rf * bf_hi(a.w) + rb * bf_hi(b.w));
                stg<u32x4>(O + (size_t)r * 2048 + i * 512 + F.lane * 8, w);
            } }
    }
}

DI void final_phase(const Frame& F) {
    const bf16_t* y2 = (const bf16_t*)(F.ws + WS_PROJ + PJ_Y2);
    const int rpw = (T + F.G * 8 - 1) / (F.G * 8), rbeg = (F.bid * 8 + F.wave) * rpw;
    int mkey = -1; f32x4 g2v[4];
#pragma unroll
    for (int i = 0; i < 4; ++i) g2v[i] = (f32x4){0.f, 0.f, 0.f, 0.f};
    for (int r = rbeg; r < rbeg + rpw && r < T; ++r) {
        const int b = r / NTOK, n = r % NTOK; if (n < CTXL) continue;
        float* hp = F.out + ((size_t)b * 2048 + (n - 256)) * 1024;
        if (b != mkey) { mkey = b; const float* modp = mod_lat(F, 3, b);
#pragma unroll
            for (int i = 0; i < 4; ++i) g2v[i] = ldg<f32x4>(modp + 5120 + i * 256 + F.lane * 4); }
        const bf16_t* hrow = (const bf16_t*)(F.ws + WS_HB) + (size_t)r * 1024;
#pragma unroll
        for (int i = 0; i < 4; ++i) {
            const u32x2 hw = ldg<u32x2>(hrow + i * 256 + F.lane * 4); f32x4 x = {bf_lo(hw.x), bf_hi(hw.x), bf_lo(hw.y), bf_hi(hw.y)};
            const u32x2 a = ldg<u32x2>(y2 + (size_t)(2 * r) * 1024 + i * 256 + F.lane * 4), c = ldg<u32x2>(y2 + (size_t)(2 * r + 1) * 1024 + i * 256 + F.lane * 4);
            const f32x4 g2 = g2v[i];
            x[0] += g2[0] * (bf_lo(a.x) + bf_lo(c.x)); x[1] += g2[1] * (bf_hi(a.x) + bf_hi(c.x)); x[2] += g2[2] * (bf_lo(a.y) + bf_lo(c.y)); x[3] += g2[3] * (bf_hi(a.y) + bf_hi(c.y));
            stg<f32x4>(hp + i * 256 + F.lane * 4, x);
        }
    }
}

#ifndef STAGGER_TICKS
#define STAGGER_TICKS 0
#endif
constexpr int NPHASE = 50;
__global__ void __launch_bounds__(512, 2) fwd_kernel(Args args) {
    extern __shared__ __attribute__((aligned(16))) unsigned char lds_raw[];
    Frame F;
    F.a = &args;
    F.out = args.out; F.ws = args.ws; F.lds = (LAS unsigned char*)lds_raw;
    F.tid = threadIdx.x; F.lane = F.tid & 63; F.wave = __builtin_amdgcn_readfirstlane(F.tid >> 6); F.G = gridDim.x;
    const int lo = args.ph_lo, hi = args.ph_hi;
    const int wave_s = __builtin_amdgcn_readfirstlane((int)threadIdx.x >> 6);
    volatile LAS unsigned* bst = (volatile LAS unsigned*)(F.lds + LDS_MISC);
    if (F.tid < 4) bst[F.tid] = 0u;
    __syncthreads();
    XcdBarrier bar; bar.bar = (unsigned*)(F.ws + WS_CTL) + CW_BAR; bar.x = 0; bar.st = bst;
    if (hi - lo > 1) bar = xcd_barrier_post((unsigned*)(F.ws + WS_CTL) + CW_BAR, bst);
#ifndef PH_MASK
#define PH_MASK 0xFFFFFFFFu
#endif
#define PHASE(site, p, ...) do { if (((PH_MASK >> (site)) & 1u) && lo <= (p) && (p) < hi) { F.ws = launder_p(args.ws); F.out = (float*)launder_p((unsigned char*)args.out); { int ws_ = wave_s, bi_ = (int)blockIdx.x; asm volatile("" : "+s"(ws_), "+s"(bi_)); F.wave = ws_; F.bid = bi_; } F.lane = lane_id_asm(); F.tid = (F.wave << 6) | F.lane; __VA_ARGS__; if ((p) + 1 < hi) xcd_barrier(bar, (wave_s << 6) | lane_id_asm()); } } while (0)

    PHASE(0, 0, p0_prologue(F));
    for (int layer = 0; layer < DEPTH; ++layer) {
        const int pb = 1 + 12 * layer, j = layer >> 1; const bool isRT = layer & 1;
        PHASE(1, pb + 0, { norm_phase<false>(F, layer); if (layer > 0) convert_moe_weights(F, layer, moe_split_lo(F, layer), MOE_NT, F.bid, F.G); });
        if (!isRT) {
            PHASE(2, pb + 1, {
                ProbQKV S; S.K = 1024; S.abuf = (const char*)(F.ws + WS_ABUF); S.wqk = (const char*)(F.ws + WS_WQK) + (size_t)j * 2048 * 1024 * 2; S.wv = (const char*)(F.ws + WS_WV) + (size_t)j * 1024 * 1024 * 2;
                S.go.init(NTILE, 8); S.G = F.G; S.c = F.bid; S.stagger = STAGGER_TICKS; S.noepi = args.flags & 1;
                EpiQKV E{(bf16_t*)(F.ws + WS_PROJ + PJ_Q), (bf16_t*)(F.ws + WS_PROJ + PJ_K), (bf16_t*)(F.ws + WS_PROJ + PJ_VT), F.a->in[9] + j * 64, F.a->in[10] + j * 64,
                         (const float*)(F.ws + WS_ROPE + RP_CDA), (const float*)(F.ws + WS_ROPE + RP_SDA)};
                pg8::gemm_phase<EpiQKV, ProbQKV, true>(F.lds, S, E, F.tid, F.wave);
                if (F.G == 256 && F.bid >= 128) convert_moe_weights(F, layer, MOE_T_WO, MOE_T_WO + MOE_T_QKV, F.bid - 128, 128);
            });
            PHASE(3, pb + 2, attn_phase(F, layer));
        } else {
            for (int hf = 0; hf < 2; ++hf) {
                PHASE(4, pb + 1 + 3 * hf, {
                    ProbWIN S; S.K = 1024; S.abuf = (const char*)(F.ws + WS_ABUF) + (size_t)hf * 144 * 256 * 1024 * 2; S.win = (const char*)(F.ws + WS_WIN) + (size_t)j * 8192 * 1024 * 2;
                    S.latonly = (layer == DEPTH - 1); S.nnat = S.latonly ? 128 * 20 : 144 * 20; S.go.init(S.latonly ? 128 : 144, 20); S.G = F.G; S.c = F.bid; S.stagger = STAGGER_TICKS; S.noepi = args.flags & 1;
                    EpiWIN E{(bf16_t*)(F.ws + WS_PROJ + PJ_RQ), (bf16_t*)(F.ws + WS_PROJ + PJ_RG), (bf16_t*)(F.ws + WS_PROJ + PJ_RKT), (bf16_t*)(F.ws + WS_PROJ + PJ_RVT), hf * 144,
                             (const float*)(F.ws + WS_ROPE + RP_CRT), (const float*)(F.ws + WS_ROPE + RP_SRT), (const float*)(F.ws + WS_MISC + MS_CRTT), (const float*)(F.ws + WS_MISC + MS_SRTT)};
                    pg8::gemm_phase<EpiWIN, ProbWIN, true>(F.lds, S, E, F.tid, F.wave);
                });
                PHASE(5, pb + 2 + 3 * hf, scan_phase(F, layer, hf));
                PHASE(6, pb + 3 + 3 * hf, comb_phase(F, hf, layer == DEPTH - 1));
            }
        }
        PHASE(7, pb + 7, {
            ProbDense S; S.G = F.G; S.c = F.bid; S.stagger = STAGGER_TICKS; S.noepi = args.flags & 1; S.latonly = (layer == DEPTH - 1); S.go.init(S.latonly ? NB * 8 : NTILE, 4);
            if (!isRT) { S.K = 1024; S.A0 = (const char*)(F.ws + WS_OBUF); S.A1 = S.A0; S.pm_split = 1 << 30; S.Bt = (const char*)(F.ws + WS_WODA) + (size_t)j * 1024 * 1024 * 2; }
            else { S.K = 2048; S.A0 = (const char*)(F.ws + WS_OBUF); S.A1 = (const char*)(F.ws + WS_ABUF); S.pm_split = 144; S.Bt = (const char*)(F.ws + WS_WORT) + (size_t)j * 1024 * 2048 * 2; }
            EpiResid E{F.a->in[2], F.a->in[0], (bf16_t*)(F.ws + WS_HB), (const float*)(F.ws + WS_ADA) + (size_t)layer * 33 * 6144, layer == 0 ? 1 : 0};
            pg8::gemm_phase<EpiResid, ProbDense, true>(F.lds, S, E, F.tid, F.wave);
            if (F.G == 256 && F.bid >= 128 && layer != DEPTH - 1) convert_moe_weights(F, layer, 0, MOE_T_WO, F.bid - 128, 128);
        });
        PHASE(8, pb + 8, norm_phase<true>(F, layer));
        PHASE(9, pb + 9, sort_phase(F, layer));
        PHASE(10, pb + 10, {
            LAS int* segs = (LAS int*)(F.lds + LDS_MISC + 2048); LAS int* tile_e = (LAS int*)(F.lds + LDS_TILE_E);
            const int ntl = build_segments(F, layer, segs, tile_e);
            ProbMoE<true> S; S.K = 1024; S.A = (const char*)(F.ws + WS_ABUF); S.W = (const char*)(F.ws + WS_WGU); S.tile_e = tile_e; S.go.init(ntl, 4); S.G = F.G; S.c = F.bid; S.stagger = STAGGER_TICKS; S.noepi = args.flags & 1;
            LAS int* rowtok = (LAS int*)(F.lds + LDS_TILE_E + 4096); S.rowtok = rowtok;
            { const int* rowmap = (const int*)(F.ws + WS_MISC + MS_WSORT); Unit uu;
              int dd[11];
              _Pragma("unroll") for (int i = 0; i < 11; ++i) { dd[i] = 0; if (S.next(i, uu) && F.tid < 256) dd[i] = ldg<int>(rowmap + 2 * (uu.pm * 256 + F.tid)); }
              _Pragma("unroll") for (int i = 0; i < 11; ++i) { if (F.tid < 256) rowtok[i * 256 + F.tid] = dd[i] >= 0 ? (dd[i] >> 1) : 0; }
              __syncthreads(); }
            EpiSwiGLU E{(bf16_t*)(F.ws + WS_PROJ + PJ_ACT)};
            pg8::gemm_phase<EpiSwiGLU, ProbMoE<true>, true>(F.lds, S, E, F.tid, F.wave);
        });
        PHASE(11, pb + 11, {
            LAS int* segs = (LAS int*)(F.lds + LDS_MISC + 2048); LAS int* tile_e = (LAS int*)(F.lds + LDS_TILE_E);
            const int ntl = build_segments(F, layer, segs, tile_e);
            ProbMoE<false> S; S.K = 512; S.A = (const char*)(F.ws + WS_PROJ + PJ_ACT); S.W = (const char*)(F.ws + WS_WD); S.tile_e = tile_e; S.rowtok = tile_e; S.go.init(ntl, 4); S.G = F.G; S.c = F.bid; S.stagger = STAGGER_TICKS; S.noepi = args.flags & 1;
            EpiDown E{(bf16_t*)(F.ws + WS_PROJ + PJ_Y2), (const int*)(F.ws + WS_MISC + MS_WSORT), nullptr};
            pg8::gemm_phase<EpiDown, ProbMoE<false>, true>(F.lds, S, E, F.tid, F.wave);
        });
    }
    PHASE(12, 49, final_phase(F));
#ifdef PROBE_BARRIERS
    for (int i = 0; i < PROBE_BARRIERS; ++i) xcd_barrier(bar, (wave_s << 6) | lane_id_asm());
#endif
#undef PHASE
}

static bool phase_exists(int p) {
    if (p == 0 || p == 49) return true;
    const int layer = (p - 1) / 12, slot = (p - 1) % 12; const bool isRT = layer & 1;
    if (!isRT && slot >= 3 && slot <= 6) return false;
    return true;
}
extern "C" void kernel_launch(void* const* d_in, const int* in_sizes, int n_in, void* d_out, int out_size, void* d_ws, size_t ws_size, hipStream_t stream) {
    static int grid = 0;
    if (grid == 0) {
        if (n_in != 24 || ws_size < WS_END) { fprintf(stderr, "kernel_launch: need 24 inputs and >= %zu bytes of workspace (got %d, %zu)\n", (size_t)WS_END, n_in, ws_size); grid = -1; return; }
        int dev = 0, cus = 0, per_cu = 0;
        if (hipGetDevice(&dev) != hipSuccess || hipDeviceGetAttribute(&cus, hipDeviceAttributeMultiprocessorCount, dev) != hipSuccess) { grid = -1; return; }
        if (hipFuncSetAttribute((const void*)fwd_kernel, hipFuncAttributeMaxDynamicSharedMemorySize, LDS_BYTES) != hipSuccess) { fprintf(stderr, "kernel_launch: hipFuncSetAttribute failed\n"); grid = -1; return; }
        if (hipOccupancyMaxActiveBlocksPerMultiprocessor(&per_cu, (const void*)fwd_kernel, 512, LDS_BYTES) != hipSuccess || per_cu < 1) fprintf(stderr, "kernel_launch: occupancy query reports %d\n", per_cu);
        (void)hipGetLastError();
        grid = cus;
    }
    if (grid < 0) return;
    (void)hipMemsetAsync((char*)d_ws + WS_CTL, 0, 1 * MiB, stream);
    Args a{};
    for (int i = 0; i < 24; ++i) a.in[i] = (const float*)d_in[i];
    a.out = (float*)d_out; a.ws = (unsigned char*)d_ws;
#ifdef MULTI_LAUNCH
    for (int p = 0; p < NPHASE; ++p) { if (!phase_exists(p)) continue; a.ph_lo = p; a.ph_hi = p + 1; hipLaunchKernelGGL(fwd_kernel, dim3(grid), dim3(512), LDS_BYTES, stream, a); }
#elif defined(PROBE_DUP_LO)
    a.ph_lo = 0; a.ph_hi = PROBE_DUP_HI; hipLaunchKernelGGL(fwd_kernel, dim3(grid), dim3(512), LDS_BYTES, stream, a);
#ifdef PROBE_NOEPI
    a.flags = 1;
#endif
    for (int p = PROBE_DUP_LO; p < PROBE_DUP_HI; ++p) { if (!phase_exists(p)) continue; a.ph_lo = p; a.ph_hi = p + 1; hipLaunchKernelGGL(fwd_kernel, dim3(grid), dim3(512), LDS_BYTES, stream, a); }
    a.flags = 0;
    (void)hipMemsetAsync((char*)d_ws + WS_CTL, 0, 16384, stream);
    a.ph_lo = PROBE_DUP_HI; a.ph_hi = NPHASE; hipLaunchKernelGGL(fwd_kernel, dim3(grid), dim3(512), LDS_BYTES, stream, a);
#else
    a.ph_lo = 0; a.ph_hi = NPHASE; hipLaunchKernelGGL(fwd_kernel, dim3(grid), dim3(512), LDS_BYTES, stream, a);
#endif
}
```
